# Optimizing an MI355X kernel written in HIP

```python
import jax, jax.numpy as jnp
from jax import lax
import numpy as np

D_MODEL = 1024
BATCH = 8
SEQ = 4096
DEPTH = 4

GRID_W = 64
HEAD_DIM = 64
EPS = 1e-6
ROPE_THETA = 10000.0
Q_BLOCK = 128
NEG_INF = -1e30
NA_HEADS = 4
NA_WIN_ROWS = 8
NA_WIN_COLS = 16
GQA_Q_HEADS = 6
GQA_KV_HEADS = 2
DIL_GROUPS = ((128, 1), (512, 4), (2048, 16))
DIL_HEADS_PER_GROUP = 2
DIL_HEADS = len(DIL_GROUPS) * DIL_HEADS_PER_GROUP
QA_W = NA_HEADS * HEAD_DIM
QB_W = GQA_Q_HEADS * HEAD_DIM
QC_W = DIL_HEADS * HEAD_DIM
KA_W = NA_HEADS * HEAD_DIM
KB_W = GQA_KV_HEADS * HEAD_DIM
KC_W = DIL_HEADS * HEAD_DIM
Q_W = QA_W + QB_W + QC_W
KV_W = KA_W + KB_W + KC_W
N_BRANCHES = 3
GATE_W = N_BRANCHES * D_MODEL
IN_W = Q_W + 2 * KV_W + GATE_W
BR_A = NA_HEADS * HEAD_DIM
BR_B = GQA_Q_HEADS * HEAD_DIM
BR_C = DIL_HEADS_PER_GROUP * HEAD_DIM
BRANCH_W = BR_A + BR_B + BR_C
FFN_DIM = 2816
N_EXPERTS = 8
TOP_K = 2
EXPERT_DIM = 3584

kernel_name = 'hybrid_gated_mixer_encoder'


def rms_norm(x, g):
    xf = x.astype(jnp.float32)
    y = xf * lax.rsqrt(jnp.mean(xf * xf, axis=-1, keepdims=True) + EPS)
    return (y * g.astype(jnp.float32)).astype(x.dtype)


def rope_angles(pos, dim):
    inv_freq = ROPE_THETA ** (-jnp.arange(0, dim, 2, dtype=jnp.float32) / dim)
    return pos.astype(jnp.float32)[:, None] * inv_freq[None, :]


def apply_rope(x, ang):
    half = x.shape[-1] // 2
    cos = jnp.cos(ang).astype(x.dtype)
    sin = jnp.sin(ang).astype(x.dtype)
    x1, x2 = x[..., :half], x[..., half:]
    return jnp.concatenate([x1 * cos - x2 * sin, x2 * cos + x1 * sin], axis=-1)


def axial_rope(x, ang_row, ang_col):
    half = x.shape[-1] // 2
    return jnp.concatenate([apply_rope(x[..., :half], ang_row), apply_rope(x[..., half:], ang_col)], axis=-1)


def to_heads(t, n):
    b, s, _ = t.shape
    return t.reshape(b, s, n, HEAD_DIM).transpose(0, 2, 1, 3)


def from_heads(t):
    b, h, s, dh = t.shape
    return t.transpose(0, 2, 1, 3).reshape(b, s, h * dh)


def neighbourhood_attention(q, k, v, rpb):
    b, h, s, dh = q.shape
    rows = s // GRID_W
    kh = min(NA_WIN_ROWS, rows)
    kw = NA_WIN_COLS
    scale = HEAD_DIM ** -0.5
    qg = q.reshape(b, h, rows, GRID_W, dh).astype(jnp.float32)
    kg = k.reshape(b, h, rows, GRID_W, dh).astype(jnp.float32)
    vg = v.reshape(b, h, rows, GRID_W, dh)
    r = jnp.arange(rows)
    row_start = jnp.clip(r - kh // 2, 0, rows - kh)
    key_rows = row_start[:, None] + jnp.arange(kh)[None, :]
    c = jnp.arange(GRID_W)
    col_start = jnp.clip(c - kw // 2, 0, GRID_W - kw)
    col_mask = (c[None, :] >= col_start[:, None]) & (c[None, :] < col_start[:, None] + kw)
    k_band = kg[:, :, key_rows]
    v_band = vg[:, :, key_rows]
    sc = jnp.einsum('bhrqd,bhrkcd->bhrqkc', qg, k_band) * scale
    dr_idx = key_rows - r[:, None] + NA_WIN_ROWS - 1
    dc_idx = jnp.clip(c[None, :] - c[:, None], -(kw - 1), kw - 1) + NA_WIN_COLS - 1
    bias = rpb.astype(jnp.float32)[:, dr_idx[:, None, :, None], dc_idx[None, :, None, :]]
    sc = jnp.where(col_mask[:, None, :], sc + bias, NEG_INF)
    p = jax.nn.softmax(sc.reshape(b, h, rows, GRID_W, kh * GRID_W), axis=-1)
    p = p.reshape(b, h, rows, GRID_W, kh, GRID_W).astype(v.dtype)
    o = jnp.einsum('bhrqkc,bhrkcd->bhrqd', p, v_band)
    return o.reshape(b, h, s, dh)


def gqa_attention(q, k, v):
    b, hq, s, dh = q.shape
    hkv = k.shape[1]
    g = hq // hkv
    nb = s // Q_BLOCK
    scale = HEAD_DIM ** -0.5
    kf = k.astype(jnp.float32)
    qb = q.reshape(b, hkv, g, nb, Q_BLOCK, dh).transpose(3, 0, 1, 2, 4, 5)

    def block(qi):
        sc = jnp.einsum('bkgqd,bksd->bkgqs', qi.astype(jnp.float32), kf) * scale
        p = jax.nn.softmax(sc, axis=-1).astype(v.dtype)
        return jnp.einsum('bkgqs,bksd->bkgqd', p, v)

    o = lax.map(block, qb)
    return o.transpose(1, 2, 3, 0, 4, 5).reshape(b, hq, s, dh)


def dilated_attention(q, k, v):
    b, h, s, dh = q.shape
    hpg = DIL_HEADS_PER_GROUP
    nb = s // Q_BLOCK
    scale = HEAD_DIM ** -0.5
    k_groups = [k[:, gi * hpg:(gi + 1) * hpg].astype(jnp.float32) for gi in range(len(DIL_GROUPS))]
    v_groups = [v[:, gi * hpg:(gi + 1) * hpg] for gi in range(len(DIL_GROUPS))]
    qb = q.reshape(b, h, nb, Q_BLOCK, dh).transpose(2, 0, 1, 3, 4)

    def block(args):
        qi, bi = args
        t = bi * Q_BLOCK + jnp.arange(Q_BLOCK)
        outs, lses = [], []
        for gi, (window, dil) in enumerate(DIL_GROUPS):
            side = window // dil // 2
            pos = t[:, None] + dil * jnp.arange(-side, side + 1)[None, :]
            valid = (pos >= 0) & (pos < s)
            pos = jnp.clip(pos, 0, s - 1)
            kgat = k_groups[gi][:, :, pos]
            vgat = v_groups[gi][:, :, pos]
            qg = qi[:, gi * hpg:(gi + 1) * hpg].astype(jnp.float32)
            sc = jnp.einsum('bhqd,bhqnd->bhqn', qg, kgat) * scale
            sc = jnp.where(valid, sc, NEG_INF)
            lse = jax.nn.logsumexp(sc, axis=-1)
            p = jnp.exp(sc - lse[..., None]).astype(v.dtype)
            outs.append(jnp.einsum('bhqn,bhqnd->bhqd', p, vgat).astype(jnp.float32))
            lses.append(lse)
        w = jax.nn.softmax(jnp.stack(lses), axis=0)
        o = jnp.sum(w[..., None] * jnp.stack(outs), axis=0)
        return o.astype(v.dtype)

    o = lax.map(block, (qb, jnp.arange(nb)))
    return o.transpose(1, 2, 0, 3, 4).reshape(b, hpg, s, dh)


def swiglu(h, w_gu, w_down):
    gu = h @ w_gu
    g, u = jnp.split(gu, 2, axis=-1)
    return (jax.nn.silu(g) * u) @ w_down


def moe_swiglu(h, w_router, w_gu, w_down):
    b, s, d = h.shape
    ht = h.reshape(b * s, d)
    logits = (ht @ w_router).astype(jnp.float32)
    top_val, top_idx = lax.top_k(logits, TOP_K)
    top_w = jax.nn.softmax(top_val, axis=-1)
    gates = jnp.sum(jax.nn.one_hot(top_idx, N_EXPERTS, dtype=jnp.float32) * top_w[..., None], axis=1)
    gates = gates.astype(h.dtype)
    out = jnp.zeros_like(ht)
    for e in range(N_EXPERTS):
        out = out + gates[:, e:e + 1] * swiglu(ht, w_gu[e], w_down[e])
    return out.reshape(b, s, d)


def setup_inputs(seed: int = 0) -> dict:
    key = jax.random.key(seed)
    ks = jax.random.split(key, 12)
    n_dense = (DEPTH + 1) // 2
    n_moe = DEPTH // 2
    f32 = jnp.float32
    nrm = jax.random.normal
    x = nrm(ks[0], (BATCH, SEQ, D_MODEL), f32)
    norm_gains = 1.0 + 0.1 * nrm(ks[1], (DEPTH, 2, D_MODEL), f32)
    w_in = nrm(ks[2], (DEPTH, D_MODEL, IN_W), f32) * D_MODEL ** -0.5
    qk_gains = 1.0 + 0.1 * nrm(ks[3], (DEPTH, 3, 2, HEAD_DIM), f32)
    na_rpb = 0.1 * nrm(ks[4], (DEPTH, NA_HEADS, 2 * NA_WIN_ROWS - 1, 2 * NA_WIN_COLS - 1), f32)
    branch_scale = jnp.concatenate([
        jnp.full((BR_A,), BR_A ** -0.5, f32),
        jnp.full((BR_B,), BR_B ** -0.5, f32),
        jnp.full((BR_C,), BR_C ** -0.5, f32)])
    w_branch = nrm(ks[5], (DEPTH, BRANCH_W, D_MODEL), f32) * branch_scale[None, :, None]
    w_out = nrm(ks[6], (DEPTH, D_MODEL, D_MODEL), f32) * D_MODEL ** -0.5
    ffn_w_gu = nrm(ks[7], (n_dense, D_MODEL, 2 * FFN_DIM), f32) * D_MODEL ** -0.5
    ffn_w_down = nrm(ks[8], (n_dense, FFN_DIM, D_MODEL), f32) * FFN_DIM ** -0.5
    moe_router = nrm(ks[9], (n_moe, D_MODEL, N_EXPERTS), f32) * D_MODEL ** -0.5
    moe_w_gu = nrm(ks[10], (n_moe, N_EXPERTS, D_MODEL, 2 * EXPERT_DIM), f32) * D_MODEL ** -0.5
    moe_w_down = nrm(ks[11], (n_moe, N_EXPERTS, EXPERT_DIM, D_MODEL), f32) * EXPERT_DIM ** -0.5
    return {'x': x, 'norm_gains': norm_gains, 'w_in': w_in, 'qk_gains': qk_gains,
            'na_rpb': na_rpb, 'w_branch': w_branch, 'w_out': w_out,
            'ffn_w_gu': ffn_w_gu, 'ffn_w_down': ffn_w_down, 'moe_router': moe_router,
            'moe_w_gu': moe_w_gu, 'moe_w_down': moe_w_down}


def reference(x, norm_gains, w_in, qk_gains, na_rpb, w_branch, w_out,
              ffn_w_gu, ffn_w_down, moe_router, moe_w_gu, moe_w_down):
    b, s, d = x.shape
    pos = jnp.arange(s)
    ang_1d = rope_angles(pos, HEAD_DIM)
    ang_row = rope_angles(pos // GRID_W, HEAD_DIM // 2)
    ang_col = rope_angles(pos % GRID_W, HEAD_DIM // 2)
    for layer in range(DEPTH):
        h = rms_norm(x, norm_gains[layer, 0])
        proj = h @ w_in[layer]
        q_all = proj[..., :Q_W]
        k_all = proj[..., Q_W:Q_W + KV_W]
        v_all = proj[..., Q_W + KV_W:Q_W + 2 * KV_W]
        gate = proj[..., Q_W + 2 * KV_W:]
        qk = qk_gains[layer]
        qa = rms_norm(to_heads(q_all[..., :QA_W], NA_HEADS), qk[0, 0])
        ka = rms_norm(to_heads(k_all[..., :KA_W], NA_HEADS), qk[0, 1])
        va = to_heads(v_all[..., :KA_W], NA_HEADS)
        oa = neighbourhood_attention(qa, ka, va, na_rpb[layer])
        qb = axial_rope(rms_norm(to_heads(q_all[..., QA_W:QA_W + QB_W], GQA_Q_HEADS), qk[1, 0]), ang_row, ang_col)
        kb = axial_rope(rms_norm(to_heads(k_all[..., KA_W:KA_W + KB_W], GQA_KV_HEADS), qk[1, 1]), ang_row, ang_col)
        vb = to_heads(v_all[..., KA_W:KA_W + KB_W], GQA_KV_HEADS)
        ob = gqa_attention(qb, kb, vb)
        qc = apply_rope(rms_norm(to_heads(q_all[..., QA_W + QB_W:], DIL_HEADS), qk[2, 0]), ang_1d)
        kc = apply_rope(rms_norm(to_heads(k_all[..., KA_W + KB_W:], DIL_HEADS), qk[2, 1]), ang_1d)
        vc = to_heads(v_all[..., KA_W + KB_W:], DIL_HEADS)
        oc = dilated_attention(qc, kc, vc)
        wb = w_branch[layer]
        ya = from_heads(oa) @ wb[:BR_A]
        yb = from_heads(ob) @ wb[BR_A:BR_A + BR_B]
        yc = from_heads(oc) @ wb[BR_A + BR_B:]
        gt = jax.nn.sigmoid(gate.astype(jnp.float32)).astype(x.dtype).reshape(b, s, N_BRANCHES, d)
        merged = gt[:, :, 0] * ya + gt[:, :, 1] * yb + gt[:, :, 2] * yc
        x = x + merged @ w_out[layer]
        h2 = rms_norm(x, norm_gains[layer, 1])
        if layer % 2 == 0:
            x = x + swiglu(h2, ffn_w_gu[layer // 2], ffn_w_down[layer // 2])
        else:
            i = layer // 2
            x = x + moe_swiglu(h2, moe_router[i], moe_w_gu[i], moe_w_down[i])
    return x
```

```cpp
#include <hip/hip_runtime.h>
#include <cstdint>
#include <cstdio>

#ifndef MK_DEBUG
#define MK_DEBUG 0
#endif

#define DI __device__ __forceinline__
#define LAS __attribute__((address_space(3)))
#define GAS __attribute__((address_space(1)))

typedef unsigned short bf16_t;
typedef short bf16x8 __attribute__((ext_vector_type(8)));
typedef float f32x2 __attribute__((ext_vector_type(2)));
typedef float f32x4 __attribute__((ext_vector_type(4)));
typedef float f32x16 __attribute__((ext_vector_type(16)));
typedef unsigned u32x2 __attribute__((ext_vector_type(2)));
typedef unsigned u32x4 __attribute__((ext_vector_type(4)));
typedef __bf16 bf16x2_t __attribute__((ext_vector_type(2)));

constexpr int NB = 8, SEQ = 4096, DM = 1024, NTOK = NB * SEQ, DEPTH = 4;
constexpr int INW = 5632, FF = 2816, ED = 3584, NE = 8;
constexpr int MROWS = 2 * NTOK + NE * 256;
constexpr float EPS = 1e-6f;
constexpr float QSCALE = 0.125f * 1.4426950408889634f;
constexpr float LOG2E = 1.4426950408889634f;
constexpr int NWG = 256, NTHR = 512;

constexpr size_t MiB = 1u << 20;
constexpr size_t WS_CTL = 0, CTL_ZERO_BYTES = 1 * MiB;
constexpr size_t WS_ROPE1 = 1 * MiB;
constexpr size_t WS_ROPEA = 2 * MiB;
constexpr size_t WS_TOPI = 3 * MiB;
constexpr size_t WS_TOPW = 3 * MiB + 512 * 1024;
constexpr size_t WS_PERM = 4 * MiB;
constexpr size_t WS_RGATE = 4 * MiB + 512 * 1024;
constexpr size_t WS_CNT = 5 * MiB;
constexpr size_t WS_W_IN = 8 * MiB;
constexpr size_t WS_W_BRA = 52 * MiB;
constexpr size_t WS_W_BRB = 54 * MiB;
constexpr size_t WS_W_BRC = 57 * MiB;
constexpr size_t WS_W_OUT = 59 * MiB;
constexpr size_t WS_W_FGU = 67 * MiB;
constexpr size_t WS_W_FDN = 89 * MiB;
constexpr size_t WS_W_MGU = 100 * MiB;
constexpr size_t WS_W_MDN = 324 * MiB;
constexpr size_t WS_H = 436 * MiB;
constexpr size_t WS_XS = 500 * MiB;
constexpr size_t WS_YBUF = 632 * MiB;
constexpr size_t WS_Q = 760 * MiB;
constexpr size_t WS_K = 824 * MiB;
constexpr size_t WS_VRAW = 872 * MiB;
constexpr size_t WS_VT = 920 * MiB;
constexpr size_t WS_G = 968 * MiB;
constexpr size_t WS_OA = 1160 * MiB;
constexpr size_t WS_OB = 1176 * MiB;
constexpr size_t WS_OC = 1200 * MiB;
constexpr size_t WS_MERGED = 1216 * MiB;
constexpr size_t WS_ACT = 760 * MiB;
constexpr size_t WS_END = 1280 * MiB;
constexpr size_t WS_DBG = 1280 * MiB;
static_assert(WS_ACT + (size_t)MROWS * ED * 2 <= WS_END, "act overlay");
static_assert(WS_W_MDN + (size_t)2 * 8 * 1024 * 3584 * 2 <= WS_H, "weights");

constexpr int CW_BAR = 4096;
constexpr int CW_ERR = 32768;

constexpr int LDS_SCR = 0, LDS_SCR_BYTES = 131072;
constexpr int LDS_MISC = 131072;
constexpr int LDS_BYTES = 135168;

DI unsigned pk2(float lo, float hi) { f32x2 v = {lo, hi}; bf16x2_t b = __builtin_convertvector(v, bf16x2_t); return __builtin_bit_cast(unsigned, b); }
DI float bflo(unsigned w) { return __uint_as_float(w << 16); }
DI float bfhi(unsigned w) { return __uint_as_float(w & 0xffff0000u); }
DI float bf2f(bf16_t u) { return __uint_as_float((unsigned)u << 16); }
DI float wave_sum(float v) {
#pragma unroll
    for (int o = 1; o < 64; o <<= 1) v += __shfl_xor(v, o);
    return v;
}
DI float sigmoidf_(float x) { return 1.f / (1.f + __expf(-x)); }

namespace pg8 {
#define PG8_LAS __attribute__((address_space(3)))
constexpr int BM = 256, BK = 64, HALF = 128, HTB = HALF * BK * 2, STAGE_BYTES = 8 * HTB, NXCD = 8, WGM = 8;
__host__ __device__ __forceinline__ int lds_byte(int r, int c) { const int st = (r >> 4) * 2 + (c >> 5), rr = r & 15, cc = c & 31, ob = rr * 64 + cc * 2; return st * 1024 + (ob ^ (((ob >> 9) & 1) << 5)); }
__host__ __device__ __forceinline__ void stage_rc(int b, int& R, int& C) { const int st = b / 1024, sb = b % 1024, swz = sb ^ (((sb >> 9) & 1) << 5); R = (st >> 1) * 16 + swz / 64; C = (st & 1) * 32 + (swz % 64) / 2; }
__host__ __device__ __forceinline__ int perm32(int rho) { const int n = rho >> 4, i = rho & 15; return 8 * (i >> 2) + 4 * n + (i & 3); }

struct Unit { int pm, pn; long bo; };
struct Gemm { const bf16_t* A; const bf16_t* Bt; int K; };

struct StaticOrder {
    int nM, nN, nwg, G, c;
    __host__ __device__ void init(int M, int N, int G_, int c_) { nM = M / BM; nN = N / BM; nwg = nM * nN; G = G_; c = c_; }
    __host__ __device__ bool next(int i, Unit& u) const {
        const long L = (long)i * G + c; if (L >= nwg) return false;
        int wgid = (int)L; { const int q = nwg / NXCD, r = nwg % NXCD, xcd = wgid % NXCD, off = wgid / NXCD; wgid = (xcd < r ? xcd * (q + 1) : r * (q + 1) + (xcd - r) * q) + off; }
        const int nig = WGM * nN, gid = wgid / nig, fm = gid * WGM, gsz = (nM - fm) < WGM ? (nM - fm) : WGM;
        u.pm = fm + ((wgid % nig) % gsz); u.pn = (wgid % nig) / gsz; u.bo = 0; return true;
    }
    __device__ __forceinline__ void a_ready(const Unit&) const {}
    __device__ __forceinline__ void done(const Unit&) const {}
};
struct GroupedOrder {
    int nN, c8, loc, per; int tp[9]; long bstride;
    __device__ __forceinline__ bool next(int i, Unit& u) const {
        const int j = loc + per * i, pm = c8 + 8 * (j / nN);
        if (pm >= tp[8]) return false;
        u.pm = pm; u.pn = j % nN;
        int e = 0;
#pragma unroll
        for (int k = 1; k < 8; ++k) e += (pm >= tp[k]) ? 1 : 0;
        u.bo = (long)e * bstride; return true;
    }
    __device__ __forceinline__ void a_ready(const Unit&) const {}
    __device__ __forceinline__ void done(const Unit&) const {}
};

template <class Epi, class Sched, bool ALIGN_EPI = false, bool SP2 = false>
__device__ __forceinline__ void gemm_phase(PG8_LAS unsigned char* lds, const Gemm g, const Sched& S, const Epi& E) {
    int tid_o = threadIdx.x; asm volatile("" : "+v"(tid_o));
    const int tid = tid_o, wid = __builtin_amdgcn_readfirstlane(tid >> 6), lane = tid & 63, wr = wid >> 2, wc = wid & 3, fr = lane & 15, fq = lane >> 4;
    const int K = g.K, nt = K / BK;
    unsigned voffA[2], voffB[2];
#pragma unroll
    for (int i = 0; i < 2; ++i) { int R, C; stage_rc(tid * 16 + i * 8192, R, C); const int Rb = Epi::PERM ? ((R & ~31) + perm32(R & 31)) : R;
        voffA[i] = (unsigned)(R * K + C) * 2u; voffB[i] = (unsigned)(Rb * K + C) * 2u; }
    const size_t kstep = (size_t)(BK * 2);
    const size_t hstep = (size_t)HALF * K * 2;
    const size_t tstep = 2 * hstep;
    const unsigned ldsw = (unsigned)wid * 1024u;
    const int aoff = lds_byte(wr * 64 + fr, fq * 8), boff = lds_byte(wc * 32 + fr, fq * 8);
#define PG8_SA(b, h) (((b) * 2 + (h)) * HTB)
#define PG8_SB(b, h) ((4 + (b) * 2 + (h)) * HTB)
#define PG8_STAGE(bufoff, gbase, voff) do { _Pragma("unroll") for (int _i = 0; _i < 2; ++_i) \
        __builtin_amdgcn_global_load_lds((const unsigned*)((const char*)(gbase) + (voff)[_i]), (PG8_LAS unsigned*)(lds + (bufoff) + ldsw + _i * 8192), 16, 0, 0); } while (0)
#define PG8_LDA(dst, b, h) do { _Pragma("unroll") for (int m = 0; m < 4; ++m) _Pragma("unroll") for (int k = 0; k < 2; ++k) dst[m][k] = *(const PG8_LAS bf16x8*)(lds + PG8_SA(b, h) + aoff + m * 2048 + k * 1024); } while (0)
#define PG8_LDB(dst, b, h) do { _Pragma("unroll") for (int n = 0; n < 2; ++n) _Pragma("unroll") for (int k = 0; k < 2; ++k) dst[n][k] = *(const PG8_LAS bf16x8*)(lds + PG8_SB(b, h) + boff + n * 2048 + k * 1024); } while (0)
#define PG8_MMA(ai, bj, At, Bt) do { __builtin_amdgcn_s_setprio(1); _Pragma("unroll") for (int m = 0; m < 4; ++m) _Pragma("unroll") for (int n = 0; n < 2; ++n) _Pragma("unroll") for (int k = 0; k < 2; ++k) \
        acc[ai][bj][m][n] = __builtin_amdgcn_mfma_f32_16x16x32_bf16(Bt[n][k], At[m][k], acc[ai][bj][m][n], 0, 0, 0); __builtin_amdgcn_s_setprio(0); } while (0)
#define PG8_WAIT_V(n) asm volatile("s_waitcnt vmcnt(" #n ")" ::: "memory")
#define PG8_WAIT_L(n) asm volatile("s_waitcnt lgkmcnt(" #n ")" ::: "memory")
#define PG8_BAR __builtin_amdgcn_s_barrier()
#define PG8_SCHED __builtin_amdgcn_sched_barrier(0)
    Unit cur, nxt; int ui = 0;
    if (!S.next(0, cur)) return;
    f32x4 acc[2][2][4][2];
#pragma unroll
    for (int a = 0; a < 2; ++a)
#pragma unroll
        for (int b = 0; b < 2; ++b)
#pragma unroll
            for (int m = 0; m < 4; ++m)
#pragma unroll
                for (int n = 0; n < 2; ++n) acc[a][b][m][n] = (f32x4){0.f, 0.f, 0.f, 0.f};
    bf16x8 At[4][2], B0[2][2], B1[2][2];
    const char* cA = (const char*)g.A + (size_t)cur.pm * tstep; const char* cB = (const char*)g.Bt + cur.bo + (size_t)cur.pn * tstep;
    S.a_ready(cur);
    if constexpr (SP2) {
        PG8_STAGE(PG8_SB(0, 0), cB, voffB); PG8_STAGE(PG8_SB(0, 1), cB + hstep, voffB); PG8_STAGE(PG8_SA(0, 0), cA, voffA); PG8_STAGE(PG8_SA(0, 1), cA + hstep, voffA);
        if (wr == 1) PG8_BAR;
        PG8_WAIT_V(2); PG8_BAR;
        PG8_STAGE(PG8_SB(1, 0), cB + kstep, voffB); PG8_STAGE(PG8_SA(1, 0), cA + kstep, voffA); PG8_STAGE(PG8_SB(1, 1), cB + hstep + kstep, voffB);
        PG8_WAIT_V(6); PG8_BAR;
    } else {
        PG8_STAGE(PG8_SB(0, 0), cB, voffB); PG8_STAGE(PG8_SA(0, 0), cA, voffA); PG8_STAGE(PG8_SB(0, 1), cB + hstep, voffB); PG8_STAGE(PG8_SA(0, 1), cA + hstep, voffA);
        if (wr == 1) PG8_BAR;
        PG8_WAIT_V(4); PG8_BAR;
        PG8_STAGE(PG8_SB(1, 0), cB + kstep, voffB); PG8_STAGE(PG8_SA(1, 0), cA + kstep, voffA); PG8_STAGE(PG8_SB(1, 1), cB + hstep + kstep, voffB);
        PG8_WAIT_V(6); PG8_BAR;
    }
    for (;;) {
        const bool has_next = S.next(ui + 1, nxt);
        const char* nA = has_next ? (const char*)g.A + (size_t)nxt.pm * tstep : cA; const char* nB = has_next ? (const char*)g.Bt + nxt.bo + (size_t)nxt.pn * tstep : cB;
        for (int t = 0; t < nt; t += 2) {
            const bool last = (t == nt - 2);
            const char* a1 = cA + (size_t)(t + 1) * kstep;
            const char* a2 = last ? nA : cA + (size_t)(t + 2) * kstep; const char* b2 = last ? nB : cB + (size_t)(t + 2) * kstep;
            const char* a3 = a2 + kstep; const char* b3 = b2 + kstep;
            if (last && has_next) S.a_ready(nxt);
            if constexpr (SP2) {
            PG8_LDB(B0, 0, 0); PG8_LDB(B1, 0, 1); PG8_SCHED; PG8_LDA(At, 0, 0); PG8_STAGE(PG8_SA(1, 1), a1 + hstep, voffA);
            PG8_WAIT_V(8); PG8_WAIT_L(0); PG8_BAR; PG8_MMA(0, 0, At, B0); PG8_MMA(0, 1, At, B1); PG8_BAR; PG8_SCHED;
            PG8_LDA(At, 0, 1); PG8_STAGE(PG8_SB(0, 0), b2, voffB); PG8_STAGE(PG8_SB(0, 1), b2 + hstep, voffB); PG8_STAGE(PG8_SA(0, 0), a2, voffA);
            PG8_WAIT_V(8); PG8_WAIT_L(0); PG8_BAR; PG8_MMA(1, 0, At, B0); PG8_MMA(1, 1, At, B1); PG8_BAR; PG8_SCHED;
            PG8_LDB(B0, 1, 0); PG8_LDB(B1, 1, 1); PG8_SCHED; PG8_LDA(At, 1, 0); PG8_STAGE(PG8_SA(0, 1), a2 + hstep, voffA);
            PG8_WAIT_V(8); PG8_WAIT_L(0); PG8_BAR; PG8_MMA(0, 0, At, B0); PG8_MMA(0, 1, At, B1); PG8_BAR; PG8_SCHED;
            PG8_LDA(At, 1, 1); PG8_STAGE(PG8_SB(1, 0), b3, voffB); PG8_STAGE(PG8_SB(1, 1), b3 + hstep, voffB); PG8_STAGE(PG8_SA(1, 0), a3, voffA);
            PG8_WAIT_V(8); PG8_WAIT_L(0); PG8_BAR; PG8_MMA(1, 0, At, B0); PG8_MMA(1, 1, At, B1); PG8_BAR; PG8_SCHED;
            } else {
            PG8_LDB(B0, 0, 0); PG8_SCHED; PG8_LDA(At, 0, 0); PG8_STAGE(PG8_SA(1, 1), a1 + hstep, voffA);
            PG8_WAIT_L(8); PG8_BAR; PG8_WAIT_L(0); PG8_MMA(0, 0, At, B0); PG8_BAR; PG8_SCHED;
            PG8_LDB(B1, 0, 1); PG8_STAGE(PG8_SB(0, 0), b2, voffB);
            PG8_BAR; PG8_WAIT_L(0); PG8_MMA(0, 1, At, B1); PG8_BAR;
            PG8_LDA(At, 0, 1); PG8_STAGE(PG8_SA(0, 0), a2, voffA);
            PG8_BAR; PG8_WAIT_L(0); PG8_MMA(1, 0, At, B0); PG8_BAR; PG8_SCHED;
            PG8_STAGE(PG8_SB(0, 1), b2 + hstep, voffB);
            PG8_WAIT_V(6); PG8_BAR; PG8_MMA(1, 1, At, B1); PG8_BAR;
            PG8_LDB(B0, 1, 0); PG8_SCHED; PG8_LDA(At, 1, 0); PG8_STAGE(PG8_SA(0, 1), a2 + hstep, voffA);
            PG8_WAIT_L(8); PG8_BAR; PG8_WAIT_L(0); PG8_MMA(0, 0, At, B0); PG8_BAR; PG8_SCHED;
            PG8_LDB(B1, 1, 1); PG8_STAGE(PG8_SB(1, 0), b3, voffB);
            PG8_BAR; PG8_WAIT_L(0); PG8_MMA(0, 1, At, B1); PG8_BAR;
            PG8_LDA(At, 1, 1); PG8_STAGE(PG8_SA(1, 0), a3, voffA);
            PG8_BAR; PG8_WAIT_L(0); PG8_MMA(1, 0, At, B0); PG8_BAR; PG8_SCHED;
            PG8_STAGE(PG8_SB(1, 1), b3 + hstep, voffB);
            PG8_WAIT_V(6); PG8_BAR; PG8_MMA(1, 1, At, B1); PG8_BAR;
            }
        }
        if constexpr (ALIGN_EPI) { if (wr == 0) PG8_BAR; }
        if constexpr (!Epi::AFTER_DRAIN) { E(acc, cur, wr, wc, fr, fq); S.done(cur); }
        if (!has_next) break;
#pragma unroll
        for (int a = 0; a < 2; ++a)
#pragma unroll
            for (int b = 0; b < 2; ++b)
#pragma unroll
                for (int m = 0; m < 4; ++m)
#pragma unroll
                    for (int n = 0; n < 2; ++n) acc[a][b][m][n] = (f32x4){0.f, 0.f, 0.f, 0.f};
        cur = nxt; cA = nA; cB = nB; ++ui;
        if constexpr (ALIGN_EPI) { if (wr == 1) PG8_BAR; }
    }
    PG8_WAIT_V(0);
    if constexpr (!ALIGN_EPI) { if (wr == 0) PG8_BAR; }
    PG8_BAR;
    if constexpr (Epi::AFTER_DRAIN) { E.fused(acc, cur, wr, wc, fr, fq, lds, wid, lane); S.done(cur); }
#undef PG8_SA
#undef PG8_SB
#undef PG8_STAGE
#undef PG8_LDA
#undef PG8_LDB
#undef PG8_MMA
#undef PG8_WAIT_V
#undef PG8_WAIT_L
#undef PG8_BAR
#undef PG8_SCHED
}
}

typedef const f32x4 (&AccRef)[2][2][4][2];

struct EpiIn {
    static constexpr bool PERM = true, AFTER_DRAIN = false;
    bf16_t *Q, *Kb, *V, *G;
    DI void operator()(AccRef acc, const pg8::Unit& u, int wr, int wc, int fr, int fq) const {
        const int pn = u.pn; bf16_t* base; int ld, colt; bool sig = false;
        if (pn < 4) { base = Q; ld = 1024; colt = pn * 256; }
        else if (pn < 7) { base = Kb; ld = 768; colt = (pn - 4) * 256; }
        else if (pn < 10) { base = V; ld = 768; colt = (pn - 7) * 256; }
        else { base = G; ld = 3072; colt = (pn - 10) * 256; sig = true; }
        const int row0 = u.pm * 256 + wr * 64 + fr, col0 = colt + wc * 32 + 8 * fq;
#pragma unroll
        for (int ai = 0; ai < 2; ++ai)
#pragma unroll
            for (int m = 0; m < 4; ++m) { bf16_t* rowp = base + (size_t)(row0 + ai * 128 + m * 16) * ld + col0;
#pragma unroll
                for (int bj = 0; bj < 2; ++bj) { f32x4 v0 = acc[ai][bj][m][0], v1 = acc[ai][bj][m][1];
                    if (sig) {
#pragma unroll
                        for (int j = 0; j < 4; ++j) { v0[j] = sigmoidf_(v0[j]); v1[j] = sigmoidf_(v1[j]); } }
                    u32x4 w; w.x = pk2(v0[0], v0[1]); w.y = pk2(v0[2], v0[3]); w.z = pk2(v1[0], v1[1]); w.w = pk2(v1[2], v1[3]);
                    *(u32x4*)(rowp + bj * 128) = w; } }
    }
};

struct EpiGate {
    static constexpr bool PERM = true, AFTER_DRAIN = false;
    const bf16_t* G; int goff; bf16_t* Mg; int first;
    DI void operator()(AccRef acc, const pg8::Unit& u, int wr, int wc, int fr, int fq) const {
        const int row0 = u.pm * 256 + wr * 64 + fr, col0 = u.pn * 256 + wc * 32 + 8 * fq;
#pragma unroll
        for (int ai = 0; ai < 2; ++ai)
#pragma unroll
            for (int m = 0; m < 4; ++m) { const size_t row = (size_t)(row0 + ai * 128 + m * 16);
#pragma unroll
                for (int bj = 0; bj < 2; ++bj) { const int col = col0 + bj * 128;
                    const u32x4 g = *(const u32x4*)(G + row * 3072 + goff + col);
                    u32x4 p = {0u, 0u, 0u, 0u}; if (!first) p = *(const u32x4*)(Mg + row * 1024 + col);
                    const f32x4 v0 = acc[ai][bj][m][0], v1 = acc[ai][bj][m][1];
                    u32x4 w;
                    w.x = pk2(bflo(p.x) + bflo(g.x) * v0[0], bfhi(p.x) + bfhi(g.x) * v0[1]);
                    w.y = pk2(bflo(p.y) + bflo(g.y) * v0[2], bfhi(p.y) + bfhi(g.y) * v0[3]);
                    w.z = pk2(bflo(p.z) + bflo(g.z) * v1[0], bfhi(p.z) + bfhi(g.z) * v1[1]);
                    w.w = pk2(bflo(p.w) + bflo(g.w) * v1[2], bfhi(p.w) + bfhi(g.w) * v1[3]);
                    *(u32x4*)(Mg + row * 1024 + col) = w; } }
    }
};

struct EpiResid {
    static constexpr bool PERM = false, AFTER_DRAIN = false;
    const float* xin; float* xout;
    DI void operator()(AccRef acc, const pg8::Unit& u, int wr, int wc, int fr, int fq) const {
        const int row0 = u.pm * 256 + wr * 64 + fr, col0 = u.pn * 256 + wc * 32 + 4 * fq;
#pragma unroll
        for (int ai = 0; ai < 2; ++ai)
#pragma unroll
            for (int m = 0; m < 4; ++m) { const size_t ro = (size_t)(row0 + ai * 128 + m * 16) * 1024;
#pragma unroll
                for (int bj = 0; bj < 2; ++bj)
#pragma unroll
                    for (int n = 0; n < 2; ++n) { const size_t o = ro + col0 + bj * 128 + n * 16;
                        const f32x4 xv = *(const f32x4*)(xin + o); *(f32x4*)(xout + o) = xv + acc[ai][bj][m][n]; } }
    }
};

struct EpiSwiglu {
    static constexpr bool PERM = true, AFTER_DRAIN = false;
    bf16_t* act; int ld;
    DI void operator()(AccRef acc, const pg8::Unit& u, int wr, int wc, int fr, int fq) const {
        const int row0 = u.pm * 256 + wr * 64 + fr, col0 = u.pn * 128 + wc * 32 + 8 * fq;
#pragma unroll
        for (int ai = 0; ai < 2; ++ai)
#pragma unroll
            for (int m = 0; m < 4; ++m) { bf16_t* dst = act + (size_t)(row0 + ai * 128 + m * 16) * ld + col0;
                float o[8];
#pragma unroll
                for (int n = 0; n < 2; ++n)
#pragma unroll
                    for (int j = 0; j < 4; ++j) { const float g = acc[ai][0][m][n][j], uu = acc[ai][1][m][n][j]; o[4 * n + j] = g * sigmoidf_(g) * uu; }
                u32x4 w; w.x = pk2(o[0], o[1]); w.y = pk2(o[2], o[3]); w.z = pk2(o[4], o[5]); w.w = pk2(o[6], o[7]);
                *(u32x4*)dst = w; }
    }
};

struct EpiMoeDown {
    static constexpr bool PERM = true, AFTER_DRAIN = false;
    const int* perm; const float* rgate; bf16_t* ybuf;
    DI void operator()(AccRef acc, const pg8::Unit& u, int wr, int wc, int fr, int fq) const {
        const int row0 = u.pm * 256 + wr * 64 + fr, col0 = u.pn * 256 + wc * 32 + 8 * fq;
#pragma unroll
        for (int ai = 0; ai < 2; ++ai)
#pragma unroll
            for (int m = 0; m < 4; ++m) { const int row = row0 + ai * 128 + m * 16; const int p = perm[row];
                if (p >= 0) { const float gt = rgate[row]; bf16_t* dst = ybuf + ((size_t)(p & 1) * NTOK + (size_t)(p >> 1)) * 1024 + col0;
#pragma unroll
                    for (int bj = 0; bj < 2; ++bj) { const f32x4 v0 = acc[ai][bj][m][0] * gt, v1 = acc[ai][bj][m][1] * gt;
                        u32x4 w; w.x = pk2(v0[0], v0[1]); w.y = pk2(v0[2], v0[3]); w.z = pk2(v1[0], v1[1]); w.w = pk2(v1[2], v1[3]);
                        *(u32x4*)(dst + bj * 128) = w; } } }
    }
};

#define LDS_WAIT() asm volatile("s_waitcnt lgkmcnt(0)" ::: "memory")

DI void prep_tile(const float* src, int src_ld, bool zero, bf16_t* dst, int dst_ld, LAS bf16_t* t, int lane) {
#pragma unroll 4
    for (int i = 0; i < 16; ++i) { const int k = i * 4 + (lane >> 4), c = (lane & 15) * 4;
        f32x4 v = {0.f, 0.f, 0.f, 0.f}; if (!zero) v = *(const f32x4*)(src + (size_t)k * src_ld + c);
        u32x2 w; w.x = pk2(v[0], v[1]); w.y = pk2(v[2], v[3]); *(LAS u32x2*)(t + k * 68 + c) = w; }
    LDS_WAIT();
#pragma unroll
    for (int kc = 0; kc < 8; ++kc) { unsigned e[8];
#pragma unroll
        for (int j = 0; j < 8; ++j) e[j] = t[(8 * kc + j) * 68 + lane];
        u32x4 w; w.x = e[0] | (e[1] << 16); w.y = e[2] | (e[3] << 16); w.z = e[4] | (e[5] << 16); w.w = e[6] | (e[7] << 16);
        *(u32x4*)(dst + (size_t)lane * dst_ld + 8 * kc) = w; }
    LDS_WAIT();
}

struct Ptrs {
    const float* in[12]; float* out; unsigned char* ws;
};

DI void phase_prep(const Ptrs& P, LAS unsigned char* lds, int tid) {
    const int wave = tid >> 6, lane = tid & 63;
    LAS bf16_t* t = (LAS bf16_t*)(lds + LDS_SCR + wave * 8704);
    const int gw = blockIdx.x * 8 + wave, NGW = gridDim.x * 8;
    constexpr int T0 = 4 * 1408, T1 = T0 + 4 * 64, T2 = T1 + 4 * 96, T3 = T2 + 4 * 64, T4 = T3 + 4 * 256, T5 = T4 + 2 * 1408, T6 = T5 + 2 * 704, T7 = T6 + 16 * 1792, T8 = T7 + 16 * 896;
    for (int it = gw; it < T8; it += NGW) {
        const float* src; int src_ld; bf16_t* dst; int dst_ld; bool zero = false;
        int r = it;
        if (r < T0) { const int L = r / 1408, q = r % 1408, kt = q / 88, nt = q % 88;
            src = P.in[2] + (size_t)L * 1024 * 5632 + (size_t)kt * 64 * 5632 + nt * 64; src_ld = 5632;
            dst = (bf16_t*)(P.ws + WS_W_IN) + ((size_t)L * 5632 + nt * 64) * 1024 + kt * 64; dst_ld = 1024; }
        else if (r < T1) { r -= T0; const int L = r / 64, q = r % 64, kt = q / 16, nt = q % 16;
            src = P.in[5] + (size_t)L * 768 * 1024 + (size_t)(kt * 64) * 1024 + nt * 64; src_ld = 1024;
            dst = (bf16_t*)(P.ws + WS_W_BRA) + ((size_t)L * 1024 + nt * 64) * 256 + kt * 64; dst_ld = 256; }
        else if (r < T2) { r -= T1; const int L = r / 96, q = r % 96, kt = q / 16, nt = q % 16;
            src = P.in[5] + (size_t)L * 768 * 1024 + (size_t)(256 + kt * 64) * 1024 + nt * 64; src_ld = 1024;
            dst = (bf16_t*)(P.ws + WS_W_BRB) + ((size_t)L * 1024 + nt * 64) * 384 + kt * 64; dst_ld = 384; }
        else if (r < T3) { r -= T2; const int L = r / 64, q = r % 64, kt = q / 16, nt = q % 16;
            zero = kt >= 2;
            src = P.in[5] + (size_t)L * 768 * 1024 + (size_t)(640 + (zero ? 0 : kt) * 64) * 1024 + nt * 64; src_ld = 1024;
            dst = (bf16_t*)(P.ws + WS_W_BRC) + ((size_t)L * 1024 + nt * 64) * 256 + kt * 64; dst_ld = 256; }
        else if (r < T4) { r -= T3; const int L = r / 256, q = r % 256, kt = q / 16, nt = q % 16;
            src = P.in[6] + (size_t)L * 1024 * 1024 + (size_t)(kt * 64) * 1024 + nt * 64; src_ld = 1024;
            dst = (bf16_t*)(P.ws + WS_W_OUT) + ((size_t)L * 1024 + nt * 64) * 1024 + kt * 64; dst_ld = 1024; }
        else if (r < T5) { r -= T4; const int L = r / 1408, q = r % 1408, kt = q / 88, nt = q % 88;
            const int n0 = nt * 64, pn = n0 >> 8, j = n0 & 255, c0 = (j < 128) ? pn * 128 + j : FF + pn * 128 + (j - 128);
            src = P.in[7] + (size_t)L * 1024 * 5632 + (size_t)(kt * 64) * 5632 + c0; src_ld = 5632;
            dst = (bf16_t*)(P.ws + WS_W_FGU) + ((size_t)L * 5632 + n0) * 1024 + kt * 64; dst_ld = 1024; }
        else if (r < T6) { r -= T5; const int L = r / 704, q = r % 704, kt = q / 16, nt = q % 16;
            src = P.in[8] + (size_t)L * 2816 * 1024 + (size_t)(kt * 64) * 1024 + nt * 64; src_ld = 1024;
            dst = (bf16_t*)(P.ws + WS_W_FDN) + ((size_t)L * 1024 + nt * 64) * 2816 + kt * 64; dst_ld = 2816; }
        else if (r < T7) { r -= T6; const int L = r / 1792, q = r % 1792, kt = q / 112, nt = q % 112;
            const int n0 = nt * 64, pn = n0 >> 8, j = n0 & 255, c0 = (j < 128) ? pn * 128 + j : ED + pn * 128 + (j - 128);
            src = P.in[10] + (size_t)L * 1024 * 7168 + (size_t)(kt * 64) * 7168 + c0; src_ld = 7168;
            dst = (bf16_t*)(P.ws + WS_W_MGU) + ((size_t)L * 7168 + n0) * 1024 + kt * 64; dst_ld = 1024; }
        else { r -= T7; const int L = r / 896, q = r % 896, kt = q / 16, nt = q % 16;
            src = P.in[11] + (size_t)L * 3584 * 1024 + (size_t)(kt * 64) * 1024 + nt * 64; src_ld = 1024;
            dst = (bf16_t*)(P.ws + WS_W_MDN) + ((size_t)L * 1024 + nt * 64) * 3584 + kt * 64; dst_ld = 3584; }
        prep_tile(src, src_ld, zero, dst, dst_ld, t, lane);
    }
    const int gid = blockIdx.x * NTHR + tid;
    if (gid < 4096 * 32) { const int pos = gid >> 5, i = gid & 31; const float inv = powf(10000.f, -(float)(2 * i) / 64.f); float s, c; sincosf((float)pos * inv, &s, &c);
        ((f32x2*)(P.ws + WS_ROPE1))[gid] = (f32x2){c, s}; }
    if (gid < 64 * 16) { const int pos = gid >> 4, i = gid & 15; const float inv = powf(10000.f, -(float)(2 * i) / 32.f); float s, c; sincosf((float)pos * inv, &s, &c);
        ((f32x2*)(P.ws + WS_ROPEA))[gid] = (f32x2){c, s}; }
}

template <bool COMBINE, bool ROUTER>
DI void phase_norm(const float* xin, float* xout, const bf16_t* ybuf, const float* gain, bf16_t* H, const float* wrt, int* topi, float* topw, int* cnt, int* perm,
                   LAS unsigned char* lds, int tid) {
    const int wave = tid >> 6, lane = tid & 63, w = blockIdx.x;
    LAS float* wrl = (LAS float*)(lds + LDS_SCR);
    LAS int* cntl = (LAS int*)(lds + LDS_SCR + 32768);
    if (ROUTER) {
        for (int i = tid; i < 8192; i += NTHR) wrl[(i & 7) * 1024 + (i >> 3)] = wrt[i];
        if (tid < 8) cntl[tid] = 0;
        for (int i = tid; i < MROWS / NWG; i += NTHR) perm[w * (MROWS / NWG) + i] = -1;
        __syncthreads();
    }
    f32x4 g[4];
#pragma unroll
    for (int q = 0; q < 4; ++q) g[q] = *(const f32x4*)(gain + 256 * q + 4 * lane);
    for (int j = 0; j < 16; ++j) {
        const int row = w * 128 + wave * 16 + j; const size_t ro = (size_t)row * 1024;
        f32x4 v[4]; float ss = 0.f;
#pragma unroll
        for (int q = 0; q < 4; ++q) { v[q] = *(const f32x4*)(xin + ro + 256 * q + 4 * lane);
            if (COMBINE) { const u32x2 a = *(const u32x2*)(ybuf + ro + 256 * q + 4 * lane), b = *(const u32x2*)(ybuf + (size_t)NTOK * 1024 + ro + 256 * q + 4 * lane);
                v[q][0] += bflo(a.x) + bflo(b.x); v[q][1] += bfhi(a.x) + bfhi(b.x); v[q][2] += bflo(a.y) + bflo(b.y); v[q][3] += bfhi(a.y) + bfhi(b.y);
                *(f32x4*)(xout + ro + 256 * q + 4 * lane) = v[q]; }
            ss += (v[q][0] * v[q][0] + v[q][1] * v[q][1]) + (v[q][2] * v[q][2] + v[q][3] * v[q][3]); }
        const float rstd = 1.f / sqrtf(wave_sum(ss) * (1.f / 1024.f) + EPS);
#pragma unroll
        for (int q = 0; q < 4; ++q) { v[q] = v[q] * rstd * g[q];
            u32x2 o; o.x = pk2(v[q][0], v[q][1]); o.y = pk2(v[q][2], v[q][3]); *(u32x2*)(H + ro + 256 * q + 4 * lane) = o; }
        if (ROUTER) {
            float lg[8];
#pragma unroll
            for (int e = 0; e < 8; ++e) { float a = 0.f;
#pragma unroll
                for (int q = 0; q < 4; ++q) { const f32x4 wv = *(const LAS f32x4*)(wrl + e * 1024 + 256 * q + 4 * lane); a += (v[q][0] * wv[0] + v[q][1] * wv[1]) + (v[q][2] * wv[2] + v[q][3] * wv[3]); }
                lg[e] = wave_sum(a); }
            float v0 = -3.0e38f; int e0 = 0;
#pragma unroll
            for (int e = 0; e < 8; ++e) if (lg[e] > v0) { v0 = lg[e]; e0 = e; }
            float v1 = -3.0e38f; int e1 = 0;
#pragma unroll
            for (int e = 0; e < 8; ++e) if (e != e0 && lg[e] > v1) { v1 = lg[e]; e1 = e; }
            if (lane == 0) { const float t = __expf(v1 - v0), w0 = 1.f / (1.f + t);
                topi[row * 2] = e0; topi[row * 2 + 1] = e1; topw[row * 2] = w0; topw[row * 2 + 1] = t * w0;
                atomicAdd((int*)(cntl + e0), 1); atomicAdd((int*)(cntl + e1), 1); }
        }
    }
    if (ROUTER) { __syncthreads(); if (tid < 8) cnt[w * 8 + tid] = cntl[tid]; }
}

DI void moe_totals(const int* cnt, volatile LAS int* misc, int tid) {
    const int e = tid >> 6, lane = tid & 63, w = blockIdx.x;
    int c[4]; int s4 = 0;
#pragma unroll
    for (int i = 0; i < 4; ++i) { c[i] = cnt[(4 * lane + i) * 8 + e]; s4 += c[i]; }
    int x = s4;
#pragma unroll
    for (int o = 1; o < 64; o <<= 1) { const int y = __shfl_up(x, o); if (lane >= o) x += y; }
    const int total = __shfl(x, 63);
    int p = x - s4;
#pragma unroll
    for (int i = 0; i < 3; ++i) if (i < (w & 3)) p += c[i];
    p = __shfl(p, w >> 2);
    if (lane == 0) { misc[e] = total; misc[8 + e] = p; }
    __syncthreads();
}

DI void phase_scatter(const int* cnt, const int* topi, const float* topw, const bf16_t* H, bf16_t* XS, int* perm, float* rgate, LAS unsigned char* lds, int tid) {
    const int wave = tid >> 6, lane = tid & 63, w = blockIdx.x;
    volatile LAS int* misc = (volatile LAS int*)(lds + LDS_MISC + 64);
    LAS int* posl = (LAS int*)(lds + LDS_SCR);
    moe_totals(cnt, misc, tid);
    { const int e = wave; int base = 0;
        for (int k = 0; k < e; ++k) base += ((misc[k] + 255) >> 8) << 8;
        int running = base + misc[8 + e];
        for (int pss = 0; pss < 2; ++pss) { const int j = 64 * pss + lane, tok = w * 128 + j;
            const int a0 = topi[tok * 2], a1 = topi[tok * 2 + 1]; const bool f0 = a0 == e, f1 = a1 == e, has = f0 || f1;
            const unsigned long long mask = __ballot(has); const int rank = __popcll(mask & ((1ull << lane) - 1ull));
            if (has) { const int pos = running + rank, slot = f1 ? 1 : 0; perm[pos] = tok * 2 + slot; rgate[pos] = topw[tok * 2 + slot]; posl[j * 2 + slot] = pos; }
            running += __popcll(mask); }
    }
    __syncthreads();
    for (int i = 0; i < 32; ++i) { const int pr = wave * 32 + i, pos = posl[pr], tok = w * 128 + (pr >> 1);
        const u32x4* s = (const u32x4*)(H + (size_t)tok * 1024) + lane; u32x4* d = (u32x4*)(XS + (size_t)pos * 1024) + lane;
        const u32x4 a = s[0], b = s[64]; d[0] = a; d[64] = b; }
}

DI void phase_final(const float* x, const bf16_t* ybuf, float* out, int tid) {
    const size_t n4 = (size_t)NTOK * 1024 / 4;
    for (size_t i = (size_t)blockIdx.x * NTHR + tid; i < n4; i += (size_t)gridDim.x * NTHR) {
        f32x4 v = ((const f32x4*)x)[i]; const u32x2 a = ((const u32x2*)ybuf)[i], b = ((const u32x2*)(ybuf + (size_t)NTOK * 1024))[i];
        v[0] += bflo(a.x) + bflo(b.x); v[1] += bfhi(a.x) + bfhi(b.x); v[2] += bflo(a.y) + bflo(b.y); v[3] += bfhi(a.y) + bfhi(b.y);
        ((f32x4*)out)[i] = v; }
}

DI void qk_row(bf16_t* rowp, int nheads_b0, int nheads_b1, const float* qkg  , int which, float scale, const f32x2* rope1, const f32x2* ropea, int s, int lane) {
    const int head = lane >> 2, qd = lane & 3;
    const int br = head < nheads_b0 ? 0 : (head < nheads_b0 + nheads_b1 ? 1 : 2);
    u32x4 r0 = *(const u32x4*)(rowp + lane * 16), r1 = *(const u32x4*)(rowp + lane * 16 + 8);
    float v[16];
    v[0] = bflo(r0.x); v[1] = bfhi(r0.x); v[2] = bflo(r0.y); v[3] = bfhi(r0.y); v[4] = bflo(r0.z); v[5] = bfhi(r0.z); v[6] = bflo(r0.w); v[7] = bfhi(r0.w);
    v[8] = bflo(r1.x); v[9] = bfhi(r1.x); v[10] = bflo(r1.y); v[11] = bfhi(r1.y); v[12] = bflo(r1.z); v[13] = bfhi(r1.z); v[14] = bflo(r1.w); v[15] = bfhi(r1.w);
    float ss = 0.f;
#pragma unroll
    for (int j = 0; j < 16; ++j) ss += v[j] * v[j];
    ss += __shfl_xor(ss, 1); ss += __shfl_xor(ss, 2);
    const float rstd = 1.f / sqrtf(ss * (1.f / 64.f) + EPS);
    const float* gp = qkg + (br * 2 + which) * 64 + 16 * qd;
    float o[16];
#pragma unroll
    for (int j = 0; j < 16; ++j) v[j] = v[j] * rstd * gp[j];
    const bool first = (br == 2) ? (qd < 2) : ((qd & 1) == 0);
    const f32x2* tab = (br == 2) ? rope1 + s * 32 + 16 * (qd & 1) : ropea + ((qd >> 1) ? (s & 63) : (s >> 6)) * 16;
#pragma unroll
    for (int j = 0; j < 16; ++j) { const float p1 = __shfl_xor(v[j], 1), p2 = __shfl_xor(v[j], 2); const float pv = (br == 2) ? p2 : p1;
        const f32x2 cs = tab[j];
        const float rot = first ? v[j] * cs.x - pv * cs.y : v[j] * cs.x + pv * cs.y;
        o[j] = ((br == 0) ? v[j] : rot) * scale; }
    r0.x = pk2(o[0], o[1]); r0.y = pk2(o[2], o[3]); r0.z = pk2(o[4], o[5]); r0.w = pk2(o[6], o[7]);
    r1.x = pk2(o[8], o[9]); r1.y = pk2(o[10], o[11]); r1.z = pk2(o[12], o[13]); r1.w = pk2(o[14], o[15]);
    *(u32x4*)(rowp + lane * 16) = r0; *(u32x4*)(rowp + lane * 16 + 8) = r1;
}

DI void phase_qkvprep(const Ptrs& P, int layer, LAS unsigned char* lds, int tid) {
    const int wave = tid >> 6, lane = tid & 63, gw = blockIdx.x * 8 + wave, NGW = gridDim.x * 8;
    bf16_t* Q = (bf16_t*)(P.ws + WS_Q); bf16_t* Kb = (bf16_t*)(P.ws + WS_K); const bf16_t* V = (const bf16_t*)(P.ws + WS_VRAW); bf16_t* Vt = (bf16_t*)(P.ws + WS_VT);
    const float* qkg = P.in[3] + (size_t)layer * 3 * 2 * 64;
    const f32x2* rope1 = (const f32x2*)(P.ws + WS_ROPE1); const f32x2* ropea = (const f32x2*)(P.ws + WS_ROPEA);
    for (int tok = gw; tok < NTOK; tok += NGW) { const int s = tok & (SEQ - 1);
        qk_row(Q + (size_t)tok * 1024, 4, 6, qkg, 0, QSCALE, rope1, ropea, s, lane);
        if (lane < 48) qk_row(Kb + (size_t)tok * 768, 4, 2, qkg, 1, 1.0f, rope1, ropea, s, lane);
    }
    LAS bf16_t* t = (LAS bf16_t*)(lds + LDS_SCR + wave * 9216);
    for (int un = gw; un < 512 * 12; un += NGW) { const int tt = un / 12, hv = un % 12, tok0 = tt * 64, b = tok0 >> 12, s0 = tok0 & (SEQ - 1);
        const bf16_t* src = V + (size_t)(tok0 + lane) * 768 + hv * 64;
#pragma unroll
        for (int c = 0; c < 8; ++c) *(LAS u32x4*)(t + lane * 72 + c * 8) = *(const u32x4*)(src + c * 8);
        LDS_WAIT();
        const int g = hv < 6 ? 0 : ((hv - 6) >> 1), sh = 2 * g, dd = 1 << sh, Sd = SEQ >> sh, run = 64 >> sh;
        bf16_t* drow = Vt + ((size_t)(b * 12 + hv) * 64 + lane) * SEQ;
#pragma unroll
        for (int q = 0; q < 16; ++q) { const int o = 4 * q, rho = o / run, k0 = o % run; unsigned e[4];
#pragma unroll
            for (int j = 0; j < 4; ++j) e[j] = t[(rho + dd * (k0 + j)) * 72 + lane];
            u32x2 w; w.x = e[0] | (e[1] << 16); w.y = e[2] | (e[3] << 16);
            *(u32x2*)(drow + rho * Sd + (s0 >> sh) + k0) = w; }
        LDS_WAIT();
    }
}

#define XB_TMO      128
#define XB_XCNT(j)  (256  + 64 * (j))
#define XB_XSUB(j)  (1280 + 64 * (j))
#define XB_XGEN(j)  (2304 + 64 * (j))
#define XB_TOP      3328
#define XB_TOPGEN   3392
#define XCD_BAR_WORDS 3456
#define XB_SPIN_CAP (1u << 18)

__device__ __forceinline__ unsigned xb_ld(unsigned* p)              { return __hip_atomic_load(p, __ATOMIC_RELAXED, __HIP_MEMORY_SCOPE_AGENT); }
__device__ __forceinline__ unsigned xb_add(unsigned* p, unsigned v) { return __hip_atomic_fetch_add(p, v, __ATOMIC_RELAXED, __HIP_MEMORY_SCOPE_AGENT); }
__device__ __forceinline__ unsigned xb_xcc_id() { return (unsigned)__builtin_amdgcn_s_getreg((3 << 11) | 20) & 0xFu; }
#define XB_SPIN(cond, bar) do { unsigned _sp = 0; while (cond) { __builtin_amdgcn_s_sleep(1); \
    if ((++_sp & 255u) == 0u) { if (xb_ld(&(bar)[XB_TMO])) break; if (_sp > XB_SPIN_CAP) { atomicAdd(&(bar)[XB_TMO], 1u); break; } } } } while (0)

struct XcdBarrier {
    unsigned* bar; unsigned x;
    volatile LAS unsigned* st;
};

__device__ __forceinline__ XcdBarrier xcd_barrier_post(unsigned* bar, volatile LAS unsigned* st) {
    XcdBarrier b; b.bar = bar; b.x = xb_xcc_id(); b.st = st;
    if (threadIdx.x == 0) (void)xb_add(&bar[XB_XCNT(b.x)], 1u);
    return b;
}
__device__ __forceinline__ void xcd_barrier_complete(unsigned* bar, unsigned x, unsigned& nloc, unsigned& nx) {
    const unsigned G = gridDim.x * gridDim.y * gridDim.z;
    unsigned sum, cnt, mine, sp = 0u;
    for (;;) {
        sum = 0u; cnt = 0u; mine = 0u;
#pragma unroll
        for (unsigned j = 0; j < 16; ++j) { const unsigned c = xb_ld(&bar[XB_XCNT(j)]); sum += c; cnt += (c > 0u) ? 1u : 0u; mine = (j == x) ? c : mine; }
        if (sum == G) break;
        __builtin_amdgcn_s_sleep(1);
        if ((++sp & 255u) == 0u) { if (xb_ld(&bar[XB_TMO])) break; if (sp > XB_SPIN_CAP) { atomicAdd(&bar[XB_TMO], 1u); break; } }
    }
    nloc = mine > 0u ? mine : 1u; nx = cnt > 0u ? cnt : 1u;
}

__device__ __forceinline__ void xcd_barrier(const XcdBarrier& b) {
    asm volatile("s_waitcnt vmcnt(0)" ::: "memory");
    __syncthreads();
    if (threadIdx.x == 0) {
        unsigned* bar = b.bar;
        __builtin_amdgcn_s_waitcnt(0);
        unsigned nloc = b.st[0], nx = b.st[1];
        if (nloc == 0u) { xcd_barrier_complete(bar, b.x, nloc, nx); b.st[0] = nloc; b.st[1] = nx; }
        const unsigned old = xb_add(&bar[XB_XSUB(b.x)], 1u);
        const unsigned gen = old / nloc;
        if (old + 1u == (gen + 1u) * nloc) {
            __builtin_amdgcn_fence(__ATOMIC_RELEASE, "agent");
            asm volatile("s_waitcnt vmcnt(0)" ::: "memory");
            const unsigned og = xb_add(&bar[XB_TOP], 1u);
            const unsigned tg = og / nx;
            if (og + 1u == (tg + 1u) * nx) xb_add(&bar[XB_TOPGEN], 1u);
            else XB_SPIN(xb_ld(&bar[XB_TOPGEN]) == tg, bar);
            __builtin_amdgcn_fence(__ATOMIC_ACQUIRE, "agent");
            xb_add(&bar[XB_XGEN(b.x)], 1u);
            asm volatile("s_waitcnt vmcnt(0)" ::: "memory");
        } else {
            XB_SPIN(xb_ld(&bar[XB_XGEN(b.x)]) == gen, bar);
            __builtin_amdgcn_fence(__ATOMIC_ACQUIRE, "agent");
            asm volatile("s_waitcnt vmcnt(0)" ::: "memory");
        }
    }
    __syncthreads();
}

DI f32x16 mfma32(bf16x8 a, bf16x8 b, f32x16 c) { return __builtin_amdgcn_mfma_f32_32x32x16_bf16(a, b, c, 0, 0, 0); }
DI int pi32(int r) { return (r & 19) | ((r & 4) << 1) | ((r & 8) >> 1); }
DI int keyidx(int i, int hi) { return 16 * (i >> 3) + 8 * hi + (i & 7); }
DI bf16x8 pack8(const f32x16& x, int s) { u32x4 p; p.x = pk2(x[8 * s], x[8 * s + 1]); p.y = pk2(x[8 * s + 2], x[8 * s + 3]); p.z = pk2(x[8 * s + 4], x[8 * s + 5]); p.w = pk2(x[8 * s + 6], x[8 * s + 7]); return __builtin_bit_cast(bf16x8, p); }
DI f32x16 zero16() { f32x16 z;
#pragma unroll
    for (int i = 0; i < 16; ++i) z[i] = 0.f; return z; }

template <bool MASKED>
DI void softmax_step(f32x16& s0, f32x16& s1, float& m, float& l, f32x16& o0, f32x16& o1) {
    float mx = fmaxf(s0[0], s1[0]);
#pragma unroll
    for (int i = 1; i < 16; ++i) mx = fmaxf(mx, fmaxf(s0[i], s1[i]));
    mx = fmaxf(mx, __shfl_xor(mx, 32));
    const float mn = fmaxf(m, mx), alpha = __builtin_amdgcn_exp2f(m - mn);
    float sum = 0.f;
#pragma unroll
    for (int i = 0; i < 16; ++i) {
        float p0 = __builtin_amdgcn_exp2f(s0[i] - mn), p1 = __builtin_amdgcn_exp2f(s1[i] - mn);
        if (MASKED) { p0 = (s0[i] > -1e29f) ? p0 : 0.f; p1 = (s1[i] > -1e29f) ? p1 : 0.f; }
        s0[i] = p0; s1[i] = p1; sum += p0 + p1; }
    l = l * alpha + sum; m = mn;
#pragma unroll
    for (int i = 0; i < 16; ++i) { o0[i] *= alpha; o1[i] *= alpha; }
}
DI void store_o(bf16_t* op  , const f32x16& o0, const f32x16& o1, float l) {
    const float inv = 1.f / (l + __shfl_xor(l, 32));
#pragma unroll
    for (int g = 0; g < 4; ++g) { u32x2 a, b;
        a.x = pk2(o0[4 * g] * inv, o0[4 * g + 1] * inv); a.y = pk2(o0[4 * g + 2] * inv, o0[4 * g + 3] * inv);
        b.x = pk2(o1[4 * g] * inv, o1[4 * g + 1] * inv); b.y = pk2(o1[4 * g + 2] * inv, o1[4 * g + 3] * inv);
        *(u32x2*)(op + 8 * g) = a; *(u32x2*)(op + 32 + 8 * g) = b; }
}

DI void gqa_unit(LAS unsigned char* lds, const bf16_t* Q, const bf16_t* Kb, const bf16_t* Vt, bf16_t* OB, int b, int hq, int qb, int tid) {
    const int wave = tid >> 6, lane = tid & 63, r = lane & 31, hi = lane >> 5, kvh = hq / 3;
    const int qtok = b * SEQ + qb * 256 + wave * 32 + r;
    bf16x8 qf[4];
    { const bf16_t* qp = Q + (size_t)qtok * 1024 + (4 + hq) * 64 + 8 * hi;
#pragma unroll
      for (int c = 0; c < 4; ++c) qf[c] = *(const bf16x8*)(qp + 16 * c); }
    const int srow = tid >> 3, sch = tid & 7;
    const bf16_t* kg = Kb + (size_t)(b * SEQ + srow) * 768 + (4 + kvh) * 64 + sch * 8;
    const bf16_t* vg = Vt + ((size_t)(b * 12 + 4 + kvh) * 64 + srow) * SEQ + sch * 8;
    LAS unsigned char* Ks = lds; LAS unsigned char* Vs = lds + 18432;
    const int soff = srow * 144 + sch * 16;
    u32x4 kr = *(const u32x4*)kg, vr = *(const u32x4*)vg;
    *(LAS u32x4*)(Ks + soff) = kr; *(LAS u32x4*)(Vs + soff) = vr;
    __syncthreads();
    float m = -1e30f, l = 0.f; f32x16 o0 = zero16(), o1 = zero16();
    const int koff = pi32(r) * 144 + hi * 16, voff = r * 144 + hi * 16;
    for (int kt = 0; kt < 64; ++kt) {
        const int cur = kt & 1;
        if (kt + 1 < 64) { kr = *(const u32x4*)(kg + (size_t)(kt + 1) * 64 * 768); vr = *(const u32x4*)(vg + (kt + 1) * 64); }
        const LAS unsigned char* Kc = Ks + cur * 9216; const LAS unsigned char* Vc = Vs + cur * 9216;
        f32x16 s0 = zero16(), s1 = zero16();
#pragma unroll
        for (int c = 0; c < 4; ++c) { const bf16x8 k0 = *(const LAS bf16x8*)(Kc + koff + c * 32), k1 = *(const LAS bf16x8*)(Kc + 32 * 144 + koff + c * 32);
            s0 = mfma32(k0, qf[c], s0); s1 = mfma32(k1, qf[c], s1); }
        softmax_step<false>(s0, s1, m, l, o0, o1);
#pragma unroll
        for (int s4 = 0; s4 < 4; ++s4) { const bf16x8 pf = pack8(s4 < 2 ? s0 : s1, s4 & 1);
            const bf16x8 v0 = *(const LAS bf16x8*)(Vc + voff + s4 * 32), v1 = *(const LAS bf16x8*)(Vc + 32 * 144 + voff + s4 * 32);
            o0 = mfma32(v0, pf, o0); o1 = mfma32(v1, pf, o1); }
        if (kt + 1 < 64) { *(LAS u32x4*)(Ks + (cur ^ 1) * 9216 + soff) = kr; *(LAS u32x4*)(Vs + (cur ^ 1) * 9216 + soff) = vr; }
        __syncthreads();
    }
    store_o(OB + (size_t)qtok * 384 + hq * 64 + 4 * hi, o0, o1, l);
}

DI void na_unit(const LAS float* biasl, const bf16_t* Q, const bf16_t* Kb, const bf16_t* Vt, bf16_t* OA, int b, int gr, int wave, int lane) {
    const int h = wave >> 1, qh = wave & 1, r = lane & 31, hi = lane >> 5, pr = pi32(r);
    const int cq = 32 * qh + r, qtok = b * SEQ + gr * 64 + cq;
    bf16x8 qf[4];
    { const bf16_t* qp = Q + (size_t)qtok * 1024 + h * 64 + 8 * hi;
#pragma unroll
      for (int c = 0; c < 4; ++c) qf[c] = *(const bf16x8*)(qp + 16 * c); }
    const int rs = min(max(gr - 4, 0), 56), cs = min(max(cq - 8, 0), 48);
    float m = -1e30f, l = 0.f; f32x16 o0 = zero16(), o1 = zero16();
    for (int j = 0; j < 8; ++j) { const int kr = rs + j;
        const bf16_t* kp = Kb + (size_t)(b * SEQ + kr * 64 + pr) * 768 + h * 64 + 8 * hi;
        f32x16 s0 = zero16(), s1 = zero16();
#pragma unroll
        for (int c = 0; c < 4; ++c) { const bf16x8 k0 = *(const bf16x8*)(kp + 16 * c), k1 = *(const bf16x8*)(kp + 32 * 768 + 16 * c);
            s0 = mfma32(k0, qf[c], s0); s1 = mfma32(k1, qf[c], s1); }
        const LAS float* brow = biasl + (h * 15 + (kr - gr + 7)) * 31 + 15 - cq;
#pragma unroll
        for (int i = 0; i < 16; ++i) { const int c0 = keyidx(i, hi), c1 = c0 + 32;
            const bool v0 = (c0 >= cs) && (c0 < cs + 16), v1 = (c1 >= cs) && (c1 < cs + 16);
            const float b0 = brow[v0 ? c0 : cq], b1 = brow[v1 ? c1 : cq];
            s0[i] = v0 ? s0[i] + b0 : -1e30f; s1[i] = v1 ? s1[i] + b1 : -1e30f; }
        softmax_step<true>(s0, s1, m, l, o0, o1);
        const bf16_t* vp = Vt + ((size_t)(b * 12 + h) * 64 + r) * SEQ + kr * 64 + 8 * hi;
#pragma unroll
        for (int s4 = 0; s4 < 4; ++s4) { const bf16x8 pf = pack8(s4 < 2 ? s0 : s1, s4 & 1);
            const bf16x8 v0 = *(const bf16x8*)(vp + 16 * s4), v1 = *(const bf16x8*)(vp + (size_t)32 * SEQ + 16 * s4);
            o0 = mfma32(v0, pf, o0); o1 = mfma32(v1, pf, o1); }
    }
    store_o(OA + (size_t)qtok * 256 + h * 64 + 4 * hi, o0, o1, l);
}

DI void dil_unit(const bf16_t* Q, const bf16_t* Kb, const bf16_t* Vt, bf16_t* OC, int b, int hs, int r16, int ib, int lane) {
    const int r = lane & 31, hi = lane >> 5, pr = pi32(r);
    const int iq16 = 32 * ib + r, qtok = b * SEQ + r16 + 16 * iq16;
    float m = -1e30f, l = 0.f; f32x16 o0 = zero16(), o1 = zero16();
    for (int g = 0; g < 3; ++g) {
        const int sh = 2 * g, dd = 1 << sh, Sd = SEQ >> sh, step = 16 >> sh, hk = 6 + 2 * g + hs;
        bf16x8 qf[4];
        { const bf16_t* qp = Q + (size_t)qtok * 1024 + (10 + 2 * g + hs) * 64 + 8 * hi;
#pragma unroll
          for (int c = 0; c < 4; ++c) qf[c] = *(const bf16x8*)(qp + 16 * c); }
        const int rd = r16 & (dd - 1), qd = r16 >> sh, iq = qd + step * iq16;
        const int lo = qd + step * 32 * ib - 64, hiend = qd + step * (32 * ib + 31) + 64;
        const bf16_t* kbase = Kb + (size_t)(b * SEQ + rd) * 768 + hk * 64 + 8 * hi;
        const bf16_t* vbase = Vt + ((size_t)(b * 12 + hk) * 64 + r) * SEQ + rd * Sd;
        for (int ks = (lo >> 5) << 5; ks <= hiend; ks += 64) {
            const int ik0 = min(max(ks + pr, 0), Sd - 1), ik1 = min(max(ks + 32 + pr, 0), Sd - 1);
            const bf16_t* kp0 = kbase + (size_t)(ik0 << sh) * 768; const bf16_t* kp1 = kbase + (size_t)(ik1 << sh) * 768;
            f32x16 s0 = zero16(), s1 = zero16();
#pragma unroll
            for (int c = 0; c < 4; ++c) { const bf16x8 k0 = *(const bf16x8*)(kp0 + 16 * c), k1 = *(const bf16x8*)(kp1 + 16 * c);
                s0 = mfma32(k0, qf[c], s0); s1 = mfma32(k1, qf[c], s1); }
#pragma unroll
            for (int i = 0; i < 16; ++i) { const int a0 = ks + keyidx(i, hi), a1 = a0 + 32;
                const bool v0 = (a0 >= 0) && (a0 < Sd) && (abs(a0 - iq) <= 64), v1 = (a1 >= 0) && (a1 < Sd) && (abs(a1 - iq) <= 64);
                s0[i] = v0 ? s0[i] : -1e30f; s1[i] = v1 ? s1[i] : -1e30f; }
            softmax_step<true>(s0, s1, m, l, o0, o1);
#pragma unroll
            for (int s4 = 0; s4 < 4; ++s4) { const bf16x8 pf = pack8(s4 < 2 ? s0 : s1, s4 & 1);
                const int g8 = min(max(ks + 16 * s4 + 8 * hi, 0), Sd - 8);
                const bf16x8 v0 = *(const bf16x8*)(vbase + g8), v1 = *(const bf16x8*)(vbase + (size_t)32 * SEQ + g8);
                o0 = mfma32(v0, pf, o0); o1 = mfma32(v1, pf, o1); }
        }
    }
    bf16_t* orow = OC + (size_t)qtok * 256;
    store_o(orow + hs * 64 + 4 * hi, o0, o1, l);
    const u32x4 z = {0u, 0u, 0u, 0u};
#pragma unroll
    for (int c = 0; c < 4; ++c) *(u32x4*)(orow + 128 + hs * 64 + hi * 32 + c * 8) = z;
}

DI void phase_attn(const Ptrs& P, int layer, LAS unsigned char* lds, int tid) {
    const int wave = tid >> 6, lane = tid & 63, c = blockIdx.x;
    const bf16_t* Q = (const bf16_t*)(P.ws + WS_Q); const bf16_t* Kb = (const bf16_t*)(P.ws + WS_K); const bf16_t* Vt = (const bf16_t*)(P.ws + WS_VT);
    bf16_t* OA = (bf16_t*)(P.ws + WS_OA); bf16_t* OB = (bf16_t*)(P.ws + WS_OB); bf16_t* OC = (bf16_t*)(P.ws + WS_OC);
    LAS float* biasl = (LAS float*)(lds + LDS_SCR + 40960);
    { const float* rpb = P.in[4] + (size_t)layer * 4 * 15 * 31;
      for (int i = tid; i < 4 * 15 * 31; i += NTHR) biasl[i] = rpb[i] * LOG2E; }
    __syncthreads();
    for (int u = 0; u < 2; ++u) { const int un = 2 * c + u; na_unit(biasl, Q, Kb, Vt, OA, un >> 6, un & 63, wave, lane); }
    { const int w = c * 8 + wave; dil_unit(Q, Kb, Vt, OC, w >> 8, (w >> 7) & 1, (w >> 3) & 15, w & 7, lane); }
    { const int xcd = c & 7, loc = c >> 3;
      for (int i = 0; i < 3; ++i) { const int j = loc + 32 * i, pair = 2 * xcd + j / 48, jj = j % 48;
          gqa_unit(lds + LDS_SCR, Q, Kb, Vt, OB, pair >> 1, (pair & 1) * 3 + jj / 16, jj & 15, tid); } }
}

struct Args { const float* in[12]; float* out; unsigned char* ws; int lo, hi; };

__global__ void __launch_bounds__(NTHR, 2) mk_fwd(Args a) {
    extern __shared__ __attribute__((aligned(16))) unsigned char lds_raw[];
    LAS unsigned char* lds = (LAS unsigned char*)lds_raw;
    const int tid0 = threadIdx.x;
#define OTID() ({ int t_ = threadIdx.x; asm volatile("" : "+v"(t_)); t_; })
    for (int i = tid0; i < 256; i += NTHR) ((LAS unsigned*)(lds + LDS_MISC))[i] = 0u;
    __syncthreads();
    Ptrs P;
#pragma unroll
    for (int i = 0; i < 12; ++i) P.in[i] = a.in[i];
    P.out = a.out; P.ws = a.ws;
    unsigned char* ws = a.ws;
    const bool multi = (a.hi - a.lo) > 1;
    XcdBarrier bar; bar.bar = (unsigned*)ws + CW_BAR; bar.x = 0; bar.st = (volatile LAS unsigned*)(lds + LDS_MISC);
    if (multi) bar = xcd_barrier_post((unsigned*)ws + CW_BAR, (volatile LAS unsigned*)(lds + LDS_MISC));
#ifndef PHM
#define PHM 0xFFFFFFFFu
#endif
#define RUN(s) (a.lo <= (s) && (s) < a.hi)
#define PM(k) ((PHM >> (k)) & 1u)
#define SEAM() do { if (multi) xcd_barrier(bar); } while (0)
    bf16_t* H = (bf16_t*)(ws + WS_H); bf16_t* YB = (bf16_t*)(ws + WS_YBUF); bf16_t* ACT = (bf16_t*)(ws + WS_ACT); bf16_t* XS = (bf16_t*)(ws + WS_XS);
    int* topi = (int*)(ws + WS_TOPI); float* topw = (float*)(ws + WS_TOPW); int* perm = (int*)(ws + WS_PERM); float* rgate = (float*)(ws + WS_RGATE); int* cnt = (int*)(ws + WS_CNT);
    const int G = gridDim.x, c = blockIdx.x;

    if (PM(0) && RUN(0)) { phase_prep(P, lds, OTID()); SEAM(); }

    for (int L = 0; L < DEPTH; ++L) {
        const int base = 1 + 10 * L;
        const bool moe = (L & 1) != 0;
        const float* xcur = (L == 0) ? P.in[0] : (const float*)P.out;
        const float* gains = P.in[1] + (size_t)L * 2 * 1024;
        if (PM(1) && RUN(base + 0)) {
            if (L == 2) phase_norm<true, false>(P.out, P.out, YB, gains, H, nullptr, nullptr, nullptr, nullptr, nullptr, lds, OTID());
            else phase_norm<false, false>(xcur, nullptr, nullptr, gains, H, nullptr, nullptr, nullptr, nullptr, nullptr, lds, OTID());
            SEAM(); }
        if (PM(2) && RUN(base + 1)) {
            pg8::Gemm g{H, (const bf16_t*)(ws + WS_W_IN) + (size_t)L * INW * 1024, 1024}; pg8::StaticOrder S; S.init(NTOK, INW, G, c);
            EpiIn E{(bf16_t*)(ws + WS_Q), (bf16_t*)(ws + WS_K), (bf16_t*)(ws + WS_VRAW), (bf16_t*)(ws + WS_G)};
            pg8::gemm_phase<EpiIn, pg8::StaticOrder, true, true>(lds + LDS_SCR, g, S, E);
            SEAM(); }
        if (PM(3) && RUN(base + 2)) { phase_qkvprep(P, L, lds, OTID()); SEAM(); }
        if (PM(4) && RUN(base + 3)) { phase_attn(P, L, lds, OTID()); SEAM(); }
        if (PM(5) && RUN(base + 4)) {
            for (int br = 0; br < 3; ++br) {
                const bf16_t* A = (const bf16_t*)(ws + (br == 0 ? WS_OA : (br == 1 ? WS_OB : WS_OC)));
                const int K = br == 1 ? 384 : 256;
                const bf16_t* Bt = (const bf16_t*)(ws + (br == 0 ? WS_W_BRA : (br == 1 ? WS_W_BRB : WS_W_BRC))) + (size_t)L * 1024 * K;
                pg8::Gemm g{A, Bt, K}; pg8::StaticOrder S; S.init(NTOK, 1024, G, c);
                EpiGate E{(const bf16_t*)(ws + WS_G), br * 1024, (bf16_t*)(ws + WS_MERGED), br == 0 ? 1 : 0};
                pg8::gemm_phase<EpiGate, pg8::StaticOrder, true, true>(lds + LDS_SCR, g, S, E);
            }
            SEAM(); }
        if (PM(6) && RUN(base + 5)) {
            pg8::Gemm g{(const bf16_t*)(ws + WS_MERGED), (const bf16_t*)(ws + WS_W_OUT) + (size_t)L * 1024 * 1024, 1024}; pg8::StaticOrder S; S.init(NTOK, 1024, G, c);
            EpiResid E{xcur, P.out};
            pg8::gemm_phase<EpiResid, pg8::StaticOrder, true, true>(lds + LDS_SCR, g, S, E);
            SEAM(); }
        if (!moe) {
            if (PM(7) && RUN(base + 6)) { phase_norm<false, false>(P.out, nullptr, nullptr, gains + 1024, H, nullptr, nullptr, nullptr, nullptr, nullptr, lds, OTID()); SEAM(); }
            if (PM(8) && RUN(base + 7)) {
                pg8::Gemm g{H, (const bf16_t*)(ws + WS_W_FGU) + (size_t)(L >> 1) * 2 * FF * 1024, 1024}; pg8::StaticOrder S; S.init(NTOK, 2 * FF, G, c);
                EpiSwiglu E{ACT, FF};
                pg8::gemm_phase<EpiSwiglu, pg8::StaticOrder, true, true>(lds + LDS_SCR, g, S, E);
                SEAM(); }
            if (PM(9) && RUN(base + 8)) {
                pg8::Gemm g{ACT, (const bf16_t*)(ws + WS_W_FDN) + (size_t)(L >> 1) * 1024 * FF, FF}; pg8::StaticOrder S; S.init(NTOK, 1024, G, c);
                EpiResid E{P.out, P.out};
                pg8::gemm_phase<EpiResid, pg8::StaticOrder, true, true>(lds + LDS_SCR, g, S, E);
                SEAM(); }
        } else {
            const int li = L >> 1;
            if (PM(10) && RUN(base + 6)) { phase_norm<false, true>(P.out, nullptr, nullptr, gains + 1024, H, P.in[9] + (size_t)li * 1024 * 8, topi, topw, cnt, perm, lds, OTID()); SEAM(); }
            if (PM(11) && RUN(base + 7)) { phase_scatter(cnt, topi, topw, H, XS, perm, rgate, lds, OTID()); SEAM(); }
            if ((PM(12) || PM(13)) && (RUN(base + 8) || RUN(base + 9))) {
                volatile LAS int* misc = (volatile LAS int*)(lds + LDS_MISC + 64);
                moe_totals(cnt, misc, OTID());
                pg8::GroupedOrder S; S.c8 = c & 7; S.loc = c >> 3; S.per = G >> 3;
                S.tp[0] = 0;
#pragma unroll
                for (int e = 0; e < 8; ++e) S.tp[e + 1] = S.tp[e] + ((misc[e] + 255) >> 8);
                if (PM(12) && RUN(base + 8)) {
                    S.nN = 2 * ED / 256; S.bstride = (long)2 * ED * 1024 * 2;
                    pg8::Gemm g{XS, (const bf16_t*)(ws + WS_W_MGU) + (size_t)li * 8 * 2 * ED * 1024, 1024};
                    EpiSwiglu E{ACT, ED};
                    pg8::gemm_phase<EpiSwiglu, pg8::GroupedOrder, true, true>(lds + LDS_SCR, g, S, E);
                    SEAM(); }
                if (PM(13) && RUN(base + 9)) {
                    S.nN = 4; S.bstride = (long)1024 * ED * 2;
                    pg8::Gemm g{ACT, (const bf16_t*)(ws + WS_W_MDN) + (size_t)li * 8 * 1024 * ED, ED};
                    EpiMoeDown E{perm, rgate, YB};
                    pg8::gemm_phase<EpiMoeDown, pg8::GroupedOrder, true, true>(lds + LDS_SCR, g, S, E);
                    SEAM(); }
            }
        }
    }
    if (PM(14) && RUN(41)) phase_final(P.out, YB, P.out, OTID());
#undef RUN
#undef SEAM
}

#if MK_DEBUG
DI unsigned hsh(unsigned x) { x ^= x >> 16; x *= 0x7feb352du; x ^= x >> 15; x *= 0x846ca68bu; x ^= x >> 16; return x; }
DI void rep(unsigned* ctl, int slot, float got, float ref, float scale) { float e = fabsf(got - ref) / (fabsf(ref) + scale); if (!(e == e) || e > 1e30f) e = 1e30f; atomicMax(ctl + CW_ERR + slot, __float_as_uint(e)); }
DI float dotbf(const bf16_t* a, const bf16_t* b, int K, int lane) { float s = 0.f; for (int k = lane; k < K; k += 64) s += bf2f(a[k]) * bf2f(b[k]); return wave_sum(s); }
DI float rbf(float x) { return bflo(pk2(x, 0.f) & 0xffffu); }

__global__ void chk_prep(Args a) {
    unsigned* ctl = (unsigned*)a.ws; const unsigned h0 = hsh(blockIdx.x * 64 + threadIdx.x + 1);
    unsigned h = h0;
#define NXT() (h = hsh(h + 0x9e3779b9u))
    { const int L = NXT() % 4, n = NXT() % 5632, k = NXT() % 1024; rep(ctl, 0, bf2f(((const bf16_t*)(a.ws + WS_W_IN))[((size_t)L * 5632 + n) * 1024 + k]), rbf(a.in[2][((size_t)L * 1024 + k) * 5632 + n]), 1e-3f); }
    { const int L = NXT() % 4, n = NXT() % 1024, k = NXT() % 256; rep(ctl, 0, bf2f(((const bf16_t*)(a.ws + WS_W_BRA))[((size_t)L * 1024 + n) * 256 + k]), rbf(a.in[5][((size_t)L * 768 + k) * 1024 + n]), 1e-3f); }
    { const int L = NXT() % 4, n = NXT() % 1024, k = NXT() % 384; rep(ctl, 0, bf2f(((const bf16_t*)(a.ws + WS_W_BRB))[((size_t)L * 1024 + n) * 384 + k]), rbf(a.in[5][((size_t)L * 768 + 256 + k) * 1024 + n]), 1e-3f); }
    { const int L = NXT() % 4, n = NXT() % 1024, k = NXT() % 256; rep(ctl, 0, bf2f(((const bf16_t*)(a.ws + WS_W_BRC))[((size_t)L * 1024 + n) * 256 + k]), k < 128 ? rbf(a.in[5][((size_t)L * 768 + 640 + k) * 1024 + n]) : 0.f, 1e-3f); }
    { const int L = NXT() % 4, n = NXT() % 1024, k = NXT() % 1024; rep(ctl, 0, bf2f(((const bf16_t*)(a.ws + WS_W_OUT))[((size_t)L * 1024 + n) * 1024 + k]), rbf(a.in[6][((size_t)L * 1024 + k) * 1024 + n]), 1e-3f); }
    { const int L = NXT() % 2, n = NXT() % 5632, k = NXT() % 1024, pn = n >> 8, j = n & 255, cc = j < 128 ? pn * 128 + j : FF + pn * 128 + j - 128;
      rep(ctl, 0, bf2f(((const bf16_t*)(a.ws + WS_W_FGU))[((size_t)L * 5632 + n) * 1024 + k]), rbf(a.in[7][((size_t)L * 1024 + k) * 5632 + cc]), 1e-3f); }
    { const int L = NXT() % 2, n = NXT() % 1024, k = NXT() % 2816; rep(ctl, 0, bf2f(((const bf16_t*)(a.ws + WS_W_FDN))[((size_t)L * 1024 + n) * 2816 + k]), rbf(a.in[8][((size_t)L * 2816 + k) * 1024 + n]), 1e-3f); }
    { const int L = NXT() % 16, n = NXT() % 7168, k = NXT() % 1024, pn = n >> 8, j = n & 255, cc = j < 128 ? pn * 128 + j : ED + pn * 128 + j - 128;
      rep(ctl, 0, bf2f(((const bf16_t*)(a.ws + WS_W_MGU))[((size_t)L * 7168 + n) * 1024 + k]), rbf(a.in[10][((size_t)L * 1024 + k) * 7168 + cc]), 1e-3f); }
    { const int L = NXT() % 16, n = NXT() % 1024, k = NXT() % 3584; rep(ctl, 0, bf2f(((const bf16_t*)(a.ws + WS_W_MDN))[((size_t)L * 1024 + n) * 3584 + k]), rbf(a.in[11][((size_t)L * 3584 + k) * 1024 + n]), 1e-3f); }
#undef NXT
}
__global__ void chk_norm(Args a, const float* xin, const float* gain, int comb, int slot) {
    unsigned* ctl = (unsigned*)a.ws; const int lane = threadIdx.x; const int row = blockIdx.x == 0 ? 0 : (blockIdx.x == 1 ? NTOK - 1 : hsh(blockIdx.x * 7 + slot) % NTOK);
    const bf16_t* H = (const bf16_t*)(a.ws + WS_H); const bf16_t* yb = (const bf16_t*)(a.ws + WS_YBUF);
    float v[16], ss = 0.f;
    for (int j = 0; j < 16; ++j) { const int cidx = lane + 64 * j; float x = xin[(size_t)row * 1024 + cidx];
        if (comb) { x += bf2f(yb[(size_t)row * 1024 + cidx]) + bf2f(yb[((size_t)NTOK + row) * 1024 + cidx]); rep(ctl, slot, a.out[(size_t)row * 1024 + cidx], x, 1e-2f); }
        v[j] = x; ss += x * x; }
    const float rstd = 1.f / sqrtf(wave_sum(ss) / 1024.f + EPS);
    for (int j = 0; j < 16; ++j) { const int cidx = lane + 64 * j; rep(ctl, slot, bf2f(H[(size_t)row * 1024 + cidx]), v[j] * rstd * gain[cidx], 2e-2f); }
}
__global__ void chk_gemm_in(Args a, int L) {
    unsigned* ctl = (unsigned*)a.ws; const int lane = threadIdx.x; unsigned h = hsh(blockIdx.x + 77 * L + 5);
    const int row = blockIdx.x < 4 ? (blockIdx.x & 1 ? NTOK - 1 : 0) : h % NTOK; h = hsh(h + 1); const int col = blockIdx.x < 2 ? 0 : (blockIdx.x < 4 ? INW - 1 : h % INW);
    const float d = dotbf((const bf16_t*)(a.ws + WS_H) + (size_t)row * 1024, (const bf16_t*)(a.ws + WS_W_IN) + ((size_t)L * INW + col) * 1024, 1024, lane);
    float got;
    if (col < 1024) got = bf2f(((const bf16_t*)(a.ws + WS_Q))[(size_t)row * 1024 + col]);
    else if (col < 1792) got = bf2f(((const bf16_t*)(a.ws + WS_K))[(size_t)row * 768 + col - 1024]);
    else if (col < 2560) got = bf2f(((const bf16_t*)(a.ws + WS_VRAW))[(size_t)row * 768 + col - 1792]);
    else got = bf2f(((const bf16_t*)(a.ws + WS_G))[(size_t)row * 3072 + col - 2560]);
    const float ref = col < 2560 ? d : 1.f / (1.f + expf(-d));
    if (lane == 0) rep(ctl, 2, got, ref, 5e-2f);
}
__global__ void chk_qk(Args a, int L) {
    unsigned* ctl = (unsigned*)a.ws; const int j = threadIdx.x; unsigned h = hsh(blockIdx.x + 131 * L + 9);
    const int tok = blockIdx.x == 0 ? 0 : (blockIdx.x == 1 ? NTOK - 1 : h % NTOK); h = hsh(h + 1); const int isk = h & 1; h = hsh(h + 1); const int head = h % (isk ? 12 : 16);
    const int col = (isk ? 1024 : 0) + head * 64 + j;
    const bf16_t* hr = (const bf16_t*)(a.ws + WS_H) + (size_t)tok * 1024; const bf16_t* wr = (const bf16_t*)(a.ws + WS_W_IN) + ((size_t)L * INW + col) * 1024;
    float d = 0.f; for (int k = 0; k < 1024; ++k) d += bf2f(hr[k]) * bf2f(wr[k]);
    d = rbf(d);
    const float rstd = 1.f / sqrtf(wave_sum(d * d) / 64.f + EPS);
    const int br = isk ? (head < 4 ? 0 : (head < 6 ? 1 : 2)) : (head < 4 ? 0 : (head < 10 ? 1 : 2));
    const float y = d * rstd * a.in[3][((size_t)(L * 3 + br) * 2 + isk) * 64 + j];
    const int s = tok & 4095; float o = y;
    if (br == 2) { const int i = j & 31; const float ang = (float)s * powf(10000.f, -(float)(2 * i) / 64.f); const float p = __shfl_xor(y, 32); o = j < 32 ? y * cosf(ang) - p * sinf(ang) : y * cosf(ang) + p * sinf(ang); }
    if (br == 1) { const int i = j & 15; const float pos = (float)((j < 32) ? (s >> 6) : (s & 63)); const float ang = pos * powf(10000.f, -(float)(2 * i) / 32.f); const float p = __shfl_xor(y, 16);
        o = (j & 16) == 0 ? y * cosf(ang) - p * sinf(ang) : y * cosf(ang) + p * sinf(ang); }
    if (!isk) o *= QSCALE;
    const float got = isk ? bf2f(((const bf16_t*)(a.ws + WS_K))[(size_t)tok * 768 + head * 64 + j]) : bf2f(((const bf16_t*)(a.ws + WS_Q))[(size_t)tok * 1024 + head * 64 + j]);
    rep(ctl, 3, got, o, 3e-2f);
}
__global__ void chk_vt(Args a) {
    unsigned* ctl = (unsigned*)a.ws; unsigned h = hsh(blockIdx.x * 64 + threadIdx.x + 3);
    const int b = h % 8; h = hsh(h + 1); const int hv = h % 12; h = hsh(h + 1); const int d = h % 64; h = hsh(h + 1); const int s = h % 4096;
    const int g = hv < 6 ? 0 : (hv - 6) >> 1, dd = 1 << (2 * g), Sd = 4096 / dd, pos = (s % dd) * Sd + s / dd;
    rep(ctl, 4, bf2f(((const bf16_t*)(a.ws + WS_VT))[((size_t)(b * 12 + hv) * 64 + d) * 4096 + pos]), bf2f(((const bf16_t*)(a.ws + WS_VRAW))[(size_t)(b * 4096 + s) * 768 + hv * 64 + d]), 1e-3f);
}
DI float dot64(const bf16_t* x, const bf16_t* y) { float s = 0.f; for (int k = 0; k < 64; ++k) s += bf2f(x[k]) * bf2f(y[k]); return s; }
__global__ void chk_na(Args a, int L) {
    __shared__ float p[128]; unsigned* ctl = (unsigned*)a.ws; const int t = threadIdx.x; unsigned h = hsh(blockIdx.x + 31 * L + 11);
    const int tok = blockIdx.x == 0 ? 0 : (blockIdx.x == 1 ? NTOK - 1 : h % NTOK); h = hsh(h + 1); const int hd = h % 4;
    const int b = tok >> 12, s = tok & 4095, gr = s >> 6, cq = s & 63, rs = min(max(gr - 4, 0), 56), cs = min(max(cq - 8, 0), 48);
    const bf16_t* Q = (const bf16_t*)(a.ws + WS_Q); const bf16_t* Kb = (const bf16_t*)(a.ws + WS_K); const bf16_t* V = (const bf16_t*)(a.ws + WS_VRAW);
    float mx = -1e30f;
    for (int q = 0; q < 2; ++q) { const int idx = t + 64 * q, kr = rs + idx / 16, ck = cs + idx % 16, kt = b * 4096 + kr * 64 + ck;
        const float sc = dot64(Q + (size_t)tok * 1024 + hd * 64, Kb + (size_t)kt * 768 + hd * 64) + LOG2E * a.in[4][(((size_t)L * 4 + hd) * 15 + (kr - gr + 7)) * 31 + (ck - cq + 15)];
        p[idx] = sc; mx = fmaxf(mx, sc); }
    for (int o = 1; o < 64; o <<= 1) mx = fmaxf(mx, __shfl_xor(mx, o));
    __syncthreads();
    float sum = 0.f, acc = 0.f;
    for (int idx = 0; idx < 128; ++idx) { const int kr = rs + idx / 16, ck = cs + idx % 16, kt = b * 4096 + kr * 64 + ck; const float e = exp2f(p[idx] - mx); sum += e; acc += e * bf2f(V[(size_t)kt * 768 + hd * 64 + t]); }
    rep(ctl, 5, bf2f(((const bf16_t*)(a.ws + WS_OA))[(size_t)tok * 256 + hd * 64 + t]), acc / sum, 3e-2f);
}
__global__ void chk_dil(Args a, int L) {
    __shared__ float p[3][192]; unsigned* ctl = (unsigned*)a.ws; const int t = threadIdx.x; unsigned h = hsh(blockIdx.x + 37 * L + 13);
    const int tok = blockIdx.x == 0 ? 0 : (blockIdx.x == 1 ? NTOK - 1 : (blockIdx.x == 2 ? 4095 : (blockIdx.x == 3 ? 4096 + 70 : h % NTOK))); h = hsh(h + 1); const int hs = h & 1;
    const int b = tok >> 12, s = tok & 4095;
    const bf16_t* Q = (const bf16_t*)(a.ws + WS_Q); const bf16_t* Kb = (const bf16_t*)(a.ws + WS_K); const bf16_t* V = (const bf16_t*)(a.ws + WS_VRAW);
    float lse[3], og[3];
    for (int g = 0; g < 3; ++g) { const int dd = 1 << (2 * g), hq = 10 + 2 * g + hs, hk = 6 + 2 * g + hs; float mx = -1e30f;
        for (int q = 0; q < 3; ++q) { const int idx = t + 64 * q; if (idx < 129) { const int pos = s + dd * (idx - 64); float sc = -1e30f;
            if (pos >= 0 && pos < 4096) sc = dot64(Q + (size_t)tok * 1024 + hq * 64, Kb + (size_t)(b * 4096 + pos) * 768 + hk * 64);
            p[g][idx] = sc; mx = fmaxf(mx, sc); } }
        for (int o = 1; o < 64; o <<= 1) mx = fmaxf(mx, __shfl_xor(mx, o));
        __syncthreads();
        float sum = 0.f, acc = 0.f;
        for (int idx = 0; idx < 129; ++idx) { const int pos = s + dd * (idx - 64); if (pos >= 0 && pos < 4096) { const float e = exp2f(p[g][idx] - mx); sum += e; acc += e * bf2f(V[(size_t)(b * 4096 + pos) * 768 + hk * 64 + t]); } }
        lse[g] = mx + log2f(sum); og[g] = acc / sum; }
    const float M = fmaxf(lse[0], fmaxf(lse[1], lse[2])); const float w0 = exp2f(lse[0] - M), w1 = exp2f(lse[1] - M), w2 = exp2f(lse[2] - M);
    rep(ctl, 6, bf2f(((const bf16_t*)(a.ws + WS_OC))[(size_t)tok * 256 + hs * 64 + t]), (w0 * og[0] + w1 * og[1] + w2 * og[2]) / (w0 + w1 + w2), 3e-2f);
    rep(ctl, 6, bf2f(((const bf16_t*)(a.ws + WS_OC))[(size_t)tok * 256 + 128 + hs * 64 + t]), 0.f, 1e-3f);
}
__global__ void chk_gqa(Args a, int L) {
    __shared__ float p[4096]; unsigned* ctl = (unsigned*)a.ws; const int t = threadIdx.x; unsigned h = hsh(blockIdx.x + 41 * L + 17);
    const int tok = blockIdx.x == 0 ? 0 : (blockIdx.x == 1 ? NTOK - 1 : h % NTOK); h = hsh(h + 1); const int hq = h % 6, kvh = hq / 3, b = tok >> 12;
    const bf16_t* Q = (const bf16_t*)(a.ws + WS_Q); const bf16_t* Kb = (const bf16_t*)(a.ws + WS_K); const bf16_t* V = (const bf16_t*)(a.ws + WS_VRAW);
    float mx = -1e30f;
    for (int k = t; k < 4096; k += 64) { const float sc = dot64(Q + (size_t)tok * 1024 + (4 + hq) * 64, Kb + (size_t)(b * 4096 + k) * 768 + (4 + kvh) * 64); p[k] = sc; mx = fmaxf(mx, sc); }
    for (int o = 1; o < 64; o <<= 1) mx = fmaxf(mx, __shfl_xor(mx, o));
    __syncthreads();
    float sum = 0.f, acc = 0.f;
    for (int k = 0; k < 4096; ++k) { const float e = exp2f(p[k] - mx); sum += e; acc += e * bf2f(V[(size_t)(b * 4096 + k) * 768 + (4 + kvh) * 64 + t]); }
    rep(ctl, 7, bf2f(((const bf16_t*)(a.ws + WS_OB))[(size_t)tok * 384 + hq * 64 + t]), acc / sum, 3e-2f);
}
__global__ void chk_gate(Args a, int L) {
    unsigned* ctl = (unsigned*)a.ws; const int lane = threadIdx.x; unsigned h = hsh(blockIdx.x + 43 * L + 19);
    const int row = blockIdx.x < 2 ? (blockIdx.x ? NTOK - 1 : 0) : h % NTOK; h = hsh(h + 1); const int col = blockIdx.x < 2 ? (blockIdx.x ? 1023 : 0) : h % 1024;
    const float ya = dotbf((const bf16_t*)(a.ws + WS_OA) + (size_t)row * 256, (const bf16_t*)(a.ws + WS_W_BRA) + ((size_t)L * 1024 + col) * 256, 256, lane);
    const float yb = dotbf((const bf16_t*)(a.ws + WS_OB) + (size_t)row * 384, (const bf16_t*)(a.ws + WS_W_BRB) + ((size_t)L * 1024 + col) * 384, 384, lane);
    const float yc = dotbf((const bf16_t*)(a.ws + WS_OC) + (size_t)row * 256, (const bf16_t*)(a.ws + WS_W_BRC) + ((size_t)L * 1024 + col) * 256, 256, lane);
    const bf16_t* G = (const bf16_t*)(a.ws + WS_G) + (size_t)row * 3072;
    const float ref = bf2f(G[col]) * ya + bf2f(G[1024 + col]) * yb + bf2f(G[2048 + col]) * yc;
    if (lane == 0) rep(ctl, 8, bf2f(((const bf16_t*)(a.ws + WS_MERGED))[(size_t)row * 1024 + col]), ref, 5e-2f);
}
__global__ void chk_resid(Args a, const float* xold, const bf16_t* A, const bf16_t* Bt, int K, int slot) {
    unsigned* ctl = (unsigned*)a.ws; const int lane = threadIdx.x; unsigned h = hsh(blockIdx.x + 47 * slot + 23);
    const int row = blockIdx.x < 2 ? (blockIdx.x ? NTOK - 1 : 0) : h % NTOK; h = hsh(h + 1); const int col = blockIdx.x < 2 ? (blockIdx.x ? 1023 : 0) : h % 1024;
    const float d = dotbf(A + (size_t)row * K, Bt + (size_t)col * K, K, lane);
    if (lane == 0) rep(ctl, slot, a.out[(size_t)row * 1024 + col], xold[(size_t)row * 1024 + col] + d, 5e-2f);
}
__global__ void chk_router(Args a, const float* gain, const float* wr) {
    unsigned* ctl = (unsigned*)a.ws; const int lane = threadIdx.x; const int row = blockIdx.x == 0 ? 0 : (blockIdx.x == 1 ? NTOK - 1 : hsh(blockIdx.x + 29) % NTOK);
    float v[16], ss = 0.f;
    for (int j = 0; j < 16; ++j) { v[j] = a.out[(size_t)row * 1024 + lane + 64 * j]; ss += v[j] * v[j]; }
    const float rstd = 1.f / sqrtf(wave_sum(ss) / 1024.f + EPS);
    float lg[8];
    for (int e = 0; e < 8; ++e) { float s = 0.f; for (int j = 0; j < 16; ++j) { const int k = lane + 64 * j; s += v[j] * rstd * gain[k] * wr[k * 8 + e]; } lg[e] = wave_sum(s); }
    int e0 = 0; for (int e = 1; e < 8; ++e) if (lg[e] > lg[e0]) e0 = e;
    int e1 = e0 == 0 ? 1 : 0; for (int e = 0; e < 8; ++e) if (e != e0 && lg[e] > lg[e1]) e1 = e;
    float third = -1e30f; for (int e = 0; e < 8; ++e) if (e != e0 && e != e1) third = fmaxf(third, lg[e]);
    const int* topi = (const int*)(a.ws + WS_TOPI); const float* topw = (const float*)(a.ws + WS_TOPW);
    if (lane == 0) { const bool clear = (lg[e0] - lg[e1] > 1e-3f) && (lg[e1] - third > 1e-3f);
        if (clear) { rep(ctl, 13, (float)topi[row * 2], (float)e0, 1e-3f); rep(ctl, 13, (float)topi[row * 2 + 1], (float)e1, 1e-3f);
            const float t = expf(lg[e1] - lg[e0]); rep(ctl, 13, topw[row * 2], 1.f / (1.f + t), 1e-2f); rep(ctl, 13, topw[row * 2 + 1], t / (1.f + t), 1e-2f); } }
}
__global__ void chk_up(Args a, const bf16_t* A, const bf16_t* Wt, int ffd, int slot) {
    unsigned* ctl = (unsigned*)a.ws; const int lane = threadIdx.x; unsigned h = hsh(blockIdx.x + 53 * slot + 3);
    const int row = blockIdx.x < 2 ? (blockIdx.x ? NTOK - 1 : 0) : h % NTOK; h = hsh(h + 1); const int j = blockIdx.x < 2 ? (blockIdx.x ? ffd - 1 : 0) : h % ffd;
    const int pn = j >> 7, jj = j & 127;
    const float g = dotbf(A + (size_t)row * 1024, Wt + (size_t)(256 * pn + jj) * 1024, 1024, lane), u = dotbf(A + (size_t)row * 1024, Wt + (size_t)(256 * pn + 128 + jj) * 1024, 1024, lane);
    if (lane == 0) rep(ctl, slot, bf2f(((const bf16_t*)(a.ws + WS_ACT))[(size_t)row * ffd + j]), g / (1.f + expf(-g)) * u, 3e-2f);
}
__global__ void chk_scatter(Args a) {
    unsigned* ctl = (unsigned*)a.ws; const int lane = threadIdx.x; const int* cnt = (const int*)(a.ws + WS_CNT); const int* perm = (const int*)(a.ws + WS_PERM);
    const int* topi = (const int*)(a.ws + WS_TOPI); const float* topw = (const float*)(a.ws + WS_TOPW); const float* rg = (const float*)(a.ws + WS_RGATE);
    int tot[8], base[9]; base[0] = 0;
    for (int e = 0; e < 8; ++e) { int s = 0; for (int w = lane; w < 256; w += 64) s += cnt[w * 8 + e]; for (int o = 1; o < 64; o <<= 1) s += __shfl_xor(s, o); tot[e] = s; base[e + 1] = base[e] + ((s + 255) >> 8 << 8); }
    if (blockIdx.x == 0) { int sum = 0; for (int e = 0; e < 8; ++e) sum += tot[e]; if (lane == 0) rep(ctl, 14, (float)sum, 65536.f, 1e-3f);
        unsigned long long cs = 0; int nv = 0; for (int i = lane; i < MROWS; i += 64) { const int p = perm[i]; if (p >= 0) { cs += (unsigned long long)p; ++nv; } }
        for (int o = 1; o < 64; o <<= 1) { cs += __shfl_xor(cs, o); nv += __shfl_xor(nv, o); }
        if (lane == 0) { rep(ctl, 14, (float)nv, 65536.f, 1e-3f); rep(ctl, 14, (float)(cs == 65536ull * 65535ull / 2ull), 1.f, 1e-3f); } }
    const int pos = hsh(blockIdx.x + 5) % MROWS; const int p = perm[pos];
    int e = 0; for (int k = 1; k < 8; ++k) e += pos >= base[k];
    const bool inr = pos < base[e] + tot[e];
    if (lane == 0) rep(ctl, 14, (float)(p >= 0), (float)inr, 1e-3f);
    if (p >= 0 && inr) { const int tok = p >> 1, slot = p & 1;
        if (lane == 0) { rep(ctl, 14, (float)topi[tok * 2 + slot], (float)e, 1e-3f); rep(ctl, 14, rg[pos], topw[tok * 2 + slot], 1e-3f); }
        for (int j = 0; j < 16; ++j) rep(ctl, 14, bf2f(((const bf16_t*)(a.ws + WS_XS))[(size_t)pos * 1024 + lane + 64 * j]), bf2f(((const bf16_t*)(a.ws + WS_H))[(size_t)tok * 1024 + lane + 64 * j]), 1e-3f); }
}
__global__ void chk_moe(Args a, int li, int down) {
    unsigned* ctl = (unsigned*)a.ws; const int lane = threadIdx.x; const int* perm = (const int*)(a.ws + WS_PERM); const int* topi = (const int*)(a.ws + WS_TOPI); const float* rg = (const float*)(a.ws + WS_RGATE);
    unsigned h = hsh(blockIdx.x + 59 * down + 7); int pos = h % MROWS; while (perm[pos] < 0) pos = (pos + 1) % MROWS;
    const int p = perm[pos], tok = p >> 1, slot = p & 1, e = topi[tok * 2 + slot]; h = hsh(h + 1);
    if (!down) { const int j = h % ED, pn = j >> 7, jj = j & 127; const bf16_t* Wt = (const bf16_t*)(a.ws + WS_W_MGU) + (size_t)(li * 8 + e) * 2 * ED * 1024; const bf16_t* A = (const bf16_t*)(a.ws + WS_XS) + (size_t)pos * 1024;
        const float g = dotbf(A, Wt + (size_t)(256 * pn + jj) * 1024, 1024, lane), u = dotbf(A, Wt + (size_t)(256 * pn + 128 + jj) * 1024, 1024, lane);
        if (lane == 0) rep(ctl, 15, bf2f(((const bf16_t*)(a.ws + WS_ACT))[(size_t)pos * ED + j]), g / (1.f + expf(-g)) * u, 3e-2f); }
    else { const int col = h % 1024; const float d = dotbf((const bf16_t*)(a.ws + WS_ACT) + (size_t)pos * ED, (const bf16_t*)(a.ws + WS_W_MDN) + ((size_t)(li * 8 + e) * 1024 + col) * ED, ED, lane);
        if (lane == 0) rep(ctl, 16, bf2f(((const bf16_t*)(a.ws + WS_YBUF))[((size_t)slot * NTOK + tok) * 1024 + col]), rg[pos] * d, 3e-2f); }
}
__global__ void chk_final(Args a, const float* xold) {
    unsigned* ctl = (unsigned*)a.ws; const size_t i = hsh(blockIdx.x * 64 + threadIdx.x + 9) % ((size_t)NTOK * 1024); const bf16_t* yb = (const bf16_t*)(a.ws + WS_YBUF);
    rep(ctl, 18, a.out[i], xold[i] + bf2f(yb[i]) + bf2f(yb[(size_t)NTOK * 1024 + i]), 1e-2f);
}
__global__ void chk_report(Args a) {
    const unsigned* ctl = (const unsigned*)a.ws; int code = -1;
    for (int s = 18; s >= 0; --s) { const float e = __uint_as_float(ctl[CW_ERR + s]); const float tol = (s == 0 || s == 4 || s == 14) ? 1e-3f : 0.08f; if (e > tol) code = s; }
    if (code >= 0) { float v = 10.f; for (int k = 0; k < code; ++k) v *= 10.f;
        for (size_t i = (size_t)blockIdx.x * blockDim.x + threadIdx.x; i < (size_t)NTOK * 1024; i += (size_t)gridDim.x * blockDim.x) a.out[i] = v; }
}
#endif

extern "C" void kernel_launch(void* const* d_in, const int* in_sizes, int n_in, void* d_out, int out_size, void* d_ws, size_t ws_size, hipStream_t stream) {
    static int ready = 0;
    if (ready == 0) {
        ready = -1;
        if (n_in != 12 || out_size != NTOK * 1024 || ws_size < WS_END + (MK_DEBUG ? (size_t)128 * MiB : 0)) { fprintf(stderr, "kernel_launch: unexpected shapes / workspace (%d inputs, out %d, ws %zu)\n", n_in, out_size, ws_size); return; }
        if (hipFuncSetAttribute((const void*)mk_fwd, hipFuncAttributeMaxDynamicSharedMemorySize, LDS_BYTES) != hipSuccess) { fprintf(stderr, "kernel_launch: hipFuncSetAttribute failed\n"); return; }
        int per_cu = 0; (void)hipOccupancyMaxActiveBlocksPerMultiprocessor(&per_cu, (const void*)mk_fwd, NTHR, LDS_BYTES); (void)hipGetLastError();
        if (per_cu < 1) fprintf(stderr, "kernel_launch: occupancy query says %d blocks per CU\n", per_cu);
        ready = 1;
    }
    if (ready < 0) return;
    (void)hipMemsetAsync((char*)d_ws + WS_CTL, 0, CTL_ZERO_BYTES, stream);
    Args a{};
    for (int i = 0; i < 12; ++i) a.in[i] = (const float*)d_in[i];
    a.out = (float*)d_out; a.ws = (unsigned char*)d_ws;
#if !MK_DEBUG
    a.lo = 0; a.hi = 42;
    hipLaunchKernelGGL(mk_fwd, dim3(NWG), dim3(NTHR), LDS_BYTES, stream, a);
#else
    unsigned char* ws = (unsigned char*)d_ws; float* snap = (float*)(ws + WS_DBG);
    const int NS = 96;
    for (int s = 0; s < 42; ++s) {
        const int L = (s - 1) / 10, k = (s - 1) % 10; const bool moe = (L & 1) != 0;
        if (s >= 1 && s < 41 && !moe && k == 9) continue;
        const bool snapx = (s == 41) || (s >= 1 && s < 41 && ((k == 0 && L == 2) || (k == 8 && !moe) || (k == 5 && L > 0)));
        if (snapx) (void)hipMemcpyAsync(snap, d_out, (size_t)NTOK * 1024 * 4, hipMemcpyDeviceToDevice, stream);
        a.lo = s; a.hi = s + 1;
        hipLaunchKernelGGL(mk_fwd, dim3(NWG), dim3(NTHR), LDS_BYTES, stream, a);
        if (s == 0) { hipLaunchKernelGGL(chk_prep, dim3(64), dim3(64), 0, stream, a); continue; }
        if (s == 41) { hipLaunchKernelGGL(chk_final, dim3(64), dim3(64), 0, stream, a, (const float*)snap); continue; }
        const float* gains = (const float*)d_in[1] + (size_t)L * 2048; const float* xin0 = (const float*)d_in[0];
        switch (k) {
        case 0: hipLaunchKernelGGL(chk_norm, dim3(NS), dim3(64), 0, stream, a, L == 0 ? xin0 : (L == 2 ? (const float*)snap : (const float*)d_out), gains, L == 2 ? 1 : 0, L == 2 ? 17 : 1); break;
        case 1: hipLaunchKernelGGL(chk_gemm_in, dim3(NS), dim3(64), 0, stream, a, L); break;
        case 2: hipLaunchKernelGGL(chk_qk, dim3(NS), dim3(64), 0, stream, a, L); hipLaunchKernelGGL(chk_vt, dim3(NS), dim3(64), 0, stream, a); break;
        case 3: hipLaunchKernelGGL(chk_na, dim3(NS), dim3(64), 0, stream, a, L); hipLaunchKernelGGL(chk_dil, dim3(NS), dim3(64), 0, stream, a, L); hipLaunchKernelGGL(chk_gqa, dim3(32), dim3(64), 0, stream, a, L); break;
        case 4: hipLaunchKernelGGL(chk_gate, dim3(NS), dim3(64), 0, stream, a, L); break;
        case 5: hipLaunchKernelGGL(chk_resid, dim3(NS), dim3(64), 0, stream, a, L == 0 ? xin0 : (const float*)snap, (const bf16_t*)(ws + WS_MERGED), (const bf16_t*)(ws + WS_W_OUT) + (size_t)L * 1024 * 1024, 1024, 9); break;
        case 6: if (!moe) hipLaunchKernelGGL(chk_norm, dim3(NS), dim3(64), 0, stream, a, (const float*)d_out, gains + 1024, 0, 10);
                else { hipLaunchKernelGGL(chk_norm, dim3(NS), dim3(64), 0, stream, a, (const float*)d_out, gains + 1024, 0, 10);
                       hipLaunchKernelGGL(chk_router, dim3(NS), dim3(64), 0, stream, a, gains + 1024, (const float*)d_in[9] + (size_t)(L >> 1) * 8192); } break;
        case 7: if (!moe) hipLaunchKernelGGL(chk_up, dim3(NS), dim3(64), 0, stream, a, (const bf16_t*)(ws + WS_H), (const bf16_t*)(ws + WS_W_FGU) + (size_t)(L >> 1) * 2 * FF * 1024, FF, 11);
                else hipLaunchKernelGGL(chk_scatter, dim3(NS), dim3(64), 0, stream, a); break;
        case 8: if (!moe) hipLaunchKernelGGL(chk_resid, dim3(NS), dim3(64), 0, stream, a, (const float*)snap, (const bf16_t*)(ws + WS_ACT), (const bf16_t*)(ws + WS_W_FDN) + (size_t)(L >> 1) * 1024 * FF, FF, 12);
                else hipLaunchKernelGGL(chk_moe, dim3(NS), dim3(64), 0, stream, a, L >> 1, 0); break;
        case 9: hipLaunchKernelGGL(chk_moe, dim3(NS), dim3(64), 0, stream, a, L >> 1, 1); break;
        }
    }
    hipLaunchKernelGGL(chk_report, dim3(1024), dim3(256), 0, stream, a);
#endif
}
```

```cpp
#include <hip/hip_runtime.h>
#include <cstdint>
#include <cstdio>

#ifndef MK_DEBUG
#define MK_DEBUG 0
#endif

#ifndef PHM
#define PHM 0xFFFFFFFFu
#endif
#define PM(k) ((PHM >> (k)) & 1u)
#ifndef REPM
#define REPM 0u
#endif
#define RP(k) for (int rp_ = 0; rp_ <= (int)((REPM >> (k)) & 1u); ++rp_)
#ifndef F8_IN
#define F8_IN 0
#endif
#ifndef F8_FFN
#define F8_FFN 0
#endif
#ifndef F8_MOE
#define F8_MOE 3
#endif
#if MK_DEBUG
#undef F8_IN
#undef F8_FFN
#undef F8_MOE
#define F8_IN 0
#define F8_FFN 0
#define F8_MOE 0
#endif
#define DI __device__ __forceinline__
#define LAS __attribute__((address_space(3)))
#define GAS __attribute__((address_space(1)))

typedef unsigned short bf16_t;
typedef short bf16x8 __attribute__((ext_vector_type(8)));
typedef float f32x2 __attribute__((ext_vector_type(2)));
typedef float f32x4 __attribute__((ext_vector_type(4)));
typedef float f32x16 __attribute__((ext_vector_type(16)));
typedef unsigned u32x2 __attribute__((ext_vector_type(2)));
typedef unsigned u32x4 __attribute__((ext_vector_type(4)));
typedef __bf16 bf16x2_t __attribute__((ext_vector_type(2)));

constexpr int NB = 8, SEQ = 4096, DM = 1024, NTOK = NB * SEQ, DEPTH = 4;
constexpr int INW = 5632, FF = 2816, ED = 3584, NE = 8;
constexpr int MROWS = 2 * NTOK + NE * 256;
constexpr float EPS = 1e-6f;
constexpr float QSCALE = 0.125f * 1.4426950408889634f;
constexpr float LOG2E = 1.4426950408889634f;
constexpr int NWG = 256, NTHR = 512;

constexpr size_t MiB = 1u << 20;
constexpr size_t WS_CTL = 0, CTL_ZERO_BYTES = 1 * MiB;
constexpr size_t WS_ROPE1 = 1 * MiB;
constexpr size_t WS_ROPEA = 2 * MiB;
constexpr size_t WS_TOPI = 3 * MiB;
constexpr size_t WS_TOPW = 3 * MiB + 512 * 1024;
constexpr size_t WS_PERM = 4 * MiB;
constexpr size_t WS_RGATE = 4 * MiB + 512 * 1024;
constexpr size_t WS_CNT = 5 * MiB;
constexpr size_t WS_W_IN = 8 * MiB;
constexpr size_t WS_W_BRA = 52 * MiB;
constexpr size_t WS_W_BRB = 54 * MiB;
constexpr size_t WS_W_BRC = 57 * MiB;
constexpr size_t WS_W_OUT = 59 * MiB;
constexpr size_t WS_W_FGU = 67 * MiB;
constexpr size_t WS_W_FDN = 89 * MiB;
constexpr size_t WS_W_MGU = 100 * MiB;
constexpr size_t WS_W_MDN = 324 * MiB;
constexpr size_t WS_H = 436 * MiB;
constexpr size_t WS_XS = 500 * MiB;
constexpr size_t WS_YBUF = 632 * MiB;
constexpr size_t WS_Q = 760 * MiB;
constexpr size_t WS_K = 824 * MiB;
constexpr size_t WS_VRAW = 872 * MiB;
constexpr size_t WS_VT = 920 * MiB;
constexpr size_t WS_G = 968 * MiB;
constexpr size_t WS_OA = 1160 * MiB;
constexpr size_t WS_OB = 1176 * MiB;
constexpr size_t WS_OC = 1200 * MiB;
constexpr size_t WS_MERGED = 1216 * MiB;
constexpr size_t WS_ACT = 760 * MiB;
constexpr size_t WS_END = 1280 * MiB;
constexpr size_t WS_DBG = 1280 * MiB;
static_assert(WS_ACT + (size_t)MROWS * ED * 2 <= WS_END, "act overlay");
static_assert(WS_W_MDN + (size_t)2 * 8 * 1024 * 3584 * 2 <= WS_H, "weights");

constexpr int CW_BAR = 4096;
constexpr int CW_ERR = 32768;

constexpr int LDS_SCR = 0, LDS_SCR_BYTES = 131072;
constexpr int LDS_MISC = 131072;
constexpr int LDS_BYTES = 135168;

DI unsigned pk2(float lo, float hi) { f32x2 v = {lo, hi}; bf16x2_t b = __builtin_convertvector(v, bf16x2_t); return __builtin_bit_cast(unsigned, b); }
DI float bflo(unsigned w) { return __uint_as_float(w << 16); }
DI float bfhi(unsigned w) { return __uint_as_float(w & 0xffff0000u); }
DI float bf2f(bf16_t u) { return __uint_as_float((unsigned)u << 16); }
DI int lane_v() { int l; asm volatile("v_mbcnt_lo_u32_b32 %0, -1, 0\n\tv_mbcnt_hi_u32_b32 %0, -1, %0" : "=v"(l)); return l; }
DI float shx(float v, int m) { return __builtin_bit_cast(float, __builtin_amdgcn_ds_bpermute((lane_v() ^ m) << 2, __builtin_bit_cast(int, v))); }
DI int shx(int v, int m) { return __builtin_amdgcn_ds_bpermute((lane_v() ^ m) << 2, v); }
DI int shup(int v, int o) { return __builtin_amdgcn_ds_bpermute((lane_v() - o) << 2, v); }
DI int shidx(int v, int src) { return __builtin_amdgcn_ds_bpermute(src << 2, v); }
DI float wave_sum(float v) {
#pragma unroll
    for (int o = 1; o < 64; o <<= 1) v += shx(v, o);
    return v;
}
DI float sigmoidf_(float x) { return 1.f / (1.f + __expf(-x)); }

namespace pg8 {
#define PG8_LAS __attribute__((address_space(3)))
constexpr int BM = 256, BK = 64, HALF = 128, HTB = HALF * BK * 2, STAGE_BYTES = 8 * HTB, NXCD = 8, WGM = 8;
__host__ __device__ __forceinline__ int lds_byte(int r, int c) { const int st = (r >> 4) * 2 + (c >> 5), rr = r & 15, cc = c & 31, ob = rr * 64 + cc * 2; return st * 1024 + (ob ^ (((ob >> 9) & 1) << 5)); }
__host__ __device__ __forceinline__ void stage_rc(int b, int& R, int& C) { const int st = b / 1024, sb = b % 1024, swz = sb ^ (((sb >> 9) & 1) << 5); R = (st >> 1) * 16 + swz / 64; C = (st & 1) * 32 + (swz % 64) / 2; }
__host__ __device__ __forceinline__ int perm32(int rho) { const int n = rho >> 4, i = rho & 15; return 8 * (i >> 2) + 4 * n + (i & 3); }

struct Unit { int pm, pn; long bo; };
struct Gemm { const bf16_t* A; const bf16_t* Bt; int K; int sclB; };
typedef int v4i_t __attribute__((ext_vector_type(4)));
typedef int v8i_t __attribute__((ext_vector_type(8)));
__device__ __forceinline__ void mfma_f8(f32x4& acc, v8i_t b, v8i_t a, int sclb) {
    asm volatile("v_mfma_scale_f32_16x16x128_f8f6f4 %0, %1, %2, %0, %3, %4 op_sel_hi:[0,0,0]" : "+v"(acc) : "v"(b), "v"(a), "v"(sclb), "v"(0x7F7F7F7F));
}
__device__ __forceinline__ v8i_t cat8(bf16x8 lo, bf16x8 hi) { return __builtin_shufflevector(__builtin_bit_cast(v4i_t, lo), __builtin_bit_cast(v4i_t, hi), 0, 1, 2, 3, 4, 5, 6, 7); }

struct StaticOrder {
    int nM, nN, nwg, G, c;
    __host__ __device__ void init(int M, int N, int G_, int c_) { nM = M / BM; nN = N / BM; nwg = nM * nN; G = G_; c = c_; }
    __host__ __device__ bool next(int i, Unit& u) const {
        const long L = (long)i * G + c; if (L >= nwg) return false;
        int wgid = (int)L; { const int q = nwg / NXCD, r = nwg % NXCD, xcd = wgid % NXCD, off = wgid / NXCD; wgid = (xcd < r ? xcd * (q + 1) : r * (q + 1) + (xcd - r) * q) + off; }
        const int nig = WGM * nN, gid = wgid / nig, fm = gid * WGM, gsz = (nM - fm) < WGM ? (nM - fm) : WGM;
        u.pm = fm + ((wgid % nig) % gsz); u.pn = (wgid % nig) / gsz; u.bo = 0; return true;
    }
    __device__ __forceinline__ void a_ready(const Unit&) const {}
    __device__ __forceinline__ void done(const Unit&) const {}
};
struct GroupedOrder {
    int nN, c8, loc, per; int tp[9]; long bstride;
    __device__ __forceinline__ bool next(int i, Unit& u) const {
        const int j = loc + per * i, pm = c8 + 8 * (j / nN);
        if (pm >= tp[8]) return false;
        u.pm = pm; u.pn = j % nN;
        int e = 0;
#pragma unroll
        for (int k = 1; k < 8; ++k) e += (pm >= tp[k]) ? 1 : 0;
        u.bo = (long)e * bstride; return true;
    }
    __device__ __forceinline__ void a_ready(const Unit&) const {}
    __device__ __forceinline__ void done(const Unit&) const {}
};

template <class Epi, class Sched, bool ALIGN_EPI = false, bool SP2 = false, bool F8 = false>
__device__ __forceinline__ void gemm_phase(PG8_LAS unsigned char* lds, const Gemm g, const Sched& S, const Epi& E, int tid_in) {
    int tid_o = tid_in; asm volatile("" : "+v"(tid_o));
    const int tid = tid_o, wid = __builtin_amdgcn_readfirstlane(tid >> 6), lane = tid & 63, wr = wid >> 2, wc = wid & 3, fr = lane & 15, fq = lane >> 4;
    const int K = g.K, nt = K / BK;
    unsigned voffA[2], voffB[2];
#pragma unroll
    for (int i = 0; i < 2; ++i) { int R, C; stage_rc(tid * 16 + i * 8192, R, C); const int Rb = Epi::PERM ? ((R & ~31) + perm32(R & 31)) : R;
        voffA[i] = (unsigned)(R * K + C) * 2u; voffB[i] = (unsigned)(Rb * K + C) * 2u; }
    const size_t kstep = (size_t)(BK * 2);
    const size_t hstep = (size_t)HALF * K * 2;
    const size_t tstep = 2 * hstep;
    const unsigned ldsw = (unsigned)wid * 1024u;
    const int aoff = lds_byte(wr * 64 + fr, fq * 8), boff = lds_byte(wc * 32 + fr, fq * 8);
#define PG8_SA(b, h) (((b) * 2 + (h)) * HTB)
#define PG8_SB(b, h) ((4 + (b) * 2 + (h)) * HTB)
#define PG8_STAGE(bufoff, gbase, voff) do { _Pragma("unroll") for (int _i = 0; _i < 2; ++_i) \
        __builtin_amdgcn_global_load_lds((const unsigned*)((const char*)(gbase) + (voff)[_i]), (PG8_LAS unsigned*)(lds + (bufoff) + ldsw + _i * 8192), 16, 0, 0); } while (0)
#define PG8_LDA(dst, b, h) do { _Pragma("unroll") for (int m = 0; m < 4; ++m) _Pragma("unroll") for (int k = 0; k < 2; ++k) dst[m][k] = *(const PG8_LAS bf16x8*)(lds + PG8_SA(b, h) + aoff + m * 2048 + k * 1024); } while (0)
#define PG8_LDB(dst, b, h) do { _Pragma("unroll") for (int n = 0; n < 2; ++n) _Pragma("unroll") for (int k = 0; k < 2; ++k) dst[n][k] = *(const PG8_LAS bf16x8*)(lds + PG8_SB(b, h) + boff + n * 2048 + k * 1024); } while (0)
#define PG8_MMA(ai, bj, At, Bt) do { __builtin_amdgcn_s_setprio(1); _Pragma("unroll") for (int m = 0; m < 4; ++m) _Pragma("unroll") for (int n = 0; n < 2; ++n) { \
        if constexpr (F8) mfma_f8(acc[ai][bj][m][n], cat8(Bt[n][0], Bt[n][1]), cat8(At[m][0], At[m][1]), g.sclB); \
        else { _Pragma("unroll") for (int k = 0; k < 2; ++k) acc[ai][bj][m][n] = __builtin_amdgcn_mfma_f32_16x16x32_bf16(Bt[n][k], At[m][k], acc[ai][bj][m][n], 0, 0, 0); } } __builtin_amdgcn_s_setprio(0); } while (0)
#define PG8_WAIT_V(n) asm volatile("s_waitcnt vmcnt(" #n ")" ::: "memory")
#define PG8_WAIT_L(n) asm volatile("s_waitcnt lgkmcnt(" #n ")" ::: "memory")
#define PG8_BAR __builtin_amdgcn_s_barrier()
#define PG8_SCHED __builtin_amdgcn_sched_barrier(0)
    Unit cur, nxt; int ui = 0;
    if (!S.next(0, cur)) return;
    f32x4 acc[2][2][4][2];
#pragma unroll
    for (int a = 0; a < 2; ++a)
#pragma unroll
        for (int b = 0; b < 2; ++b)
#pragma unroll
            for (int m = 0; m < 4; ++m)
#pragma unroll
                for (int n = 0; n < 2; ++n) acc[a][b][m][n] = (f32x4){0.f, 0.f, 0.f, 0.f};
    bf16x8 At[4][2], B0[2][2], B1[2][2];
    const char* cA = (const char*)g.A + (size_t)cur.pm * tstep; const char* cB = (const char*)g.Bt + cur.bo + (size_t)cur.pn * tstep;
    S.a_ready(cur);
    if constexpr (SP2) {
        PG8_STAGE(PG8_SB(0, 0), cB, voffB); PG8_STAGE(PG8_SB(0, 1), cB + hstep, voffB); PG8_STAGE(PG8_SA(0, 0), cA, voffA); PG8_STAGE(PG8_SA(0, 1), cA + hstep, voffA);
        if (wr == 1) PG8_BAR;
        PG8_WAIT_V(2); PG8_BAR;
        PG8_STAGE(PG8_SB(1, 0), cB + kstep, voffB); PG8_STAGE(PG8_SA(1, 0), cA + kstep, voffA); PG8_STAGE(PG8_SB(1, 1), cB + hstep + kstep, voffB);
        PG8_WAIT_V(6); PG8_BAR;
    } else {
        PG8_STAGE(PG8_SB(0, 0), cB, voffB); PG8_STAGE(PG8_SA(0, 0), cA, voffA); PG8_STAGE(PG8_SB(0, 1), cB + hstep, voffB); PG8_STAGE(PG8_SA(0, 1), cA + hstep, voffA);
        if (wr == 1) PG8_BAR;
        PG8_WAIT_V(4); PG8_BAR;
        PG8_STAGE(PG8_SB(1, 0), cB + kstep, voffB); PG8_STAGE(PG8_SA(1, 0), cA + kstep, voffA); PG8_STAGE(PG8_SB(1, 1), cB + hstep + kstep, voffB);
        PG8_WAIT_V(6); PG8_BAR;
    }
    for (;;) {
        const bool has_next = S.next(ui + 1, nxt);
        const char* nA = has_next ? (const char*)g.A + (size_t)nxt.pm * tstep : cA; const char* nB = has_next ? (const char*)g.Bt + nxt.bo + (size_t)nxt.pn * tstep : cB;
        for (int t = 0; t < nt; t += 2) {
            const bool last = (t == nt - 2);
            const char* a1 = cA + (size_t)(t + 1) * kstep;
            const char* a2 = last ? nA : cA + (size_t)(t + 2) * kstep; const char* b2 = last ? nB : cB + (size_t)(t + 2) * kstep;
            const char* a3 = a2 + kstep; const char* b3 = b2 + kstep;
            if (last && has_next) S.a_ready(nxt);
            if constexpr (SP2) {
            PG8_LDB(B0, 0, 0); PG8_LDB(B1, 0, 1); PG8_SCHED; PG8_LDA(At, 0, 0); PG8_STAGE(PG8_SA(1, 1), a1 + hstep, voffA);
            PG8_WAIT_V(8); PG8_WAIT_L(0); PG8_BAR; PG8_MMA(0, 0, At, B0); PG8_MMA(0, 1, At, B1); PG8_BAR; PG8_SCHED;
            PG8_LDA(At, 0, 1); PG8_STAGE(PG8_SB(0, 0), b2, voffB); PG8_STAGE(PG8_SB(0, 1), b2 + hstep, voffB); PG8_STAGE(PG8_SA(0, 0), a2, voffA);
            PG8_WAIT_V(8); PG8_WAIT_L(0); PG8_BAR; PG8_MMA(1, 0, At, B0); PG8_MMA(1, 1, At, B1); PG8_BAR; PG8_SCHED;
            PG8_LDB(B0, 1, 0); PG8_LDB(B1, 1, 1); PG8_SCHED; PG8_LDA(At, 1, 0); PG8_STAGE(PG8_SA(0, 1), a2 + hstep, voffA);
            PG8_WAIT_V(8); PG8_WAIT_L(0); PG8_BAR; PG8_MMA(0, 0, At, B0); PG8_MMA(0, 1, At, B1); PG8_BAR; PG8_SCHED;
            PG8_LDA(At, 1, 1); PG8_STAGE(PG8_SB(1, 0), b3, voffB); PG8_STAGE(PG8_SB(1, 1), b3 + hstep, voffB); PG8_STAGE(PG8_SA(1, 0), a3, voffA);
            PG8_WAIT_V(8); PG8_WAIT_L(0); PG8_BAR; PG8_MMA(1, 0, At, B0); PG8_MMA(1, 1, At, B1); PG8_BAR; PG8_SCHED;
            } else {
            PG8_LDB(B0, 0, 0); PG8_SCHED; PG8_LDA(At, 0, 0); PG8_STAGE(PG8_SA(1, 1), a1 + hstep, voffA);
            PG8_WAIT_L(8); PG8_BAR; PG8_WAIT_L(0); PG8_MMA(0, 0, At, B0); PG8_BAR; PG8_SCHED;
            PG8_LDB(B1, 0, 1); PG8_STAGE(PG8_SB(0, 0), b2, voffB);
            PG8_BAR; PG8_WAIT_L(0); PG8_MMA(0, 1, At, B1); PG8_BAR;
            PG8_LDA(At, 0, 1); PG8_STAGE(PG8_SA(0, 0), a2, voffA);
            PG8_BAR; PG8_WAIT_L(0); PG8_MMA(1, 0, At, B0); PG8_BAR; PG8_SCHED;
            PG8_STAGE(PG8_SB(0, 1), b2 + hstep, voffB);
            PG8_WAIT_V(6); PG8_BAR; PG8_MMA(1, 1, At, B1); PG8_BAR;
            PG8_LDB(B0, 1, 0); PG8_SCHED; PG8_LDA(At, 1, 0); PG8_STAGE(PG8_SA(0, 1), a2 + hstep, voffA);
            PG8_WAIT_L(8); PG8_BAR; PG8_WAIT_L(0); PG8_MMA(0, 0, At, B0); PG8_BAR; PG8_SCHED;
            PG8_LDB(B1, 1, 1); PG8_STAGE(PG8_SB(1, 0), b3, voffB);
            PG8_BAR; PG8_WAIT_L(0); PG8_MMA(0, 1, At, B1); PG8_BAR;
            PG8_LDA(At, 1, 1); PG8_STAGE(PG8_SA(1, 0), a3, voffA);
            PG8_BAR; PG8_WAIT_L(0); PG8_MMA(1, 0, At, B0); PG8_BAR; PG8_SCHED;
            PG8_STAGE(PG8_SB(1, 1), b3 + hstep, voffB);
            PG8_WAIT_V(6); PG8_BAR; PG8_MMA(1, 1, At, B1); PG8_BAR;
            }
        }
        if constexpr (ALIGN_EPI) { if (wr == 0) PG8_BAR; }
        if constexpr (F8) asm volatile("s_nop 15\n\ts_nop 15" ::: "memory");
        if constexpr (!Epi::AFTER_DRAIN) { E(acc, cur, wr, wc, fr, fq); S.done(cur); }
        if (!has_next) break;
#pragma unroll
        for (int a = 0; a < 2; ++a)
#pragma unroll
            for (int b = 0; b < 2; ++b)
#pragma unroll
                for (int m = 0; m < 4; ++m)
#pragma unroll
                    for (int n = 0; n < 2; ++n) acc[a][b][m][n] = (f32x4){0.f, 0.f, 0.f, 0.f};
        cur = nxt; cA = nA; cB = nB; ++ui;
        if constexpr (ALIGN_EPI) { if (wr == 1) PG8_BAR; }
    }
    PG8_WAIT_V(0);
    if constexpr (!ALIGN_EPI) { if (wr == 0) PG8_BAR; }
    PG8_BAR;
    if constexpr (Epi::AFTER_DRAIN) { E.fused(acc, cur, wr, wc, fr, fq, lds, wid, lane); S.done(cur); }
#undef PG8_SA
#undef PG8_SB
#undef PG8_STAGE
#undef PG8_LDA
#undef PG8_LDB
#undef PG8_MMA
#undef PG8_WAIT_V
#undef PG8_WAIT_L
#undef PG8_BAR
#undef PG8_SCHED
}
}

typedef const f32x4 (&AccRef)[2][2][4][2];

struct EpiIn {
    static constexpr bool PERM = true, AFTER_DRAIN = false;
    bf16_t *Q, *Kb, *V, *G;
    DI void operator()(AccRef acc, const pg8::Unit& u, int wr, int wc, int fr, int fq) const {
        const int pn = u.pn; bf16_t* base; int ld, colt; bool sig = false;
        if (pn < 4) { base = Q; ld = 1024; colt = pn * 256; }
        else if (pn < 7) { base = Kb; ld = 768; colt = (pn - 4) * 256; }
        else if (pn < 10) { base = V; ld = 768; colt = (pn - 7) * 256; }
        else { base = G; ld = 3072; colt = (pn - 10) * 256; sig = true; }
        const int row0 = u.pm * 256 + wr * 64 + fr, col0 = colt + wc * 32 + 8 * fq;
#pragma unroll
        for (int ai = 0; ai < 2; ++ai)
#pragma unroll
            for (int m = 0; m < 4; ++m) { bf16_t* rowp = base + (size_t)(row0 + ai * 128 + m * 16) * ld + col0;
#pragma unroll
                for (int bj = 0; bj < 2; ++bj) { f32x4 v0 = acc[ai][bj][m][0], v1 = acc[ai][bj][m][1];
                    if (sig) {
#pragma unroll
                        for (int j = 0; j < 4; ++j) { v0[j] = sigmoidf_(v0[j]); v1[j] = sigmoidf_(v1[j]); } }
                    u32x4 w; w.x = pk2(v0[0], v0[1]); w.y = pk2(v0[2], v0[3]); w.z = pk2(v1[0], v1[1]); w.w = pk2(v1[2], v1[3]);
                    *(u32x4*)(rowp + bj * 128) = w; } }
    }
};

struct EpiGate {
    static constexpr bool PERM = true, AFTER_DRAIN = false;
    const bf16_t* G; int goff; bf16_t* Mg; int first;
    DI void operator()(AccRef acc, const pg8::Unit& u, int wr, int wc, int fr, int fq) const {
        const int row0 = u.pm * 256 + wr * 64 + fr, col0 = u.pn * 256 + wc * 32 + 8 * fq;
#pragma unroll
        for (int ai = 0; ai < 2; ++ai)
#pragma unroll
            for (int m = 0; m < 4; ++m) { const size_t row = (size_t)(row0 + ai * 128 + m * 16);
#pragma unroll
                for (int bj = 0; bj < 2; ++bj) { const int col = col0 + bj * 128;
                    const u32x4 g = *(const u32x4*)(G + row * 3072 + goff + col);
                    u32x4 p = {0u, 0u, 0u, 0u}; if (!first) p = *(const u32x4*)(Mg + row * 1024 + col);
                    const f32x4 v0 = acc[ai][bj][m][0], v1 = acc[ai][bj][m][1];
                    u32x4 w;
                    w.x = pk2(bflo(p.x) + bflo(g.x) * v0[0], bfhi(p.x) + bfhi(g.x) * v0[1]);
                    w.y = pk2(bflo(p.y) + bflo(g.y) * v0[2], bfhi(p.y) + bfhi(g.y) * v0[3]);
                    w.z = pk2(bflo(p.z) + bflo(g.z) * v1[0], bfhi(p.z) + bfhi(g.z) * v1[1]);
                    w.w = pk2(bflo(p.w) + bflo(g.w) * v1[2], bfhi(p.w) + bfhi(g.w) * v1[3]);
                    *(u32x4*)(Mg + row * 1024 + col) = w; } }
    }
};

struct EpiResid {
    static constexpr bool PERM = false, AFTER_DRAIN = false;
    const float* xin; float* xout;
    DI void operator()(AccRef acc, const pg8::Unit& u, int wr, int wc, int fr, int fq) const {
        const int row0 = u.pm * 256 + wr * 64 + fr, col0 = u.pn * 256 + wc * 32 + 4 * fq;
#pragma unroll
        for (int ai = 0; ai < 2; ++ai)
#pragma unroll
            for (int m = 0; m < 4; ++m) { const size_t ro = (size_t)(row0 + ai * 128 + m * 16) * 1024;
#pragma unroll
                for (int bj = 0; bj < 2; ++bj)
#pragma unroll
                    for (int n = 0; n < 2; ++n) { const size_t o = ro + col0 + bj * 128 + n * 16;
                        const f32x4 xv = *(const f32x4*)(xin + o); *(f32x4*)(xout + o) = xv + acc[ai][bj][m][n]; } }
    }
};

template <bool F8O>
struct EpiSwiglu {
    static constexpr bool PERM = true, AFTER_DRAIN = false;
    unsigned char* act; int ld;
    DI void operator()(AccRef acc, const pg8::Unit& u, int wr, int wc, int fr, int fq) const {
        const int row0 = u.pm * 256 + wr * 64 + fr, col0 = u.pn * 128 + wc * 32 + 8 * fq;
#pragma unroll
        for (int ai = 0; ai < 2; ++ai)
#pragma unroll
            for (int m = 0; m < 4; ++m) { const size_t eo = (size_t)(row0 + ai * 128 + m * 16) * ld + col0;
                float o[8];
#pragma unroll
                for (int n = 0; n < 2; ++n)
#pragma unroll
                    for (int j = 0; j < 4; ++j) { const float g = acc[ai][0][m][n][j], uu = acc[ai][1][m][n][j]; o[4 * n + j] = g * sigmoidf_(g) * uu; }
                if constexpr (F8O) { int w0 = 0, w1 = 0;
                    w0 = __builtin_amdgcn_cvt_pk_fp8_f32(o[0], o[1], w0, false); w0 = __builtin_amdgcn_cvt_pk_fp8_f32(o[2], o[3], w0, true);
                    w1 = __builtin_amdgcn_cvt_pk_fp8_f32(o[4], o[5], w1, false); w1 = __builtin_amdgcn_cvt_pk_fp8_f32(o[6], o[7], w1, true);
                    u32x2 w; w.x = (unsigned)w0; w.y = (unsigned)w1; *(u32x2*)(act + eo) = w; }
                else { u32x4 w; w.x = pk2(o[0], o[1]); w.y = pk2(o[2], o[3]); w.z = pk2(o[4], o[5]); w.w = pk2(o[6], o[7]); *(u32x4*)(act + 2 * eo) = w; } }
    }
};

struct EpiMoeDown {
    static constexpr bool PERM = true, AFTER_DRAIN = false;
    const int* perm; const float* rgate; bf16_t* ybuf;
    DI void operator()(AccRef acc, const pg8::Unit& u, int wr, int wc, int fr, int fq) const {
        const int row0 = u.pm * 256 + wr * 64 + fr, col0 = u.pn * 256 + wc * 32 + 8 * fq;
#pragma unroll
        for (int ai = 0; ai < 2; ++ai)
#pragma unroll
            for (int m = 0; m < 4; ++m) { const int row = row0 + ai * 128 + m * 16; const int p = perm[row];
                if (p >= 0) { const float gt = rgate[row]; bf16_t* dst = ybuf + ((size_t)(p & 1) * NTOK + (size_t)(p >> 1)) * 1024 + col0;
#pragma unroll
                    for (int bj = 0; bj < 2; ++bj) { const f32x4 v0 = acc[ai][bj][m][0] * gt, v1 = acc[ai][bj][m][1] * gt;
                        u32x4 w; w.x = pk2(v0[0], v0[1]); w.y = pk2(v0[2], v0[3]); w.z = pk2(v1[0], v1[1]); w.w = pk2(v1[2], v1[3]);
                        *(u32x4*)(dst + bj * 128) = w; } } }
    }
};

#define LDS_WAIT() asm volatile("s_waitcnt lgkmcnt(0)" ::: "memory")

DI void prep_tile(const float* src, int src_ld, bool zero, unsigned char* dst, int dst_ld, float f8mul, LAS bf16_t* t, int lane) {
#pragma unroll
    for (int i = 0; i < 16; ++i) { const int k = i * 4 + (lane >> 4), c = (lane & 15) * 4;
        f32x4 v = {0.f, 0.f, 0.f, 0.f}; if (!zero) v = *(const f32x4*)(src + (size_t)k * src_ld + c);
        u32x2 w; w.x = pk2(v[0], v[1]); w.y = pk2(v[2], v[3]); *(LAS u32x2*)(t + k * 68 + c) = w; }
    LDS_WAIT();
#pragma unroll
    for (int kc = 0; kc < 8; ++kc) { unsigned e[8];
#pragma unroll
        for (int j = 0; j < 8; ++j) e[j] = t[(8 * kc + j) * 68 + lane];
        if (f8mul != 0.f) { int w0 = 0, w1 = 0;
            w0 = __builtin_amdgcn_cvt_pk_fp8_f32(bflo(e[0]) * f8mul, bflo(e[1]) * f8mul, w0, false); w0 = __builtin_amdgcn_cvt_pk_fp8_f32(bflo(e[2]) * f8mul, bflo(e[3]) * f8mul, w0, true);
            w1 = __builtin_amdgcn_cvt_pk_fp8_f32(bflo(e[4]) * f8mul, bflo(e[5]) * f8mul, w1, false); w1 = __builtin_amdgcn_cvt_pk_fp8_f32(bflo(e[6]) * f8mul, bflo(e[7]) * f8mul, w1, true);
            u32x2 w; w.x = (unsigned)w0; w.y = (unsigned)w1; *(u32x2*)(dst + (size_t)lane * dst_ld + 8 * kc) = w; }
        else { u32x4 w; w.x = e[0] | (e[1] << 16); w.y = e[2] | (e[3] << 16); w.z = e[4] | (e[5] << 16); w.w = e[6] | (e[7] << 16);
            *(u32x4*)(dst + ((size_t)lane * dst_ld + 8 * kc) * 2) = w; } }
    LDS_WAIT();
}

struct Args { const float* in[12]; float* out; unsigned char* ws; int lo, hi; };
typedef Args Ptrs;

DI void phase_prep(const Ptrs& P, LAS unsigned char* lds, int tid) {
    const int wave = tid >> 6, lane = tid & 63;
    LAS bf16_t* t = (LAS bf16_t*)(lds + LDS_SCR + wave * 8704);
    const int gw = blockIdx.x * 8 + wave, NGW = gridDim.x * 8;
    constexpr int T0 = 4 * 1408, T1 = T0 + 4 * 64, T2 = T1 + 4 * 96, T3 = T2 + 4 * 64, T4 = T3 + 4 * 256, T5 = T4 + 2 * 1408, T6 = T5 + 2 * 704, T7 = T6 + 16 * 1792, T8 = T7 + 16 * 896;
    for (int it = gw; it < T8; it += NGW) {
        const float* src; int src_ld; size_t wsb; size_t eo; int dst_ld; bool zero = false; float f8mul = 0.f;
        int r = it;
        if (r < T0) { const int L = r / 1408, q = r % 1408, kt = q / 88, nt = q % 88;
            src = P.in[2] + (size_t)L * 1024 * 5632 + (size_t)kt * 64 * 5632 + nt * 64; src_ld = 5632;
            wsb = WS_W_IN; eo = ((size_t)L * 5632 + nt * 64) * 1024 + kt * 64; dst_ld = 1024; f8mul = F8_IN ? 32.f : 0.f; }
        else if (r < T1) { r -= T0; const int L = r / 64, q = r % 64, kt = q / 16, nt = q % 16;
            src = P.in[5] + (size_t)L * 768 * 1024 + (size_t)(kt * 64) * 1024 + nt * 64; src_ld = 1024;
            wsb = WS_W_BRA; eo = ((size_t)L * 1024 + nt * 64) * 256 + kt * 64; dst_ld = 256; }
        else if (r < T2) { r -= T1; const int L = r / 96, q = r % 96, kt = q / 16, nt = q % 16;
            src = P.in[5] + (size_t)L * 768 * 1024 + (size_t)(256 + kt * 64) * 1024 + nt * 64; src_ld = 1024;
            wsb = WS_W_BRB; eo = ((size_t)L * 1024 + nt * 64) * 384 + kt * 64; dst_ld = 384; }
        else if (r < T3) { r -= T2; const int L = r / 64, q = r % 64, kt = q / 16, nt = q % 16;
            zero = kt >= 2;
            src = P.in[5] + (size_t)L * 768 * 1024 + (size_t)(640 + (zero ? 0 : kt) * 64) * 1024 + nt * 64; src_ld = 1024;
            wsb = WS_W_BRC; eo = ((size_t)L * 1024 + nt * 64) * 256 + kt * 64; dst_ld = 256; }
        else if (r < T4) { r -= T3; const int L = r / 256, q = r % 256, kt = q / 16, nt = q % 16;
            src = P.in[6] + (size_t)L * 1024 * 1024 + (size_t)(kt * 64) * 1024 + nt * 64; src_ld = 1024;
            wsb = WS_W_OUT; eo = ((size_t)L * 1024 + nt * 64) * 1024 + kt * 64; dst_ld = 1024; }
        else if (r < T5) { r -= T4; const int L = r / 1408, q = r % 1408, kt = q / 88, nt = q % 88;
            const int n0 = nt * 64, pn = n0 >> 8, j = n0 & 255, c0 = (j < 128) ? pn * 128 + j : FF + pn * 128 + (j - 128);
            src = P.in[7] + (size_t)L * 1024 * 5632 + (size_t)(kt * 64) * 5632 + c0; src_ld = 5632;
            wsb = WS_W_FGU; eo = ((size_t)L * 5632 + n0) * 1024 + kt * 64; dst_ld = 1024; f8mul = F8_FFN ? 32.f : 0.f; }
        else if (r < T6) { r -= T5; const int L = r / 704, q = r % 704, kt = q / 16, nt = q % 16;
            src = P.in[8] + (size_t)L * 2816 * 1024 + (size_t)(kt * 64) * 1024 + nt * 64; src_ld = 1024;
            wsb = WS_W_FDN; eo = ((size_t)L * 1024 + nt * 64) * 2816 + kt * 64; dst_ld = 2816; f8mul = F8_FFN ? 64.f : 0.f; }
        else if (r < T7) { r -= T6; const int L = r / 1792, q = r % 1792, kt = q / 112, nt = q % 112;
            const int n0 = nt * 64, pn = n0 >> 8, j = n0 & 255, c0 = (j < 128) ? pn * 128 + j : ED + pn * 128 + (j - 128);
            src = P.in[10] + (size_t)L * 1024 * 7168 + (size_t)(kt * 64) * 7168 + c0; src_ld = 7168;
            wsb = WS_W_MGU + (size_t)(L >> 3) * 8 * 7168 * 1024 * 2; eo = ((size_t)(L & 7) * 7168 + n0) * 1024 + kt * 64; dst_ld = 1024; f8mul = ((F8_MOE >> (L >> 3)) & 1) ? 32.f : 0.f; }
        else { r -= T7; const int L = r / 896, q = r % 896, kt = q / 16, nt = q % 16;
            src = P.in[11] + (size_t)L * 3584 * 1024 + (size_t)(kt * 64) * 1024 + nt * 64; src_ld = 1024;
            wsb = WS_W_MDN + (size_t)(L >> 3) * 8 * 1024 * 3584 * 2; eo = ((size_t)(L & 7) * 1024 + nt * 64) * 3584 + kt * 64; dst_ld = 3584; f8mul = ((F8_MOE >> (L >> 3)) & 1) ? 64.f : 0.f; }
        prep_tile(src, src_ld, zero, P.ws + wsb + eo * (f8mul != 0.f ? 1 : 2), dst_ld, f8mul, t, lane);
    }
    const int gid = blockIdx.x * NTHR + tid;
    if (gid < 4096 * 32) { const int pos = gid >> 5, i = gid & 31; const float inv = powf(10000.f, -(float)(2 * i) / 64.f); float s, c; sincosf((float)pos * inv, &s, &c);
        ((f32x2*)(P.ws + WS_ROPE1))[gid] = (f32x2){c, s}; }
    if (gid < 64 * 16) { const int pos = gid >> 4, i = gid & 15; const float inv = powf(10000.f, -(float)(2 * i) / 32.f); float s, c; sincosf((float)pos * inv, &s, &c);
        ((f32x2*)(P.ws + WS_ROPEA))[gid] = (f32x2){c, s}; }
}

template <bool COMBINE, bool ROUTER, bool HF8>
DI void phase_norm(const float* xin, float* xout, const bf16_t* ybuf, const float* gain, bf16_t* H, const float* wrt, int* topi, float* topw, int* cnt, int* perm,
                   LAS unsigned char* lds, int tid) {
    const int wave = tid >> 6, lane = tid & 63, w = blockIdx.x;
    LAS float* wrl = (LAS float*)(lds + LDS_SCR);
    LAS int* cntl = (LAS int*)(lds + LDS_SCR + 32768);
    if (ROUTER) {
        for (int i = tid; i < 8192; i += NTHR) wrl[(i & 7) * 1024 + (i >> 3)] = wrt[i];
        if (tid < 8) cntl[tid] = 0;
        for (int i = tid; i < MROWS / NWG; i += NTHR) perm[w * (MROWS / NWG) + i] = -1;
        __syncthreads();
    }
    f32x4 g[4];
#pragma unroll
    for (int q = 0; q < 4; ++q) g[q] = *(const f32x4*)(gain + 256 * q + 4 * lane);
    for (int j = 0; j < 16; ++j) {
        const int row = w * 128 + wave * 16 + j; const size_t ro = (size_t)row * 1024;
        f32x4 v[4]; float ss = 0.f;
#pragma unroll
        for (int q = 0; q < 4; ++q) { v[q] = *(const f32x4*)(xin + ro + 256 * q + 4 * lane);
            if (COMBINE) { const u32x2 a = *(const u32x2*)(ybuf + ro + 256 * q + 4 * lane), b = *(const u32x2*)(ybuf + (size_t)NTOK * 1024 + ro + 256 * q + 4 * lane);
                v[q][0] += bflo(a.x) + bflo(b.x); v[q][1] += bfhi(a.x) + bfhi(b.x); v[q][2] += bflo(a.y) + bflo(b.y); v[q][3] += bfhi(a.y) + bfhi(b.y);
                *(f32x4*)(xout + ro + 256 * q + 4 * lane) = v[q]; }
            ss += (v[q][0] * v[q][0] + v[q][1] * v[q][1]) + (v[q][2] * v[q][2] + v[q][3] * v[q][3]); }
        const float rstd = 1.f / sqrtf(wave_sum(ss) * (1.f / 1024.f) + EPS);
#pragma unroll
        for (int q = 0; q < 4; ++q) { v[q] = v[q] * rstd * g[q];
            if constexpr (HF8) { int w = 0; w = __builtin_amdgcn_cvt_pk_fp8_f32(v[q][0], v[q][1], w, false); w = __builtin_amdgcn_cvt_pk_fp8_f32(v[q][2], v[q][3], w, true);
                *(int*)((unsigned char*)H + ro + 256 * q + 4 * lane) = w; }
            else { u32x2 o; o.x = pk2(v[q][0], v[q][1]); o.y = pk2(v[q][2], v[q][3]); *(u32x2*)(H + ro + 256 * q + 4 * lane) = o; } }
        if (ROUTER) {
            float lg[8];
#pragma unroll
            for (int e = 0; e < 8; ++e) { float a = 0.f;
#pragma unroll
                for (int q = 0; q < 4; ++q) { const f32x4 wv = *(const LAS f32x4*)(wrl + e * 1024 + 256 * q + 4 * lane); a += (v[q][0] * wv[0] + v[q][1] * wv[1]) + (v[q][2] * wv[2] + v[q][3] * wv[3]); }
                lg[e] = wave_sum(a); }
            float v0 = -3.0e38f; int e0 = 0;
#pragma unroll
            for (int e = 0; e < 8; ++e) if (lg[e] > v0) { v0 = lg[e]; e0 = e; }
            float v1 = -3.0e38f; int e1 = 0;
#pragma unroll
            for (int e = 0; e < 8; ++e) if (e != e0 && lg[e] > v1) { v1 = lg[e]; e1 = e; }
            if (lane == 0) { const float t = __expf(v1 - v0), w0 = 1.f / (1.f + t);
                topi[row * 2] = e0; topi[row * 2 + 1] = e1; topw[row * 2] = w0; topw[row * 2 + 1] = t * w0;
                atomicAdd((int*)(cntl + e0), 1); atomicAdd((int*)(cntl + e1), 1); }
        }
    }
    if (ROUTER) { __syncthreads(); if (tid < 8) cnt[w * 8 + tid] = cntl[tid]; }
}

DI void moe_totals(const int* cnt, volatile LAS int* misc, int tid) {
    const int e = tid >> 6, lane = tid & 63, w = blockIdx.x;
    int c[4]; int s4 = 0;
#pragma unroll
    for (int i = 0; i < 4; ++i) { c[i] = cnt[(4 * lane + i) * 8 + e]; s4 += c[i]; }
    int x = s4;
#pragma unroll
    for (int o = 1; o < 64; o <<= 1) { const int y = shup(x, o); if (lane >= o) x += y; }
    const int total = shidx(x, 63);
    int p = x - s4;
#pragma unroll
    for (int i = 0; i < 3; ++i) if (i < (w & 3)) p += c[i];
    p = shidx(p, w >> 2);
    if (lane == 0) { misc[e] = total; misc[8 + e] = p; }
    __syncthreads();
}

template <bool F8>
DI void phase_scatter(const int* cnt, const int* topi, const float* topw, const bf16_t* H, bf16_t* XS, int* perm, float* rgate, LAS unsigned char* lds, int tid) {
    const int wave = tid >> 6, lane = tid & 63, w = blockIdx.x;
    volatile LAS int* misc = (volatile LAS int*)(lds + LDS_MISC + 64);
    LAS int* posl = (LAS int*)(lds + LDS_SCR);
    moe_totals(cnt, misc, tid);
    { const int e = wave; int base = 0;
        for (int k = 0; k < e; ++k) base += ((misc[k] + 255) >> 8) << 8;
        int running = base + misc[8 + e];
        for (int pss = 0; pss < 2; ++pss) { const int j = 64 * pss + lane, tok = w * 128 + j;
            const int a0 = topi[tok * 2], a1 = topi[tok * 2 + 1]; const bool f0 = a0 == e, f1 = a1 == e, has = f0 || f1;
            const unsigned long long mask = __ballot(has); const int rank = __popcll(mask & ((1ull << lane) - 1ull));
            if (has) { const int pos = running + rank, slot = f1 ? 1 : 0; perm[pos] = tok * 2 + slot; rgate[pos] = topw[tok * 2 + slot]; posl[j * 2 + slot] = pos; }
            running += __popcll(mask); }
    }
    __syncthreads();
    for (int i = 0; i < 32; ++i) { const int pr = wave * 32 + i, pos = posl[pr], tok = w * 128 + (pr >> 1);
        if constexpr (F8) { *((u32x4*)((unsigned char*)XS + (size_t)pos * 1024) + lane) = *((const u32x4*)((const unsigned char*)H + (size_t)tok * 1024) + lane); }
        else { const u32x4* s = (const u32x4*)(H + (size_t)tok * 1024) + lane; u32x4* d = (u32x4*)(XS + (size_t)pos * 1024) + lane;
            const u32x4 a = s[0], b = s[64]; d[0] = a; d[64] = b; } }
}

DI void phase_final(const float* x, const bf16_t* ybuf, float* out, int tid) {
    const size_t n4 = (size_t)NTOK * 1024 / 4;
    for (size_t i = (size_t)blockIdx.x * NTHR + tid; i < n4; i += (size_t)gridDim.x * NTHR) {
        f32x4 v = ((const f32x4*)x)[i]; const u32x2 a = ((const u32x2*)ybuf)[i], b = ((const u32x2*)(ybuf + (size_t)NTOK * 1024))[i];
        v[0] += bflo(a.x) + bflo(b.x); v[1] += bfhi(a.x) + bfhi(b.x); v[2] += bflo(a.y) + bflo(b.y); v[3] += bfhi(a.y) + bfhi(b.y);
        ((f32x4*)out)[i] = v; }
}

DI void qk_row(bf16_t* rowp, int nheads_b0, int nheads_b1, const float* qkg  , int which, float scale, const f32x2* rope1, const f32x2* ropea, int s, int lane) {
    const int head = lane >> 2, qd = lane & 3;
    const int br = head < nheads_b0 ? 0 : (head < nheads_b0 + nheads_b1 ? 1 : 2);
    u32x4 r0 = *(const u32x4*)(rowp + lane * 16), r1 = *(const u32x4*)(rowp + lane * 16 + 8);
    float v[16];
    v[0] = bflo(r0.x); v[1] = bfhi(r0.x); v[2] = bflo(r0.y); v[3] = bfhi(r0.y); v[4] = bflo(r0.z); v[5] = bfhi(r0.z); v[6] = bflo(r0.w); v[7] = bfhi(r0.w);
    v[8] = bflo(r1.x); v[9] = bfhi(r1.x); v[10] = bflo(r1.y); v[11] = bfhi(r1.y); v[12] = bflo(r1.z); v[13] = bfhi(r1.z); v[14] = bflo(r1.w); v[15] = bfhi(r1.w);
    float ss = 0.f;
#pragma unroll
    for (int j = 0; j < 16; ++j) ss += v[j] * v[j];
    ss += shx(ss, 1); ss += shx(ss, 2);
    const float rstd = 1.f / sqrtf(ss * (1.f / 64.f) + EPS);
    const float* gp = qkg + (br * 2 + which) * 64 + 16 * qd;
    float o[16];
#pragma unroll
    for (int j = 0; j < 16; ++j) v[j] = v[j] * rstd * gp[j];
    const bool first = (br == 2) ? (qd < 2) : ((qd & 1) == 0);
    const f32x2* tab = (br == 2) ? rope1 + s * 32 + 16 * (qd & 1) : ropea + ((qd >> 1) ? (s & 63) : (s >> 6)) * 16;
#pragma unroll
    for (int j = 0; j < 16; ++j) { const float p1 = shx(v[j], 1), p2 = shx(v[j], 2); const float pv = (br == 2) ? p2 : p1;
        const f32x2 cs = tab[j];
        const float rot = first ? v[j] * cs.x - pv * cs.y : v[j] * cs.x + pv * cs.y;
        o[j] = ((br == 0) ? v[j] : rot) * scale; }
    r0.x = pk2(o[0], o[1]); r0.y = pk2(o[2], o[3]); r0.z = pk2(o[4], o[5]); r0.w = pk2(o[6], o[7]);
    r1.x = pk2(o[8], o[9]); r1.y = pk2(o[10], o[11]); r1.z = pk2(o[12], o[13]); r1.w = pk2(o[14], o[15]);
    *(u32x4*)(rowp + lane * 16) = r0; *(u32x4*)(rowp + lane * 16 + 8) = r1;
}

DI void phase_qkvprep(const Ptrs& P, int layer, LAS unsigned char* lds, int tid) {
    const int wave = tid >> 6, lane = tid & 63, gw = blockIdx.x * 8 + wave, NGW = gridDim.x * 8;
    bf16_t* Q = (bf16_t*)(P.ws + WS_Q); bf16_t* Kb = (bf16_t*)(P.ws + WS_K); const bf16_t* V = (const bf16_t*)(P.ws + WS_VRAW); bf16_t* Vt = (bf16_t*)(P.ws + WS_VT);
    const float* qkg = P.in[3] + (size_t)layer * 3 * 2 * 64;
    const f32x2* rope1 = (const f32x2*)(P.ws + WS_ROPE1); const f32x2* ropea = (const f32x2*)(P.ws + WS_ROPEA);
    for (int tok = gw; tok < NTOK; tok += NGW) { const int s = tok & (SEQ - 1);
        qk_row(Q + (size_t)tok * 1024, 4, 6, qkg, 0, QSCALE, rope1, ropea, s, lane);
        if (lane < 48) qk_row(Kb + (size_t)tok * 768, 4, 2, qkg, 1, 1.0f, rope1, ropea, s, lane);
    }
    LAS bf16_t* t = (LAS bf16_t*)(lds + LDS_SCR + wave * 9216);
    for (int un = gw; un < 512 * 12; un += NGW) { const int tt = un / 12, hv = un % 12, tok0 = tt * 64, b = tok0 >> 12, s0 = tok0 & (SEQ - 1);
        const bf16_t* src = V + (size_t)(tok0 + lane) * 768 + hv * 64;
#pragma unroll
        for (int c = 0; c < 8; ++c) *(LAS u32x4*)(t + lane * 72 + c * 8) = *(const u32x4*)(src + c * 8);
        LDS_WAIT();
        const int g = hv < 6 ? 0 : ((hv - 6) >> 1), sh = 2 * g, dd = 1 << sh, Sd = SEQ >> sh, run = 64 >> sh;
        bf16_t* drow = Vt + ((size_t)(b * 12 + hv) * 64 + lane) * SEQ;
#pragma unroll
        for (int q = 0; q < 16; ++q) { const int o = 4 * q, rho = o / run, k0 = o % run; unsigned e[4];
#pragma unroll
            for (int j = 0; j < 4; ++j) e[j] = t[(rho + dd * (k0 + j)) * 72 + lane];
            u32x2 w; w.x = e[0] | (e[1] << 16); w.y = e[2] | (e[3] << 16);
            *(u32x2*)(drow + rho * Sd + (s0 >> sh) + k0) = w; }
        LDS_WAIT();
    }
}

#define XB_TMO      128
#define XB_XCNT(j)  (256  + 64 * (j))
#define XB_XSUB(j)  (1280 + 64 * (j))
#define XB_XGEN(j)  (2304 + 64 * (j))
#define XB_TOP      3328
#define XB_TOPGEN   3392
#define XCD_BAR_WORDS 3456
#define XB_SPIN_CAP (1u << 18)

__device__ __forceinline__ unsigned xb_ld(unsigned* p)              { return __hip_atomic_load(p, __ATOMIC_RELAXED, __HIP_MEMORY_SCOPE_AGENT); }
__device__ __forceinline__ unsigned xb_add(unsigned* p, unsigned v) { return __hip_atomic_fetch_add(p, v, __ATOMIC_RELAXED, __HIP_MEMORY_SCOPE_AGENT); }
__device__ __forceinline__ unsigned xb_xcc_id() { return (unsigned)__builtin_amdgcn_s_getreg((3 << 11) | 20) & 0xFu; }
#define XB_SPIN(cond, bar) do { unsigned _sp = 0; while (cond) { __builtin_amdgcn_s_sleep(1); \
    if ((++_sp & 255u) == 0u) { if (xb_ld(&(bar)[XB_TMO])) break; if (_sp > XB_SPIN_CAP) { atomicAdd(&(bar)[XB_TMO], 1u); break; } } } } while (0)

struct XcdBarrier {
    unsigned* bar; unsigned x;
    volatile LAS unsigned* st;
};

__device__ __forceinline__ XcdBarrier xcd_barrier_post(unsigned* bar, volatile LAS unsigned* st, int tid) {
    XcdBarrier b; b.bar = bar; b.x = xb_xcc_id(); b.st = st;
    if (tid == 0) (void)xb_add(&bar[XB_XCNT(b.x)], 1u);
    return b;
}
__device__ __forceinline__ void xcd_barrier_complete(unsigned* bar, unsigned x, unsigned& nloc, unsigned& nx) {
    const unsigned G = gridDim.x * gridDim.y * gridDim.z;
    unsigned sum, cnt, mine, sp = 0u;
    for (;;) {
        sum = 0u; cnt = 0u; mine = 0u;
#pragma unroll
        for (unsigned j = 0; j < 16; ++j) { const unsigned c = xb_ld(&bar[XB_XCNT(j)]); sum += c; cnt += (c > 0u) ? 1u : 0u; mine = (j == x) ? c : mine; }
        if (sum == G) break;
        __builtin_amdgcn_s_sleep(1);
        if ((++sp & 255u) == 0u) { if (xb_ld(&bar[XB_TMO])) break; if (sp > XB_SPIN_CAP) { atomicAdd(&bar[XB_TMO], 1u); break; } }
    }
    nloc = mine > 0u ? mine : 1u; nx = cnt > 0u ? cnt : 1u;
}

__device__ __forceinline__ void xcd_barrier(const XcdBarrier& b, int tid) {
    asm volatile("s_waitcnt vmcnt(0)" ::: "memory");
    __syncthreads();
    if (tid == 0) {
        unsigned* bar = b.bar;
        __builtin_amdgcn_s_waitcnt(0);
        unsigned nloc = b.st[0], nx = b.st[1];
        if (nloc == 0u) { xcd_barrier_complete(bar, b.x, nloc, nx); b.st[0] = nloc; b.st[1] = nx; }
        const unsigned old = xb_add(&bar[XB_XSUB(b.x)], 1u);
        const unsigned gen = old / nloc;
        if (old + 1u == (gen + 1u) * nloc) {
            __builtin_amdgcn_fence(__ATOMIC_RELEASE, "agent");
            asm volatile("s_waitcnt vmcnt(0)" ::: "memory");
            const unsigned og = xb_add(&bar[XB_TOP], 1u);
            const unsigned tg = og / nx;
            if (og + 1u == (tg + 1u) * nx) xb_add(&bar[XB_TOPGEN], 1u);
            else XB_SPIN(xb_ld(&bar[XB_TOPGEN]) == tg, bar);
            __builtin_amdgcn_fence(__ATOMIC_ACQUIRE, "agent");
            xb_add(&bar[XB_XGEN(b.x)], 1u);
            asm volatile("s_waitcnt vmcnt(0)" ::: "memory");
        } else {
            XB_SPIN(xb_ld(&bar[XB_XGEN(b.x)]) == gen, bar);
            __builtin_amdgcn_fence(__ATOMIC_ACQUIRE, "agent");
            asm volatile("s_waitcnt vmcnt(0)" ::: "memory");
        }
    }
    __syncthreads();
}

DI f32x16 mfma32(bf16x8 a, bf16x8 b, f32x16 c) { return __builtin_amdgcn_mfma_f32_32x32x16_bf16(a, b, c, 0, 0, 0); }
DI int pi32(int r) { return (r & 19) | ((r & 4) << 1) | ((r & 8) >> 1); }
DI int keyidx(int i, int hi) { return 16 * (i >> 3) + 8 * hi + (i & 7); }
DI bf16x8 pack8(const f32x16& x, int s) { u32x4 p; p.x = pk2(x[8 * s], x[8 * s + 1]); p.y = pk2(x[8 * s + 2], x[8 * s + 3]); p.z = pk2(x[8 * s + 4], x[8 * s + 5]); p.w = pk2(x[8 * s + 6], x[8 * s + 7]); return __builtin_bit_cast(bf16x8, p); }
DI f32x16 splat16(float v) { f32x16 z;
#pragma unroll
    for (int i = 0; i < 16; ++i) z[i] = v; return z; }
constexpr float SM_THR = 8.f;
DI float max16x2(const f32x16& a, const f32x16& b) {
    float m0 = fmaxf(fmaxf(a[0], a[1]), a[2]), m1 = fmaxf(fmaxf(b[0], b[1]), b[2]);
#pragma unroll
    for (int i = 3; i < 15; i += 2) { m0 = fmaxf(fmaxf(m0, a[i]), a[i + 1]); m1 = fmaxf(fmaxf(m1, b[i]), b[i + 1]); }
    return fmaxf(fmaxf(m0, m1), fmaxf(a[15], b[15]));
}
#define SOFTMAX_BODY(UPD_NEGM) \
    const float mx = max16x2(s0, s1); \
    if (__any(mx > SM_THR)) {                                          \
        const float delta = fmaxf(fmaxf(mx, shx(mx, 32)), 0.f), alpha = __builtin_amdgcn_exp2f(-delta); \
        mref += delta; l *= alpha; UPD_NEGM \
        _Pragma("unroll") for (int i = 0; i < 16; ++i) { o0[i] *= alpha; o1[i] *= alpha; s0[i] -= delta; s1[i] -= delta; } \
    } \
    float sum0 = 0.f, sum1 = 0.f; \
    _Pragma("unroll") for (int i = 0; i < 16; ++i) { s0[i] = __builtin_amdgcn_exp2f(s0[i]); s1[i] = __builtin_amdgcn_exp2f(s1[i]); sum0 += s0[i]; sum1 += s1[i]; } \
    l += sum0 + sum1;
DI void softmax_lazy(f32x16& s0, f32x16& s1, float& mref, float& l, f32x16& o0, f32x16& o1) { SOFTMAX_BODY() }
DI void softmax_lazy(f32x16& s0, f32x16& s1, float& mref, f32x16& negm, float& l, f32x16& o0, f32x16& o1) { SOFTMAX_BODY(negm = splat16(-mref);) }
DI void store_o(bf16_t* op  , const f32x16& o0, const f32x16& o1, float l) {
    const float inv = 1.f / (l + shx(l, 32));
#pragma unroll
    for (int g = 0; g < 4; ++g) { u32x2 a, b;
        a.x = pk2(o0[4 * g] * inv, o0[4 * g + 1] * inv); a.y = pk2(o0[4 * g + 2] * inv, o0[4 * g + 3] * inv);
        b.x = pk2(o1[4 * g] * inv, o1[4 * g + 1] * inv); b.y = pk2(o1[4 * g + 2] * inv, o1[4 * g + 3] * inv);
        *(u32x2*)(op + 8 * g) = a; *(u32x2*)(op + 32 + 8 * g) = b; }
}

constexpr int GQ_KB = 128 * 144, GQ_VB = 64 * 272, GQ_BUF = GQ_KB + GQ_VB;
DI void gqa_unit(LAS unsigned char* lds, const bf16_t* Q, const bf16_t* Kb, const bf16_t* Vt, bf16_t* OB, int b, int hq, int qb, int tid) {
    const int wave = tid >> 6, lane = tid & 63, r = lane & 31, hi = lane >> 5, kvh = hq / 3;
    const int qtok = b * SEQ + qb * 256 + wave * 32 + r;
    bf16x8 qf[4];
    { const bf16_t* qp = Q + (size_t)qtok * 1024 + (4 + hq) * 64 + 8 * hi;
#pragma unroll
      for (int c = 0; c < 4; ++c) qf[c] = *(const bf16x8*)(qp + 16 * c); }
    const int kr0 = tid >> 3, kc0 = tid & 7, vr0 = tid >> 4, vc0 = tid & 15;
    const bf16_t* kg = Kb + (size_t)(b * SEQ + kr0) * 768 + (4 + kvh) * 64 + kc0 * 8;
    const bf16_t* vg = Vt + ((size_t)(b * 12 + 4 + kvh) * 64 + vr0) * SEQ + vc0 * 8;
    const int ksoff = kr0 * 144 + kc0 * 16, vsoff = GQ_KB + vr0 * 272 + vc0 * 16;
    u32x4 ka = *(const u32x4*)kg, kb2 = *(const u32x4*)(kg + (size_t)64 * 768), va = *(const u32x4*)vg, vb2 = *(const u32x4*)(vg + (size_t)32 * SEQ);
    *(LAS u32x4*)(lds + ksoff) = ka; *(LAS u32x4*)(lds + ksoff + 64 * 144) = kb2; *(LAS u32x4*)(lds + vsoff) = va; *(LAS u32x4*)(lds + vsoff + 32 * 272) = vb2;
    __syncthreads();
    float mref = 0.f, l = 0.f; f32x16 o0 = splat16(0.f), o1 = splat16(0.f), negm = splat16(0.f);
    const int koff = pi32(r) * 144 + hi * 16, voff = GQ_KB + r * 272 + hi * 16;
#define GQ_LDK(dst, base) do { _Pragma("unroll") for (int c_ = 0; c_ < 4; ++c_) { dst[c_] = *(const LAS bf16x8*)((base) + c_ * 32); dst[4 + c_] = *(const LAS bf16x8*)((base) + 32 * 144 + c_ * 32); } } while (0)
#define GQ_LDV(dst, base) do { _Pragma("unroll") for (int c_ = 0; c_ < 4; ++c_) { dst[c_] = *(const LAS bf16x8*)((base) + c_ * 32); dst[4 + c_] = *(const LAS bf16x8*)((base) + 32 * 272 + c_ * 32); } } while (0)
    for (int it = 0; it < 32; ++it) {
        const int cur = it & 1;
        if (it + 1 < 32) { const bf16_t* kn = kg + (size_t)(it + 1) * 128 * 768; const bf16_t* vn = vg + (it + 1) * 128;
            ka = *(const u32x4*)kn; kb2 = *(const u32x4*)(kn + (size_t)64 * 768); va = *(const u32x4*)vn; vb2 = *(const u32x4*)(vn + (size_t)32 * SEQ); }
        const LAS unsigned char* Bc = lds + cur * GQ_BUF;
        bf16x8 kf[8], vf[8], kf2[8];
        GQ_LDK(kf, Bc + koff);
        __builtin_amdgcn_sched_barrier(0);
        f32x16 s0 = negm, s1 = negm;
#pragma unroll
        for (int c = 0; c < 4; ++c) { s0 = mfma32(kf[c], qf[c], s0); s1 = mfma32(kf[4 + c], qf[c], s1); }
        GQ_LDV(vf, Bc + voff); GQ_LDK(kf2, Bc + 64 * 144 + koff);
        __builtin_amdgcn_sched_barrier(0);
        softmax_lazy(s0, s1, mref, negm, l, o0, o1);
#pragma unroll
        for (int s4 = 0; s4 < 4; ++s4) { const bf16x8 pf = pack8(s4 < 2 ? s0 : s1, s4 & 1); o0 = mfma32(vf[s4], pf, o0); o1 = mfma32(vf[4 + s4], pf, o1); }
        s0 = negm; s1 = negm;
#pragma unroll
        for (int c = 0; c < 4; ++c) { s0 = mfma32(kf2[c], qf[c], s0); s1 = mfma32(kf2[4 + c], qf[c], s1); }
        GQ_LDV(vf, Bc + voff + 128);
        __builtin_amdgcn_sched_barrier(0);
        softmax_lazy(s0, s1, mref, negm, l, o0, o1);
#pragma unroll
        for (int s4 = 0; s4 < 4; ++s4) { const bf16x8 pf = pack8(s4 < 2 ? s0 : s1, s4 & 1); o0 = mfma32(vf[s4], pf, o0); o1 = mfma32(vf[4 + s4], pf, o1); }
        if (it + 1 < 32) { LAS unsigned char* Bn = lds + (cur ^ 1) * GQ_BUF;
            *(LAS u32x4*)(Bn + ksoff) = ka; *(LAS u32x4*)(Bn + ksoff + 64 * 144) = kb2; *(LAS u32x4*)(Bn + vsoff) = va; *(LAS u32x4*)(Bn + vsoff + 32 * 272) = vb2; }
        __syncthreads();
    }
#undef GQ_LDK
#undef GQ_LDV
    store_o(OB + (size_t)qtok * 384 + hq * 64 + 4 * hi, o0, o1, l);
}

DI void na_unit(const LAS float* biasl, const bf16_t* Q, const bf16_t* Kb, const bf16_t* Vt, bf16_t* OA, int b, int gr, int wave, int lane) {
    const int h = wave >> 1, qh = wave & 1, r = lane & 31, hi = lane >> 5, pr = pi32(r);
    const int cq = 32 * qh + r, qtok = b * SEQ + gr * 64 + cq;
    bf16x8 qf[4];
    { const bf16_t* qp = Q + (size_t)qtok * 1024 + h * 64 + 8 * hi;
#pragma unroll
      for (int c = 0; c < 4; ++c) qf[c] = *(const bf16x8*)(qp + 16 * c); }
    const int rs = min(max(gr - 4, 0), 56), cs = min(max(cq - 8, 0), 48);
    const bf16_t* kp = Kb + (size_t)(b * SEQ + rs * 64 + pr) * 768 + h * 64 + 8 * hi;
    const bf16_t* vp = Vt + ((size_t)(b * 12 + h) * 64 + r) * SEQ + rs * 64 + 8 * hi;
    float mref = 0.f, l = 0.f; f32x16 o0 = splat16(0.f), o1 = splat16(0.f);
    bf16x8 kf[8];
#pragma unroll
    for (int c = 0; c < 4; ++c) { kf[c] = *(const bf16x8*)(kp + 16 * c); kf[4 + c] = *(const bf16x8*)(kp + 32 * 768 + 16 * c); }
#pragma unroll 1
    for (int j = 0; j < 8; ++j) {
        bf16x8 vf[8], kn[8];
        { const bf16_t* vq = vp + j * 64; const bf16_t* kq = kp + (size_t)(j < 7 ? j + 1 : j) * 64 * 768;
#pragma unroll
          for (int c = 0; c < 4; ++c) { vf[c] = *(const bf16x8*)(vq + 16 * c); vf[4 + c] = *(const bf16x8*)(vq + (size_t)32 * SEQ + 16 * c); kn[c] = *(const bf16x8*)(kq + 16 * c); kn[4 + c] = *(const bf16x8*)(kq + 32 * 768 + 16 * c); } }
        f32x16 s0 = splat16(0.f), s1 = splat16(0.f);
#pragma unroll
        for (int c = 0; c < 4; ++c) { s0 = mfma32(kf[c], qf[c], s0); s1 = mfma32(kf[4 + c], qf[c], s1); }
        const LAS float* brow = biasl + (h * 15 + (rs + j - gr + 7)) * 31 + 15 - cq;
#pragma unroll
        for (int i = 0; i < 16; ++i) { const int c0 = keyidx(i, hi), c1 = c0 + 32;
            const bool v0 = (c0 >= cs) && (c0 < cs + 16), v1 = (c1 >= cs) && (c1 < cs + 16);
            const float b0 = brow[v0 ? c0 : cq], b1 = brow[v1 ? c1 : cq];
            s0[i] = v0 ? s0[i] + (b0 - mref) : -1e30f; s1[i] = v1 ? s1[i] + (b1 - mref) : -1e30f; }
        softmax_lazy(s0, s1, mref, l, o0, o1);
#pragma unroll
        for (int s4 = 0; s4 < 4; ++s4) { const bf16x8 pf = pack8(s4 < 2 ? s0 : s1, s4 & 1); o0 = mfma32(vf[s4], pf, o0); o1 = mfma32(vf[4 + s4], pf, o1); }
#pragma unroll
        for (int c = 0; c < 8; ++c) kf[c] = kn[c];
    }
    store_o(OA + (size_t)qtok * 256 + h * 64 + 4 * hi, o0, o1, l);
}

#define DIL_LOADK(G_, KS_, KF) do { \
    constexpr int sh_ = 2 * (G_), Sd_ = SEQ >> sh_, dd_ = 1 << sh_; const int hk_ = 6 + 2 * (G_) + hs, rd_ = r16 & (dd_ - 1); \
    const bf16_t* kb_ = Kb + (size_t)(b * SEQ + rd_) * 768 + hk_ * 64 + 8 * hi; \
    const int i0_ = min(max((KS_) + pr, 0), Sd_ - 1), i1_ = min(max((KS_) + 32 + pr, 0), Sd_ - 1); \
    const bf16_t* p0_ = kb_ + (size_t)(i0_ << sh_) * 768; const bf16_t* p1_ = kb_ + (size_t)(i1_ << sh_) * 768; \
    _Pragma("unroll") for (int c_ = 0; c_ < 4; ++c_) { KF[c_] = *(const bf16x8*)(p0_ + 16 * c_); KF[4 + c_] = *(const bf16x8*)(p1_ + 16 * c_); } } while (0)
#define DIL_LOADV(G_, KS_, VF) do { \
    constexpr int sh_ = 2 * (G_), Sd_ = SEQ >> sh_, dd_ = 1 << sh_; const int hk_ = 6 + 2 * (G_) + hs, rd_ = r16 & (dd_ - 1); \
    const bf16_t* vb_ = Vt + ((size_t)(b * 12 + hk_) * 64 + r) * SEQ + rd_ * Sd_; \
    _Pragma("unroll") for (int c_ = 0; c_ < 4; ++c_) { const int g8_ = min(max((KS_) + 16 * c_ + 8 * hi, 0), Sd_ - 8); VF[c_] = *(const bf16x8*)(vb_ + g8_); VF[4 + c_] = *(const bf16x8*)(vb_ + (size_t)32 * SEQ + g8_); } } while (0)

template <int G>
DI void dil_group(const bf16_t* Q, const bf16_t* Kb, const bf16_t* Vt, int b, int hs, int r16, int ib, int qtok, int r, int hi, int pr,
                  bf16x8 (&kf)[8], float& mref, float& l, f32x16& o0, f32x16& o1) {
    constexpr int sh = 2 * G, Sd = SEQ >> sh, step = 16 >> sh;
    bf16x8 qf[4];
    { const bf16_t* qp = Q + (size_t)qtok * 1024 + (10 + 2 * G + hs) * 64 + 8 * hi;
#pragma unroll
      for (int c = 0; c < 4; ++c) qf[c] = *(const bf16x8*)(qp + 16 * c); }
    const int qd = r16 >> sh, iq = qd + step * (32 * ib + r);
    const int lo = qd + step * 32 * ib - 64, hiend = qd + step * (32 * ib + 31) + 64;
#pragma unroll 1
    for (int ks = (lo >> 5) << 5; ks <= hiend; ks += 64) {
        bf16x8 kn[8], vf[8];
        DIL_LOADV(G, ks, vf);
        const bool more = ks + 64 <= hiend;
        if (more) DIL_LOADK(G, ks + 64, kn);
        else if (G < 2) { constexpr int G1 = G < 2 ? G + 1 : 2, sh1 = 2 * G1, step1 = 16 >> sh1; const int lo1 = (r16 >> sh1) + step1 * 32 * ib - 64; DIL_LOADK(G1, (lo1 >> 5) << 5, kn); }
        else { _Pragma("unroll") for (int c = 0; c < 8; ++c) kn[c] = kf[c]; }
        f32x16 s0 = splat16(0.f), s1 = splat16(0.f);
#pragma unroll
        for (int c = 0; c < 4; ++c) { s0 = mfma32(kf[c], qf[c], s0); s1 = mfma32(kf[4 + c], qf[c], s1); }
#pragma unroll
        for (int i = 0; i < 16; ++i) { const int a0 = ks + keyidx(i, hi), a1 = a0 + 32;
            const bool v0 = (a0 >= 0) && (a0 < Sd) && (abs(a0 - iq) <= 64), v1 = (a1 >= 0) && (a1 < Sd) && (abs(a1 - iq) <= 64);
            s0[i] = v0 ? s0[i] - mref : -1e30f; s1[i] = v1 ? s1[i] - mref : -1e30f; }
        softmax_lazy(s0, s1, mref, l, o0, o1);
#pragma unroll
        for (int s4 = 0; s4 < 4; ++s4) { const bf16x8 pf = pack8(s4 < 2 ? s0 : s1, s4 & 1); o0 = mfma32(vf[s4], pf, o0); o1 = mfma32(vf[4 + s4], pf, o1); }
#pragma unroll
        for (int c = 0; c < 8; ++c) kf[c] = kn[c];
    }
}
DI void dil_unit(const bf16_t* Q, const bf16_t* Kb, const bf16_t* Vt, bf16_t* OC, int b, int hs, int r16, int ib, int lane) {
    const int r = lane & 31, hi = lane >> 5, pr = pi32(r);
    const int qtok = b * SEQ + r16 + 16 * (32 * ib + r);
    float mref = 0.f, l = 0.f; f32x16 o0 = splat16(0.f), o1 = splat16(0.f);
    bf16x8 kf[8];
    { const int lo0 = r16 + 16 * 32 * ib - 64; DIL_LOADK(0, (lo0 >> 5) << 5, kf); }
    dil_group<0>(Q, Kb, Vt, b, hs, r16, ib, qtok, r, hi, pr, kf, mref, l, o0, o1);
    dil_group<1>(Q, Kb, Vt, b, hs, r16, ib, qtok, r, hi, pr, kf, mref, l, o0, o1);
    dil_group<2>(Q, Kb, Vt, b, hs, r16, ib, qtok, r, hi, pr, kf, mref, l, o0, o1);
    bf16_t* orow = OC + (size_t)qtok * 256;
    store_o(orow + hs * 64 + 4 * hi, o0, o1, l);
    const u32x4 z = {0u, 0u, 0u, 0u};
#pragma unroll
    for (int c = 0; c < 4; ++c) *(u32x4*)(orow + 128 + hs * 64 + hi * 32 + c * 8) = z;
}

DI void phase_attn(const Ptrs& P, int layer, LAS unsigned char* lds, int tid) {
    const int wave = tid >> 6, lane = tid & 63, c = blockIdx.x;
    const bf16_t* Q = (const bf16_t*)(P.ws + WS_Q); const bf16_t* Kb = (const bf16_t*)(P.ws + WS_K); const bf16_t* Vt = (const bf16_t*)(P.ws + WS_VT);
    bf16_t* OA = (bf16_t*)(P.ws + WS_OA); bf16_t* OB = (bf16_t*)(P.ws + WS_OB); bf16_t* OC = (bf16_t*)(P.ws + WS_OC);
    LAS float* biasl = (LAS float*)(lds + LDS_SCR + 73728);
    { const float* rpb = P.in[4] + (size_t)layer * 4 * 15 * 31;
      for (int i = tid; i < 4 * 15 * 31; i += NTHR) biasl[i] = rpb[i] * LOG2E; }
    __syncthreads();
#ifndef NO_NA
    RP(16) for (int u = 0; u < 2; ++u) { const int un = 2 * c + u; na_unit(biasl, Q, Kb, Vt, OA, un >> 6, un & 63, wave, lane); }
#endif
#ifndef NO_DIL
    RP(17) { const int w = c * 8 + wave; dil_unit(Q, Kb, Vt, OC, w >> 8, (w >> 7) & 1, (w >> 3) & 15, w & 7, lane); }
#endif
#ifndef NO_GQA
    { const int xcd = c & 7, loc = c >> 3;
      RP(18) for (int i = 0; i < 3; ++i) { const int j = loc + 32 * i, pair = 2 * xcd + j / 48, jj = j % 48;
          gqa_unit(lds + LDS_SCR, Q, Kb, Vt, OB, pair >> 1, (pair & 1) * 3 + jj / 16, jj & 15, tid); } }
#endif
}


__global__ void __launch_bounds__(NTHR, 2) mk_fwd(Args a) {
    extern __shared__ __attribute__((aligned(16))) unsigned char lds_raw[];
    LAS unsigned char* lds = (LAS unsigned char*)lds_raw;
    const int tid0 = threadIdx.x;
    const int wid_s = __builtin_amdgcn_readfirstlane(tid0 >> 6);
#define OTID() ({ int l_; asm volatile("v_mbcnt_lo_u32_b32 %0, -1, 0\n\tv_mbcnt_hi_u32_b32 %0, -1, %0" : "=v"(l_)); (wid_s << 6) | l_; })
    for (int i = tid0; i < 256; i += NTHR) ((LAS unsigned*)(lds + LDS_MISC))[i] = 0u;
    __syncthreads();
#define P a
#define ws (a.ws)
    const bool multi = (a.hi - a.lo) > 1;
    XcdBarrier bar; bar.bar = (unsigned*)ws + CW_BAR; bar.x = 0; bar.st = (volatile LAS unsigned*)(lds + LDS_MISC);
    if (multi) bar = xcd_barrier_post((unsigned*)ws + CW_BAR, (volatile LAS unsigned*)(lds + LDS_MISC), tid0);
#define RUN(s) (a.lo <= (s) && (s) < a.hi)

#define SEAM() do { if (multi) xcd_barrier(bar, OTID()); } while (0)
#define H ((bf16_t*)(ws + WS_H))
#define YB ((bf16_t*)(ws + WS_YBUF))
#define ACT ((bf16_t*)(ws + WS_ACT))
#define XS ((bf16_t*)(ws + WS_XS))
#define topi ((int*)(ws + WS_TOPI))
#define topw ((float*)(ws + WS_TOPW))
#define perm ((int*)(ws + WS_PERM))
#define rgate ((float*)(ws + WS_RGATE))
#define cnt ((int*)(ws + WS_CNT))
#define G ((int)gridDim.x)
#define c ((int)blockIdx.x)

    if (PM(0) && RUN(0)) { RP(0) phase_prep(P, lds, OTID()); SEAM(); }

    for (int L = 0; L < DEPTH; ++L) {
        const int base = 1 + 10 * L;
        const bool moe = (L & 1) != 0;
        const float* xcur = (L == 0) ? P.in[0] : (const float*)P.out;
        const float* gains = P.in[1] + (size_t)L * 2 * 1024;
        if (PM(1) && RUN(base + 0)) {
            if (L == 2) phase_norm<true, false, F8_IN != 0>(P.out, P.out, YB, gains, H, nullptr, nullptr, nullptr, nullptr, nullptr, lds, OTID());
            else RP(1) phase_norm<false, false, F8_IN != 0>(xcur, nullptr, nullptr, gains, H, nullptr, nullptr, nullptr, nullptr, nullptr, lds, OTID());
            SEAM(); }
        if (PM(2) && RUN(base + 1)) {
            pg8::Gemm g{H, (const bf16_t*)(ws + WS_W_IN + (size_t)L * INW * 1024 * (F8_IN ? 1 : 2)), F8_IN ? 512 : 1024, 0x7A7A7A7A}; pg8::StaticOrder S; S.init(NTOK, INW, G, c);
            EpiIn E{(bf16_t*)(ws + WS_Q), (bf16_t*)(ws + WS_K), (bf16_t*)(ws + WS_VRAW), (bf16_t*)(ws + WS_G)};
            RP(2) pg8::gemm_phase<EpiIn, pg8::StaticOrder, true, true, F8_IN != 0>(lds + LDS_SCR, g, S, E, OTID());
            SEAM(); }
        if (PM(3) && RUN(base + 2)) { phase_qkvprep(P, L, lds, OTID()); SEAM(); }
        if (PM(4) && RUN(base + 3)) { RP(4) phase_attn(P, L, lds, OTID()); SEAM(); }
        if (PM(5) && RUN(base + 4)) {
            RP(5) for (int br = 0; br < 3; ++br) {
                const bf16_t* A = (const bf16_t*)(ws + (br == 0 ? WS_OA : (br == 1 ? WS_OB : WS_OC)));
                const int K = br == 1 ? 384 : 256;
                const bf16_t* Bt = (const bf16_t*)(ws + (br == 0 ? WS_W_BRA : (br == 1 ? WS_W_BRB : WS_W_BRC))) + (size_t)L * 1024 * K;
                pg8::Gemm g{A, Bt, K, 0}; pg8::StaticOrder S; S.init(NTOK, 1024, G, c);
                EpiGate E{(const bf16_t*)(ws + WS_G), br * 1024, (bf16_t*)(ws + WS_MERGED), br == 0 ? 1 : 0};
                pg8::gemm_phase<EpiGate, pg8::StaticOrder, true, true>(lds + LDS_SCR, g, S, E, OTID());
            }
            SEAM(); }
        if (PM(6) && RUN(base + 5)) {
            pg8::Gemm g{(const bf16_t*)(ws + WS_MERGED), (const bf16_t*)(ws + WS_W_OUT) + (size_t)L * 1024 * 1024, 1024, 0}; pg8::StaticOrder S; S.init(NTOK, 1024, G, c);
            EpiResid E{xcur, P.out};
            pg8::gemm_phase<EpiResid, pg8::StaticOrder, true, true>(lds + LDS_SCR, g, S, E, OTID());
            if ((REPM >> 6) & 1u) { EpiResid E2{xcur, (float*)(ws + WS_DBG)}; pg8::gemm_phase<EpiResid, pg8::StaticOrder, true, true>(lds + LDS_SCR, g, S, E2, OTID()); }
            SEAM(); }
        if (!moe) {
            if (PM(7) && RUN(base + 6)) { RP(7) phase_norm<false, false, F8_FFN != 0>(P.out, nullptr, nullptr, gains + 1024, H, nullptr, nullptr, nullptr, nullptr, nullptr, lds, OTID()); SEAM(); }
            if (PM(8) && RUN(base + 7)) {
                pg8::Gemm g{H, (const bf16_t*)(ws + WS_W_FGU + (size_t)(L >> 1) * 2 * FF * 1024 * (F8_FFN ? 1 : 2)), F8_FFN ? 512 : 1024, 0x7A7A7A7A}; pg8::StaticOrder S; S.init(NTOK, 2 * FF, G, c);
                EpiSwiglu<F8_FFN != 0> E{(unsigned char*)ACT, FF};
                RP(8) pg8::gemm_phase<EpiSwiglu<F8_FFN != 0>, pg8::StaticOrder, true, true, F8_FFN != 0>(lds + LDS_SCR, g, S, E, OTID());
                SEAM(); }
            if (PM(9) && RUN(base + 8)) {
                pg8::Gemm g{ACT, (const bf16_t*)(ws + WS_W_FDN + (size_t)(L >> 1) * 1024 * FF * (F8_FFN ? 1 : 2)), F8_FFN ? FF / 2 : FF, 0x79797979}; pg8::StaticOrder S; S.init(NTOK, 1024, G, c);
                EpiResid E{P.out, P.out};
                if ((REPM >> 9) & 1u) { EpiResid E2{P.out, (float*)(ws + WS_DBG)}; pg8::gemm_phase<EpiResid, pg8::StaticOrder, true, true, F8_FFN != 0>(lds + LDS_SCR, g, S, E2, OTID()); }
                pg8::gemm_phase<EpiResid, pg8::StaticOrder, true, true, F8_FFN != 0>(lds + LDS_SCR, g, S, E, OTID());
                SEAM(); }
        } else {
            const int li = L >> 1;
            const bool f8 = ((F8_MOE >> li) & 1) != 0;
            if (PM(10) && RUN(base + 6)) {
                if (f8) RP(10) phase_norm<false, true, true>(P.out, nullptr, nullptr, gains + 1024, H, P.in[9] + (size_t)li * 1024 * 8, topi, topw, cnt, perm, lds, OTID());
                else RP(10) phase_norm<false, true, false>(P.out, nullptr, nullptr, gains + 1024, H, P.in[9] + (size_t)li * 1024 * 8, topi, topw, cnt, perm, lds, OTID());
                SEAM(); }
            if (PM(11) && RUN(base + 7)) {
                if (f8) RP(11) phase_scatter<true>(cnt, topi, topw, H, XS, perm, rgate, lds, OTID());
                else RP(11) phase_scatter<false>(cnt, topi, topw, H, XS, perm, rgate, lds, OTID());
                SEAM(); }
            if ((PM(12) || PM(13)) && (RUN(base + 8) || RUN(base + 9))) {
                volatile LAS int* misc = (volatile LAS int*)(lds + LDS_MISC + 64);
                moe_totals(cnt, misc, OTID());
                pg8::GroupedOrder S; S.c8 = c & 7; S.loc = c >> 3; S.per = G >> 3;
                S.tp[0] = 0;
#pragma unroll
                for (int e = 0; e < 8; ++e) S.tp[e + 1] = S.tp[e] + ((__builtin_amdgcn_readfirstlane(misc[e]) + 255) >> 8);
                if (PM(12) && RUN(base + 8)) {
                    S.nN = 2 * ED / 256;
                    if (f8) { S.bstride = (long)2 * ED * 1024;
                        pg8::Gemm g{XS, (const bf16_t*)(ws + WS_W_MGU + (size_t)li * 8 * 2 * ED * 1024 * 2), 512, 0x7A7A7A7A};
                        EpiSwiglu<true> E{(unsigned char*)ACT, ED};
                        RP(12) pg8::gemm_phase<EpiSwiglu<true>, pg8::GroupedOrder, true, true, true>(lds + LDS_SCR, g, S, E, OTID()); }
                    else { S.bstride = (long)2 * ED * 1024 * 2;
                        pg8::Gemm g{XS, (const bf16_t*)(ws + WS_W_MGU + (size_t)li * 8 * 2 * ED * 1024 * 2), 1024, 0};
                        EpiSwiglu<false> E{(unsigned char*)ACT, ED};
                        RP(12) pg8::gemm_phase<EpiSwiglu<false>, pg8::GroupedOrder, true, true, false>(lds + LDS_SCR, g, S, E, OTID()); }
                    SEAM(); }
                if (PM(13) && RUN(base + 9)) {
                    S.nN = 4;
                    EpiMoeDown E{perm, rgate, YB};
                    if (f8) { S.bstride = (long)1024 * ED;
                        pg8::Gemm g{ACT, (const bf16_t*)(ws + WS_W_MDN + (size_t)li * 8 * 1024 * ED * 2), ED / 2, 0x79797979};
                        RP(13) pg8::gemm_phase<EpiMoeDown, pg8::GroupedOrder, true, true, true>(lds + LDS_SCR, g, S, E, OTID()); }
                    else { S.bstride = (long)1024 * ED * 2;
                        pg8::Gemm g{ACT, (const bf16_t*)(ws + WS_W_MDN + (size_t)li * 8 * 1024 * ED * 2), ED, 0};
                        RP(13) pg8::gemm_phase<EpiMoeDown, pg8::GroupedOrder, true, true, false>(lds + LDS_SCR, g, S, E, OTID()); }
                    SEAM(); }
            }
        }
    }
    if (PM(14) && RUN(41)) phase_final(P.out, YB, P.out, OTID());
#undef RUN
#undef SEAM
#undef P
#undef ws
#undef H
#undef YB
#undef ACT
#undef XS
#undef topi
#undef topw
#undef perm
#undef rgate
#undef cnt
#undef G
#undef c
}

#if MK_DEBUG
DI unsigned hsh(unsigned x) { x ^= x >> 16; x *= 0x7feb352du; x ^= x >> 15; x *= 0x846ca68bu; x ^= x >> 16; return x; }
DI void rep(unsigned* ctl, int slot, float got, float ref, float scale) { float e = fabsf(got - ref) / (fabsf(ref) + scale); if (!(e == e) || e > 1e30f) e = 1e30f; atomicMax(ctl + CW_ERR + slot, __float_as_uint(e)); }
DI float dotbf(const bf16_t* a, const bf16_t* b, int K, int lane) { float s = 0.f; for (int k = lane; k < K; k += 64) s += bf2f(a[k]) * bf2f(b[k]); return wave_sum(s); }
DI float rbf(float x) { return bflo(pk2(x, 0.f) & 0xffffu); }

__global__ void chk_prep(Args a) {
    unsigned* ctl = (unsigned*)a.ws; const unsigned h0 = hsh(blockIdx.x * 64 + threadIdx.x + 1);
    unsigned h = h0;
#define NXT() (h = hsh(h + 0x9e3779b9u))
    { const int L = NXT() % 4, n = NXT() % 5632, k = NXT() % 1024; rep(ctl, 0, bf2f(((const bf16_t*)(a.ws + WS_W_IN))[((size_t)L * 5632 + n) * 1024 + k]), rbf(a.in[2][((size_t)L * 1024 + k) * 5632 + n]), 1e-3f); }
    { const int L = NXT() % 4, n = NXT() % 1024, k = NXT() % 256; rep(ctl, 0, bf2f(((const bf16_t*)(a.ws + WS_W_BRA))[((size_t)L * 1024 + n) * 256 + k]), rbf(a.in[5][((size_t)L * 768 + k) * 1024 + n]), 1e-3f); }
    { const int L = NXT() % 4, n = NXT() % 1024, k = NXT() % 384; rep(ctl, 0, bf2f(((const bf16_t*)(a.ws + WS_W_BRB))[((size_t)L * 1024 + n) * 384 + k]), rbf(a.in[5][((size_t)L * 768 + 256 + k) * 1024 + n]), 1e-3f); }
    { const int L = NXT() % 4, n = NXT() % 1024, k = NXT() % 256; rep(ctl, 0, bf2f(((const bf16_t*)(a.ws + WS_W_BRC))[((size_t)L * 1024 + n) * 256 + k]), k < 128 ? rbf(a.in[5][((size_t)L * 768 + 640 + k) * 1024 + n]) : 0.f, 1e-3f); }
    { const int L = NXT() % 4, n = NXT() % 1024, k = NXT() % 1024; rep(ctl, 0, bf2f(((const bf16_t*)(a.ws + WS_W_OUT))[((size_t)L * 1024 + n) * 1024 + k]), rbf(a.in[6][((size_t)L * 1024 + k) * 1024 + n]), 1e-3f); }
    { const int L = NXT() % 2, n = NXT() % 5632, k = NXT() % 1024, pn = n >> 8, j = n & 255, cc = j < 128 ? pn * 128 + j : FF + pn * 128 + j - 128;
      rep(ctl, 0, bf2f(((const bf16_t*)(a.ws + WS_W_FGU))[((size_t)L * 5632 + n) * 1024 + k]), rbf(a.in[7][((size_t)L * 1024 + k) * 5632 + cc]), 1e-3f); }
    { const int L = NXT() % 2, n = NXT() % 1024, k = NXT() % 2816; rep(ctl, 0, bf2f(((const bf16_t*)(a.ws + WS_W_FDN))[((size_t)L * 1024 + n) * 2816 + k]), rbf(a.in[8][((size_t)L * 2816 + k) * 1024 + n]), 1e-3f); }
    { const int L = NXT() % 16, n = NXT() % 7168, k = NXT() % 1024, pn = n >> 8, j = n & 255, cc = j < 128 ? pn * 128 + j : ED + pn * 128 + j - 128;
      rep(ctl, 0, bf2f(((const bf16_t*)(a.ws + WS_W_MGU))[((size_t)L * 7168 + n) * 1024 + k]), rbf(a.in[10][((size_t)L * 1024 + k) * 7168 + cc]), 1e-3f); }
    { const int L = NXT() % 16, n = NXT() % 1024, k = NXT() % 3584; rep(ctl, 0, bf2f(((const bf16_t*)(a.ws + WS_W_MDN))[((size_t)L * 1024 + n) * 3584 + k]), rbf(a.in[11][((size_t)L * 3584 + k) * 1024 + n]), 1e-3f); }
#undef NXT
}
__global__ void chk_norm(Args a, const float* xin, const float* gain, int comb, int slot) {
    unsigned* ctl = (unsigned*)a.ws; const int lane = threadIdx.x; const int row = blockIdx.x == 0 ? 0 : (blockIdx.x == 1 ? NTOK - 1 : hsh(blockIdx.x * 7 + slot) % NTOK);
    const bf16_t* H = (const bf16_t*)(a.ws + WS_H); const bf16_t* yb = (const bf16_t*)(a.ws + WS_YBUF);
    float v[16], ss = 0.f;
    for (int j = 0; j < 16; ++j) { const int cidx = lane + 64 * j; float x = xin[(size_t)row * 1024 + cidx];
        if (comb) { x += bf2f(yb[(size_t)row * 1024 + cidx]) + bf2f(yb[((size_t)NTOK + row) * 1024 + cidx]); rep(ctl, slot, a.out[(size_t)row * 1024 + cidx], x, 1e-2f); }
        v[j] = x; ss += x * x; }
    const float rstd = 1.f / sqrtf(wave_sum(ss) / 1024.f + EPS);
    for (int j = 0; j < 16; ++j) { const int cidx = lane + 64 * j; rep(ctl, slot, bf2f(H[(size_t)row * 1024 + cidx]), v[j] * rstd * gain[cidx], 2e-2f); }
}
__global__ void chk_gemm_in(Args a, int L) {
    unsigned* ctl = (unsigned*)a.ws; const int lane = threadIdx.x; unsigned h = hsh(blockIdx.x + 77 * L + 5);
    const int row = blockIdx.x < 4 ? (blockIdx.x & 1 ? NTOK - 1 : 0) : h % NTOK; h = hsh(h + 1); const int col = blockIdx.x < 2 ? 0 : (blockIdx.x < 4 ? INW - 1 : h % INW);
    const float d = dotbf((const bf16_t*)(a.ws + WS_H) + (size_t)row * 1024, (const bf16_t*)(a.ws + WS_W_IN) + ((size_t)L * INW + col) * 1024, 1024, lane);
    float got;
    if (col < 1024) got = bf2f(((const bf16_t*)(a.ws + WS_Q))[(size_t)row * 1024 + col]);
    else if (col < 1792) got = bf2f(((const bf16_t*)(a.ws + WS_K))[(size_t)row * 768 + col - 1024]);
    else if (col < 2560) got = bf2f(((const bf16_t*)(a.ws + WS_VRAW))[(size_t)row * 768 + col - 1792]);
    else got = bf2f(((const bf16_t*)(a.ws + WS_G))[(size_t)row * 3072 + col - 2560]);
    const float ref = col < 2560 ? d : 1.f / (1.f + expf(-d));
    if (lane == 0) rep(ctl, 2, got, ref, 5e-2f);
}
__global__ void chk_qk(Args a, int L) {
    unsigned* ctl = (unsigned*)a.ws; const int j = threadIdx.x; unsigned h = hsh(blockIdx.x + 131 * L + 9);
    const int tok = blockIdx.x == 0 ? 0 : (blockIdx.x == 1 ? NTOK - 1 : h % NTOK); h = hsh(h + 1); const int isk = h & 1; h = hsh(h + 1); const int head = h % (isk ? 12 : 16);
    const int col = (isk ? 1024 : 0) + head * 64 + j;
    const bf16_t* hr = (const bf16_t*)(a.ws + WS_H) + (size_t)tok * 1024; const bf16_t* wr = (const bf16_t*)(a.ws + WS_W_IN) + ((size_t)L * INW + col) * 1024;
    float d = 0.f; for (int k = 0; k < 1024; ++k) d += bf2f(hr[k]) * bf2f(wr[k]);
    d = rbf(d);
    const float rstd = 1.f / sqrtf(wave_sum(d * d) / 64.f + EPS);
    const int br = isk ? (head < 4 ? 0 : (head < 6 ? 1 : 2)) : (head < 4 ? 0 : (head < 10 ? 1 : 2));
    const float y = d * rstd * a.in[3][((size_t)(L * 3 + br) * 2 + isk) * 64 + j];
    const int s = tok & 4095; float o = y;
    if (br == 2) { const int i = j & 31; const float ang = (float)s * powf(10000.f, -(float)(2 * i) / 64.f); const float p = __shfl_xor(y, 32); o = j < 32 ? y * cosf(ang) - p * sinf(ang) : y * cosf(ang) + p * sinf(ang); }
    if (br == 1) { const int i = j & 15; const float pos = (float)((j < 32) ? (s >> 6) : (s & 63)); const float ang = pos * powf(10000.f, -(float)(2 * i) / 32.f); const float p = __shfl_xor(y, 16);
        o = (j & 16) == 0 ? y * cosf(ang) - p * sinf(ang) : y * cosf(ang) + p * sinf(ang); }
    if (!isk) o *= QSCALE;
    const float got = isk ? bf2f(((const bf16_t*)(a.ws + WS_K))[(size_t)tok * 768 + head * 64 + j]) : bf2f(((const bf16_t*)(a.ws + WS_Q))[(size_t)tok * 1024 + head * 64 + j]);
    rep(ctl, 3, got, o, 3e-2f);
}
__global__ void chk_vt(Args a) {
    unsigned* ctl = (unsigned*)a.ws; unsigned h = hsh(blockIdx.x * 64 + threadIdx.x + 3);
    const int b = h % 8; h = hsh(h + 1); const int hv = h % 12; h = hsh(h + 1); const int d = h % 64; h = hsh(h + 1); const int s = h % 4096;
    const int g = hv < 6 ? 0 : (hv - 6) >> 1, dd = 1 << (2 * g), Sd = 4096 / dd, pos = (s % dd) * Sd + s / dd;
    rep(ctl, 4, bf2f(((const bf16_t*)(a.ws + WS_VT))[((size_t)(b * 12 + hv) * 64 + d) * 4096 + pos]), bf2f(((const bf16_t*)(a.ws + WS_VRAW))[(size_t)(b * 4096 + s) * 768 + hv * 64 + d]), 1e-3f);
}
DI float dot64(const bf16_t* x, const bf16_t* y) { float s = 0.f; for (int k = 0; k < 64; ++k) s += bf2f(x[k]) * bf2f(y[k]); return s; }
__global__ void chk_na(Args a, int L) {
    __shared__ float p[128]; unsigned* ctl = (unsigned*)a.ws; const int t = threadIdx.x; unsigned h = hsh(blockIdx.x + 31 * L + 11);
    const int tok = blockIdx.x == 0 ? 0 : (blockIdx.x == 1 ? NTOK - 1 : h % NTOK); h = hsh(h + 1); const int hd = h % 4;
    const int b = tok >> 12, s = tok & 4095, gr = s >> 6, cq = s & 63, rs = min(max(gr - 4, 0), 56), cs = min(max(cq - 8, 0), 48);
    const bf16_t* Q = (const bf16_t*)(a.ws + WS_Q); const bf16_t* Kb = (const bf16_t*)(a.ws + WS_K); const bf16_t* V = (const bf16_t*)(a.ws + WS_VRAW);
    float mx = -1e30f;
    for (int q = 0; q < 2; ++q) { const int idx = t + 64 * q, kr = rs + idx / 16, ck = cs + idx % 16, kt = b * 4096 + kr * 64 + ck;
        const float sc = dot64(Q + (size_t)tok * 1024 + hd * 64, Kb + (size_t)kt * 768 + hd * 64) + LOG2E * a.in[4][(((size_t)L * 4 + hd) * 15 + (kr - gr + 7)) * 31 + (ck - cq + 15)];
        p[idx] = sc; mx = fmaxf(mx, sc); }
    for (int o = 1; o < 64; o <<= 1) mx = fmaxf(mx, __shfl_xor(mx, o));
    __syncthreads();
    float sum = 0.f, acc = 0.f;
    for (int idx = 0; idx < 128; ++idx) { const int kr = rs + idx / 16, ck = cs + idx % 16, kt = b * 4096 + kr * 64 + ck; const float e = exp2f(p[idx] - mx); sum += e; acc += e * bf2f(V[(size_t)kt * 768 + hd * 64 + t]); }
    rep(ctl, 5, bf2f(((const bf16_t*)(a.ws + WS_OA))[(size_t)tok * 256 + hd * 64 + t]), acc / sum, 3e-2f);
}
__global__ void chk_dil(Args a, int L) {
    __shared__ float p[3][192]; unsigned* ctl = (unsigned*)a.ws; const int t = threadIdx.x; unsigned h = hsh(blockIdx.x + 37 * L + 13);
    const int tok = blockIdx.x == 0 ? 0 : (blockIdx.x == 1 ? NTOK - 1 : (blockIdx.x == 2 ? 4095 : (blockIdx.x == 3 ? 4096 + 70 : h % NTOK))); h = hsh(h + 1); const int hs = h & 1;
    const int b = tok >> 12, s = tok & 4095;
    const bf16_t* Q = (const bf16_t*)(a.ws + WS_Q); const bf16_t* Kb = (const bf16_t*)(a.ws + WS_K); const bf16_t* V = (const bf16_t*)(a.ws + WS_VRAW);
    float lse[3], og[3];
    for (int g = 0; g < 3; ++g) { const int dd = 1 << (2 * g), hq = 10 + 2 * g + hs, hk = 6 + 2 * g + hs; float mx = -1e30f;
        for (int q = 0; q < 3; ++q) { const int idx = t + 64 * q; if (idx < 129) { const int pos = s + dd * (idx - 64); float sc = -1e30f;
            if (pos >= 0 && pos < 4096) sc = dot64(Q + (size_t)tok * 1024 + hq * 64, Kb + (size_t)(b * 4096 + pos) * 768 + hk * 64);
            p[g][idx] = sc; mx = fmaxf(mx, sc); } }
        for (int o = 1; o < 64; o <<= 1) mx = fmaxf(mx, __shfl_xor(mx, o));
        __syncthreads();
        float sum = 0.f, acc = 0.f;
        for (int idx = 0; idx < 129; ++idx) { const int pos = s + dd * (idx - 64); if (pos >= 0 && pos < 4096) { const float e = exp2f(p[g][idx] - mx); sum += e; acc += e * bf2f(V[(size_t)(b * 4096 + pos) * 768 + hk * 64 + t]); } }
        lse[g] = mx + log2f(sum); og[g] = acc / sum; }
    const float M = fmaxf(lse[0], fmaxf(lse[1], lse[2])); const float w0 = exp2f(lse[0] - M), w1 = exp2f(lse[1] - M), w2 = exp2f(lse[2] - M);
    rep(ctl, 6, bf2f(((const bf16_t*)(a.ws + WS_OC))[(size_t)tok * 256 + hs * 64 + t]), (w0 * og[0] + w1 * og[1] + w2 * og[2]) / (w0 + w1 + w2), 3e-2f);
    rep(ctl, 6, bf2f(((const bf16_t*)(a.ws + WS_OC))[(size_t)tok * 256 + 128 + hs * 64 + t]), 0.f, 1e-3f);
}
__global__ void chk_gqa(Args a, int L) {
    __shared__ float p[4096]; unsigned* ctl = (unsigned*)a.ws; const int t = threadIdx.x; unsigned h = hsh(blockIdx.x + 41 * L + 17);
    const int tok = blockIdx.x == 0 ? 0 : (blockIdx.x == 1 ? NTOK - 1 : h % NTOK); h = hsh(h + 1); const int hq = h % 6, kvh = hq / 3, b = tok >> 12;
    const bf16_t* Q = (const bf16_t*)(a.ws + WS_Q); const bf16_t* Kb = (const bf16_t*)(a.ws + WS_K); const bf16_t* V = (const bf16_t*)(a.ws + WS_VRAW);
    float mx = -1e30f;
    for (int k = t; k < 4096; k += 64) { const float sc = dot64(Q + (size_t)tok * 1024 + (4 + hq) * 64, Kb + (size_t)(b * 4096 + k) * 768 + (4 + kvh) * 64); p[k] = sc; mx = fmaxf(mx, sc); }
    for (int o = 1; o < 64; o <<= 1) mx = fmaxf(mx, __shfl_xor(mx, o));
    __syncthreads();
    float sum = 0.f, acc = 0.f;
    for (int k = 0; k < 4096; ++k) { const float e = exp2f(p[k] - mx); sum += e; acc += e * bf2f(V[(size_t)(b * 4096 + k) * 768 + (4 + kvh) * 64 + t]); }
    rep(ctl, 7, bf2f(((const bf16_t*)(a.ws + WS_OB))[(size_t)tok * 384 + hq * 64 + t]), acc / sum, 3e-2f);
}
__global__ void chk_gate(Args a, int L) {
    unsigned* ctl = (unsigned*)a.ws; const int lane = threadIdx.x; unsigned h = hsh(blockIdx.x + 43 * L + 19);
    const int row = blockIdx.x < 2 ? (blockIdx.x ? NTOK - 1 : 0) : h % NTOK; h = hsh(h + 1); const int col = blockIdx.x < 2 ? (blockIdx.x ? 1023 : 0) : h % 1024;
    const float ya = dotbf((const bf16_t*)(a.ws + WS_OA) + (size_t)row * 256, (const bf16_t*)(a.ws + WS_W_BRA) + ((size_t)L * 1024 + col) * 256, 256, lane);
    const float yb = dotbf((const bf16_t*)(a.ws + WS_OB) + (size_t)row * 384, (const bf16_t*)(a.ws + WS_W_BRB) + ((size_t)L * 1024 + col) * 384, 384, lane);
    const float yc = dotbf((const bf16_t*)(a.ws + WS_OC) + (size_t)row * 256, (const bf16_t*)(a.ws + WS_W_BRC) + ((size_t)L * 1024 + col) * 256, 256, lane);
    const bf16_t* G = (const bf16_t*)(a.ws + WS_G) + (size_t)row * 3072;
    const float ref = bf2f(G[col]) * ya + bf2f(G[1024 + col]) * yb + bf2f(G[2048 + col]) * yc;
    if (lane == 0) rep(ctl, 8, bf2f(((const bf16_t*)(a.ws + WS_MERGED))[(size_t)row * 1024 + col]), ref, 5e-2f);
}
__global__ void chk_resid(Args a, const float* xold, const bf16_t* A, const bf16_t* Bt, int K, int slot) {
    unsigned* ctl = (unsigned*)a.ws; const int lane = threadIdx.x; unsigned h = hsh(blockIdx.x + 47 * slot + 23);
    const int row = blockIdx.x < 2 ? (blockIdx.x ? NTOK - 1 : 0) : h % NTOK; h = hsh(h + 1); const int col = blockIdx.x < 2 ? (blockIdx.x ? 1023 : 0) : h % 1024;
    const float d = dotbf(A + (size_t)row * K, Bt + (size_t)col * K, K, lane);
    if (lane == 0) rep(ctl, slot, a.out[(size_t)row * 1024 + col], xold[(size_t)row * 1024 + col] + d, 5e-2f);
}
__global__ void chk_router(Args a, const float* gain, const float* wr) {
    unsigned* ctl = (unsigned*)a.ws; const int lane = threadIdx.x; const int row = blockIdx.x == 0 ? 0 : (blockIdx.x == 1 ? NTOK - 1 : hsh(blockIdx.x + 29) % NTOK);
    float v[16], ss = 0.f;
    for (int j = 0; j < 16; ++j) { v[j] = a.out[(size_t)row * 1024 + lane + 64 * j]; ss += v[j] * v[j]; }
    const float rstd = 1.f / sqrtf(wave_sum(ss) / 1024.f + EPS);
    float lg[8];
    for (int e = 0; e < 8; ++e) { float s = 0.f; for (int j = 0; j < 16; ++j) { const int k = lane + 64 * j; s += v[j] * rstd * gain[k] * wr[k * 8 + e]; } lg[e] = wave_sum(s); }
    int e0 = 0; for (int e = 1; e < 8; ++e) if (lg[e] > lg[e0]) e0 = e;
    int e1 = e0 == 0 ? 1 : 0; for (int e = 0; e < 8; ++e) if (e != e0 && lg[e] > lg[e1]) e1 = e;
    float third = -1e30f; for (int e = 0; e < 8; ++e) if (e != e0 && e != e1) third = fmaxf(third, lg[e]);
    const int* topi = (const int*)(a.ws + WS_TOPI); const float* topw = (const float*)(a.ws + WS_TOPW);
    if (lane == 0) { const bool clear = (lg[e0] - lg[e1] > 1e-3f) && (lg[e1] - third > 1e-3f);
        if (clear) { rep(ctl, 13, (float)topi[row * 2], (float)e0, 1e-3f); rep(ctl, 13, (float)topi[row * 2 + 1], (float)e1, 1e-3f);
            const float t = expf(lg[e1] - lg[e0]); rep(ctl, 13, topw[row * 2], 1.f / (1.f + t), 1e-2f); rep(ctl, 13, topw[row * 2 + 1], t / (1.f + t), 1e-2f); } }
}
__global__ void chk_up(Args a, const bf16_t* A, const bf16_t* Wt, int ffd, int slot) {
    unsigned* ctl = (unsigned*)a.ws; const int lane = threadIdx.x; unsigned h = hsh(blockIdx.x + 53 * slot + 3);
    const int row = blockIdx.x < 2 ? (blockIdx.x ? NTOK - 1 : 0) : h % NTOK; h = hsh(h + 1); const int j = blockIdx.x < 2 ? (blockIdx.x ? ffd - 1 : 0) : h % ffd;
    const int pn = j >> 7, jj = j & 127;
    const float g = dotbf(A + (size_t)row * 1024, Wt + (size_t)(256 * pn + jj) * 1024, 1024, lane), u = dotbf(A + (size_t)row * 1024, Wt + (size_t)(256 * pn + 128 + jj) * 1024, 1024, lane);
    if (lane == 0) rep(ctl, slot, bf2f(((const bf16_t*)(a.ws + WS_ACT))[(size_t)row * ffd + j]), g / (1.f + expf(-g)) * u, 3e-2f);
}
__global__ void chk_scatter(Args a) {
    unsigned* ctl = (unsigned*)a.ws; const int lane = threadIdx.x; const int* cnt = (const int*)(a.ws + WS_CNT); const int* perm = (const int*)(a.ws + WS_PERM);
    const int* topi = (const int*)(a.ws + WS_TOPI); const float* topw = (const float*)(a.ws + WS_TOPW); const float* rg = (const float*)(a.ws + WS_RGATE);
    int tot[8], base[9]; base[0] = 0;
    for (int e = 0; e < 8; ++e) { int s = 0; for (int w = lane; w < 256; w += 64) s += cnt[w * 8 + e]; for (int o = 1; o < 64; o <<= 1) s += __shfl_xor(s, o); tot[e] = s; base[e + 1] = base[e] + ((s + 255) >> 8 << 8); }
    if (blockIdx.x == 0) { int sum = 0; for (int e = 0; e < 8; ++e) sum += tot[e]; if (lane == 0) rep(ctl, 14, (float)sum, 65536.f, 1e-3f);
        unsigned long long cs = 0; int nv = 0; for (int i = lane; i < MROWS; i += 64) { const int p = perm[i]; if (p >= 0) { cs += (unsigned long long)p; ++nv; } }
        for (int o = 1; o < 64; o <<= 1) { cs += __shfl_xor(cs, o); nv += __shfl_xor(nv, o); }
        if (lane == 0) { rep(ctl, 14, (float)nv, 65536.f, 1e-3f); rep(ctl, 14, (float)(cs == 65536ull * 65535ull / 2ull), 1.f, 1e-3f); } }
    const int pos = hsh(blockIdx.x + 5) % MROWS; const int p = perm[pos];
    int e = 0; for (int k = 1; k < 8; ++k) e += pos >= base[k];
    const bool inr = pos < base[e] + tot[e];
    if (lane == 0) rep(ctl, 14, (float)(p >= 0), (float)inr, 1e-3f);
    if (p >= 0 && inr) { const int tok = p >> 1, slot = p & 1;
        if (lane == 0) { rep(ctl, 14, (float)topi[tok * 2 + slot], (float)e, 1e-3f); rep(ctl, 14, rg[pos], topw[tok * 2 + slot], 1e-3f); }
        for (int j = 0; j < 16; ++j) rep(ctl, 14, bf2f(((const bf16_t*)(a.ws + WS_XS))[(size_t)pos * 1024 + lane + 64 * j]), bf2f(((const bf16_t*)(a.ws + WS_H))[(size_t)tok * 1024 + lane + 64 * j]), 1e-3f); }
}
__global__ void chk_moe(Args a, int li, int down) {
    unsigned* ctl = (unsigned*)a.ws; const int lane = threadIdx.x; const int* perm = (const int*)(a.ws + WS_PERM); const int* topi = (const int*)(a.ws + WS_TOPI); const float* rg = (const float*)(a.ws + WS_RGATE);
    unsigned h = hsh(blockIdx.x + 59 * down + 7); int pos = h % MROWS; while (perm[pos] < 0) pos = (pos + 1) % MROWS;
    const int p = perm[pos], tok = p >> 1, slot = p & 1, e = topi[tok * 2 + slot]; h = hsh(h + 1);
    if (!down) { const int j = h % ED, pn = j >> 7, jj = j & 127; const bf16_t* Wt = (const bf16_t*)(a.ws + WS_W_MGU) + (size_t)(li * 8 + e) * 2 * ED * 1024; const bf16_t* A = (const bf16_t*)(a.ws + WS_XS) + (size_t)pos * 1024;
        const float g = dotbf(A, Wt + (size_t)(256 * pn + jj) * 1024, 1024, lane), u = dotbf(A, Wt + (size_t)(256 * pn + 128 + jj) * 1024, 1024, lane);
        if (lane == 0) rep(ctl, 15, bf2f(((const bf16_t*)(a.ws + WS_ACT))[(size_t)pos * ED + j]), g / (1.f + expf(-g)) * u, 3e-2f); }
    else { const int col = h % 1024; const float d = dotbf((const bf16_t*)(a.ws + WS_ACT) + (size_t)pos * ED, (const bf16_t*)(a.ws + WS_W_MDN) + ((size_t)(li * 8 + e) * 1024 + col) * ED, ED, lane);
        if (lane == 0) rep(ctl, 16, bf2f(((const bf16_t*)(a.ws + WS_YBUF))[((size_t)slot * NTOK + tok) * 1024 + col]), rg[pos] * d, 3e-2f); }
}
__global__ void chk_final(Args a, const float* xold) {
    unsigned* ctl = (unsigned*)a.ws; const size_t i = hsh(blockIdx.x * 64 + threadIdx.x + 9) % ((size_t)NTOK * 1024); const bf16_t* yb = (const bf16_t*)(a.ws + WS_YBUF);
    rep(ctl, 18, a.out[i], xold[i] + bf2f(yb[i]) + bf2f(yb[(size_t)NTOK * 1024 + i]), 1e-2f);
}
__global__ void chk_report(Args a) {
    const unsigned* ctl = (const unsigned*)a.ws; int code = -1;
    for (int s = 18; s >= 0; --s) { const float e = __uint_as_float(ctl[CW_ERR + s]); const float tol = (s == 0 || s == 4 || s == 14) ? 1e-3f : 0.08f; if (e > tol) code = s; }
    if (code >= 0) { float v = 10.f; for (int k = 0; k < code; ++k) v *= 10.f;
        for (size_t i = (size_t)blockIdx.x * blockDim.x + threadIdx.x; i < (size_t)NTOK * 1024; i += (size_t)gridDim.x * blockDim.x) a.out[i] = v; }
}
#endif

extern "C" void kernel_launch(void* const* d_in, const int* in_sizes, int n_in, void* d_out, int out_size, void* d_ws, size_t ws_size, hipStream_t stream) {
    static int ready = 0;
    if (ready == 0) {
        ready = -1;
        if (n_in != 12 || out_size != NTOK * 1024 || ws_size < WS_END + (MK_DEBUG ? (size_t)128 * MiB : 0)) { fprintf(stderr, "kernel_launch: unexpected shapes / workspace (%d inputs, out %d, ws %zu)\n", n_in, out_size, ws_size); return; }
        if (hipFuncSetAttribute((const void*)mk_fwd, hipFuncAttributeMaxDynamicSharedMemorySize, LDS_BYTES) != hipSuccess) { fprintf(stderr, "kernel_launch: hipFuncSetAttribute failed\n"); return; }
        int per_cu = 0; (void)hipOccupancyMaxActiveBlocksPerMultiprocessor(&per_cu, (const void*)mk_fwd, NTHR, LDS_BYTES); (void)hipGetLastError();
        if (per_cu < 1) fprintf(stderr, "kernel_launch: occupancy query says %d blocks per CU\n", per_cu);
        ready = 1;
    }
    if (ready < 0) return;
    (void)hipMemsetAsync((char*)d_ws + WS_CTL, 0, CTL_ZERO_BYTES, stream);
    Args a{};
    for (int i = 0; i < 12; ++i) a.in[i] = (const float*)d_in[i];
    a.out = (float*)d_out; a.ws = (unsigned char*)d_ws;
#if !MK_DEBUG
    a.lo = 0; a.hi = 42;
    hipLaunchKernelGGL(mk_fwd, dim3(NWG), dim3(NTHR), LDS_BYTES, stream, a);
#else
    unsigned char* ws = (unsigned char*)d_ws; float* snap = (float*)(ws + WS_DBG);
    const int NS = 96;
    for (int s = 0; s < 42; ++s) {
        const int L = (s - 1) / 10, k = (s - 1) % 10; const bool moe = (L & 1) != 0;
        if (s >= 1 && s < 41 && !moe && k == 9) continue;
        const bool snapx = (s == 41) || (s >= 1 && s < 41 && ((k == 0 && L == 2) || (k == 8 && !moe) || (k == 5 && L > 0)));
        if (snapx) (void)hipMemcpyAsync(snap, d_out, (size_t)NTOK * 1024 * 4, hipMemcpyDeviceToDevice, stream);
        a.lo = s; a.hi = s + 1;
        hipLaunchKernelGGL(mk_fwd, dim3(NWG), dim3(NTHR), LDS_BYTES, stream, a);
        if (s == 0) { hipLaunchKernelGGL(chk_prep, dim3(64), dim3(64), 0, stream, a); continue; }
        if (s == 41) { hipLaunchKernelGGL(chk_final, dim3(64), dim3(64), 0, stream, a, (const float*)snap); continue; }
        const float* gains = (const float*)d_in[1] + (size_t)L * 2048; const float* xin0 = (const float*)d_in[0];
        switch (k) {
        case 0: hipLaunchKernelGGL(chk_norm, dim3(NS), dim3(64), 0, stream, a, L == 0 ? xin0 : (L == 2 ? (const float*)snap : (const float*)d_out), gains, L == 2 ? 1 : 0, L == 2 ? 17 : 1); break;
        case 1: hipLaunchKernelGGL(chk_gemm_in, dim3(NS), dim3(64), 0, stream, a, L); break;
        case 2: hipLaunchKernelGGL(chk_qk, dim3(NS), dim3(64), 0, stream, a, L); hipLaunchKernelGGL(chk_vt, dim3(NS), dim3(64), 0, stream, a); break;
        case 3: hipLaunchKernelGGL(chk_na, dim3(NS), dim3(64), 0, stream, a, L); hipLaunchKernelGGL(chk_dil, dim3(NS), dim3(64), 0, stream, a, L); hipLaunchKernelGGL(chk_gqa, dim3(32), dim3(64), 0, stream, a, L); break;
        case 4: hipLaunchKernelGGL(chk_gate, dim3(NS), dim3(64), 0, stream, a, L); break;
        case 5: hipLaunchKernelGGL(chk_resid, dim3(NS), dim3(64), 0, stream, a, L == 0 ? xin0 : (const float*)snap, (const bf16_t*)(ws + WS_MERGED), (const bf16_t*)(ws + WS_W_OUT) + (size_t)L * 1024 * 1024, 1024, 9); break;
        case 6: if (!moe) hipLaunchKernelGGL(chk_norm, dim3(NS), dim3(64), 0, stream, a, (const float*)d_out, gains + 1024, 0, 10);
                else { hipLaunchKernelGGL(chk_norm, dim3(NS), dim3(64), 0, stream, a, (const float*)d_out, gains + 1024, 0, 10);
                       hipLaunchKernelGGL(chk_router, dim3(NS), dim3(64), 0, stream, a, gains + 1024, (const float*)d_in[9] + (size_t)(L >> 1) * 8192); } break;
        case 7: if (!moe) hipLaunchKernelGGL(chk_up, dim3(NS), dim3(64), 0, stream, a, (const bf16_t*)(ws + WS_H), (const bf16_t*)(ws + WS_W_FGU) + (size_t)(L >> 1) * 2 * FF * 1024, FF, 11);
                else hipLaunchKernelGGL(chk_scatter, dim3(NS), dim3(64), 0, stream, a); break;
        case 8: if (!moe) hipLaunchKernelGGL(chk_resid, dim3(NS), dim3(64), 0, stream, a, (const float*)snap, (const bf16_t*)(ws + WS_ACT), (const bf16_t*)(ws + WS_W_FDN) + (size_t)(L >> 1) * 1024 * FF, FF, 12);
                else hipLaunchKernelGGL(chk_moe, dim3(NS), dim3(64), 0, stream, a, L >> 1, 0); break;
        case 9: hipLaunchKernelGGL(chk_moe, dim3(NS), dim3(64), 0, stream, a, L >> 1, 1); break;
        }
    }
    hipLaunchKernelGGL(chk_report, dim3(1024), dim3(256), 0, stream, a);
#endif
}
```

```cpp
#include <hip/hip_runtime.h>
#include <cstdint>
#include <cstdio>

#ifndef MK_DEBUG
#define MK_DEBUG 0
#endif

#ifndef PHM
#define PHM 0xFFFFFFFFu
#endif
#define PM(k) ((PHM >> (k)) & 1u)
#ifndef REPM
#define REPM 0u
#endif
#define RP(k) for (int rp_ = 0; rp_ <= (int)((REPM >> (k)) & 1u); ++rp_)
#ifndef F8_IN
#define F8_IN 0
#endif
#ifndef F8_FFN
#define F8_FFN 2
#endif
#ifndef F8_MOE
#define F8_MOE 3
#endif
#ifndef FUSE_NORM
#define FUSE_NORM 1
#endif
#if MK_DEBUG
#undef FUSE_NORM
#define FUSE_NORM 0
#undef F8_IN
#undef F8_FFN
#undef F8_MOE
#define F8_IN 0
#define F8_FFN 0
#define F8_MOE 0
#endif
#ifndef TSEL
#define TSEL -1
#endif
#define DI __device__ __forceinline__
#define LAS __attribute__((address_space(3)))
#define GAS __attribute__((address_space(1)))

typedef unsigned short bf16_t;
typedef short bf16x8 __attribute__((ext_vector_type(8)));
typedef float f32x2 __attribute__((ext_vector_type(2)));
typedef float f32x4 __attribute__((ext_vector_type(4)));
typedef float f32x16 __attribute__((ext_vector_type(16)));
typedef unsigned u32x2 __attribute__((ext_vector_type(2)));
typedef unsigned u32x4 __attribute__((ext_vector_type(4)));
typedef __bf16 bf16x2_t __attribute__((ext_vector_type(2)));

constexpr int NB = 8, SEQ = 4096, DM = 1024, NTOK = NB * SEQ, DEPTH = 4;
constexpr int INW = 5632, FF = 2816, ED = 3584, NE = 8;
constexpr int MROWS = 2 * NTOK + NE * 256;
constexpr float EPS = 1e-6f;
constexpr float QSCALE = 0.125f * 1.4426950408889634f;
constexpr float LOG2E = 1.4426950408889634f;
constexpr int NWG = 256, NTHR = 512;

constexpr size_t MiB = 1u << 20;
constexpr size_t WS_CTL = 0, CTL_ZERO_BYTES = 1 * MiB;
constexpr size_t WS_ROPE1 = 1 * MiB;
constexpr size_t WS_ROPEA = 2 * MiB;
constexpr size_t WS_TOPI = 3 * MiB;
constexpr size_t WS_TOPW = 3 * MiB + 512 * 1024;
constexpr size_t WS_PERM = 4 * MiB;
constexpr size_t WS_RGATE = 4 * MiB + 512 * 1024;
constexpr size_t WS_CNT = 5 * MiB;
constexpr size_t WS_SSQ = 6 * MiB;
constexpr size_t WS_W_IN = 8 * MiB;
constexpr size_t WS_W_BR = 52 * MiB;
constexpr size_t WS_W_OUT = 59 * MiB;
constexpr size_t WS_W_FGU = 67 * MiB;
constexpr size_t WS_W_FDN = 89 * MiB;
constexpr size_t WS_W_MGU = 100 * MiB;
constexpr size_t WS_W_MDN = 324 * MiB;
constexpr size_t WS_H = 436 * MiB;
constexpr size_t WS_XS = 500 * MiB;
constexpr size_t WS_YBUF = 632 * MiB;
constexpr size_t WS_Q = 760 * MiB;
constexpr size_t WS_K = 824 * MiB;
constexpr size_t WS_VRAW = 872 * MiB;
constexpr size_t WS_VT = 920 * MiB;
constexpr size_t WS_G = 968 * MiB;
constexpr size_t WS_OALL = 1160 * MiB;
constexpr size_t WS_MERGED = 1216 * MiB;
constexpr size_t WS_ACT = 760 * MiB;
constexpr size_t WS_END = 1280 * MiB;
constexpr size_t WS_DBG = 1280 * MiB;
static_assert(WS_ACT + (size_t)MROWS * ED * 2 <= WS_END, "act overlay");
static_assert(WS_W_MDN + (size_t)2 * 8 * 1024 * 3584 * 2 <= WS_H, "weights");

constexpr int CW_BAR = 4096;
constexpr int CW_ERR = 32768;

constexpr int LDS_SCR = 0, LDS_SCR_BYTES = 131072;
constexpr int LDS_MISC = 131072;
constexpr int LDS_BYTES = 131072 + 1024 + 8192;

DI unsigned pk2(float lo, float hi) { f32x2 v = {lo, hi}; bf16x2_t b = __builtin_convertvector(v, bf16x2_t); return __builtin_bit_cast(unsigned, b); }
DI float bflo(unsigned w) { return __uint_as_float(w << 16); }
DI float bfhi(unsigned w) { return __uint_as_float(w & 0xffff0000u); }
DI float bf2f(bf16_t u) { return __uint_as_float((unsigned)u << 16); }
DI int lane_v() { int l; asm volatile("v_mbcnt_lo_u32_b32 %0, -1, 0\n\tv_mbcnt_hi_u32_b32 %0, -1, %0" : "=v"(l)); return l; }
DI float shx(float v, int m) { return __builtin_bit_cast(float, __builtin_amdgcn_ds_bpermute((lane_v() ^ m) << 2, __builtin_bit_cast(int, v))); }
DI int shx(int v, int m) { return __builtin_amdgcn_ds_bpermute((lane_v() ^ m) << 2, v); }
DI int shup(int v, int o) { return __builtin_amdgcn_ds_bpermute((lane_v() - o) << 2, v); }
DI int shidx(int v, int src) { return __builtin_amdgcn_ds_bpermute(src << 2, v); }
DI float wave_sum(float v) {
#pragma unroll
    for (int o = 1; o < 64; o <<= 1) v += shx(v, o);
    return v;
}
DI float sigmoidf_(float x) { return __builtin_amdgcn_rcpf(1.f + __builtin_amdgcn_exp2f(x * -1.4426950408889634f)); }

namespace pg8 {
#define PG8_LAS __attribute__((address_space(3)))
constexpr int BM = 256, BK = 64, HALF = 128, HTB = HALF * BK * 2, STAGE_BYTES = 8 * HTB, NXCD = 8, WGM = 8;
__host__ __device__ __forceinline__ int lds_byte(int r, int c) { const int st = (r >> 4) * 2 + (c >> 5), rr = r & 15, cc = c & 31, ob = rr * 64 + cc * 2; return st * 1024 + (ob ^ (((ob >> 9) & 1) << 5)); }
__host__ __device__ __forceinline__ void stage_rc(int b, int& R, int& C) { const int st = b / 1024, sb = b % 1024, swz = sb ^ (((sb >> 9) & 1) << 5); R = (st >> 1) * 16 + swz / 64; C = (st & 1) * 32 + (swz % 64) / 2; }
__host__ __device__ __forceinline__ int perm32(int rho) { const int n = rho >> 4, i = rho & 15; return 8 * (i >> 2) + 4 * n + (i & 3); }

struct Unit { int pm, pn; long bo; int ord; };
struct Gemm { const bf16_t* A; const bf16_t* Bt; int K; int sclB; };
typedef int v4i_t __attribute__((ext_vector_type(4)));
typedef int v8i_t __attribute__((ext_vector_type(8)));
__device__ __forceinline__ void mfma_f8(f32x4& acc, v8i_t b, v8i_t a, int sclb) {
    asm volatile("v_mfma_scale_f32_16x16x128_f8f6f4 %0, %1, %2, %0, %3, %4 op_sel_hi:[0,0,0]" : "+v"(acc) : "v"(b), "v"(a), "v"(sclb), "v"(0x7F7F7F7F));
}
__device__ __forceinline__ v8i_t cat8(bf16x8 lo, bf16x8 hi) { return __builtin_shufflevector(__builtin_bit_cast(v4i_t, lo), __builtin_bit_cast(v4i_t, hi), 0, 1, 2, 3, 4, 5, 6, 7); }

struct StaticOrder {
    int nM, nN, nwg, G, c;
    __host__ __device__ void init(int M, int N, int G_, int c_) { nM = M / BM; nN = N / BM; nwg = nM * nN; G = G_; c = c_; }
    __host__ __device__ bool next(int i, Unit& u) const {
        const long L = (long)i * G + c; if (L >= nwg) return false;
        int wgid = (int)L; { const int q = nwg / NXCD, r = nwg % NXCD, xcd = wgid % NXCD, off = wgid / NXCD; wgid = (xcd < r ? xcd * (q + 1) : r * (q + 1) + (xcd - r) * q) + off; }
        const int nig = WGM * nN, gid = wgid / nig, fm = gid * WGM, gsz = (nM - fm) < WGM ? (nM - fm) : WGM;
        u.pm = fm + ((wgid % nig) % gsz); u.pn = (wgid % nig) / gsz; u.bo = 0; u.ord = i; return true;
    }
    __device__ __forceinline__ void a_ready(const Unit&) const {}
    __device__ __forceinline__ void done(const Unit&) const {}
};
struct StaticOrderR : StaticOrder {
    const float* ssq; PG8_LAS float* tab; int wid;
    __device__ __forceinline__ void a_ready(const Unit& u) const {
        if (ssq) { int t_; asm volatile("v_mbcnt_lo_u32_b32 %0, -1, 0\n\tv_mbcnt_hi_u32_b32 %0, -1, %0" : "=v"(t_)); const int w_ = wid;
            if (w_ < 4) { const int rr = w_ * 64 + t_; const f32x4* p = (const f32x4*)(ssq + (size_t)(u.pm * 256 + rr) * 16); const f32x4 a = p[0], b = p[1], c2 = p[2], d = p[3];
                const float s_ = ((a[0] + a[1]) + (a[2] + a[3])) + ((b[0] + b[1]) + (b[2] + b[3])) + ((c2[0] + c2[1]) + (c2[2] + c2[3])) + ((d[0] + d[1]) + (d[2] + d[3]));
                tab[(u.ord & 1) * 256 + rr] = 1.f / sqrtf(s_ * (1.f / 1024.f) + 1e-6f); } }
    }
};
struct GroupedOrder {
    int nN, c8, loc, per; int tp[9]; long bstride; int cb;
    __device__ __forceinline__ bool next(int i, Unit& u) const {
        const int R = (tp[8] - c8 + 7) >> 3;
        const int j = loc + per * i; if (j >= R * nN) return false;
        const int g = j / (4 * nN), w = j - g * 4 * nN, rg = min(4, R - 4 * g);
        const int blk = rg * cb, pc = w / blk, rem = w - pc * blk, col = rem / rg, row = rem - col * rg;
        const int pm = c8 + 8 * (4 * g + row);
        u.pm = pm; u.pn = pc * cb + col; u.ord = i;
        int e = 0;
#pragma unroll
        for (int k = 1; k < 8; ++k) e += (pm >= tp[k]) ? 1 : 0;
        u.bo = (long)e * bstride; return true;
    }
    __device__ __forceinline__ void a_ready(const Unit&) const {}
    __device__ __forceinline__ void done(const Unit&) const {}
};

template <class T, class = void> struct has_mid { static constexpr bool value = false; };
template <class T> struct has_mid<T, decltype((void)T::HAS_MID)> { static constexpr bool value = T::HAS_MID; };
template <class Epi, class Sched, bool ALIGN_EPI = false, bool SP2 = false, bool F8 = false>
__device__ __forceinline__ void gemm_phase(PG8_LAS unsigned char* lds, const Gemm g, const Sched& S, const Epi& E, int tid_in) {
    int tid_o = tid_in; asm volatile("" : "+v"(tid_o));
    const int tid = tid_o, wid = __builtin_amdgcn_readfirstlane(tid >> 6), lane = tid & 63, wr = wid >> 2, wc = wid & 3, fr = lane & 15, fq = lane >> 4;
    const int K = g.K, nt = K / BK;
    unsigned voffA[2], voffB[2];
#pragma unroll
    for (int i = 0; i < 2; ++i) { int R, C; stage_rc(tid * 16 + i * 8192, R, C); const int Rb = Epi::PERM ? ((R & ~31) + perm32(R & 31)) : R;
        voffA[i] = (unsigned)(R * K + C) * 2u; voffB[i] = (unsigned)(Rb * K + C) * 2u; }
    const size_t kstep = (size_t)(BK * 2);
    const size_t hstep = (size_t)HALF * K * 2;
    const size_t tstep = 2 * hstep;
    const unsigned ldsw = (unsigned)wid * 1024u;
    const int aoff = lds_byte(wr * 64 + fr, fq * 8), boff = lds_byte(wc * 32 + fr, fq * 8);
#define PG8_SA(b, h) (((b) * 2 + (h)) * HTB)
#define PG8_SB(b, h) ((4 + (b) * 2 + (h)) * HTB)
#define PG8_STAGE(bufoff, gbase, voff) do { _Pragma("unroll") for (int _i = 0; _i < 2; ++_i) \
        __builtin_amdgcn_global_load_lds((const unsigned*)((const char*)(gbase) + (voff)[_i]), (PG8_LAS unsigned*)(lds + (bufoff) + ldsw + _i * 8192), 16, 0, 0); } while (0)
#define PG8_LDA(dst, b, h) do { _Pragma("unroll") for (int m = 0; m < 4; ++m) _Pragma("unroll") for (int k = 0; k < 2; ++k) dst[m][k] = *(const PG8_LAS bf16x8*)(lds + PG8_SA(b, h) + aoff + m * 2048 + k * 1024); } while (0)
#define PG8_LDB(dst, b, h) do { _Pragma("unroll") for (int n = 0; n < 2; ++n) _Pragma("unroll") for (int k = 0; k < 2; ++k) dst[n][k] = *(const PG8_LAS bf16x8*)(lds + PG8_SB(b, h) + boff + n * 2048 + k * 1024); } while (0)
#define PG8_MMA(ai, bj, At, Bt) do { __builtin_amdgcn_s_setprio(1); _Pragma("unroll") for (int m = 0; m < 4; ++m) _Pragma("unroll") for (int n = 0; n < 2; ++n) { \
        if constexpr (F8) mfma_f8(acc[ai][bj][m][n], cat8(Bt[n][0], Bt[n][1]), cat8(At[m][0], At[m][1]), g.sclB); \
        else { _Pragma("unroll") for (int k = 0; k < 2; ++k) acc[ai][bj][m][n] = __builtin_amdgcn_mfma_f32_16x16x32_bf16(Bt[n][k], At[m][k], acc[ai][bj][m][n], 0, 0, 0); } } __builtin_amdgcn_s_setprio(0); } while (0)
#define PG8_WAIT_V(n) asm volatile("s_waitcnt vmcnt(" #n ")" ::: "memory")
#define PG8_WAIT_L(n) asm volatile("s_waitcnt lgkmcnt(" #n ")" ::: "memory")
#define PG8_BAR __builtin_amdgcn_s_barrier()
#define PG8_SCHED __builtin_amdgcn_sched_barrier(0)
    Unit cur, nxt; int ui = 0;
    if (!S.next(0, cur)) return;
    f32x4 acc[2][2][4][2];
#pragma unroll
    for (int a = 0; a < 2; ++a)
#pragma unroll
        for (int b = 0; b < 2; ++b)
#pragma unroll
            for (int m = 0; m < 4; ++m)
#pragma unroll
                for (int n = 0; n < 2; ++n) acc[a][b][m][n] = (f32x4){0.f, 0.f, 0.f, 0.f};
    bf16x8 At[4][2], B0[2][2], B1[2][2];
    const char* cA = (const char*)g.A + (size_t)cur.pm * tstep; const char* cB = (const char*)g.Bt + cur.bo + (size_t)cur.pn * tstep;
    S.a_ready(cur);
    if constexpr (SP2) {
        PG8_STAGE(PG8_SB(0, 0), cB, voffB); PG8_STAGE(PG8_SB(0, 1), cB + hstep, voffB); PG8_STAGE(PG8_SA(0, 0), cA, voffA); PG8_STAGE(PG8_SA(0, 1), cA + hstep, voffA);
        if (wr == 1) PG8_BAR;
        PG8_WAIT_V(2); PG8_BAR;
        PG8_STAGE(PG8_SB(1, 0), cB + kstep, voffB); PG8_STAGE(PG8_SA(1, 0), cA + kstep, voffA); PG8_STAGE(PG8_SB(1, 1), cB + hstep + kstep, voffB);
        PG8_WAIT_V(6); PG8_BAR;
    } else {
        PG8_STAGE(PG8_SB(0, 0), cB, voffB); PG8_STAGE(PG8_SA(0, 0), cA, voffA); PG8_STAGE(PG8_SB(0, 1), cB + hstep, voffB); PG8_STAGE(PG8_SA(0, 1), cA + hstep, voffA);
        if (wr == 1) PG8_BAR;
        PG8_WAIT_V(4); PG8_BAR;
        PG8_STAGE(PG8_SB(1, 0), cB + kstep, voffB); PG8_STAGE(PG8_SA(1, 0), cA + kstep, voffA); PG8_STAGE(PG8_SB(1, 1), cB + hstep + kstep, voffB);
        PG8_WAIT_V(6); PG8_BAR;
    }
    for (;;) {
        const bool has_next = S.next(ui + 1, nxt);
        const char* nA = has_next ? (const char*)g.A + (size_t)nxt.pm * tstep : cA; const char* nB = has_next ? (const char*)g.Bt + nxt.bo + (size_t)nxt.pn * tstep : cB;
        for (int t = 0; t < nt; t += 2) {
            if constexpr (has_mid<Epi>::value) { if (E.is_mid(t)) { if (wr == 0) PG8_BAR; E.mid(acc, cur, t, wr, wc, fr, fq); if (wr == 1) PG8_BAR; } }
            const bool last = (t == nt - 2);
            const char* a1 = cA + (size_t)(t + 1) * kstep;
            const char* a2 = last ? nA : cA + (size_t)(t + 2) * kstep; const char* b2 = last ? nB : cB + (size_t)(t + 2) * kstep;
            const char* a3 = a2 + kstep; const char* b3 = b2 + kstep;
            if (last && has_next) S.a_ready(nxt);
            if constexpr (SP2) {
            PG8_LDB(B0, 0, 0); PG8_LDB(B1, 0, 1); PG8_SCHED; PG8_LDA(At, 0, 0); PG8_STAGE(PG8_SA(1, 1), a1 + hstep, voffA);
            PG8_WAIT_V(8); PG8_WAIT_L(0); PG8_BAR; PG8_MMA(0, 0, At, B0); PG8_MMA(0, 1, At, B1); PG8_BAR; PG8_SCHED;
            PG8_LDA(At, 0, 1); PG8_STAGE(PG8_SB(0, 0), b2, voffB); PG8_STAGE(PG8_SB(0, 1), b2 + hstep, voffB); PG8_STAGE(PG8_SA(0, 0), a2, voffA);
            PG8_WAIT_V(8); PG8_WAIT_L(0); PG8_BAR; PG8_MMA(1, 0, At, B0); PG8_MMA(1, 1, At, B1); PG8_BAR; PG8_SCHED;
            PG8_LDB(B0, 1, 0); PG8_LDB(B1, 1, 1); PG8_SCHED; PG8_LDA(At, 1, 0); PG8_STAGE(PG8_SA(0, 1), a2 + hstep, voffA);
            PG8_WAIT_V(8); PG8_WAIT_L(0); PG8_BAR; PG8_MMA(0, 0, At, B0); PG8_MMA(0, 1, At, B1); PG8_BAR; PG8_SCHED;
            PG8_LDA(At, 1, 1); PG8_STAGE(PG8_SB(1, 0), b3, voffB); PG8_STAGE(PG8_SB(1, 1), b3 + hstep, voffB); PG8_STAGE(PG8_SA(1, 0), a3, voffA);
            PG8_WAIT_V(8); PG8_WAIT_L(0); PG8_BAR; PG8_MMA(1, 0, At, B0); PG8_MMA(1, 1, At, B1); PG8_BAR; PG8_SCHED;
            } else {
            PG8_LDB(B0, 0, 0); PG8_SCHED; PG8_LDA(At, 0, 0); PG8_STAGE(PG8_SA(1, 1), a1 + hstep, voffA);
            PG8_WAIT_L(8); PG8_BAR; PG8_WAIT_L(0); PG8_MMA(0, 0, At, B0); PG8_BAR; PG8_SCHED;
            PG8_LDB(B1, 0, 1); PG8_STAGE(PG8_SB(0, 0), b2, voffB);
            PG8_BAR; PG8_WAIT_L(0); PG8_MMA(0, 1, At, B1); PG8_BAR;
            PG8_LDA(At, 0, 1); PG8_STAGE(PG8_SA(0, 0), a2, voffA);
            PG8_BAR; PG8_WAIT_L(0); PG8_MMA(1, 0, At, B0); PG8_BAR; PG8_SCHED;
            PG8_STAGE(PG8_SB(0, 1), b2 + hstep, voffB);
            PG8_WAIT_V(6); PG8_BAR; PG8_MMA(1, 1, At, B1); PG8_BAR;
            PG8_LDB(B0, 1, 0); PG8_SCHED; PG8_LDA(At, 1, 0); PG8_STAGE(PG8_SA(0, 1), a2 + hstep, voffA);
            PG8_WAIT_L(8); PG8_BAR; PG8_WAIT_L(0); PG8_MMA(0, 0, At, B0); PG8_BAR; PG8_SCHED;
            PG8_LDB(B1, 1, 1); PG8_STAGE(PG8_SB(1, 0), b3, voffB);
            PG8_BAR; PG8_WAIT_L(0); PG8_MMA(0, 1, At, B1); PG8_BAR;
            PG8_LDA(At, 1, 1); PG8_STAGE(PG8_SA(1, 0), a3, voffA);
            PG8_BAR; PG8_WAIT_L(0); PG8_MMA(1, 0, At, B0); PG8_BAR; PG8_SCHED;
            PG8_STAGE(PG8_SB(1, 1), b3 + hstep, voffB);
            PG8_WAIT_V(6); PG8_BAR; PG8_MMA(1, 1, At, B1); PG8_BAR;
            }
        }
        if constexpr (ALIGN_EPI) { if (wr == 0) PG8_BAR; }
        if constexpr (F8) asm volatile("s_nop 15\n\ts_nop 15" ::: "memory");
        if constexpr (!Epi::AFTER_DRAIN) { E(acc, cur, wr, wc, fr, fq); S.done(cur); }
        if (!has_next) break;
#pragma unroll
        for (int a = 0; a < 2; ++a)
#pragma unroll
            for (int b = 0; b < 2; ++b)
#pragma unroll
                for (int m = 0; m < 4; ++m)
#pragma unroll
                    for (int n = 0; n < 2; ++n) acc[a][b][m][n] = (f32x4){0.f, 0.f, 0.f, 0.f};
        cur = nxt; cA = nA; cB = nB; ++ui;
        if constexpr (ALIGN_EPI) { if (wr == 1) PG8_BAR; }
    }
    PG8_WAIT_V(0);
    if constexpr (!ALIGN_EPI) { if (wr == 0) PG8_BAR; }
    PG8_BAR;
    if constexpr (Epi::AFTER_DRAIN) { E.fused(acc, cur, wr, wc, fr, fq, lds, wid, lane); S.done(cur); }
#undef PG8_SA
#undef PG8_SB
#undef PG8_STAGE
#undef PG8_LDA
#undef PG8_LDB
#undef PG8_MMA
#undef PG8_WAIT_V
#undef PG8_WAIT_L
#undef PG8_BAR
#undef PG8_SCHED
}
}

typedef const f32x4 (&AccRef)[2][2][4][2];

struct EpiIn {
    static constexpr bool PERM = true, AFTER_DRAIN = false;
    bf16_t *Q, *Kb, *V, *G; const LAS float* rtab;
    DI void operator()(AccRef acc, const pg8::Unit& u, int wr, int wc, int fr, int fq) const {
        const int pn = u.pn; bf16_t* base; int ld, colt; bool sig = false;
        if (pn < 4) { base = Q; ld = 1024; colt = pn * 256; }
        else if (pn < 7) { base = Kb; ld = 768; colt = (pn - 4) * 256; }
        else if (pn < 10) { base = V; ld = 768; colt = (pn - 7) * 256; }
        else { base = G; ld = 3072; colt = (pn - 10) * 256; sig = true; }
        const int row0 = u.pm * 256 + wr * 64 + fr, col0 = colt + wc * 32 + 8 * fq;
#pragma unroll
        for (int ai = 0; ai < 2; ++ai)
#pragma unroll
            for (int m = 0; m < 4; ++m) { bf16_t* rowp = base + (size_t)(row0 + ai * 128 + m * 16) * ld + col0;
                const float rs = rtab ? rtab[(u.ord & 1) * 256 + wr * 64 + fr + ai * 128 + m * 16] : 1.f;
#pragma unroll
                for (int bj = 0; bj < 2; ++bj) {
                    if (sig) {
                        const float rsn = rs * -1.4426950408889634f; unsigned q[8];
#pragma unroll
                        for (int j = 0; j < 4; ++j) {
                            q[j] = (unsigned)__builtin_amdgcn_rcpf(__builtin_amdgcn_exp2f(__builtin_fmaf(acc[ai][bj][m][0][j], rsn, -8.f)) + 0.00390720367431640625f);
                            q[4 + j] = (unsigned)__builtin_amdgcn_rcpf(__builtin_amdgcn_exp2f(__builtin_fmaf(acc[ai][bj][m][1][j], rsn, -8.f)) + 0.00390720367431640625f); }
                        u32x2 w; w.x = q[0] | (q[1] << 8) | (q[2] << 16) | (q[3] << 24); w.y = q[4] | (q[5] << 8) | (q[6] << 16) | (q[7] << 24);
                        *(u32x2*)((unsigned char*)G + (size_t)(row0 + ai * 128 + m * 16) * 3072 + col0 + bj * 128) = w; }
                    else { const f32x4 v0 = acc[ai][bj][m][0] * rs, v1 = acc[ai][bj][m][1] * rs;
                        u32x4 w; w.x = pk2(v0[0], v0[1]); w.y = pk2(v0[2], v0[3]); w.z = pk2(v1[0], v1[1]); w.w = pk2(v1[2], v1[3]);
                        *(u32x4*)(rowp + bj * 128) = w; } } }
    }
};

struct EpiGate {
    static constexpr bool PERM = true, AFTER_DRAIN = false, HAS_MID = true;
    const unsigned char* G; bf16_t* Mg;
    DI bool is_mid(int t) const { return t == 4 || t == 10; }
    static DI float gq(unsigned w, int k) { return (float)((w >> (8 * k)) & 0xffu) + 0.5f; }
    DI void mid(f32x4 (&acc)[2][2][4][2], const pg8::Unit& u, int t, int wr, int wc, int fr, int fq) const {
        int fr_o = fr; asm volatile("" : "+v"(fr_o));
        const int row0 = u.pm * 256 + wr * 64 + fr_o, col0 = u.pn * 256 + wc * 32 + 8 * fq, g0 = (t == 4) ? 0 : 1024;
#pragma unroll
        for (int ai = 0; ai < 2; ++ai) {
            __builtin_amdgcn_sched_barrier(0);
#pragma unroll
            for (int m = 0; m < 4; ++m) { const size_t ro = (size_t)(row0 + ai * 128 + m * 16) * 3072 + g0 + col0;
#pragma unroll
                for (int bj = 0; bj < 2; ++bj) { const u32x2 gn = *(const u32x2*)(G + ro + bj * 128), gd = *(const u32x2*)(G + ro + 1024 + bj * 128);
                    f32x4 r0, r1;
#pragma unroll
                    for (int k = 0; k < 4; ++k) { r0[k] = gq(gn.x, k) * __builtin_amdgcn_rcpf(gq(gd.x, k)); r1[k] = gq(gn.y, k) * __builtin_amdgcn_rcpf(gq(gd.y, k)); }
                    acc[ai][bj][m][0] = acc[ai][bj][m][0] * r0; acc[ai][bj][m][1] = acc[ai][bj][m][1] * r1; } } }
        __builtin_amdgcn_sched_barrier(0);
    }
    DI void operator()(AccRef acc, const pg8::Unit& u, int wr, int wc, int fr, int fq) const {
        const int row0 = u.pm * 256 + wr * 64 + fr, col0 = u.pn * 256 + wc * 32 + 8 * fq;
#pragma unroll
        for (int ai = 0; ai < 2; ++ai)
#pragma unroll
            for (int m = 0; m < 4; ++m) { const size_t row = (size_t)(row0 + ai * 128 + m * 16);
#pragma unroll
                for (int bj = 0; bj < 2; ++bj) { const int col = col0 + bj * 128;
                    const u32x2 g = *(const u32x2*)(G + row * 3072 + 2048 + col);
                    const f32x4 v0 = acc[ai][bj][m][0] * (1.f / 256.f), v1 = acc[ai][bj][m][1] * (1.f / 256.f);
                    u32x4 w;
                    w.x = pk2(gq(g.x, 0) * v0[0], gq(g.x, 1) * v0[1]); w.y = pk2(gq(g.x, 2) * v0[2], gq(g.x, 3) * v0[3]);
                    w.z = pk2(gq(g.y, 0) * v1[0], gq(g.y, 1) * v1[1]); w.w = pk2(gq(g.y, 2) * v1[2], gq(g.y, 3) * v1[3]);
                    *(u32x4*)(Mg + row * 1024 + col) = w; } }
    }
};

struct EpiResidN {
    static constexpr bool PERM = true, AFTER_DRAIN = false;
    const float* xin; float* xout; unsigned char* xb; float* ssq; int f8;
    DI void operator()(AccRef acc, const pg8::Unit& u, int wr, int wc, int fr, int fq) const {
        const int row0 = u.pm * 256 + wr * 64 + fr, col0 = u.pn * 256 + wc * 32 + 8 * fq;
#pragma unroll
        for (int ai = 0; ai < 2; ++ai)
#pragma unroll
            for (int m = 0; m < 4; ++m) { const int row = row0 + ai * 128 + m * 16; const size_t ro = (size_t)row * 1024; float ss = 0.f;
#pragma unroll
                for (int bj = 0; bj < 2; ++bj) { const size_t o = ro + col0 + bj * 128;
                    const f32x4 x0 = *(const f32x4*)(xin + o) + acc[ai][bj][m][0], x1 = *(const f32x4*)(xin + o + 4) + acc[ai][bj][m][1];
                    *(f32x4*)(xout + o) = x0; *(f32x4*)(xout + o + 4) = x1;
                    if (xb) { ss += ((x0[0] * x0[0] + x0[1] * x0[1]) + (x0[2] * x0[2] + x0[3] * x0[3])) + ((x1[0] * x1[0] + x1[1] * x1[1]) + (x1[2] * x1[2] + x1[3] * x1[3]));
                        if (f8) { int w0 = 0, w1 = 0; w0 = __builtin_amdgcn_cvt_pk_fp8_f32(x0[0], x0[1], w0, false); w0 = __builtin_amdgcn_cvt_pk_fp8_f32(x0[2], x0[3], w0, true);
                            w1 = __builtin_amdgcn_cvt_pk_fp8_f32(x1[0], x1[1], w1, false); w1 = __builtin_amdgcn_cvt_pk_fp8_f32(x1[2], x1[3], w1, true);
                            u32x2 w; w.x = (unsigned)w0; w.y = (unsigned)w1; *(u32x2*)(xb + o) = w; }
                        else { u32x4 w; w.x = pk2(x0[0], x0[1]); w.y = pk2(x0[2], x0[3]); w.z = pk2(x1[0], x1[1]); w.w = pk2(x1[2], x1[3]); *(u32x4*)(xb + 2 * o) = w; } } }
                if (xb) { ss += shx(ss, 16); ss += shx(ss, 32);
                    if (fq == 0) ssq[(size_t)row * 16 + 4 * u.pn + wc] = ss; } }
    }
};

struct EpiResid {
    static constexpr bool PERM = false, AFTER_DRAIN = false;
    const float* xin; float* xout;
    DI void operator()(AccRef acc, const pg8::Unit& u, int wr, int wc, int fr, int fq) const {
        const int row0 = u.pm * 256 + wr * 64 + fr, col0 = u.pn * 256 + wc * 32 + 4 * fq;
#pragma unroll
        for (int ai = 0; ai < 2; ++ai)
#pragma unroll
            for (int m = 0; m < 4; ++m) { const size_t ro = (size_t)(row0 + ai * 128 + m * 16) * 1024;
#pragma unroll
                for (int bj = 0; bj < 2; ++bj)
#pragma unroll
                    for (int n = 0; n < 2; ++n) { const size_t o = ro + col0 + bj * 128 + n * 16;
                        const f32x4 xv = *(const f32x4*)(xin + o); *(f32x4*)(xout + o) = xv + acc[ai][bj][m][n]; } }
    }
};

template <bool F8O>
struct EpiSwiglu {
    static constexpr bool PERM = true, AFTER_DRAIN = false;
    unsigned char* act; int ld; const LAS float* rtab;
    DI void operator()(AccRef acc, const pg8::Unit& u, int wr, int wc, int fr, int fq) const {
        const int row0 = u.pm * 256 + wr * 64 + fr, col0 = u.pn * 128 + wc * 32 + 8 * fq;
#pragma unroll
        for (int ai = 0; ai < 2; ++ai)
#pragma unroll
            for (int m = 0; m < 4; ++m) { const size_t eo = (size_t)(row0 + ai * 128 + m * 16) * ld + col0;
                const float rs = rtab ? rtab[(u.ord & 1) * 256 + wr * 64 + fr + ai * 128 + m * 16] : 1.f;
                const float rsn = rs * -1.4426950408889634f, irs2 = rtab ? __builtin_amdgcn_rcpf(rs * rs) : 1.f;
                float o[8];
#pragma unroll
                for (int n = 0; n < 2; ++n)
#pragma unroll
                    for (int j = 0; j < 4; ++j) { const float ga = acc[ai][0][m][n][j], ua = acc[ai][1][m][n][j];
                        const float e = __builtin_amdgcn_exp2f(ga * rsn); o[4 * n + j] = (ga * ua) * __builtin_amdgcn_rcpf(__builtin_fmaf(e, irs2, irs2)); }
                if constexpr (F8O) { int w0 = 0, w1 = 0;
                    w0 = __builtin_amdgcn_cvt_pk_fp8_f32(o[0], o[1], w0, false); w0 = __builtin_amdgcn_cvt_pk_fp8_f32(o[2], o[3], w0, true);
                    w1 = __builtin_amdgcn_cvt_pk_fp8_f32(o[4], o[5], w1, false); w1 = __builtin_amdgcn_cvt_pk_fp8_f32(o[6], o[7], w1, true);
                    u32x2 w; w.x = (unsigned)w0; w.y = (unsigned)w1; *(u32x2*)(act + eo) = w; }
                else { u32x4 w; w.x = pk2(o[0], o[1]); w.y = pk2(o[2], o[3]); w.z = pk2(o[4], o[5]); w.w = pk2(o[6], o[7]); *(u32x4*)(act + 2 * eo) = w; } }
    }
};

struct EpiMoeDown {
    static constexpr bool PERM = true, AFTER_DRAIN = false;
    const int* perm; const float* rgate; bf16_t* ybuf;
    DI void operator()(AccRef acc, const pg8::Unit& u, int wr, int wc, int fr, int fq) const {
        const int row0 = u.pm * 256 + wr * 64 + fr, col0 = u.pn * 256 + wc * 32 + 8 * fq;
#pragma unroll
        for (int ai = 0; ai < 2; ++ai)
#pragma unroll
            for (int m = 0; m < 4; ++m) { const int row = row0 + ai * 128 + m * 16; const int p = perm[row];
                if (p >= 0) { const float gt = rgate[row]; bf16_t* dst = ybuf + ((size_t)(p & 1) * NTOK + (size_t)(p >> 1)) * 1024 + col0;
#pragma unroll
                    for (int bj = 0; bj < 2; ++bj) { const f32x4 v0 = acc[ai][bj][m][0] * gt, v1 = acc[ai][bj][m][1] * gt;
                        u32x4 w; w.x = pk2(v0[0], v0[1]); w.y = pk2(v0[2], v0[3]); w.z = pk2(v1[0], v1[1]); w.w = pk2(v1[2], v1[3]);
                        *(u32x4*)(dst + bj * 128) = w; } } }
    }
};

#define LDS_WAIT() asm volatile("s_waitcnt lgkmcnt(0)" ::: "memory")

DI void prep_tile(const float* src, int src_ld, bool zero, unsigned char* dst, int dst_ld, float f8mul, const float* kg  , LAS bf16_t* t, int lane) {
#pragma unroll
    for (int i = 0; i < 16; ++i) { const int k = i * 4 + (lane >> 4), c = (lane & 15) * 4;
        f32x4 v = {0.f, 0.f, 0.f, 0.f}; if (!zero) v = *(const f32x4*)(src + (size_t)k * src_ld + c);
        if (kg) v = v * kg[k];
        u32x2 w; w.x = pk2(v[0], v[1]); w.y = pk2(v[2], v[3]); *(LAS u32x2*)(t + k * 68 + c) = w; }
    LDS_WAIT();
#pragma unroll
    for (int kc = 0; kc < 8; ++kc) { unsigned e[8];
#pragma unroll
        for (int j = 0; j < 8; ++j) e[j] = t[(8 * kc + j) * 68 + lane];
        if (f8mul != 0.f) { int w0 = 0, w1 = 0;
            w0 = __builtin_amdgcn_cvt_pk_fp8_f32(bflo(e[0]) * f8mul, bflo(e[1]) * f8mul, w0, false); w0 = __builtin_amdgcn_cvt_pk_fp8_f32(bflo(e[2]) * f8mul, bflo(e[3]) * f8mul, w0, true);
            w1 = __builtin_amdgcn_cvt_pk_fp8_f32(bflo(e[4]) * f8mul, bflo(e[5]) * f8mul, w1, false); w1 = __builtin_amdgcn_cvt_pk_fp8_f32(bflo(e[6]) * f8mul, bflo(e[7]) * f8mul, w1, true);
            u32x2 w; w.x = (unsigned)w0; w.y = (unsigned)w1; *(u32x2*)(dst + (size_t)lane * dst_ld + 8 * kc) = w; }
        else { u32x4 w; w.x = e[0] | (e[1] << 16); w.y = e[2] | (e[3] << 16); w.z = e[4] | (e[5] << 16); w.w = e[6] | (e[7] << 16);
            *(u32x4*)(dst + ((size_t)lane * dst_ld + 8 * kc) * 2) = w; } }
    LDS_WAIT();
}

struct Args { const float* in[12]; float* out; unsigned char* ws; int lo, hi; };
typedef Args Ptrs;

DI void prep_wg_tile(const float* src0, const float* src1, int src_ld, unsigned char* dst, int dst_ld, float f8mul, const float* kg, LAS bf16_t* t, int tid) {
    { const int c = (tid & 127) * 4, kk = tid >> 7;
      const float* sp; int dn;
      if (src1) { const int run = c >> 8, cc = c & 255; sp = (run ? src1 : src0) + cc; dn = ((cc >> 7) << 8) + (run << 7) + (cc & 127); } else { sp = src0 + c; dn = c; }
#pragma unroll
      for (int p = 0; p < 16; ++p) { const int k = 4 * p + kk; f32x4 v = *(const f32x4*)(sp + (size_t)k * src_ld);
          if (kg) v = v * kg[k];
          u32x2 w; w.x = pk2(v[0], v[1]); w.y = pk2(v[2], v[3]); *(LAS u32x2*)(t + k * 520 + (dn ^ (((k >> 3) & 7) << 3))) = w; } }
    __syncthreads();
    { const int kc = tid & 7;
#pragma unroll
      for (int i = 0; i < 8; ++i) { const int n = 64 * i + (tid >> 3); unsigned e[8];
#pragma unroll
          for (int j = 0; j < 8; ++j) e[j] = t[(8 * kc + j) * 520 + (n ^ (kc << 3))];
          if (f8mul != 0.f) { int w0 = 0, w1 = 0;
              w0 = __builtin_amdgcn_cvt_pk_fp8_f32(bflo(e[0]) * f8mul, bflo(e[1]) * f8mul, w0, false); w0 = __builtin_amdgcn_cvt_pk_fp8_f32(bflo(e[2]) * f8mul, bflo(e[3]) * f8mul, w0, true);
              w1 = __builtin_amdgcn_cvt_pk_fp8_f32(bflo(e[4]) * f8mul, bflo(e[5]) * f8mul, w1, false); w1 = __builtin_amdgcn_cvt_pk_fp8_f32(bflo(e[6]) * f8mul, bflo(e[7]) * f8mul, w1, true);
              u32x2 w; w.x = (unsigned)w0; w.y = (unsigned)w1; *(u32x2*)(dst + (size_t)n * dst_ld + 8 * kc) = w; }
          else { u32x4 w; w.x = e[0] | (e[1] << 16); w.y = e[2] | (e[3] << 16); w.z = e[4] | (e[5] << 16); w.w = e[6] | (e[7] << 16);
              *(u32x4*)(dst + ((size_t)n * dst_ld + 8 * kc) * 2) = w; } } }
    __syncthreads();
}

DI void phase_prep(const Ptrs& P, LAS unsigned char* lds, int tid) {
    LAS bf16_t* t = (LAS bf16_t*)(lds + LDS_SCR);
    constexpr int T0 = 4 * 176, T3 = T0 + 4 * 24, T4 = T3 + 4 * 32, T5 = T4 + 2 * 176, T6 = T5 + 2 * 88, T7 = T6 + 16 * 224, T8 = T7 + 16 * 112;
    for (int it = blockIdx.x; it < T8; it += gridDim.x) {
        const float* src; const float* src1 = nullptr; int src_ld; size_t wsb; size_t eo; int dst_ld; float f8mul = 0.f; const float* kg = nullptr;
        int r = it;
        if (r < T0) { const int L = r / 176, q = r % 176, kt = q / 11, nt = q % 11;
            src = P.in[2] + (size_t)L * 1024 * 5632 + (size_t)kt * 64 * 5632 + nt * 512; src_ld = 5632;
            wsb = WS_W_IN; eo = ((size_t)L * 5632 + nt * 512) * 1024 + kt * 64; dst_ld = 1024; f8mul = F8_IN ? 32.f : 0.f;
            if (FUSE_NORM && (L & 1)) kg = P.in[1] + (size_t)L * 2048 + kt * 64; }
        else if (r < T3) { r -= T0; const int L = r / 24, q = r % 24, kt = q / 2, nt = q % 2;
            src = P.in[5] + (size_t)L * 768 * 1024 + (size_t)(kt * 64) * 1024 + nt * 512; src_ld = 1024;
            wsb = WS_W_BR; eo = ((size_t)L * 1024 + nt * 512) * 768 + kt * 64; dst_ld = 768; }
        else if (r < T4) { r -= T3; const int L = r / 32, q = r % 32, kt = q / 2, nt = q % 2;
            src = P.in[6] + (size_t)L * 1024 * 1024 + (size_t)(kt * 64) * 1024 + nt * 512; src_ld = 1024;
            wsb = WS_W_OUT; eo = ((size_t)L * 1024 + nt * 512) * 1024 + kt * 64; dst_ld = 1024; }
        else if (r < T5) { r -= T4; const int L = r / 176, q = r % 176, kt = q / 11, nt = q % 11;
            src = P.in[7] + (size_t)L * 1024 * 5632 + (size_t)(kt * 64) * 5632 + nt * 256; src1 = src + FF; src_ld = 5632;
            wsb = WS_W_FGU + (size_t)L * 5632 * 1024 * 2; eo = (size_t)(nt * 512) * 1024 + kt * 64; dst_ld = 1024; f8mul = ((F8_FFN >> L) & 1) ? 32.f : 0.f;
            if (FUSE_NORM) kg = P.in[1] + (size_t)(2 * L) * 2048 + 1024 + kt * 64; }
        else if (r < T6) { r -= T5; const int L = r / 88, q = r % 88, kt = q / 2, nt = q % 2;
            src = P.in[8] + (size_t)L * 2816 * 1024 + (size_t)(kt * 64) * 1024 + nt * 512; src_ld = 1024;
            wsb = WS_W_FDN + (size_t)L * 1024 * 2816 * 2; eo = (size_t)(nt * 512) * 2816 + kt * 64; dst_ld = 2816; f8mul = ((F8_FFN >> L) & 1) ? 64.f : 0.f; }
        else if (r < T7) { r -= T6; const int L = r / 224, q = r % 224, kt = q / 14, nt = q % 14;
            src = P.in[10] + (size_t)L * 1024 * 7168 + (size_t)(kt * 64) * 7168 + nt * 256; src1 = src + ED; src_ld = 7168;
            wsb = WS_W_MGU + (size_t)(L >> 3) * 8 * 7168 * 1024 * 2; eo = ((size_t)(L & 7) * 7168 + nt * 512) * 1024 + kt * 64; dst_ld = 1024; f8mul = ((F8_MOE >> (L >> 3)) & 1) ? 32.f : 0.f; }
        else { r -= T7; const int L = r / 112, q = r % 112, kt = q / 2, nt = q % 2;
            src = P.in[11] + (size_t)L * 3584 * 1024 + (size_t)(kt * 64) * 1024 + nt * 512; src_ld = 1024;
            wsb = WS_W_MDN + (size_t)(L >> 3) * 8 * 1024 * 3584 * 2; eo = ((size_t)(L & 7) * 1024 + nt * 512) * 3584 + kt * 64; dst_ld = 3584; f8mul = ((F8_MOE >> (L >> 3)) & 1) ? 64.f : 0.f; }
        prep_wg_tile(src, src1, src_ld, P.ws + wsb + eo * (f8mul != 0.f ? 1 : 2), dst_ld, f8mul, kg, t, tid);
    }
    const int gid = blockIdx.x * NTHR + tid;
    if (gid < 4096 * 32) { const int pos = gid >> 5, i = gid & 31; const float inv = powf(10000.f, -(float)(2 * i) / 64.f); float s, c; sincosf((float)pos * inv, &s, &c);
        ((f32x2*)(P.ws + WS_ROPE1))[gid] = (f32x2){c, s}; }
    if (gid < 64 * 16) { const int pos = gid >> 4, i = gid & 15; const float inv = powf(10000.f, -(float)(2 * i) / 32.f); float s, c; sincosf((float)pos * inv, &s, &c);
        ((f32x2*)(P.ws + WS_ROPEA))[gid] = (f32x2){c, s}; }
}

template <bool COMBINE, bool ROUTER, bool HF8>
DI void phase_norm(const float* xin, float* xout, const bf16_t* ybuf, const float* gain, bf16_t* H, const float* wrt, int* topi, float* topw, int* cnt, int* perm,
                   LAS unsigned char* lds, int tid) {
    const int wave = tid >> 6, lane = tid & 63, w = blockIdx.x;
    LAS float* wrl = (LAS float*)(lds + LDS_SCR);
    LAS int* cntl = (LAS int*)(lds + LDS_SCR + 32768);
    if (ROUTER) {
        for (int i = tid; i < 8192; i += NTHR) wrl[(i & 7) * 1024 + (i >> 3)] = wrt[i];
        if (tid < 8) cntl[tid] = 0;
        for (int i = tid; i < MROWS / NWG; i += NTHR) perm[w * (MROWS / NWG) + i] = -1;
        __syncthreads();
    }
    f32x4 g[4];
#pragma unroll
    for (int q = 0; q < 4; ++q) g[q] = *(const f32x4*)(gain + 256 * q + 4 * lane);
    for (int j = 0; j < 16; ++j) {
        const int row = w * 128 + wave * 16 + j; const size_t ro = (size_t)row * 1024;
        f32x4 v[4]; float ss = 0.f;
#pragma unroll
        for (int q = 0; q < 4; ++q) { v[q] = *(const f32x4*)(xin + ro + 256 * q + 4 * lane);
            if (COMBINE) { const u32x2 a = *(const u32x2*)(ybuf + ro + 256 * q + 4 * lane), b = *(const u32x2*)(ybuf + (size_t)NTOK * 1024 + ro + 256 * q + 4 * lane);
                v[q][0] += bflo(a.x) + bflo(b.x); v[q][1] += bfhi(a.x) + bfhi(b.x); v[q][2] += bflo(a.y) + bflo(b.y); v[q][3] += bfhi(a.y) + bfhi(b.y);
                *(f32x4*)(xout + ro + 256 * q + 4 * lane) = v[q]; }
            ss += (v[q][0] * v[q][0] + v[q][1] * v[q][1]) + (v[q][2] * v[q][2] + v[q][3] * v[q][3]); }
        const float rstd = 1.f / sqrtf(wave_sum(ss) * (1.f / 1024.f) + EPS);
#pragma unroll
        for (int q = 0; q < 4; ++q) { v[q] = v[q] * rstd * g[q];
            if constexpr (HF8) { int w = 0; w = __builtin_amdgcn_cvt_pk_fp8_f32(v[q][0], v[q][1], w, false); w = __builtin_amdgcn_cvt_pk_fp8_f32(v[q][2], v[q][3], w, true);
                *(int*)((unsigned char*)H + ro + 256 * q + 4 * lane) = w; }
            else { u32x2 o; o.x = pk2(v[q][0], v[q][1]); o.y = pk2(v[q][2], v[q][3]); *(u32x2*)(H + ro + 256 * q + 4 * lane) = o; } }
        if (ROUTER) {
            float lg[8];
#pragma unroll
            for (int e = 0; e < 8; ++e) { float a = 0.f;
#pragma unroll
                for (int q = 0; q < 4; ++q) { const f32x4 wv = *(const LAS f32x4*)(wrl + e * 1024 + 256 * q + 4 * lane); a += (v[q][0] * wv[0] + v[q][1] * wv[1]) + (v[q][2] * wv[2] + v[q][3] * wv[3]); }
                lg[e] = wave_sum(a); }
            float v0 = -3.0e38f; int e0 = 0;
#pragma unroll
            for (int e = 0; e < 8; ++e) if (lg[e] > v0) { v0 = lg[e]; e0 = e; }
            float v1 = -3.0e38f; int e1 = 0;
#pragma unroll
            for (int e = 0; e < 8; ++e) if (e != e0 && lg[e] > v1) { v1 = lg[e]; e1 = e; }
            if (lane == 0) { const float t = __expf(v1 - v0), w0 = 1.f / (1.f + t);
                topi[row * 2] = e0; topi[row * 2 + 1] = e1; topw[row * 2] = w0; topw[row * 2 + 1] = t * w0;
                atomicAdd((int*)(cntl + e0), 1); atomicAdd((int*)(cntl + e1), 1); }
        }
    }
    if (ROUTER) { __syncthreads(); if (tid < 8) cnt[w * 8 + tid] = cntl[tid]; }
}

DI void moe_totals(const int* cnt, volatile LAS int* misc, int tid) {
    const int e = tid >> 6, lane = tid & 63, w = blockIdx.x;
    int c[4]; int s4 = 0;
#pragma unroll
    for (int i = 0; i < 4; ++i) { c[i] = cnt[(4 * lane + i) * 8 + e]; s4 += c[i]; }
    int x = s4;
#pragma unroll
    for (int o = 1; o < 64; o <<= 1) { const int y = shup(x, o); if (lane >= o) x += y; }
    const int total = shidx(x, 63);
    int p = x - s4;
#pragma unroll
    for (int i = 0; i < 3; ++i) if (i < (w & 3)) p += c[i];
    p = shidx(p, w >> 2);
    if (lane == 0) { misc[e] = total; misc[8 + e] = p; }
    __syncthreads();
}

template <bool F8>
DI void phase_scatter(const int* cnt, const int* topi, const float* topw, const bf16_t* H, bf16_t* XS, int* perm, float* rgate, LAS unsigned char* lds, int tid) {
    const int wave = tid >> 6, lane = tid & 63, w = blockIdx.x;
    volatile LAS int* misc = (volatile LAS int*)(lds + LDS_MISC + 64);
    LAS int* posl = (LAS int*)(lds + LDS_SCR);
    moe_totals(cnt, misc, tid);
    { const int e = wave; int base = 0;
        for (int k = 0; k < e; ++k) base += ((misc[k] + 255) >> 8) << 8;
        int running = base + misc[8 + e];
        for (int pss = 0; pss < 2; ++pss) { const int j = 64 * pss + lane, tok = w * 128 + j;
            const int a0 = topi[tok * 2], a1 = topi[tok * 2 + 1]; const bool f0 = a0 == e, f1 = a1 == e, has = f0 || f1;
            const unsigned long long mask = __ballot(has); const int rank = __popcll(mask & ((1ull << lane) - 1ull));
            if (has) { const int pos = running + rank, slot = f1 ? 1 : 0; perm[pos] = tok * 2 + slot; rgate[pos] = topw[tok * 2 + slot]; posl[j * 2 + slot] = pos; }
            running += __popcll(mask); }
    }
    __syncthreads();
    for (int i = 0; i < 32; ++i) { const int pr = wave * 32 + i, pos = posl[pr], tok = w * 128 + (pr >> 1);
        if constexpr (F8) { *((u32x4*)((unsigned char*)XS + (size_t)pos * 1024) + lane) = *((const u32x4*)((const unsigned char*)H + (size_t)tok * 1024) + lane); }
        else { const u32x4* s = (const u32x4*)(H + (size_t)tok * 1024) + lane; u32x4* d = (u32x4*)(XS + (size_t)pos * 1024) + lane;
            const u32x4 a = s[0], b = s[64]; d[0] = a; d[64] = b; } }
}

DI void phase_final(const float* x, const bf16_t* ybuf, float* out, int tid) {
    const size_t n4 = (size_t)NTOK * 1024 / 4;
    for (size_t i = (size_t)blockIdx.x * NTHR + tid; i < n4; i += (size_t)gridDim.x * NTHR) {
        f32x4 v = ((const f32x4*)x)[i]; const u32x2 a = ((const u32x2*)ybuf)[i], b = ((const u32x2*)(ybuf + (size_t)NTOK * 1024))[i];
        v[0] += bflo(a.x) + bflo(b.x); v[1] += bfhi(a.x) + bfhi(b.x); v[2] += bflo(a.y) + bflo(b.y); v[3] += bfhi(a.y) + bfhi(b.y);
        ((f32x4*)out)[i] = v; }
}

struct QKRaw { u32x2 w[4]; };
DI void qk_load(QKRaw& R, const bf16_t* rowp, int lane, bool active) {
    const bf16_t* hp = rowp + (active ? (lane >> 2) * 64 + 4 * (lane & 3) : 0);
#pragma unroll
    for (int m = 0; m < 4; ++m) R.w[m] = *(const u32x2*)(hp + 16 * m);
}
DI void qk_finish(const QKRaw& R, bf16_t* rowp, int nh0, int nh1, const LAS float* gl  , int which, float scale, const LAS f32x2* r1l  , const LAS f32x2* ral  ,
                  int sl  , int s, int lane, bool active) {
    const int head = lane >> 2, q = lane & 3;
    const int br = head < nh0 ? 0 : (head < nh0 + nh1 ? 1 : 2);
    float v[4][4], ss = 0.f;
#pragma unroll
    for (int m = 0; m < 4; ++m) { const u32x2 w = R.w[m]; v[m][0] = bflo(w.x); v[m][1] = bfhi(w.x); v[m][2] = bflo(w.y); v[m][3] = bfhi(w.y);
        ss += (v[m][0] * v[m][0] + v[m][1] * v[m][1]) + (v[m][2] * v[m][2] + v[m][3] * v[m][3]); }
    ss += shx(ss, 1); ss += shx(ss, 2);
    const float rstd = 1.f / sqrtf(ss * (1.f / 64.f) + EPS);
    const LAS float* gp = gl + (br * 2 + which) * 64 + 4 * q;
    float o[4][4];
    f32x4 cs[4][2];
#pragma unroll
    for (int m = 0; m < 4; ++m) { const f32x4 g4 = *(const LAS f32x4*)(gp + 16 * m);
#pragma unroll
        for (int j = 0; j < 4; ++j) v[m][j] = v[m][j] * rstd * g4[j];
        const LAS f32x2* tp = (br == 2) ? r1l + sl * 32 + (m & 1) * 16 + 4 * q : ral + ((m < 2) ? (s >> 6) : (s & 63)) * 16 + 4 * q;
        cs[m][0] = *(const LAS f32x4*)tp; cs[m][1] = *(const LAS f32x4*)(tp + 2); }
#pragma unroll
    for (int m = 0; m < 4; ++m) { const bool first = (br == 2) ? (m < 2) : ((m & 1) == 0);
#pragma unroll
        for (int j = 0; j < 4; ++j) { const float pv = (br == 2) ? v[m ^ 2][j] : v[m ^ 1][j]; const float c = cs[m][j >> 1][2 * (j & 1)], sn = cs[m][j >> 1][2 * (j & 1) + 1];
            const float rot = first ? v[m][j] * c - pv * sn : v[m][j] * c + pv * sn;
            o[m][j] = ((br == 0) ? v[m][j] : rot) * scale; } }
    if (active) { bf16_t* hp = rowp + head * 64 + 4 * q;
#pragma unroll
        for (int m = 0; m < 4; ++m) { u32x2 w; w.x = pk2(o[m][0], o[m][1]); w.y = pk2(o[m][2], o[m][3]); *(u32x2*)(hp + 16 * m) = w; } }
}

DI void qk_rows_wave(const Ptrs& P, const LAS float* gl, const LAS f32x2* r1l, const LAS f32x2* ral, int wave, int lane) {
    bf16_t* Kb = (bf16_t*)(P.ws + WS_K);
    const int t0 = blockIdx.x * 128 + wave * 16;
    const bool act = lane < 48;
    QKRaw a0, a1, a2, a3, b0, b1, b2, b3;
    qk_load(a0, Kb + (size_t)t0 * 768, lane, act); qk_load(a1, Kb + (size_t)(t0 + 1) * 768, lane, act); qk_load(a2, Kb + (size_t)(t0 + 2) * 768, lane, act); qk_load(a3, Kb + (size_t)(t0 + 3) * 768, lane, act);
#pragma unroll 1
    for (int j = 0; j < 16; j += 4) { const int tok = t0 + j, tn = (j + 4 < 16) ? tok + 4 : tok, s = tok & (SEQ - 1), sl = wave * 16 + j;
        qk_load(b0, Kb + (size_t)tn * 768, lane, act); qk_load(b1, Kb + (size_t)(tn + 1) * 768, lane, act); qk_load(b2, Kb + (size_t)(tn + 2) * 768, lane, act); qk_load(b3, Kb + (size_t)(tn + 3) * 768, lane, act);
        qk_finish(a0, Kb + (size_t)tok * 768, 4, 2, gl, 1, 1.0f, r1l, ral, sl, s, lane, act);
        qk_finish(a1, Kb + (size_t)(tok + 1) * 768, 4, 2, gl, 1, 1.0f, r1l, ral, sl + 1, s + 1, lane, act);
        qk_finish(a2, Kb + (size_t)(tok + 2) * 768, 4, 2, gl, 1, 1.0f, r1l, ral, sl + 2, s + 2, lane, act);
        qk_finish(a3, Kb + (size_t)(tok + 3) * 768, 4, 2, gl, 1, 1.0f, r1l, ral, sl + 3, s + 3, lane, act);
        a0 = b0; a1 = b1; a2 = b2; a3 = b3; }
}
DI void v_units_wave(const Ptrs& P, LAS unsigned* L, int gw, int NGW, int lane) {
    const bf16_t* V = (const bf16_t*)(P.ws + WS_VRAW); bf16_t* Vt = (bf16_t*)(P.ws + WS_VT);
    u32x4 rw[8];
    { const int tt = gw / 12, hv = gw % 12; const bf16_t* src = V + (size_t)(tt * 64 + lane) * 768 + hv * 64;
#pragma unroll
      for (int c = 0; c < 8; ++c) rw[c] = *(const u32x4*)(src + c * 8); }
#pragma unroll 1
    for (int un = gw; un < 512 * 12; un += NGW) { const int tt = un / 12, hv = un % 12, tok0 = tt * 64, b = tok0 >> 12, s0 = tok0 & (SEQ - 1);
        const int g = hv < 6 ? 0 : ((hv - 6) >> 1), sh = 2 * g, dd = 1 << sh, Sd = SEQ >> sh, run = 64 >> sh;
        const int pos = (lane & (dd - 1)) * run + (lane >> sh);
#pragma unroll
        for (int c = 0; c < 8; ++c) { L[(4 * c + 0) * 68 + pos] = rw[c].x; L[(4 * c + 1) * 68 + pos] = rw[c].y; L[(4 * c + 2) * 68 + pos] = rw[c].z; L[(4 * c + 3) * 68 + pos] = rw[c].w; }
        { const int un2 = (un + NGW < 512 * 12) ? un + NGW : un; const int tt2 = un2 / 12, hv2 = un2 % 12; const bf16_t* src = V + (size_t)(tt2 * 64 + lane) * 768 + hv2 * 64;
#pragma unroll
          for (int c = 0; c < 8; ++c) rw[c] = *(const u32x4*)(src + c * 8); }
        LDS_WAIT();
        const int ch = lane & 7, p = 8 * ch;
        const size_t g1 = (size_t)(p >> (6 - sh)) * Sd + (s0 >> sh) + (p & (run - 1)), g2 = (size_t)((p + 4) >> (6 - sh)) * Sd + (s0 >> sh) + ((p + 4) & (run - 1));
#pragma unroll
        for (int i = 0; i < 8; ++i) { const int d = 8 * i + (lane >> 3), k = d >> 1;
            const u32x4 wa = *(const LAS u32x4*)(L + k * 68 + p), wb = *(const LAS u32x4*)(L + k * 68 + p + 4);
            const unsigned sel = (d & 1) ? 0x07060302u : 0x05040100u;
            u32x4 o; o.x = __builtin_amdgcn_perm(wa.y, wa.x, sel); o.y = __builtin_amdgcn_perm(wa.w, wa.z, sel); o.z = __builtin_amdgcn_perm(wb.y, wb.x, sel); o.w = __builtin_amdgcn_perm(wb.w, wb.z, sel);
            bf16_t* drow = Vt + ((size_t)(b * 12 + hv) * 64 + d) * SEQ;
            if (run >= 8) *(u32x4*)(drow + g1) = o;
            else { u32x2 t; t.x = o.x; t.y = o.y; *(u32x2*)(drow + g1) = t; t.x = o.z; t.y = o.w; *(u32x2*)(drow + g2) = t; } }
        LDS_WAIT();
    }
}
DI void phase_qkvprep(const Ptrs& P, int layer, LAS unsigned char* lds, int tid) {
    const int wave = tid >> 6, lane = tid & 63, gw = blockIdx.x * 8 + wave, NGW = gridDim.x * 8;
    LAS f32x4* r1l4 = (LAS f32x4*)(lds + LDS_SCR); LAS f32x4* ral4 = (LAS f32x4*)(lds + LDS_SCR + 32768); LAS float* gl = (LAS float*)(lds + LDS_SCR + 40960);
    const int s0 = (blockIdx.x * 128) & (SEQ - 1);
    const f32x4* r1g = (const f32x4*)(P.ws + WS_ROPE1) + (size_t)s0 * 16; const f32x4* rag = (const f32x4*)(P.ws + WS_ROPEA);
    for (int i = tid; i < 128 * 16; i += NTHR) r1l4[i] = r1g[i];
    for (int i = tid; i < 64 * 8; i += NTHR) ral4[i] = rag[i];
    if (tid < 384) gl[tid] = (P.in[3] + (size_t)layer * 384)[tid];
    __syncthreads();
    const LAS f32x2* r1l = (const LAS f32x2*)(lds + LDS_SCR); const LAS f32x2* ral = (const LAS f32x2*)(lds + LDS_SCR + 32768);
    LAS unsigned* L = (LAS unsigned*)(lds + LDS_SCR + 49152 + wave * 8704);
    if (wave < 4) { qk_rows_wave(P, gl, r1l, ral, wave, lane); v_units_wave(P, L, gw, NGW, lane); }
    else { v_units_wave(P, L, gw, NGW, lane); qk_rows_wave(P, gl, r1l, ral, wave, lane); }
}

#define XB_TMO      128
#define XB_XCNT(j)  (256  + 64 * (j))
#define XB_XSUB(j)  (1280 + 64 * (j))
#define XB_XGEN(j)  (2304 + 64 * (j))
#define XB_TOP      3328
#define XB_TOPGEN   3392
#define XCD_BAR_WORDS 3456
#define XB_SPIN_CAP (1u << 18)

__device__ __forceinline__ unsigned xb_ld(unsigned* p)              { return __hip_atomic_load(p, __ATOMIC_RELAXED, __HIP_MEMORY_SCOPE_AGENT); }
__device__ __forceinline__ unsigned xb_add(unsigned* p, unsigned v) { return __hip_atomic_fetch_add(p, v, __ATOMIC_RELAXED, __HIP_MEMORY_SCOPE_AGENT); }
__device__ __forceinline__ unsigned xb_xcc_id() { return (unsigned)__builtin_amdgcn_s_getreg((3 << 11) | 20) & 0xFu; }
#define XB_SPIN(cond, bar) do { unsigned _sp = 0; while (cond) { __builtin_amdgcn_s_sleep(1); \
    if ((++_sp & 255u) == 0u) { if (xb_ld(&(bar)[XB_TMO])) break; if (_sp > XB_SPIN_CAP) { atomicAdd(&(bar)[XB_TMO], 1u); break; } } } } while (0)

struct XcdBarrier {
    unsigned* bar; unsigned x;
    volatile LAS unsigned* st;
};

__device__ __forceinline__ XcdBarrier xcd_barrier_post(unsigned* bar, volatile LAS unsigned* st, int tid) {
    XcdBarrier b; b.bar = bar; b.x = xb_xcc_id(); b.st = st;
    if (tid == 0) (void)xb_add(&bar[XB_XCNT(b.x)], 1u);
    return b;
}
__device__ __forceinline__ void xcd_barrier_complete(unsigned* bar, unsigned x, unsigned& nloc, unsigned& nx) {
    const unsigned G = gridDim.x * gridDim.y * gridDim.z;
    unsigned sum, cnt, mine, sp = 0u;
    for (;;) {
        sum = 0u; cnt = 0u; mine = 0u;
#pragma unroll
        for (unsigned j = 0; j < 16; ++j) { const unsigned c = xb_ld(&bar[XB_XCNT(j)]); sum += c; cnt += (c > 0u) ? 1u : 0u; mine = (j == x) ? c : mine; }
        if (sum == G) break;
        __builtin_amdgcn_s_sleep(1);
        if ((++sp & 255u) == 0u) { if (xb_ld(&bar[XB_TMO])) break; if (sp > XB_SPIN_CAP) { atomicAdd(&bar[XB_TMO], 1u); break; } }
    }
    nloc = mine > 0u ? mine : 1u; nx = cnt > 0u ? cnt : 1u;
}

__device__ __forceinline__ void xcd_barrier(const XcdBarrier& b, int tid) {
    asm volatile("s_waitcnt vmcnt(0)" ::: "memory");
    __syncthreads();
    if (tid == 0) {
        unsigned* bar = b.bar;
        __builtin_amdgcn_s_waitcnt(0);
        unsigned nloc = b.st[0], nx = b.st[1];
        if (nloc == 0u) { xcd_barrier_complete(bar, b.x, nloc, nx); b.st[0] = nloc; b.st[1] = nx; }
        const unsigned old = xb_add(&bar[XB_XSUB(b.x)], 1u);
        const unsigned gen = old / nloc;
        if (old + 1u == (gen + 1u) * nloc) {
            __builtin_amdgcn_fence(__ATOMIC_RELEASE, "agent");
            asm volatile("s_waitcnt vmcnt(0)" ::: "memory");
            const unsigned og = xb_add(&bar[XB_TOP], 1u);
            const unsigned tg = og / nx;
            if (og + 1u == (tg + 1u) * nx) xb_add(&bar[XB_TOPGEN], 1u);
            else XB_SPIN(xb_ld(&bar[XB_TOPGEN]) == tg, bar);
            __builtin_amdgcn_fence(__ATOMIC_ACQUIRE, "agent");
            xb_add(&bar[XB_XGEN(b.x)], 1u);
            asm volatile("s_waitcnt vmcnt(0)" ::: "memory");
        } else {
            XB_SPIN(xb_ld(&bar[XB_XGEN(b.x)]) == gen, bar);
            __builtin_amdgcn_fence(__ATOMIC_ACQUIRE, "agent");
            asm volatile("s_waitcnt vmcnt(0)" ::: "memory");
        }
    }
    __syncthreads();
}

DI f32x16 mfma32(bf16x8 a, bf16x8 b, f32x16 c) { return __builtin_amdgcn_mfma_f32_32x32x16_bf16(a, b, c, 0, 0, 0); }
DI int pi32(int r) { return (r & 19) | ((r & 4) << 1) | ((r & 8) >> 1); }
DI int keyidx(int i, int hi) { return 16 * (i >> 3) + 8 * hi + (i & 7); }
DI bf16x8 pack8(const f32x16& x, int s) { u32x4 p; p.x = pk2(x[8 * s], x[8 * s + 1]); p.y = pk2(x[8 * s + 2], x[8 * s + 3]); p.z = pk2(x[8 * s + 4], x[8 * s + 5]); p.w = pk2(x[8 * s + 6], x[8 * s + 7]); return __builtin_bit_cast(bf16x8, p); }
DI f32x16 splat16(float v) { f32x16 z;
#pragma unroll
    for (int i = 0; i < 16; ++i) z[i] = v; return z; }
DI f32x16 zero16() { float z_ = 0.f; asm volatile("" : "+v"(z_)); return splat16(z_); }
template <int BR>
DI void q_prep(bf16x8 (&qf)[4], const bf16_t* qp  , const float* gq  , int hi, int s, const f32x2* rope1, const f32x2* ropea) {
    { int z_ = 0; asm volatile("" : "+v"(z_)); gq += z_; rope1 += z_; ropea += z_; }
    float v[4][8]; float ss = 0.f;
#pragma unroll
    for (int c = 0; c < 4; ++c) { const u32x4 w = *(const u32x4*)(qp + 16 * c);
        v[c][0] = bflo(w.x); v[c][1] = bfhi(w.x); v[c][2] = bflo(w.y); v[c][3] = bfhi(w.y); v[c][4] = bflo(w.z); v[c][5] = bfhi(w.z); v[c][6] = bflo(w.w); v[c][7] = bfhi(w.w);
#pragma unroll
        for (int j = 0; j < 8; ++j) ss += v[c][j] * v[c][j]; }
    ss += shx(ss, 32);
    const float rstd = 1.f / sqrtf(ss * (1.f / 64.f) + EPS);
#pragma unroll
    for (int c = 0; c < 4; ++c) { const f32x4 g0 = *(const f32x4*)(gq + 16 * c + 8 * hi), g1 = *(const f32x4*)(gq + 16 * c + 8 * hi + 4);
#pragma unroll
        for (int j = 0; j < 4; ++j) { v[c][j] *= rstd * g0[j]; v[c][4 + j] *= rstd * g1[j]; } }
    float o[4][8];
    if (BR == 0) {
#pragma unroll
        for (int c = 0; c < 4; ++c)
#pragma unroll
            for (int j = 0; j < 8; ++j) o[c][j] = v[c][j];
    } else {
#pragma unroll
        for (int pp = 0; pp < 2; ++pp) {
            const int cl = (BR == 2) ? pp : 2 * pp, ch = (BR == 2) ? pp + 2 : 2 * pp + 1;
            const f32x2* tp = (BR == 2) ? rope1 + s * 32 + 16 * pp + 8 * hi : ropea + ((pp == 0) ? (s >> 6) : (s & 63)) * 16 + 8 * hi;
#pragma unroll
            for (int j2 = 0; j2 < 4; ++j2) { const f32x4 t = *(const f32x4*)(tp + 2 * j2);
                o[cl][2 * j2] = v[cl][2 * j2] * t[0] - v[ch][2 * j2] * t[1]; o[ch][2 * j2] = v[ch][2 * j2] * t[0] + v[cl][2 * j2] * t[1];
                o[cl][2 * j2 + 1] = v[cl][2 * j2 + 1] * t[2] - v[ch][2 * j2 + 1] * t[3]; o[ch][2 * j2 + 1] = v[ch][2 * j2 + 1] * t[2] + v[cl][2 * j2 + 1] * t[3]; } }
    }
#pragma unroll
    for (int c = 0; c < 4; ++c) { u32x4 w; w.x = pk2(o[c][0] * QSCALE, o[c][1] * QSCALE); w.y = pk2(o[c][2] * QSCALE, o[c][3] * QSCALE); w.z = pk2(o[c][4] * QSCALE, o[c][5] * QSCALE); w.w = pk2(o[c][6] * QSCALE, o[c][7] * QSCALE);
        qf[c] = __builtin_bit_cast(bf16x8, w); }
}
struct QTab { const float* qkg; const f32x2* rope1; const f32x2* ropea; };
constexpr float SM_THR = 8.f;
DI float max16x2(const f32x16& a, const f32x16& b) {
    float m0 = fmaxf(fmaxf(a[0], a[1]), a[2]), m1 = fmaxf(fmaxf(b[0], b[1]), b[2]);
#pragma unroll
    for (int i = 3; i < 15; i += 2) { m0 = fmaxf(fmaxf(m0, a[i]), a[i + 1]); m1 = fmaxf(fmaxf(m1, b[i]), b[i + 1]); }
    return fmaxf(fmaxf(m0, m1), fmaxf(a[15], b[15]));
}
#define SOFTMAX_BODY(UPD_NEGM) \
    const float mx = max16x2(s0, s1); \
    if (__any(mx > SM_THR)) {                                          \
        float delta = fmaxf(fmaxf(mx, shx(mx, 32)), 0.f); asm volatile("" : "+v"(delta));     \
        const float alpha = __builtin_amdgcn_exp2f(-delta); \
        mref += delta; l *= alpha; UPD_NEGM \
        _Pragma("unroll") for (int i = 0; i < 16; ++i) { o0[i] *= alpha; o1[i] *= alpha; s0[i] -= delta; s1[i] -= delta; } \
    } \
    float sum0 = 0.f, sum1 = 0.f; \
    _Pragma("unroll") for (int i = 0; i < 16; ++i) { s0[i] = __builtin_amdgcn_exp2f(s0[i]); s1[i] = __builtin_amdgcn_exp2f(s1[i]); sum0 += s0[i]; sum1 += s1[i]; } \
    l += sum0 + sum1;
DI void softmax_lazy(f32x16& s0, f32x16& s1, float& mref, float& l, f32x16& o0, f32x16& o1) { SOFTMAX_BODY() }
DI void softmax_lazy(f32x16& s0, f32x16& s1, float& mref, f32x16& negm, float& l, f32x16& o0, f32x16& o1) { SOFTMAX_BODY(negm = splat16(-mref);) }
DI void store_o(bf16_t* op  , const f32x16& o0, const f32x16& o1, float l) {
    const float inv = 1.f / (l + shx(l, 32));
#pragma unroll
    for (int g = 0; g < 4; ++g) { u32x2 a, b;
        a.x = pk2(o0[4 * g] * inv, o0[4 * g + 1] * inv); a.y = pk2(o0[4 * g + 2] * inv, o0[4 * g + 3] * inv);
        b.x = pk2(o1[4 * g] * inv, o1[4 * g + 1] * inv); b.y = pk2(o1[4 * g + 2] * inv, o1[4 * g + 3] * inv);
        *(u32x2*)(op + 8 * g) = a; *(u32x2*)(op + 32 + 8 * g) = b; }
}

constexpr int GQ_KB = 128 * 144, GQ_VB = 64 * 272, GQ_BUF = GQ_KB + GQ_VB;
template <bool FAST>
DI void gqa_unit(LAS unsigned char* lds, const QTab& qt, const bf16_t* Q, const bf16_t* Kb, const bf16_t* Vt, bf16_t* OB, int b, int hq, int qb, int tid) {
    const int wave = tid >> 6, lane = tid & 63, r = lane & 31, hi = lane >> 5, kvh = hq / 3;
    const int qtok = b * SEQ + qb * 256 + wave * 32 + r;
    bf16x8 qf[4];
    q_prep<1>(qf, Q + (size_t)qtok * 1024 + (4 + hq) * 64 + 8 * hi, qt.qkg + 2 * 64, hi, qtok & (SEQ - 1), qt.rope1, qt.ropea);
    const int kr0 = tid >> 3, kc0 = tid & 7, vr0 = tid >> 4, vc0 = tid & 15;
    const bf16_t* kg = Kb + (size_t)(b * SEQ + kr0) * 768 + (4 + kvh) * 64 + kc0 * 8;
    const bf16_t* vg = Vt + ((size_t)(b * 12 + 4 + kvh) * 64 + vr0) * SEQ + vc0 * 8;
    const int ksoff = kr0 * 144 + kc0 * 16, vsoff = GQ_KB + vr0 * 272 + vc0 * 16;
    u32x4 ka = *(const u32x4*)kg, kb2 = *(const u32x4*)(kg + (size_t)64 * 768), va = *(const u32x4*)vg, vb2 = *(const u32x4*)(vg + (size_t)32 * SEQ);
    *(LAS u32x4*)(lds + ksoff) = ka; *(LAS u32x4*)(lds + ksoff + 64 * 144) = kb2; *(LAS u32x4*)(lds + vsoff) = va; *(LAS u32x4*)(lds + vsoff + 32 * 272) = vb2;
    __syncthreads();
    float mref = 0.f, l = 0.f; f32x16 o0 = zero16(), o1 = zero16(), negm = zero16(), lacc = zero16();
    const u32x4 ones_u = {0x3F803F80u, 0x3F803F80u, 0x3F803F80u, 0x3F803F80u}; const bf16x8 ones = __builtin_bit_cast(bf16x8, ones_u);
    const int koff = pi32(r) * 144 + hi * 16, voff = GQ_KB + r * 272 + hi * 16;
#define GQ_LDK(dst, base) do { _Pragma("unroll") for (int c_ = 0; c_ < 4; ++c_) { dst[c_] = *(const LAS bf16x8*)((base) + c_ * 32); dst[4 + c_] = *(const LAS bf16x8*)((base) + 32 * 144 + c_ * 32); } } while (0)
#define GQ_LDV(dst, base) do { _Pragma("unroll") for (int c_ = 0; c_ < 4; ++c_) { dst[c_] = *(const LAS bf16x8*)((base) + c_ * 32); dst[4 + c_] = *(const LAS bf16x8*)((base) + 32 * 272 + c_ * 32); } } while (0)
    for (int it = 0; it < 32; ++it) {
        const int cur = it & 1;
        if (it + 1 < 32) { const bf16_t* kn = kg + (size_t)(it + 1) * 128 * 768; const bf16_t* vn = vg + (it + 1) * 128;
            ka = *(const u32x4*)kn; kb2 = *(const u32x4*)(kn + (size_t)64 * 768); va = *(const u32x4*)vn; vb2 = *(const u32x4*)(vn + (size_t)32 * SEQ); }
        const LAS unsigned char* Bc = lds + cur * GQ_BUF;
        bf16x8 kf[8], vf[8], kf2[8];
        GQ_LDK(kf, Bc + koff);
        __builtin_amdgcn_sched_barrier(0);
        f32x16 s0 = FAST ? splat16(0.f) : negm, s1 = FAST ? splat16(0.f) : negm;
#pragma unroll
        for (int c = 0; c < 4; ++c) { s0 = mfma32(kf[c], qf[c], s0); s1 = mfma32(kf[4 + c], qf[c], s1); }
        GQ_LDV(vf, Bc + voff); if constexpr (FAST) GQ_LDK(kf2, Bc + 64 * 144 + koff);
        __builtin_amdgcn_sched_barrier(0);
        if constexpr (FAST) {
#pragma unroll
            for (int i = 0; i < 16; ++i) { s0[i] = __builtin_amdgcn_exp2f(s0[i]); s1[i] = __builtin_amdgcn_exp2f(s1[i]); } }
        else softmax_lazy(s0, s1, mref, negm, l, o0, o1);
#pragma unroll
        for (int s4 = 0; s4 < 4; ++s4) { const bf16x8 pf = pack8(s4 < 2 ? s0 : s1, s4 & 1); o0 = mfma32(vf[s4], pf, o0); o1 = mfma32(vf[4 + s4], pf, o1); if constexpr (FAST) lacc = mfma32(ones, pf, lacc); }
        if constexpr (!FAST) { __builtin_amdgcn_sched_barrier(0); GQ_LDK(kf2, Bc + 64 * 144 + koff); }
        s0 = FAST ? splat16(0.f) : negm; s1 = FAST ? splat16(0.f) : negm;
#pragma unroll
        for (int c = 0; c < 4; ++c) { s0 = mfma32(kf2[c], qf[c], s0); s1 = mfma32(kf2[4 + c], qf[c], s1); }
        GQ_LDV(vf, Bc + voff + 128);
        __builtin_amdgcn_sched_barrier(0);
        if constexpr (FAST) {
#pragma unroll
            for (int i = 0; i < 16; ++i) { s0[i] = __builtin_amdgcn_exp2f(s0[i]); s1[i] = __builtin_amdgcn_exp2f(s1[i]); } }
        else softmax_lazy(s0, s1, mref, negm, l, o0, o1);
#pragma unroll
        for (int s4 = 0; s4 < 4; ++s4) { const bf16x8 pf = pack8(s4 < 2 ? s0 : s1, s4 & 1); o0 = mfma32(vf[s4], pf, o0); o1 = mfma32(vf[4 + s4], pf, o1); if constexpr (FAST) lacc = mfma32(ones, pf, lacc); }
        if (it + 1 < 32) { LAS unsigned char* Bn = lds + (cur ^ 1) * GQ_BUF;
            *(LAS u32x4*)(Bn + ksoff) = ka; *(LAS u32x4*)(Bn + ksoff + 64 * 144) = kb2; *(LAS u32x4*)(Bn + vsoff) = va; *(LAS u32x4*)(Bn + vsoff + 32 * 272) = vb2; }
        __syncthreads();
    }
#undef GQ_LDK
#undef GQ_LDV
    if constexpr (FAST) store_o(OB + (size_t)qtok * 768 + hq * 64 + 4 * hi, o0, o1, 0.5f * lacc[0]);
    else store_o(OB + (size_t)qtok * 768 + hq * 64 + 4 * hi, o0, o1, l);
}

template <int NT>
DI void gqa3_wave(LAS unsigned char* lds, const QTab& qt, const bf16_t* Q, const bf16_t* Kb, const bf16_t* Vt, bf16_t* OB, int b, int kvh, int qblk, int wave, int lane) {
    const int r = lane & 31, hi = lane >> 5;
    const int tq0 = (NT == 2) ? 2 * wave : 8 + (wave - 4), hl = tq0 >> 2, hq = 3 * kvh + hl;
    int qtok[NT]; bf16x8 qf[NT][4]; f32x16 o0[NT], o1[NT]; float l[NT];
#pragma unroll
    for (int t = 0; t < NT; ++t) { qtok[t] = b * SEQ + qblk * 128 + ((tq0 + t) & 3) * 32 + r;
        q_prep<1>(qf[t], Q + (size_t)qtok[t] * 1024 + (4 + hq) * 64 + 8 * hi, qt.qkg + 2 * 64, hi, qtok[t] & (SEQ - 1), qt.rope1, qt.ropea);
        __builtin_amdgcn_sched_barrier(0); }
#pragma unroll
    for (int t = 0; t < NT; ++t) { o0[t] = zero16(); o1[t] = zero16(); l[t] = 0.f; }
    const int st = (wave & 3) * 64 + lane;
    const bf16_t* kg = Kb + (size_t)(b * SEQ + (st >> 3)) * 768 + (4 + kvh) * 64 + (st & 7) * 8;
    const bf16_t* vg = Vt + ((size_t)(b * 12 + 4 + kvh) * 64 + (st >> 4)) * SEQ + (st & 15) * 8;
    const int ksoff = (st >> 3) * 144 + (st & 7) * 16, vsoff = GQ_KB + (st >> 4) * 272 + (st & 15) * 16;
    u32x4 kq[4], vq[4];
#define G3_GLOAD(T_) do { _Pragma("unroll") for (int i_ = 0; i_ < 4; ++i_) { kq[i_] = *(const u32x4*)(kg + (size_t)((T_) * 128 + 32 * i_) * 768); vq[i_] = *(const u32x4*)(vg + (size_t)16 * i_ * SEQ + (T_) * 128); } } while (0)
#define G3_LSTORE(B_) do { LAS unsigned char* Bn_ = lds + (B_) * GQ_BUF; _Pragma("unroll") for (int i_ = 0; i_ < 4; ++i_) { *(LAS u32x4*)(Bn_ + ksoff + 32 * i_ * 144) = kq[i_]; *(LAS u32x4*)(Bn_ + vsoff + 16 * i_ * 272) = vq[i_]; } } while (0)
    if (NT == 1) { G3_GLOAD(0); G3_LSTORE(0); }
    __syncthreads();
    const int koff = pi32(r) * 144 + hi * 16, voff = GQ_KB + r * 272 + hi * 16;
#pragma unroll 1
    for (int it = 0; it < 32; ++it) {
        const int cur = it & 1;
        if (NT == 1 && it + 1 < 32) G3_GLOAD(it + 1);
        const LAS unsigned char* Bc = lds + cur * GQ_BUF;
#pragma unroll
        for (int hf = 0; hf < 2; ++hf) {
            bf16x8 kf[8], pf[NT][4];
#pragma unroll
            for (int c = 0; c < 4; ++c) { kf[c] = *(const LAS bf16x8*)(Bc + hf * 64 * 144 + koff + c * 32); kf[4 + c] = *(const LAS bf16x8*)(Bc + hf * 64 * 144 + koff + 32 * 144 + c * 32); }
#define G3_QK(t_, s0_, s1_) do { _Pragma("unroll") for (int c = 0; c < 4; ++c) { s0_ = mfma32(kf[c], qf[t_][c], s0_); s1_ = mfma32(kf[4 + c], qf[t_][c], s1_); } } while (0)
#define G3_SM(t_, s0_, s1_) do { float sum0 = 0.f, sum1 = 0.f; \
                _Pragma("unroll") for (int i = 0; i < 16; ++i) { s0_[i] = __builtin_amdgcn_exp2f(s0_[i]); s1_[i] = __builtin_amdgcn_exp2f(s1_[i]); sum0 += s0_[i]; sum1 += s1_[i]; } \
                l[t_] += sum0 + sum1; pf[t_][0] = pack8(s0_, 0); pf[t_][1] = pack8(s0_, 1); pf[t_][2] = pack8(s1_, 0); pf[t_][3] = pack8(s1_, 1); } while (0)
#define G3_LDV() do { _Pragma("unroll") for (int c = 0; c < 4; ++c) { vf[c] = *(const LAS bf16x8*)(Bc + voff + hf * 128 + c * 32); vf[4 + c] = *(const LAS bf16x8*)(Bc + voff + hf * 128 + 32 * 272 + c * 32); } } while (0)
#define G3_PV(t_) do { _Pragma("unroll") for (int s4 = 0; s4 < 4; ++s4) { o0[t_] = mfma32(vf[s4], pf[t_][s4], o0[t_]); o1[t_] = mfma32(vf[4 + s4], pf[t_][s4], o1[t_]); } } while (0)
            bf16x8 vf[8];
            if constexpr (NT == 2) {
                f32x16 sa0 = splat16(0.f), sa1 = splat16(0.f), sb0 = splat16(0.f), sb1 = splat16(0.f);
                bf16x8 vh[4];
#define G3_HSM(t_, s_, j_) do { float sum_ = 0.f; _Pragma("unroll") for (int i = 0; i < 16; ++i) { s_[i] = __builtin_amdgcn_exp2f(s_[i]); sum_ += s_[i]; } \
                l[t_] += sum_; pf[t_][2 * (j_)] = pack8(s_, 0); pf[t_][2 * (j_) + 1] = pack8(s_, 1); } while (0)
#define G3_FENCE() __builtin_amdgcn_sched_barrier(0)
#define G3_PIN(x_) asm volatile("" : "+v"(x_))
#define G3_QS(t_, s_, j_, MF_) do { float sum_ = 0.f; unsigned w_[8]; \
                _Pragma("unroll") for (int q = 0; q < 4; ++q) { \
                    const float x0_ = __builtin_amdgcn_exp2f(s_[4 * q]), x1_ = __builtin_amdgcn_exp2f(s_[4 * q + 1]), x2_ = __builtin_amdgcn_exp2f(s_[4 * q + 2]), x3_ = __builtin_amdgcn_exp2f(s_[4 * q + 3]); \
                    MF_(q); \
                    sum_ += x0_; sum_ += x1_; sum_ += x2_; sum_ += x3_; w_[2 * q] = pk2(x0_, x1_); w_[2 * q + 1] = pk2(x2_, x3_); \
                    G3_PIN(w_[2 * q]); G3_PIN(w_[2 * q + 1]); G3_PIN(sum_); G3_FENCE(); } \
                l[t_] += sum_; { u32x4 a_ = {w_[0], w_[1], w_[2], w_[3]}, b_ = {w_[4], w_[5], w_[6], w_[7]}; pf[t_][2 * (j_)] = __builtin_bit_cast(bf16x8, a_); pf[t_][2 * (j_) + 1] = __builtin_bit_cast(bf16x8, b_); } } while (0)
#define G3_MF2(q) do { sb0 = mfma32(kf[q], qf[1][q], sb0); G3_PIN(sb0); } while (0)
#define G3_MF3(q) do { sb1 = mfma32(kf[4 + q], qf[1][q], sb1); G3_PIN(sb1); } while (0)
#define G3_MF4(q) do { o0[0] = mfma32(vf[q], pf[0][q], o0[0]); G3_PIN(o0[0]); } while (0)
#define G3_MF5(q) do { o1[0] = mfma32(vh[q], pf[0][q], o1[0]); G3_PIN(o1[0]); } while (0)
                G3_QK(0, sa0, sa1);
                G3_PIN(sa0); G3_PIN(sa1); G3_FENCE();
                G3_QS(0, sa0, 0, G3_MF2);
                G3_PIN(sb0); G3_PIN(pf[0][0]); G3_PIN(pf[0][1]); G3_PIN(l[0]); G3_FENCE();
                G3_QS(0, sa1, 1, G3_MF3);
                G3_PIN(sb1); G3_PIN(pf[0][2]); G3_PIN(pf[0][3]); G3_PIN(l[0]); G3_FENCE();
                _Pragma("unroll") for (int c = 0; c < 4; ++c) vf[c] = *(const LAS bf16x8*)(Bc + voff + hf * 128 + c * 32);
                G3_QS(1, sb0, 0, G3_MF4);
                G3_PIN(o0[0]); G3_PIN(pf[1][0]); G3_PIN(pf[1][1]); G3_PIN(l[1]); G3_FENCE();
                _Pragma("unroll") for (int c = 0; c < 4; ++c) vh[c] = *(const LAS bf16x8*)(Bc + voff + hf * 128 + 32 * 272 + c * 32);
                G3_QS(1, sb1, 1, G3_MF5);
                G3_PIN(o1[0]); G3_PIN(pf[1][2]); G3_PIN(pf[1][3]); G3_PIN(l[1]); G3_FENCE();
                _Pragma("unroll") for (int s4 = 0; s4 < 4; ++s4) { o0[1] = mfma32(vf[s4], pf[1][s4], o0[1]); o1[1] = mfma32(vh[s4], pf[1][s4], o1[1]); }
                G3_PIN(o0[1]); G3_PIN(o1[1]); G3_FENCE();
#undef G3_PIN
#undef G3_HSM
#undef G3_FENCE
#undef G3_QS
#undef G3_MF2
#undef G3_MF3
#undef G3_MF4
#undef G3_MF5
            } else {
                f32x16 sa0 = splat16(0.f), sa1 = splat16(0.f);
                G3_QK(0, sa0, sa1); G3_SM(0, sa0, sa1); G3_LDV(); G3_PV(0);
            }
#undef G3_QK
#undef G3_SM
#undef G3_LDV
#undef G3_PV
        }
        if (NT == 1 && it + 1 < 32) G3_LSTORE(cur ^ 1);
        __syncthreads();
    }
#undef G3_GLOAD
#undef G3_LSTORE
    { const int ln = lane_v(), r2 = ln & 31, hi2 = ln >> 5;
#pragma unroll
      for (int t = 0; t < NT; ++t) store_o(OB + (size_t)(b * SEQ + qblk * 128 + ((tq0 + t) & 3) * 32 + r2) * 768 + hq * 64 + 4 * hi2, o0[t], o1[t], l[t]); }
}

struct WTile { u32x4 k[4], v[4]; };
DI void wt_store(LAS unsigned char* wl, const WTile& T, int lane) {
#pragma unroll
    for (int i = 0; i < 4; ++i) { const int kr = 8 * i + (lane >> 3), vr = 16 * i + (lane >> 2);
        *(LAS u32x4*)(wl + kr * 128 + (((lane & 7) ^ ((kr >> 1) & 7)) << 4)) = T.k[i];
        *(LAS u32x4*)(wl + 4096 + vr * 64 + (((lane & 3) ^ ((vr >> 2) & 3)) << 4)) = T.v[i]; }
}
DI void wt_ldk(bf16x8 (&kf)[4], const LAS unsigned char* wl, int pr, int hi) {
#pragma unroll
    for (int c = 0; c < 4; ++c) kf[c] = *(const LAS bf16x8*)(wl + pr * 128 + (((2 * c + hi) ^ ((pr >> 1) & 7)) << 4));
}
DI void wt_ldv(bf16x8 (&vf)[4], const LAS unsigned char* wl, int r, int hi) {
#pragma unroll
    for (int dt = 0; dt < 2; ++dt)
#pragma unroll
        for (int sk = 0; sk < 2; ++sk) { const int row = 32 * dt + r; vf[2 * dt + sk] = *(const LAS bf16x8*)(wl + 4096 + row * 64 + (((2 * sk + hi) ^ ((row >> 2) & 3)) << 4)); }
}
DI void softmax_lazy1(f32x16& s, float& mref, float& l, f32x16& o0, f32x16& o1) {
    float mx = fmaxf(fmaxf(s[0], s[1]), s[2]);
#pragma unroll
    for (int i = 3; i < 15; i += 2) mx = fmaxf(fmaxf(mx, s[i]), s[i + 1]);
    mx = fmaxf(mx, s[15]);
    if (__any(mx > SM_THR)) {
        float delta = fmaxf(fmaxf(mx, shx(mx, 32)), 0.f); asm volatile("" : "+v"(delta));
        const float alpha = __builtin_amdgcn_exp2f(-delta);
        mref += delta; l *= alpha;
#pragma unroll
        for (int i = 0; i < 16; ++i) { o0[i] *= alpha; o1[i] *= alpha; s[i] -= delta; }
    }
    float sum = 0.f;
#pragma unroll
    for (int i = 0; i < 16; ++i) { s[i] = __builtin_amdgcn_exp2f(s[i]); sum += s[i]; }
    l += sum;
}
DI void pv_step(f32x16& o0, f32x16& o1, const f32x16& p, const bf16x8 (&vf)[4]) {
    const bf16x8 p0 = pack8(p, 0), p1 = pack8(p, 1);
    o0 = mfma32(vf[0], p0, o0); o1 = mfma32(vf[2], p0, o1); o0 = mfma32(vf[1], p1, o0); o1 = mfma32(vf[3], p1, o1);
}

DI void na_unit(LAS unsigned char* wl, const QTab& qt, const LAS float* biasl, const bf16_t* Q, const bf16_t* Kb, const bf16_t* Vt, bf16_t* OA, int b, int rp, int h, int a, int lane) {
    const int r = lane & 31, hi = lane >> 5, pr = pi32(r);
    const int grow = 2 * rp + (r >> 4), qcol = 16 * a + (r & 15), qtok = b * SEQ + grow * 64 + qcol;
    bf16x8 qf[4];
    q_prep<0>(qf, Q + (size_t)qtok * 1024 + h * 64 + 8 * hi, qt.qkg, hi, 0, qt.rope1, qt.ropea);
    const int rs = min(max(grow - 4, 0), 56), cs = min(max(qcol - 8, 0), 48);
    const int krs = min(max(2 * rp - 4, 0), 56), nk = min(max(2 * rp - 3, 0), 56) + 8 - krs, kc0 = min(max(16 * a - 8, 0), 32);
    const bf16_t* kp = Kb + (size_t)(b * SEQ + krs * 64 + kc0 + (lane >> 3)) * 768 + h * 64 + (lane & 7) * 8;
    const bf16_t* vp = Vt + ((size_t)(b * 12 + h) * 64 + (lane >> 2)) * SEQ + krs * 64 + kc0 + (lane & 3) * 8;
    float mref = 0.f, l = 0.f; f32x16 o0 = zero16(), o1 = zero16();
    WTile T;
#pragma unroll
    for (int i = 0; i < 4; ++i) { T.k[i] = *(const u32x4*)(kp + (size_t)8 * i * 768); T.v[i] = *(const u32x4*)(vp + (size_t)16 * i * SEQ); }
    wt_store(wl, T, lane);
#pragma unroll 1
    for (int st = 0; st < nk; ++st) {
        if (st + 1 < nk) { const int n = st + 1;
#pragma unroll
            for (int i = 0; i < 4; ++i) { T.k[i] = *(const u32x4*)(kp + (size_t)(64 * n + 8 * i) * 768); T.v[i] = *(const u32x4*)(vp + (size_t)16 * i * SEQ + 64 * n); } }
        bf16x8 kf[4], vf[4];
        wt_ldk(kf, wl, pr, hi);
        f32x16 sc = splat16(0.f);
#pragma unroll
        for (int c = 0; c < 4; ++c) sc = mfma32(kf[c], qf[c], sc);
        wt_ldv(vf, wl, r, hi);
        const int kr = krs + st; const bool rowok = (kr >= rs) && (kr < rs + 8);
        const LAS float* brow = biasl + (h * 15 + min(max(kr - grow + 7, 0), 14)) * 31 + 15 - qcol;
#pragma unroll
        for (int i = 0; i < 16; ++i) { const int c0 = kc0 + keyidx(i, hi);
            const bool v0 = rowok && (c0 >= cs) && (c0 < cs + 16);
            const float b0 = brow[v0 ? c0 : qcol];
            sc[i] = v0 ? sc[i] + (b0 - mref) : -1e30f; }
        softmax_lazy1(sc, mref, l, o0, o1);
        pv_step(o0, o1, sc, vf);
        if (st + 1 < nk) wt_store(wl, T, lane);
    }
    store_o(OA + (size_t)qtok * 768 + h * 64 + 4 * hi, o0, o1, l);
}

#define DIL_ISSUE(G_, KS_, T_) do { \
    constexpr int sh_ = 2 * (G_), Sd_ = SEQ >> sh_, dd_ = 1 << sh_; const int hk_ = 6 + 2 * (G_) + hs, rd_ = r16 & (dd_ - 1); \
    const bf16_t* kb_ = Kb + (size_t)(b * SEQ + rd_) * 768 + hk_ * 64 + (lane & 7) * 8; \
    const bf16_t* vb_ = Vt + ((size_t)(b * 12 + hk_) * 64 + (lane >> 2)) * SEQ + rd_ * Sd_ + min(max((KS_) + 8 * (lane & 3), 0), Sd_ - 8); \
    _Pragma("unroll") for (int i_ = 0; i_ < 4; ++i_) { const int ik_ = min(max((KS_) + 8 * i_ + (lane >> 3), 0), Sd_ - 1); \
        T_.k[i_] = *(const u32x4*)(kb_ + (size_t)(ik_ << sh_) * 768); T_.v[i_] = *(const u32x4*)(vb_ + (size_t)16 * i_ * SEQ); } } while (0)

template <int G>
DI void dil_group(LAS unsigned char* wl, const QTab& qt, WTile& T, const bf16_t* Q, const bf16_t* Kb, const bf16_t* Vt, int b, int hs, int r16, int ib, int qtok, int lane,
                  float& mref, float& l, f32x16& o0, f32x16& o1) {
    constexpr int sh = 2 * G, Sd = SEQ >> sh, step = 16 >> sh;
    const int r = lane & 31, hi = lane >> 5, pr = pi32(r);
    bf16x8 qf[4];
    q_prep<2>(qf, Q + (size_t)qtok * 1024 + (10 + 2 * G + hs) * 64 + 8 * hi, qt.qkg + 4 * 64, hi, qtok & (SEQ - 1), qt.rope1, qt.ropea);
    const int qd = r16 >> sh, iq = qd + step * (32 * ib + r);
    const int lo = qd + step * 32 * ib - 64, hiend = qd + step * (32 * ib + 31) + 64;
#pragma unroll 1
    for (int ks = (lo >> 5) << 5; ks <= hiend; ks += 32) {
        const bool more = ks + 32 <= hiend;
        if (more) DIL_ISSUE(G, ks + 32, T);
        else if (G < 2) { constexpr int G1 = G < 2 ? G + 1 : 2, sh1 = 2 * G1, step1 = 16 >> sh1; const int lo1 = (r16 >> sh1) + step1 * 32 * ib - 64; DIL_ISSUE(G1, (lo1 >> 5) << 5, T); }
        bf16x8 kf[4], vf[4];
        wt_ldk(kf, wl, pr, hi);
        f32x16 sc = splat16(0.f);
#pragma unroll
        for (int c = 0; c < 4; ++c) sc = mfma32(kf[c], qf[c], sc);
        wt_ldv(vf, wl, r, hi);
#pragma unroll
        for (int i = 0; i < 16; ++i) { const int a0 = ks + keyidx(i, hi);
            const bool v0 = (a0 >= 0) && (a0 < Sd) && (abs(a0 - iq) <= 64);
            sc[i] = v0 ? sc[i] - mref : -1e30f; }
        softmax_lazy1(sc, mref, l, o0, o1);
        pv_step(o0, o1, sc, vf);
        if (more || G < 2) wt_store(wl, T, lane);
    }
}
DI void dil_unit(LAS unsigned char* wl, const QTab& qt, const bf16_t* Q, const bf16_t* Kb, const bf16_t* Vt, bf16_t* OC, int b, int hs, int r16, int ib, int lane) {
    const int r = lane & 31, hi = lane >> 5;
    const int qtok = b * SEQ + r16 + 16 * (32 * ib + r);
    float mref = 0.f, l = 0.f; f32x16 o0 = zero16(), o1 = zero16();
    WTile T;
    { const int lo0 = r16 + 16 * 32 * ib - 64; DIL_ISSUE(0, (lo0 >> 5) << 5, T); wt_store(wl, T, lane); }
    dil_group<0>(wl, qt, T, Q, Kb, Vt, b, hs, r16, ib, qtok, lane, mref, l, o0, o1);
    dil_group<1>(wl, qt, T, Q, Kb, Vt, b, hs, r16, ib, qtok, lane, mref, l, o0, o1);
    dil_group<2>(wl, qt, T, Q, Kb, Vt, b, hs, r16, ib, qtok, lane, mref, l, o0, o1);
    store_o(OC + (size_t)qtok * 768 + hs * 64 + 4 * hi, o0, o1, l);
}

DI void phase_attn(const Ptrs& P, int layer, LAS unsigned char* lds, int tid) {
    const int wave = __builtin_amdgcn_readfirstlane(tid >> 6), lane = tid & 63, c = blockIdx.x;
    const bf16_t* Q = (const bf16_t*)(P.ws + WS_Q); const bf16_t* Kb = (const bf16_t*)(P.ws + WS_K); const bf16_t* Vt = (const bf16_t*)(P.ws + WS_VT);
    bf16_t* OA = (bf16_t*)(P.ws + WS_OALL); bf16_t* OB = OA + 256; bf16_t* OC = OA + 640;
    const QTab qt{P.in[3] + (size_t)layer * 384, (const f32x2*)(P.ws + WS_ROPE1), (const f32x2*)(P.ws + WS_ROPEA)};
    bool gqa_fast;
    { float gq = fabsf(qt.qkg[2 * 64 + lane]), gk = fabsf(qt.qkg[3 * 64 + lane]);
#pragma unroll
      for (int o = 1; o < 64; o <<= 1) { gq = fmaxf(gq, shx(gq, o)); gk = fmaxf(gk, shx(gk, o)); }
      gqa_fast = __builtin_amdgcn_readfirstlane((int)(64.f * QSCALE * gq * gk < 60.f)) != 0; }
    LAS float* biasl = (LAS float*)(lds + LDS_MISC + 1024);
    LAS unsigned char* wl = lds + LDS_SCR + wave * 16384;
    { const float* rpb = P.in[4] + (size_t)layer * 4 * 15 * 31;
      for (int i = tid; i < 4 * 15 * 31; i += NTHR) biasl[i] = rpb[i] * LOG2E; }
    __syncthreads();
#ifndef NO_NA
    int cx = (c & 7) * 32 + (c >> 3); asm volatile("" : "+s"(cx));
    RP(16) for (int u = 0; u < 2; ++u) na_unit(wl, qt, biasl, Q, Kb, Vt, OA, cx >> 5, cx & 31, wave >> 1, 2 * (wave & 1) + u, lane);
#endif
#ifndef NO_DIL
    RP(17) { const int w = cx * 8 + wave; dil_unit(wl, qt, Q, Kb, Vt, OC, w >> 8, (w >> 7) & 1, (w >> 3) & 15, w & 7, lane); }
    __syncthreads();
#endif
#ifndef NO_GQA
    { const int xcd = c & 7, loc = c >> 3;
      if (gqa_fast) { RP(18) for (int i = 0; i < 2; ++i) { const int j = loc + 32 * i, pair = 2 * xcd + (j >> 5), qblk = j & 31;
          if (wave < 4) gqa3_wave<2>(lds + LDS_SCR, qt, Q, Kb, Vt, OB, pair >> 1, pair & 1, qblk, wave, lane_v());
          else gqa3_wave<1>(lds + LDS_SCR, qt, Q, Kb, Vt, OB, pair >> 1, pair & 1, qblk, wave, lane_v()); } }
      else { for (int i = 0; i < 3; ++i) { const int j = loc + 32 * i, pair = 2 * xcd + j / 48, jj = j % 48;
          const int tid2 = (wave << 6) | lane_v();
          gqa_unit<false>(lds + LDS_SCR, qt, Q, Kb, Vt, OB, pair >> 1, (pair & 1) * 3 + jj / 16, jj & 15, tid2); } } }
#endif
}


__global__ void __launch_bounds__(NTHR, 2) mk_fwd(Args a) {
    extern __shared__ __attribute__((aligned(16))) unsigned char lds_raw[];
    LAS unsigned char* lds = (LAS unsigned char*)lds_raw;
    const int tid0 = threadIdx.x;
    const int wid_s = __builtin_amdgcn_readfirstlane(tid0 >> 6);
#define OTID() ({ int l_; asm volatile("v_mbcnt_lo_u32_b32 %0, -1, 0\n\tv_mbcnt_hi_u32_b32 %0, -1, %0" : "=v"(l_)); (wid_s << 6) | l_; })
    for (int i = tid0; i < 256; i += NTHR) ((LAS unsigned*)(lds + LDS_MISC))[i] = 0u;
    __syncthreads();
#define P a
#define ws (a.ws)
    const bool multi = (a.hi - a.lo) > 1;
    XcdBarrier bar; bar.bar = (unsigned*)ws + CW_BAR; bar.x = 0; bar.st = (volatile LAS unsigned*)(lds + LDS_MISC);
    if (multi) bar = xcd_barrier_post((unsigned*)ws + CW_BAR, (volatile LAS unsigned*)(lds + LDS_MISC), tid0);
#define RUN(s) (a.lo <= (s) && (s) < a.hi)

#if TSEL >= 0
    unsigned long long* tsb = (unsigned long long*)(ws + WS_CTL + 262144); int tsi = 0;
#define TSTAMP() do { if (blockIdx.x == 0 && OTID() == 0) tsb[tsi] = __builtin_amdgcn_s_memrealtime(); ++tsi; } while (0)
    TSTAMP();
#else
#define TSTAMP() do { } while (0)
#endif
#define SEAM() do { if (multi) xcd_barrier(bar, OTID()); TSTAMP(); } while (0)
#define H ((bf16_t*)(ws + WS_H))
#define YB ((bf16_t*)(ws + WS_YBUF))
#define ACT ((bf16_t*)(ws + WS_ACT))
#define XS ((bf16_t*)(ws + WS_XS))
#define topi ((int*)(ws + WS_TOPI))
#define topw ((float*)(ws + WS_TOPW))
#define perm ((int*)(ws + WS_PERM))
#define rgate ((float*)(ws + WS_RGATE))
#define cnt ((int*)(ws + WS_CNT))
#define G ((int)gridDim.x)
#define c ((int)blockIdx.x)

    if (PM(0) && RUN(0)) { RP(0) phase_prep(P, lds, OTID()); SEAM(); }

    for (int L = 0; L < DEPTH; ++L) {
        const int base = 1 + 10 * L;
        const bool moe = (L & 1) != 0;
        const float* xcur = (L == 0) ? P.in[0] : (const float*)P.out;
        const float* gains = P.in[1] + (size_t)L * 2 * 1024;
        const bool fuse1 = FUSE_NORM && (L & 1);
        if (PM(1) && RUN(base + 0) && !fuse1) {
            if (L == 2) phase_norm<true, false, F8_IN != 0>(P.out, P.out, YB, gains, H, nullptr, nullptr, nullptr, nullptr, nullptr, lds, OTID());
            else RP(1) phase_norm<false, false, F8_IN != 0>(xcur, nullptr, nullptr, gains, H, nullptr, nullptr, nullptr, nullptr, nullptr, lds, OTID());
            SEAM(); }
        if (PM(2) && RUN(base + 1)) {
            pg8::Gemm g{H, (const bf16_t*)(ws + WS_W_IN + (size_t)L * INW * 1024 * (F8_IN ? 1 : 2)), F8_IN ? 512 : 1024, 0x7A7A7A7A}; pg8::StaticOrderR S; S.init(NTOK, INW, G, c); S.ssq = fuse1 ? (const float*)(ws + WS_SSQ) : nullptr; S.tab = (LAS float*)(lds + LDS_MISC + 1024); S.wid = wid_s;
            EpiIn E{(bf16_t*)(ws + WS_Q), (bf16_t*)(ws + WS_K), (bf16_t*)(ws + WS_VRAW), (bf16_t*)(ws + WS_G), fuse1 ? (const LAS float*)(lds + LDS_MISC + 1024) : nullptr};
            RP(2) pg8::gemm_phase<EpiIn, pg8::StaticOrderR, true, true, F8_IN != 0>(lds + LDS_SCR, g, S, E, OTID());
            SEAM(); }
        if (PM(3) && RUN(base + 2)) { phase_qkvprep(P, L, lds, OTID()); SEAM(); }
        if (PM(4) && RUN(base + 3)) { RP(4) phase_attn(P, L, lds, OTID()); SEAM(); }
        if (PM(5) && RUN(base + 4)) {
            pg8::Gemm g{(const bf16_t*)(ws + WS_OALL), (const bf16_t*)(ws + WS_W_BR) + (size_t)L * 1024 * 768, 768, 0}; pg8::StaticOrder S; S.init(NTOK, 1024, G, c);
            EpiGate E{(const unsigned char*)(ws + WS_G), (bf16_t*)(ws + WS_MERGED)};
            RP(5) pg8::gemm_phase<EpiGate, pg8::StaticOrder, true, true>(lds + LDS_SCR, g, S, E, OTID());
            SEAM(); }
        if (PM(6) && RUN(base + 5)) {
            pg8::Gemm g{(const bf16_t*)(ws + WS_MERGED), (const bf16_t*)(ws + WS_W_OUT) + (size_t)L * 1024 * 1024, 1024, 0}; pg8::StaticOrder S; S.init(NTOK, 1024, G, c);
            const bool fuse2 = FUSE_NORM && !moe;
            EpiResidN E{xcur, P.out, fuse2 ? (unsigned char*)H : nullptr, (float*)(ws + WS_SSQ), (int)((F8_FFN >> (L >> 1)) & 1)};
            pg8::gemm_phase<EpiResidN, pg8::StaticOrder, true, true>(lds + LDS_SCR, g, S, E, OTID());
            SEAM(); }
        if (!moe) {
            const int di = L >> 1; const bool f8d = ((F8_FFN >> di) & 1) != 0;
            if (PM(7) && RUN(base + 6) && !FUSE_NORM) {
                if (f8d) RP(7) phase_norm<false, false, true>(P.out, nullptr, nullptr, gains + 1024, H, nullptr, nullptr, nullptr, nullptr, nullptr, lds, OTID());
                else RP(7) phase_norm<false, false, false>(P.out, nullptr, nullptr, gains + 1024, H, nullptr, nullptr, nullptr, nullptr, nullptr, lds, OTID());
                SEAM(); }
            if (PM(8) && RUN(base + 7)) {
                pg8::StaticOrderR S; S.init(NTOK, 2 * FF, G, c); S.ssq = FUSE_NORM ? (const float*)(ws + WS_SSQ) : nullptr; S.tab = (LAS float*)(lds + LDS_MISC + 1024); S.wid = wid_s;
                if (f8d) { pg8::Gemm g{H, (const bf16_t*)(ws + WS_W_FGU + (size_t)di * 2 * FF * 1024 * 2), 512, 0x7A7A7A7A}; EpiSwiglu<true> E{(unsigned char*)ACT, FF, FUSE_NORM ? (const LAS float*)(lds + LDS_MISC + 1024) : nullptr};
                    RP(8) pg8::gemm_phase<EpiSwiglu<true>, pg8::StaticOrderR, true, true, true>(lds + LDS_SCR, g, S, E, OTID()); }
                else { pg8::Gemm g{H, (const bf16_t*)(ws + WS_W_FGU + (size_t)di * 2 * FF * 1024 * 2), 1024, 0}; EpiSwiglu<false> E{(unsigned char*)ACT, FF, FUSE_NORM ? (const LAS float*)(lds + LDS_MISC + 1024) : nullptr};
                    RP(8) pg8::gemm_phase<EpiSwiglu<false>, pg8::StaticOrderR, true, true, false>(lds + LDS_SCR, g, S, E, OTID()); }
                SEAM(); }
            if (PM(9) && RUN(base + 8)) {
                pg8::StaticOrder S; S.init(NTOK, 1024, G, c); EpiResidN E{P.out, P.out, FUSE_NORM ? (unsigned char*)H : nullptr, (float*)(ws + WS_SSQ), 0};
                if (f8d) { pg8::Gemm g{ACT, (const bf16_t*)(ws + WS_W_FDN + (size_t)di * 1024 * FF * 2), FF / 2, 0x79797979};
                    pg8::gemm_phase<EpiResidN, pg8::StaticOrder, true, true, true>(lds + LDS_SCR, g, S, E, OTID()); }
                else { pg8::Gemm g{ACT, (const bf16_t*)(ws + WS_W_FDN + (size_t)di * 1024 * FF * 2), FF, 0};
                    pg8::gemm_phase<EpiResidN, pg8::StaticOrder, true, true, false>(lds + LDS_SCR, g, S, E, OTID()); }
                SEAM(); }
        } else {
            const int li = L >> 1;
            const bool f8 = ((F8_MOE >> li) & 1) != 0;
            if (PM(10) && RUN(base + 6)) {
                if (f8) RP(10) phase_norm<false, true, true>(P.out, nullptr, nullptr, gains + 1024, H, P.in[9] + (size_t)li * 1024 * 8, topi, topw, cnt, perm, lds, OTID());
                else RP(10) phase_norm<false, true, false>(P.out, nullptr, nullptr, gains + 1024, H, P.in[9] + (size_t)li * 1024 * 8, topi, topw, cnt, perm, lds, OTID());
                SEAM(); }
            if (PM(11) && RUN(base + 7)) {
                if (f8) RP(11) phase_scatter<true>(cnt, topi, topw, H, XS, perm, rgate, lds, OTID());
                else RP(11) phase_scatter<false>(cnt, topi, topw, H, XS, perm, rgate, lds, OTID());
                SEAM(); }
            if ((PM(12) || PM(13)) && (RUN(base + 8) || RUN(base + 9))) {
                volatile LAS int* misc = (volatile LAS int*)(lds + LDS_MISC + 64);
                moe_totals(cnt, misc, OTID());
                pg8::GroupedOrder S; S.c8 = c & 7; S.loc = c >> 3; S.per = G >> 3;
                S.tp[0] = 0;
#pragma unroll
                for (int e = 0; e < 8; ++e) S.tp[e + 1] = S.tp[e] + ((__builtin_amdgcn_readfirstlane(misc[e]) + 255) >> 8);
                if (PM(12) && RUN(base + 8)) {
                    S.nN = 2 * ED / 256; S.cb = 7;
                    if (f8) { S.bstride = (long)2 * ED * 1024;
                        pg8::Gemm g{XS, (const bf16_t*)(ws + WS_W_MGU + (size_t)li * 8 * 2 * ED * 1024 * 2), 512, 0x7A7A7A7A};
                        EpiSwiglu<true> E{(unsigned char*)ACT, ED, nullptr};
                        RP(12) pg8::gemm_phase<EpiSwiglu<true>, pg8::GroupedOrder, true, true, true>(lds + LDS_SCR, g, S, E, OTID()); }
                    else { S.bstride = (long)2 * ED * 1024 * 2;
                        pg8::Gemm g{XS, (const bf16_t*)(ws + WS_W_MGU + (size_t)li * 8 * 2 * ED * 1024 * 2), 1024, 0};
                        EpiSwiglu<false> E{(unsigned char*)ACT, ED, nullptr};
                        RP(12) pg8::gemm_phase<EpiSwiglu<false>, pg8::GroupedOrder, true, true, false>(lds + LDS_SCR, g, S, E, OTID()); }
                    SEAM(); }
                if (PM(13) && RUN(base + 9)) {
                    S.nN = 4; S.cb = 4;
                    EpiMoeDown E{perm, rgate, YB};
                    if (f8) { S.bstride = (long)1024 * ED;
                        pg8::Gemm g{ACT, (const bf16_t*)(ws + WS_W_MDN + (size_t)li * 8 * 1024 * ED * 2), ED / 2, 0x79797979};
                        RP(13) pg8::gemm_phase<EpiMoeDown, pg8::GroupedOrder, true, true, true>(lds + LDS_SCR, g, S, E, OTID()); }
                    else { S.bstride = (long)1024 * ED * 2;
                        pg8::Gemm g{ACT, (const bf16_t*)(ws + WS_W_MDN + (size_t)li * 8 * 1024 * ED * 2), ED, 0};
                        RP(13) pg8::gemm_phase<EpiMoeDown, pg8::GroupedOrder, true, true, false>(lds + LDS_SCR, g, S, E, OTID()); }
                    SEAM(); }
            }
        }
    }
    if (PM(14) && RUN(41)) phase_final(P.out, YB, P.out, OTID());
#if TSEL >= 0
    xcd_barrier(bar, OTID()); TSTAMP();
    if (blockIdx.x == 0 && OTID() == 0) { asm volatile("s_waitcnt vmcnt(0)" ::: "memory"); const unsigned long long d = tsb[TSEL + 1] - tsb[TSEL]; P.out[0] += (float)d * (0.01f * 0.25f); }
#endif
#undef RUN
#undef SEAM
#undef P
#undef ws
#undef H
#undef YB
#undef ACT
#undef XS
#undef topi
#undef topw
#undef perm
#undef rgate
#undef cnt
#undef G
#undef c
}

#if MK_DEBUG
DI unsigned hsh(unsigned x) { x ^= x >> 16; x *= 0x7feb352du; x ^= x >> 15; x *= 0x846ca68bu; x ^= x >> 16; return x; }
DI void rep(unsigned* ctl, int slot, float got, float ref, float scale) { float e = fabsf(got - ref) / (fabsf(ref) + scale); if (!(e == e) || e > 1e30f) e = 1e30f; atomicMax(ctl + CW_ERR + slot, __float_as_uint(e)); }
DI float dotbf(const bf16_t* a, const bf16_t* b, int K, int lane) { float s = 0.f; for (int k = lane; k < K; k += 64) s += bf2f(a[k]) * bf2f(b[k]); return wave_sum(s); }
DI float rbf(float x) { return bflo(pk2(x, 0.f) & 0xffffu); }

__global__ void chk_prep(Args a) {
    unsigned* ctl = (unsigned*)a.ws; const unsigned h0 = hsh(blockIdx.x * 64 + threadIdx.x + 1);
    unsigned h = h0;
#define NXT() (h = hsh(h + 0x9e3779b9u))
    { const int L = NXT() % 4, n = NXT() % 5632, k = NXT() % 1024; rep(ctl, 0, bf2f(((const bf16_t*)(a.ws + WS_W_IN))[((size_t)L * 5632 + n) * 1024 + k]), rbf(a.in[2][((size_t)L * 1024 + k) * 5632 + n]), 1e-3f); }
    { const int L = NXT() % 4, n = NXT() % 1024, k = NXT() % 768; rep(ctl, 0, bf2f(((const bf16_t*)(a.ws + WS_W_BR))[((size_t)L * 1024 + n) * 768 + k]), rbf(a.in[5][((size_t)L * 768 + k) * 1024 + n]), 1e-3f); }
    { const int L = NXT() % 4, n = NXT() % 1024, k = NXT() % 1024; rep(ctl, 0, bf2f(((const bf16_t*)(a.ws + WS_W_OUT))[((size_t)L * 1024 + n) * 1024 + k]), rbf(a.in[6][((size_t)L * 1024 + k) * 1024 + n]), 1e-3f); }
    { const int L = NXT() % 2, n = NXT() % 5632, k = NXT() % 1024, pn = n >> 8, j = n & 255, cc = j < 128 ? pn * 128 + j : FF + pn * 128 + j - 128;
      rep(ctl, 0, bf2f(((const bf16_t*)(a.ws + WS_W_FGU))[((size_t)L * 5632 + n) * 1024 + k]), rbf(a.in[7][((size_t)L * 1024 + k) * 5632 + cc]), 1e-3f); }
    { const int L = NXT() % 2, n = NXT() % 1024, k = NXT() % 2816; rep(ctl, 0, bf2f(((const bf16_t*)(a.ws + WS_W_FDN))[((size_t)L * 1024 + n) * 2816 + k]), rbf(a.in[8][((size_t)L * 2816 + k) * 1024 + n]), 1e-3f); }
    { const int L = NXT() % 16, n = NXT() % 7168, k = NXT() % 1024, pn = n >> 8, j = n & 255, cc = j < 128 ? pn * 128 + j : ED + pn * 128 + j - 128;
      rep(ctl, 0, bf2f(((const bf16_t*)(a.ws + WS_W_MGU))[((size_t)L * 7168 + n) * 1024 + k]), rbf(a.in[10][((size_t)L * 1024 + k) * 7168 + cc]), 1e-3f); }
    { const int L = NXT() % 16, n = NXT() % 1024, k = NXT() % 3584; rep(ctl, 0, bf2f(((const bf16_t*)(a.ws + WS_W_MDN))[((size_t)L * 1024 + n) * 3584 + k]), rbf(a.in[11][((size_t)L * 3584 + k) * 1024 + n]), 1e-3f); }
#undef NXT
}
__global__ void chk_norm(Args a, const float* xin, const float* gain, int comb, int slot) {
    unsigned* ctl = (unsigned*)a.ws; const int lane = threadIdx.x; const int row = blockIdx.x == 0 ? 0 : (blockIdx.x == 1 ? NTOK - 1 : hsh(blockIdx.x * 7 + slot) % NTOK);
    const bf16_t* H = (const bf16_t*)(a.ws + WS_H); const bf16_t* yb = (const bf16_t*)(a.ws + WS_YBUF);
    float v[16], ss = 0.f;
    for (int j = 0; j < 16; ++j) { const int cidx = lane + 64 * j; float x = xin[(size_t)row * 1024 + cidx];
        if (comb) { x += bf2f(yb[(size_t)row * 1024 + cidx]) + bf2f(yb[((size_t)NTOK + row) * 1024 + cidx]); rep(ctl, slot, a.out[(size_t)row * 1024 + cidx], x, 1e-2f); }
        v[j] = x; ss += x * x; }
    const float rstd = 1.f / sqrtf(wave_sum(ss) / 1024.f + EPS);
    for (int j = 0; j < 16; ++j) { const int cidx = lane + 64 * j; rep(ctl, slot, bf2f(H[(size_t)row * 1024 + cidx]), v[j] * rstd * gain[cidx], 2e-2f); }
}
__global__ void chk_gemm_in(Args a, int L) {
    unsigned* ctl = (unsigned*)a.ws; const int lane = threadIdx.x; unsigned h = hsh(blockIdx.x + 77 * L + 5);
    const int row = blockIdx.x < 4 ? (blockIdx.x & 1 ? NTOK - 1 : 0) : h % NTOK; h = hsh(h + 1); const int col = blockIdx.x < 2 ? 0 : (blockIdx.x < 4 ? INW - 1 : h % INW);
    const float d = dotbf((const bf16_t*)(a.ws + WS_H) + (size_t)row * 1024, (const bf16_t*)(a.ws + WS_W_IN) + ((size_t)L * INW + col) * 1024, 1024, lane);
    float got;
    if (col < 1024) got = bf2f(((const bf16_t*)(a.ws + WS_Q))[(size_t)row * 1024 + col]);
    else if (col < 1792) got = bf2f(((const bf16_t*)(a.ws + WS_K))[(size_t)row * 768 + col - 1024]);
    else if (col < 2560) got = bf2f(((const bf16_t*)(a.ws + WS_VRAW))[(size_t)row * 768 + col - 1792]);
    else got = ((float)((const unsigned char*)(a.ws + WS_G))[(size_t)row * 3072 + col - 2560] + 0.5f) * (1.f / 256.f);
    const float ref = col < 2560 ? d : 1.f / (1.f + expf(-d));
    if (lane == 0) rep(ctl, 2, got, ref, 5e-2f);
}
__global__ void chk_qk(Args a, int L) {
    unsigned* ctl = (unsigned*)a.ws; const int j = threadIdx.x; unsigned h = hsh(blockIdx.x + 131 * L + 9);
    const int tok = blockIdx.x == 0 ? 0 : (blockIdx.x == 1 ? NTOK - 1 : h % NTOK); h = hsh(h + 1); const int isk = 1; h = hsh(h + 1); const int head = h % 12;
    const int col = (isk ? 1024 : 0) + head * 64 + j;
    const bf16_t* hr = (const bf16_t*)(a.ws + WS_H) + (size_t)tok * 1024; const bf16_t* wr = (const bf16_t*)(a.ws + WS_W_IN) + ((size_t)L * INW + col) * 1024;
    float d = 0.f; for (int k = 0; k < 1024; ++k) d += bf2f(hr[k]) * bf2f(wr[k]);
    d = rbf(d);
    const float rstd = 1.f / sqrtf(wave_sum(d * d) / 64.f + EPS);
    const int br = isk ? (head < 4 ? 0 : (head < 6 ? 1 : 2)) : (head < 4 ? 0 : (head < 10 ? 1 : 2));
    const float y = d * rstd * a.in[3][((size_t)(L * 3 + br) * 2 + isk) * 64 + j];
    const int s = tok & 4095; float o = y;
    if (br == 2) { const int i = j & 31; const float ang = (float)s * powf(10000.f, -(float)(2 * i) / 64.f); const float p = __shfl_xor(y, 32); o = j < 32 ? y * cosf(ang) - p * sinf(ang) : y * cosf(ang) + p * sinf(ang); }
    if (br == 1) { const int i = j & 15; const float pos = (float)((j < 32) ? (s >> 6) : (s & 63)); const float ang = pos * powf(10000.f, -(float)(2 * i) / 32.f); const float p = __shfl_xor(y, 16);
        o = (j & 16) == 0 ? y * cosf(ang) - p * sinf(ang) : y * cosf(ang) + p * sinf(ang); }
    if (!isk) o *= QSCALE;
    const float got = isk ? bf2f(((const bf16_t*)(a.ws + WS_K))[(size_t)tok * 768 + head * 64 + j]) : bf2f(((const bf16_t*)(a.ws + WS_Q))[(size_t)tok * 1024 + head * 64 + j]);
    rep(ctl, 3, got, o, 3e-2f);
}
__global__ void chk_vt(Args a) {
    unsigned* ctl = (unsigned*)a.ws; unsigned h = hsh(blockIdx.x * 64 + threadIdx.x + 3);
    const int b = h % 8; h = hsh(h + 1); const int hv = h % 12; h = hsh(h + 1); const int d = h % 64; h = hsh(h + 1); const int s = h % 4096;
    const int g = hv < 6 ? 0 : (hv - 6) >> 1, dd = 1 << (2 * g), Sd = 4096 / dd, pos = (s % dd) * Sd + s / dd;
    rep(ctl, 4, bf2f(((const bf16_t*)(a.ws + WS_VT))[((size_t)(b * 12 + hv) * 64 + d) * 4096 + pos]), bf2f(((const bf16_t*)(a.ws + WS_VRAW))[(size_t)(b * 4096 + s) * 768 + hv * 64 + d]), 1e-3f);
}
DI float dot64(const bf16_t* x, const bf16_t* y) { float s = 0.f; for (int k = 0; k < 64; ++k) s += bf2f(x[k]) * bf2f(y[k]); return s; }
DI float dot64q(const float* x, const bf16_t* y) { float s = 0.f; for (int k = 0; k < 64; ++k) s += x[k] * bf2f(y[k]); return s; }
DI float chk_qn(const Args& a, int L, int tok, int head, int t) {
    const float d = bf2f(((const bf16_t*)(a.ws + WS_Q))[(size_t)tok * 1024 + head * 64 + t]);
    const float rstd = 1.f / sqrtf(wave_sum(d * d) / 64.f + EPS);
    const int br = head < 4 ? 0 : (head < 10 ? 1 : 2);
    const float y = d * rstd * a.in[3][((size_t)(L * 3 + br) * 2 + 0) * 64 + t];
    const int s = tok & 4095; float o = y;
    if (br == 2) { const int i = t & 31; const float ang = (float)s * powf(10000.f, -(float)(2 * i) / 64.f); const float p = __shfl_xor(y, 32); o = t < 32 ? y * cosf(ang) - p * sinf(ang) : y * cosf(ang) + p * sinf(ang); }
    if (br == 1) { const int i = t & 15; const float pos = (float)((t < 32) ? (s >> 6) : (s & 63)); const float ang = pos * powf(10000.f, -(float)(2 * i) / 32.f); const float p = __shfl_xor(y, 16);
        o = (t & 16) == 0 ? y * cosf(ang) - p * sinf(ang) : y * cosf(ang) + p * sinf(ang); }
    return rbf(o * QSCALE);
}
__global__ void chk_na(Args a, int L) {
    __shared__ float p[128]; __shared__ float qn[64]; unsigned* ctl = (unsigned*)a.ws; const int t = threadIdx.x; unsigned h = hsh(blockIdx.x + 31 * L + 11);
    const int tok = blockIdx.x == 0 ? 0 : (blockIdx.x == 1 ? NTOK - 1 : h % NTOK); h = hsh(h + 1); const int hd = h % 4;
    const int b = tok >> 12, s = tok & 4095, gr = s >> 6, cq = s & 63, rs = min(max(gr - 4, 0), 56), cs = min(max(cq - 8, 0), 48);
    const bf16_t* Kb = (const bf16_t*)(a.ws + WS_K); const bf16_t* V = (const bf16_t*)(a.ws + WS_VRAW);
    qn[t] = chk_qn(a, L, tok, hd, t); __syncthreads();
    float mx = -1e30f;
    for (int q = 0; q < 2; ++q) { const int idx = t + 64 * q, kr = rs + idx / 16, ck = cs + idx % 16, kt = b * 4096 + kr * 64 + ck;
        const float sc = dot64q(qn, Kb + (size_t)kt * 768 + hd * 64) + LOG2E * a.in[4][(((size_t)L * 4 + hd) * 15 + (kr - gr + 7)) * 31 + (ck - cq + 15)];
        p[idx] = sc; mx = fmaxf(mx, sc); }
    for (int o = 1; o < 64; o <<= 1) mx = fmaxf(mx, __shfl_xor(mx, o));
    __syncthreads();
    float sum = 0.f, acc = 0.f;
    for (int idx = 0; idx < 128; ++idx) { const int kr = rs + idx / 16, ck = cs + idx % 16, kt = b * 4096 + kr * 64 + ck; const float e = exp2f(p[idx] - mx); sum += e; acc += e * bf2f(V[(size_t)kt * 768 + hd * 64 + t]); }
    rep(ctl, 5, bf2f(((const bf16_t*)(a.ws + WS_OALL))[(size_t)tok * 768 + hd * 64 + t]), acc / sum, 3e-2f);
}
__global__ void chk_dil(Args a, int L) {
    __shared__ float p[3][192]; __shared__ float qn[3][64]; unsigned* ctl = (unsigned*)a.ws; const int t = threadIdx.x; unsigned h = hsh(blockIdx.x + 37 * L + 13);
    const int tok = blockIdx.x == 0 ? 0 : (blockIdx.x == 1 ? NTOK - 1 : (blockIdx.x == 2 ? 4095 : (blockIdx.x == 3 ? 4096 + 70 : h % NTOK))); h = hsh(h + 1); const int hs = h & 1;
    const int b = tok >> 12, s = tok & 4095;
    const bf16_t* Kb = (const bf16_t*)(a.ws + WS_K); const bf16_t* V = (const bf16_t*)(a.ws + WS_VRAW);
    for (int g = 0; g < 3; ++g) qn[g][t] = chk_qn(a, L, tok, 10 + 2 * g + hs, t);
    __syncthreads();
    float lse[3], og[3];
    for (int g = 0; g < 3; ++g) { const int dd = 1 << (2 * g), hq = 10 + 2 * g + hs, hk = 6 + 2 * g + hs; float mx = -1e30f;
        for (int q = 0; q < 3; ++q) { const int idx = t + 64 * q; if (idx < 129) { const int pos = s + dd * (idx - 64); float sc = -1e30f;
            if (pos >= 0 && pos < 4096) sc = dot64q(qn[g], Kb + (size_t)(b * 4096 + pos) * 768 + hk * 64);
            p[g][idx] = sc; mx = fmaxf(mx, sc); } }
        for (int o = 1; o < 64; o <<= 1) mx = fmaxf(mx, __shfl_xor(mx, o));
        __syncthreads();
        float sum = 0.f, acc = 0.f;
        for (int idx = 0; idx < 129; ++idx) { const int pos = s + dd * (idx - 64); if (pos >= 0 && pos < 4096) { const float e = exp2f(p[g][idx] - mx); sum += e; acc += e * bf2f(V[(size_t)(b * 4096 + pos) * 768 + hk * 64 + t]); } }
        lse[g] = mx + log2f(sum); og[g] = acc / sum; }
    const float M = fmaxf(lse[0], fmaxf(lse[1], lse[2])); const float w0 = exp2f(lse[0] - M), w1 = exp2f(lse[1] - M), w2 = exp2f(lse[2] - M);
    rep(ctl, 6, bf2f(((const bf16_t*)(a.ws + WS_OALL))[(size_t)tok * 768 + 640 + hs * 64 + t]), (w0 * og[0] + w1 * og[1] + w2 * og[2]) / (w0 + w1 + w2), 3e-2f);
}
__global__ void chk_gqa(Args a, int L) {
    __shared__ float p[4096]; __shared__ float qn[64]; unsigned* ctl = (unsigned*)a.ws; const int t = threadIdx.x; unsigned h = hsh(blockIdx.x + 41 * L + 17);
    const int tok = blockIdx.x == 0 ? 0 : (blockIdx.x == 1 ? NTOK - 1 : h % NTOK); h = hsh(h + 1); const int hq = h % 6, kvh = hq / 3, b = tok >> 12;
    const bf16_t* Kb = (const bf16_t*)(a.ws + WS_K); const bf16_t* V = (const bf16_t*)(a.ws + WS_VRAW);
    qn[t] = chk_qn(a, L, tok, 4 + hq, t); __syncthreads();
    float mx = -1e30f;
    for (int k = t; k < 4096; k += 64) { const float sc = dot64q(qn, Kb + (size_t)(b * 4096 + k) * 768 + (4 + kvh) * 64); p[k] = sc; mx = fmaxf(mx, sc); }
    for (int o = 1; o < 64; o <<= 1) mx = fmaxf(mx, __shfl_xor(mx, o));
    __syncthreads();
    float sum = 0.f, acc = 0.f;
    for (int k = 0; k < 4096; ++k) { const float e = exp2f(p[k] - mx); sum += e; acc += e * bf2f(V[(size_t)(b * 4096 + k) * 768 + (4 + kvh) * 64 + t]); }
    rep(ctl, 7, bf2f(((const bf16_t*)(a.ws + WS_OALL))[(size_t)tok * 768 + 256 + hq * 64 + t]), acc / sum, 3e-2f);
}
__global__ void chk_gate(Args a, int L) {
    unsigned* ctl = (unsigned*)a.ws; const int lane = threadIdx.x; unsigned h = hsh(blockIdx.x + 43 * L + 19);
    const int row = blockIdx.x < 2 ? (blockIdx.x ? NTOK - 1 : 0) : h % NTOK; h = hsh(h + 1); const int col = blockIdx.x < 2 ? (blockIdx.x ? 1023 : 0) : h % 1024;
    const bf16_t* orow = (const bf16_t*)(a.ws + WS_OALL) + (size_t)row * 768; const bf16_t* wrow = (const bf16_t*)(a.ws + WS_W_BR) + ((size_t)L * 1024 + col) * 768;
    const float ya = dotbf(orow, wrow, 256, lane), yb = dotbf(orow + 256, wrow + 256, 384, lane), yc = dotbf(orow + 640, wrow + 640, 128, lane);
    const unsigned char* G = (const unsigned char*)(a.ws + WS_G) + (size_t)row * 3072;
    const float ref = (((float)G[col] + 0.5f) * ya + ((float)G[1024 + col] + 0.5f) * yb + ((float)G[2048 + col] + 0.5f) * yc) * (1.f / 256.f);
    if (lane == 0) rep(ctl, 8, bf2f(((const bf16_t*)(a.ws + WS_MERGED))[(size_t)row * 1024 + col]), ref, 5e-2f);
}
__global__ void chk_resid(Args a, const float* xold, const bf16_t* A, const bf16_t* Bt, int K, int slot) {
    unsigned* ctl = (unsigned*)a.ws; const int lane = threadIdx.x; unsigned h = hsh(blockIdx.x + 47 * slot + 23);
    const int row = blockIdx.x < 2 ? (blockIdx.x ? NTOK - 1 : 0) : h % NTOK; h = hsh(h + 1); const int col = blockIdx.x < 2 ? (blockIdx.x ? 1023 : 0) : h % 1024;
    const float d = dotbf(A + (size_t)row * K, Bt + (size_t)col * K, K, lane);
    if (lane == 0) rep(ctl, slot, a.out[(size_t)row * 1024 + col], xold[(size_t)row * 1024 + col] + d, 5e-2f);
}
__global__ void chk_router(Args a, const float* gain, const float* wr) {
    unsigned* ctl = (unsigned*)a.ws; const int lane = threadIdx.x; const int row = blockIdx.x == 0 ? 0 : (blockIdx.x == 1 ? NTOK - 1 : hsh(blockIdx.x + 29) % NTOK);
    float v[16], ss = 0.f;
    for (int j = 0; j < 16; ++j) { v[j] = a.out[(size_t)row * 1024 + lane + 64 * j]; ss += v[j] * v[j]; }
    const float rstd = 1.f / sqrtf(wave_sum(ss) / 1024.f + EPS);
    float lg[8];
    for (int e = 0; e < 8; ++e) { float s = 0.f; for (int j = 0; j < 16; ++j) { const int k = lane + 64 * j; s += v[j] * rstd * gain[k] * wr[k * 8 + e]; } lg[e] = wave_sum(s); }
    int e0 = 0; for (int e = 1; e < 8; ++e) if (lg[e] > lg[e0]) e0 = e;
    int e1 = e0 == 0 ? 1 : 0; for (int e = 0; e < 8; ++e) if (e != e0 && lg[e] > lg[e1]) e1 = e;
    float third = -1e30f; for (int e = 0; e < 8; ++e) if (e != e0 && e != e1) third = fmaxf(third, lg[e]);
    const int* topi = (const int*)(a.ws + WS_TOPI); const float* topw = (const float*)(a.ws + WS_TOPW);
    if (lane == 0) { const bool clear = (lg[e0] - lg[e1] > 1e-3f) && (lg[e1] - third > 1e-3f);
        if (clear) { rep(ctl, 13, (float)topi[row * 2], (float)e0, 1e-3f); rep(ctl, 13, (float)topi[row * 2 + 1], (float)e1, 1e-3f);
            const float t = expf(lg[e1] - lg[e0]); rep(ctl, 13, topw[row * 2], 1.f / (1.f + t), 1e-2f); rep(ctl, 13, topw[row * 2 + 1], t / (1.f + t), 1e-2f); } }
}
__global__ void chk_up(Args a, const bf16_t* A, const bf16_t* Wt, int ffd, int slot) {
    unsigned* ctl = (unsigned*)a.ws; const int lane = threadIdx.x; unsigned h = hsh(blockIdx.x + 53 * slot + 3);
    const int row = blockIdx.x < 2 ? (blockIdx.x ? NTOK - 1 : 0) : h % NTOK; h = hsh(h + 1); const int j = blockIdx.x < 2 ? (blockIdx.x ? ffd - 1 : 0) : h % ffd;
    const int pn = j >> 7, jj = j & 127;
    const float g = dotbf(A + (size_t)row * 1024, Wt + (size_t)(256 * pn + jj) * 1024, 1024, lane), u = dotbf(A + (size_t)row * 1024, Wt + (size_t)(256 * pn + 128 + jj) * 1024, 1024, lane);
    if (lane == 0) rep(ctl, slot, bf2f(((const bf16_t*)(a.ws + WS_ACT))[(size_t)row * ffd + j]), g / (1.f + expf(-g)) * u, 3e-2f);
}
__global__ void chk_scatter(Args a) {
    unsigned* ctl = (unsigned*)a.ws; const int lane = threadIdx.x; const int* cnt = (const int*)(a.ws + WS_CNT); const int* perm = (const int*)(a.ws + WS_PERM);
    const int* topi = (const int*)(a.ws + WS_TOPI); const float* topw = (const float*)(a.ws + WS_TOPW); const float* rg = (const float*)(a.ws + WS_RGATE);
    int tot[8], base[9]; base[0] = 0;
    for (int e = 0; e < 8; ++e) { int s = 0; for (int w = lane; w < 256; w += 64) s += cnt[w * 8 + e]; for (int o = 1; o < 64; o <<= 1) s += __shfl_xor(s, o); tot[e] = s; base[e + 1] = base[e] + ((s + 255) >> 8 << 8); }
    if (blockIdx.x == 0) { int sum = 0; for (int e = 0; e < 8; ++e) sum += tot[e]; if (lane == 0) rep(ctl, 14, (float)sum, 65536.f, 1e-3f);
        unsigned long long cs = 0; int nv = 0; for (int i = lane; i < MROWS; i += 64) { const int p = perm[i]; if (p >= 0) { cs += (unsigned long long)p; ++nv; } }
        for (int o = 1; o < 64; o <<= 1) { cs += __shfl_xor(cs, o); nv += __shfl_xor(nv, o); }
        if (lane == 0) { rep(ctl, 14, (float)nv, 65536.f, 1e-3f); rep(ctl, 14, (float)(cs == 65536ull * 65535ull / 2ull), 1.f, 1e-3f); } }
    const int pos = hsh(blockIdx.x + 5) % MROWS; const int p = perm[pos];
    int e = 0; for (int k = 1; k < 8; ++k) e += pos >= base[k];
    const bool inr = pos < base[e] + tot[e];
    if (lane == 0) rep(ctl, 14, (float)(p >= 0), (float)inr, 1e-3f);
    if (p >= 0 && inr) { const int tok = p >> 1, slot = p & 1;
        if (lane == 0) { rep(ctl, 14, (float)topi[tok * 2 + slot], (float)e, 1e-3f); rep(ctl, 14, rg[pos], topw[tok * 2 + slot], 1e-3f); }
        for (int j = 0; j < 16; ++j) rep(ctl, 14, bf2f(((const bf16_t*)(a.ws + WS_XS))[(size_t)pos * 1024 + lane + 64 * j]), bf2f(((const bf16_t*)(a.ws + WS_H))[(size_t)tok * 1024 + lane + 64 * j]), 1e-3f); }
}
__global__ void chk_moe(Args a, int li, int down) {
    unsigned* ctl = (unsigned*)a.ws; const int lane = threadIdx.x; const int* perm = (const int*)(a.ws + WS_PERM); const int* topi = (const int*)(a.ws + WS_TOPI); const float* rg = (const float*)(a.ws + WS_RGATE);
    unsigned h = hsh(blockIdx.x + 59 * down + 7); int pos = h % MROWS; while (perm[pos] < 0) pos = (pos + 1) % MROWS;
    const int p = perm[pos], tok = p >> 1, slot = p & 1, e = topi[tok * 2 + slot]; h = hsh(h + 1);
    if (!down) { const int j = h % ED, pn = j >> 7, jj = j & 127; const bf16_t* Wt = (const bf16_t*)(a.ws + WS_W_MGU) + (size_t)(li * 8 + e) * 2 * ED * 1024; const bf16_t* A = (const bf16_t*)(a.ws + WS_XS) + (size_t)pos * 1024;
        const float g = dotbf(A, Wt + (size_t)(256 * pn + jj) * 1024, 1024, lane), u = dotbf(A, Wt + (size_t)(256 * pn + 128 + jj) * 1024, 1024, lane);
        if (lane == 0) rep(ctl, 15, bf2f(((const bf16_t*)(a.ws + WS_ACT))[(size_t)pos * ED + j]), g / (1.f + expf(-g)) * u, 3e-2f); }
    else { const int col = h % 1024; const float d = dotbf((const bf16_t*)(a.ws + WS_ACT) + (size_t)pos * ED, (const bf16_t*)(a.ws + WS_W_MDN) + ((size_t)(li * 8 + e) * 1024 + col) * ED, ED, lane);
        if (lane == 0) rep(ctl, 16, bf2f(((const bf16_t*)(a.ws + WS_YBUF))[((size_t)slot * NTOK + tok) * 1024 + col]), rg[pos] * d, 3e-2f); }
}
__global__ void chk_final(Args a, const float* xold) {
    unsigned* ctl = (unsigned*)a.ws; const size_t i = hsh(blockIdx.x * 64 + threadIdx.x + 9) % ((size_t)NTOK * 1024); const bf16_t* yb = (const bf16_t*)(a.ws + WS_YBUF);
    rep(ctl, 18, a.out[i], xold[i] + bf2f(yb[i]) + bf2f(yb[(size_t)NTOK * 1024 + i]), 1e-2f);
}
__global__ void chk_report(Args a) {
    const unsigned* ctl = (const unsigned*)a.ws; int code = -1;
    for (int s = 18; s >= 0; --s) { const float e = __uint_as_float(ctl[CW_ERR + s]); const float tol = (s == 0 || s == 4 || s == 14) ? 1e-3f : 0.08f; if (e > tol) code = s; }
    if (code >= 0) { float v = 10.f; for (int k = 0; k < code; ++k) v *= 10.f;
        for (size_t i = (size_t)blockIdx.x * blockDim.x + threadIdx.x; i < (size_t)NTOK * 1024; i += (size_t)gridDim.x * blockDim.x) a.out[i] = v; }
}
#endif

extern "C" void kernel_launch(void* const* d_in, const int* in_sizes, int n_in, void* d_out, int out_size, void* d_ws, size_t ws_size, hipStream_t stream) {
    static int ready = 0;
    if (ready == 0) {
        ready = -1;
        if (n_in != 12 || out_size != NTOK * 1024 || ws_size < WS_END + (MK_DEBUG ? (size_t)128 * MiB : 0)) { fprintf(stderr, "kernel_launch: unexpected shapes / workspace (%d inputs, out %d, ws %zu)\n", n_in, out_size, ws_size); return; }
        if (hipFuncSetAttribute((const void*)mk_fwd, hipFuncAttributeMaxDynamicSharedMemorySize, LDS_BYTES) != hipSuccess) { fprintf(stderr, "kernel_launch: hipFuncSetAttribute failed\n"); return; }
        int per_cu = 0; (void)hipOccupancyMaxActiveBlocksPerMultiprocessor(&per_cu, (const void*)mk_fwd, NTHR, LDS_BYTES); (void)hipGetLastError();
        if (per_cu < 1) fprintf(stderr, "kernel_launch: occupancy query says %d blocks per CU\n", per_cu);
        ready = 1;
    }
    if (ready < 0) return;
    (void)hipMemsetAsync((char*)d_ws + WS_CTL, 0, CTL_ZERO_BYTES, stream);
    Args a{};
    for (int i = 0; i < 12; ++i) a.in[i] = (const float*)d_in[i];
    a.out = (float*)d_out; a.ws = (unsigned char*)d_ws;
#if !MK_DEBUG
    a.lo = 0; a.hi = 42;
    hipLaunchKernelGGL(mk_fwd, dim3(NWG), dim3(NTHR), LDS_BYTES, stream, a);
#else
    unsigned char* ws = (unsigned char*)d_ws; float* snap = (float*)(ws + WS_DBG);
    const int NS = 96;
    for (int s = 0; s < 42; ++s) {
        const int L = (s - 1) / 10, k = (s - 1) % 10; const bool moe = (L & 1) != 0;
        if (s >= 1 && s < 41 && !moe && k == 9) continue;
        const bool snapx = (s == 41) || (s >= 1 && s < 41 && ((k == 0 && L == 2) || (k == 8 && !moe) || (k == 5 && L > 0)));
        if (snapx) (void)hipMemcpyAsync(snap, d_out, (size_t)NTOK * 1024 * 4, hipMemcpyDeviceToDevice, stream);
        a.lo = s; a.hi = s + 1;
        hipLaunchKernelGGL(mk_fwd, dim3(NWG), dim3(NTHR), LDS_BYTES, stream, a);
        if (s == 0) { hipLaunchKernelGGL(chk_prep, dim3(64), dim3(64), 0, stream, a); continue; }
        if (s == 41) { hipLaunchKernelGGL(chk_final, dim3(64), dim3(64), 0, stream, a, (const float*)snap); continue; }
        const float* gains = (const float*)d_in[1] + (size_t)L * 2048; const float* xin0 = (const float*)d_in[0];
        switch (k) {
        case 0: hipLaunchKernelGGL(chk_norm, dim3(NS), dim3(64), 0, stream, a, L == 0 ? xin0 : (L == 2 ? (const float*)snap : (const float*)d_out), gains, L == 2 ? 1 : 0, L == 2 ? 17 : 1); break;
        case 1: hipLaunchKernelGGL(chk_gemm_in, dim3(NS), dim3(64), 0, stream, a, L); break;
        case 2: hipLaunchKernelGGL(chk_qk, dim3(NS), dim3(64), 0, stream, a, L); hipLaunchKernelGGL(chk_vt, dim3(NS), dim3(64), 0, stream, a); break;
        case 3: hipLaunchKernelGGL(chk_na, dim3(NS), dim3(64), 0, stream, a, L); hipLaunchKernelGGL(chk_dil, dim3(NS), dim3(64), 0, stream, a, L); hipLaunchKernelGGL(chk_gqa, dim3(32), dim3(64), 0, stream, a, L); break;
        case 4: hipLaunchKernelGGL(chk_gate, dim3(NS), dim3(64), 0, stream, a, L); break;
        case 5: hipLaunchKernelGGL(chk_resid, dim3(NS), dim3(64), 0, stream, a, L == 0 ? xin0 : (const float*)snap, (const bf16_t*)(ws + WS_MERGED), (const bf16_t*)(ws + WS_W_OUT) + (size_t)L * 1024 * 1024, 1024, 9); break;
        case 6: if (!moe) hipLaunchKernelGGL(chk_norm, dim3(NS), dim3(64), 0, stream, a, (const float*)d_out, gains + 1024, 0, 10);
                else { hipLaunchKernelGGL(chk_norm, dim3(NS), dim3(64), 0, stream, a, (const float*)d_out, gains + 1024, 0, 10);
                       hipLaunchKernelGGL(chk_router, dim3(NS), dim3(64), 0, stream, a, gains + 1024, (const float*)d_in[9] + (size_t)(L >> 1) * 8192); } break;
        case 7: if (!moe) hipLaunchKernelGGL(chk_up, dim3(NS), dim3(64), 0, stream, a, (const bf16_t*)(ws + WS_H), (const bf16_t*)(ws + WS_W_FGU) + (size_t)(L >> 1) * 2 * FF * 1024, FF, 11);
                else hipLaunchKernelGGL(chk_scatter, dim3(NS), dim3(64), 0, stream, a); break;
        case 8: if (!moe) hipLaunchKernelGGL(chk_resid, dim3(NS), dim3(64), 0, stream, a, (const float*)snap, (const bf16_t*)(ws + WS_ACT), (const bf16_t*)(ws + WS_W_FDN) + (size_t)(L >> 1) * 1024 * FF, FF, 12);
                else hipLaunchKernelGGL(chk_moe, dim3(NS), dim3(64), 0, stream, a, L >> 1, 0); break;
        case 9: hipLaunchKernelGGL(chk_moe, dim3(NS), dim3(64), 0, stream, a, L >> 1, 1); break;
        }
    }
    hipLaunchKernelGGL(chk_report, dim3(1024), dim3(256), 0, stream, a);
#endif
}
```

```cpp
#include <hip/hip_runtime.h>
#include <cstdint>
#include <cstdio>

#ifndef MK_DEBUG
#define MK_DEBUG 0
#endif

#ifndef PHM
#define PHM 0xFFFFFFFFu
#endif
#define PM(k) ((PHM >> (k)) & 1u)
#ifndef REPM
#define REPM 0u
#endif
#define RP(k) for (int rp_ = 0; rp_ <= (int)((REPM >> (k)) & 1u); ++rp_)
#ifndef F8_IN
#define F8_IN 8
#endif
#ifndef F8_FFN
#define F8_FFN 2
#endif
#ifndef F8_MOE
#define F8_MOE 3
#endif
#ifndef FUSE_NORM
#define FUSE_NORM 1
#endif
#if MK_DEBUG
#undef FUSE_NORM
#define FUSE_NORM 0
#undef F8_IN
#undef F8_FFN
#undef F8_MOE
#define F8_IN 0
#define F8_FFN 0
#define F8_MOE 0
#endif
#ifndef TSEL
#define TSEL -1
#endif
#define DI __device__ __forceinline__
#define LAS __attribute__((address_space(3)))
#define GAS __attribute__((address_space(1)))

typedef unsigned short bf16_t;
typedef short bf16x8 __attribute__((ext_vector_type(8)));
typedef float f32x2 __attribute__((ext_vector_type(2)));
typedef float f32x4 __attribute__((ext_vector_type(4)));
typedef float f32x16 __attribute__((ext_vector_type(16)));
typedef unsigned u32x2 __attribute__((ext_vector_type(2)));
typedef unsigned u32x4 __attribute__((ext_vector_type(4)));
typedef __bf16 bf16x2_t __attribute__((ext_vector_type(2)));

constexpr int NB = 8, SEQ = 4096, DM = 1024, NTOK = NB * SEQ, DEPTH = 4;
constexpr int INW = 5632, FF = 2816, ED = 3584, NE = 8;
constexpr int MROWS = 2 * NTOK + NE * 256;
constexpr float EPS = 1e-6f;
constexpr float QSCALE = 0.125f * 1.4426950408889634f;
constexpr float LOG2E = 1.4426950408889634f;
constexpr int NWG = 256, NTHR = 512;

constexpr size_t MiB = 1u << 20;
constexpr size_t WS_CTL = 0, CTL_ZERO_BYTES = 1 * MiB;
constexpr size_t WS_ROPE1 = 1 * MiB;
constexpr size_t WS_ROPEA = 2 * MiB;
constexpr size_t WS_TOPI = 3 * MiB;
constexpr size_t WS_TOPW = 3 * MiB + 512 * 1024;
constexpr size_t WS_PERM = 4 * MiB;
constexpr size_t WS_RGATE = 4 * MiB + 512 * 1024;
constexpr size_t WS_CNT = 5 * MiB;
constexpr size_t WS_SSQ = 6 * MiB;
constexpr size_t WS_W_IN = 8 * MiB;
constexpr size_t WS_W_BR = 52 * MiB;
constexpr size_t WS_W_OUT = 59 * MiB;
constexpr size_t WS_W_FGU = 67 * MiB;
constexpr size_t WS_W_FDN = 89 * MiB;
constexpr size_t WS_W_MGU = 100 * MiB;
constexpr size_t WS_W_MDN = 324 * MiB;
constexpr size_t WS_H = 436 * MiB;
constexpr size_t WS_XS = 500 * MiB;
constexpr size_t WS_YBUF = 632 * MiB;
constexpr size_t WS_Q = 760 * MiB;
constexpr size_t WS_K = 824 * MiB;
constexpr size_t WS_VRAW = 872 * MiB;
constexpr size_t WS_VT = 920 * MiB;
constexpr size_t WS_G = 968 * MiB;
constexpr size_t WS_OALL = 1160 * MiB;
constexpr size_t WS_MERGED = 1216 * MiB;
constexpr size_t WS_ACT = 760 * MiB;
constexpr size_t WS_END = 1280 * MiB;
constexpr size_t WS_DBG = 1280 * MiB;
static_assert(WS_ACT + (size_t)MROWS * ED * 2 <= WS_END, "act overlay");
static_assert(WS_W_MDN + (size_t)2 * 8 * 1024 * 3584 * 2 <= WS_H, "weights");

constexpr int CW_BAR = 4096;
constexpr int CW_ERR = 32768;

constexpr int LDS_SCR = 0, LDS_SCR_BYTES = 131072;
constexpr int LDS_MISC = 131072;
constexpr int LDS_BYTES = 131072 + 1024 + 8192;

DI unsigned pk2(float lo, float hi) { f32x2 v = {lo, hi}; bf16x2_t b = __builtin_convertvector(v, bf16x2_t); return __builtin_bit_cast(unsigned, b); }
DI float bflo(unsigned w) { return __uint_as_float(w << 16); }
DI float bfhi(unsigned w) { return __uint_as_float(w & 0xffff0000u); }
DI float bf2f(bf16_t u) { return __uint_as_float((unsigned)u << 16); }
DI int lane_v() { int l; asm volatile("v_mbcnt_lo_u32_b32 %0, -1, 0\n\tv_mbcnt_hi_u32_b32 %0, -1, %0" : "=v"(l)); return l; }
DI float shx(float v, int m) { return __builtin_bit_cast(float, __builtin_amdgcn_ds_bpermute((lane_v() ^ m) << 2, __builtin_bit_cast(int, v))); }
DI int shx(int v, int m) { return __builtin_amdgcn_ds_bpermute((lane_v() ^ m) << 2, v); }
DI int shup(int v, int o) { return __builtin_amdgcn_ds_bpermute((lane_v() - o) << 2, v); }
DI int shidx(int v, int src) { return __builtin_amdgcn_ds_bpermute(src << 2, v); }
DI float wave_sum(float v) {
#pragma unroll
    for (int o = 1; o < 64; o <<= 1) v += shx(v, o);
    return v;
}
DI float sigmoidf_(float x) { return __builtin_amdgcn_rcpf(1.f + __builtin_amdgcn_exp2f(x * -1.4426950408889634f)); }

namespace pg8 {
#define PG8_LAS __attribute__((address_space(3)))
constexpr int BM = 256, BK = 64, HALF = 128, HTB = HALF * BK * 2, STAGE_BYTES = 8 * HTB, NXCD = 8, WGM = 8;
__host__ __device__ __forceinline__ int lds_byte(int r, int c) { const int st = (r >> 4) * 2 + (c >> 5), rr = r & 15, cc = c & 31, ob = rr * 64 + cc * 2; return st * 1024 + (ob ^ (((ob >> 9) & 1) << 5)); }
__host__ __device__ __forceinline__ void stage_rc(int b, int& R, int& C) { const int st = b / 1024, sb = b % 1024, swz = sb ^ (((sb >> 9) & 1) << 5); R = (st >> 1) * 16 + swz / 64; C = (st & 1) * 32 + (swz % 64) / 2; }
__host__ __device__ __forceinline__ int perm32(int rho) { const int n = rho >> 4, i = rho & 15; return 8 * (i >> 2) + 4 * n + (i & 3); }

struct Unit { int pm, pn; long bo; int ord; };
struct Gemm { const bf16_t* A; const bf16_t* Bt; int K; int sclB; };
typedef int v4i_t __attribute__((ext_vector_type(4)));
typedef int v8i_t __attribute__((ext_vector_type(8)));
__device__ __forceinline__ void mfma_f8(f32x4& acc, v8i_t b, v8i_t a, int sclb) {
    asm volatile("v_mfma_scale_f32_16x16x128_f8f6f4 %0, %1, %2, %0, %3, %4 op_sel_hi:[0,0,0]" : "+v"(acc) : "v"(b), "v"(a), "v"(sclb), "v"(0x7F7F7F7F));
}
__device__ __forceinline__ v8i_t cat8(bf16x8 lo, bf16x8 hi) { return __builtin_shufflevector(__builtin_bit_cast(v4i_t, lo), __builtin_bit_cast(v4i_t, hi), 0, 1, 2, 3, 4, 5, 6, 7); }

struct StaticOrder {
    int nM, nN, nwg, G, c;
    __host__ __device__ void init(int M, int N, int G_, int c_) { nM = M / BM; nN = N / BM; nwg = nM * nN; G = G_; c = c_; }
    __host__ __device__ bool next(int i, Unit& u) const {
        const long L = (long)i * G + c; if (L >= nwg) return false;
        int wgid = (int)L; { const int q = nwg / NXCD, r = nwg % NXCD, xcd = wgid % NXCD, off = wgid / NXCD; wgid = (xcd < r ? xcd * (q + 1) : r * (q + 1) + (xcd - r) * q) + off; }
        const int nig = WGM * nN, gid = wgid / nig, fm = gid * WGM, gsz = (nM - fm) < WGM ? (nM - fm) : WGM;
        u.pm = fm + ((wgid % nig) % gsz); u.pn = (wgid % nig) / gsz; u.bo = 0; u.ord = i; return true;
    }
    __device__ __forceinline__ void a_ready(const Unit&) const {}
    __device__ __forceinline__ void done(const Unit&) const {}
};
struct StaticOrderR : StaticOrder {
    const float* ssq; PG8_LAS float* tab; int wid;
    __device__ __forceinline__ void a_ready(const Unit& u) const {
        if (ssq) { int t_; asm volatile("v_mbcnt_lo_u32_b32 %0, -1, 0\n\tv_mbcnt_hi_u32_b32 %0, -1, %0" : "=v"(t_)); const int w_ = wid;
            if (w_ < 4) { const int rr = w_ * 64 + t_; const f32x4* p = (const f32x4*)(ssq + (size_t)(u.pm * 256 + rr) * 16); const f32x4 a = p[0], b = p[1], c2 = p[2], d = p[3];
                const float s_ = ((a[0] + a[1]) + (a[2] + a[3])) + ((b[0] + b[1]) + (b[2] + b[3])) + ((c2[0] + c2[1]) + (c2[2] + c2[3])) + ((d[0] + d[1]) + (d[2] + d[3]));
                tab[(u.ord & 1) * 256 + rr] = 1.f / sqrtf(s_ * (1.f / 1024.f) + 1e-6f); } }
    }
};
struct GroupedOrder {
    int nN, c8, loc, per; int tp[9]; long bstride; int cb;
    __device__ __forceinline__ bool next(int i, Unit& u) const {
        const int R = (tp[8] - c8 + 7) >> 3;
        const int j = loc + per * i; if (j >= R * nN) return false;
        const int g = j / (4 * nN), w = j - g * 4 * nN, rg = min(4, R - 4 * g);
        const int blk = rg * cb, pc = w / blk, rem = w - pc * blk, col = rem / rg, row = rem - col * rg;
        const int pm = c8 + 8 * (4 * g + row);
        u.pm = pm; u.pn = pc * cb + col; u.ord = i;
        int e = 0;
#pragma unroll
        for (int k = 1; k < 8; ++k) e += (pm >= tp[k]) ? 1 : 0;
        u.bo = (long)e * bstride; return true;
    }
    __device__ __forceinline__ void a_ready(const Unit&) const {}
    __device__ __forceinline__ void done(const Unit&) const {}
};

template <class T, class = void> struct has_mid { static constexpr bool value = false; };
template <class T> struct has_mid<T, decltype((void)T::HAS_MID)> { static constexpr bool value = T::HAS_MID; };
template <class Epi, class Sched, bool ALIGN_EPI = false, bool SP2 = false, bool F8 = false>
__device__ __forceinline__ void gemm_phase(PG8_LAS unsigned char* lds, const Gemm g, const Sched& S, const Epi& E, int tid_in) {
    int tid_o = tid_in; asm volatile("" : "+v"(tid_o));
    const int tid = tid_o, wid = __builtin_amdgcn_readfirstlane(tid >> 6), lane = tid & 63, wr = wid >> 2, wc = wid & 3, fr = lane & 15, fq = lane >> 4;
    const int K = g.K, nt = K / BK;
    unsigned voffA[2], voffB[2];
#pragma unroll
    for (int i = 0; i < 2; ++i) { int R, C; stage_rc(tid * 16 + i * 8192, R, C); const int Rb = Epi::PERM ? ((R & ~31) + perm32(R & 31)) : R;
        voffA[i] = (unsigned)(R * K + C) * 2u; voffB[i] = (unsigned)(Rb * K + C) * 2u; }
    const size_t kstep = (size_t)(BK * 2);
    const size_t hstep = (size_t)HALF * K * 2;
    const size_t tstep = 2 * hstep;
    const unsigned ldsw = (unsigned)wid * 1024u;
    const int aoff = lds_byte(wr * 64 + fr, fq * 8), boff = lds_byte(wc * 32 + fr, fq * 8);
#define PG8_SA(b, h) (((b) * 2 + (h)) * HTB)
#define PG8_SB(b, h) ((4 + (b) * 2 + (h)) * HTB)
#define PG8_STAGE(bufoff, gbase, voff) do { _Pragma("unroll") for (int _i = 0; _i < 2; ++_i) \
        __builtin_amdgcn_global_load_lds((const unsigned*)((const char*)(gbase) + (voff)[_i]), (PG8_LAS unsigned*)(lds + (bufoff) + ldsw + _i * 8192), 16, 0, 0); } while (0)
#define PG8_LDA(dst, b, h) do { _Pragma("unroll") for (int m = 0; m < 4; ++m) _Pragma("unroll") for (int k = 0; k < 2; ++k) dst[m][k] = *(const PG8_LAS bf16x8*)(lds + PG8_SA(b, h) + aoff + m * 2048 + k * 1024); } while (0)
#define PG8_LDB(dst, b, h) do { _Pragma("unroll") for (int n = 0; n < 2; ++n) _Pragma("unroll") for (int k = 0; k < 2; ++k) dst[n][k] = *(const PG8_LAS bf16x8*)(lds + PG8_SB(b, h) + boff + n * 2048 + k * 1024); } while (0)
#define PG8_MMA(ai, bj, At, Bt) do { __builtin_amdgcn_s_setprio(1); _Pragma("unroll") for (int m = 0; m < 4; ++m) _Pragma("unroll") for (int n = 0; n < 2; ++n) { \
        if constexpr (F8) mfma_f8(acc[ai][bj][m][n], cat8(Bt[n][0], Bt[n][1]), cat8(At[m][0], At[m][1]), g.sclB); \
        else { _Pragma("unroll") for (int k = 0; k < 2; ++k) acc[ai][bj][m][n] = __builtin_amdgcn_mfma_f32_16x16x32_bf16(Bt[n][k], At[m][k], acc[ai][bj][m][n], 0, 0, 0); } } __builtin_amdgcn_s_setprio(0); } while (0)
#define PG8_WAIT_V(n) asm volatile("s_waitcnt vmcnt(" #n ")" ::: "memory")
#define PG8_WAIT_L(n) asm volatile("s_waitcnt lgkmcnt(" #n ")" ::: "memory")
#define PG8_BAR __builtin_amdgcn_s_barrier()
#define PG8_SCHED __builtin_amdgcn_sched_barrier(0)
    Unit cur, nxt; int ui = 0;
    if (!S.next(0, cur)) return;
    f32x4 acc[2][2][4][2];
#pragma unroll
    for (int a = 0; a < 2; ++a)
#pragma unroll
        for (int b = 0; b < 2; ++b)
#pragma unroll
            for (int m = 0; m < 4; ++m)
#pragma unroll
                for (int n = 0; n < 2; ++n) acc[a][b][m][n] = (f32x4){0.f, 0.f, 0.f, 0.f};
    bf16x8 At[4][2], B0[2][2], B1[2][2];
    const char* cA = (const char*)g.A + (size_t)cur.pm * tstep; const char* cB = (const char*)g.Bt + cur.bo + (size_t)cur.pn * tstep;
    S.a_ready(cur);
    if constexpr (SP2) {
        PG8_STAGE(PG8_SB(0, 0), cB, voffB); PG8_STAGE(PG8_SB(0, 1), cB + hstep, voffB); PG8_STAGE(PG8_SA(0, 0), cA, voffA); PG8_STAGE(PG8_SA(0, 1), cA + hstep, voffA);
        if (wr == 1) PG8_BAR;
        PG8_WAIT_V(2); PG8_BAR;
        PG8_STAGE(PG8_SB(1, 0), cB + kstep, voffB); PG8_STAGE(PG8_SA(1, 0), cA + kstep, voffA); PG8_STAGE(PG8_SB(1, 1), cB + hstep + kstep, voffB);
        PG8_WAIT_V(6); PG8_BAR;
    } else {
        PG8_STAGE(PG8_SB(0, 0), cB, voffB); PG8_STAGE(PG8_SA(0, 0), cA, voffA); PG8_STAGE(PG8_SB(0, 1), cB + hstep, voffB); PG8_STAGE(PG8_SA(0, 1), cA + hstep, voffA);
        if (wr == 1) PG8_BAR;
        PG8_WAIT_V(4); PG8_BAR;
        PG8_STAGE(PG8_SB(1, 0), cB + kstep, voffB); PG8_STAGE(PG8_SA(1, 0), cA + kstep, voffA); PG8_STAGE(PG8_SB(1, 1), cB + hstep + kstep, voffB);
        PG8_WAIT_V(6); PG8_BAR;
    }
    for (;;) {
        const bool has_next = S.next(ui + 1, nxt);
        const char* nA = has_next ? (const char*)g.A + (size_t)nxt.pm * tstep : cA; const char* nB = has_next ? (const char*)g.Bt + nxt.bo + (size_t)nxt.pn * tstep : cB;
        for (int t = 0; t < nt; t += 2) {
            if constexpr (has_mid<Epi>::value) { if (E.is_mid(t)) { if (wr == 0) PG8_BAR; E.mid(acc, cur, t, wr, wc, fr, fq); if (wr == 1) PG8_BAR; } }
            const bool last = (t == nt - 2);
            const char* a1 = cA + (size_t)(t + 1) * kstep;
            const char* a2 = last ? nA : cA + (size_t)(t + 2) * kstep; const char* b2 = last ? nB : cB + (size_t)(t + 2) * kstep;
            const char* a3 = a2 + kstep; const char* b3 = b2 + kstep;
            if (last && has_next) S.a_ready(nxt);
            if constexpr (SP2) {
            PG8_LDB(B0, 0, 0); PG8_LDB(B1, 0, 1); PG8_SCHED; PG8_LDA(At, 0, 0); PG8_STAGE(PG8_SA(1, 1), a1 + hstep, voffA);
            PG8_WAIT_V(8); PG8_WAIT_L(0); PG8_BAR; PG8_MMA(0, 0, At, B0); PG8_MMA(0, 1, At, B1); PG8_BAR; PG8_SCHED;
            PG8_LDA(At, 0, 1); PG8_STAGE(PG8_SB(0, 0), b2, voffB); PG8_STAGE(PG8_SB(0, 1), b2 + hstep, voffB); PG8_STAGE(PG8_SA(0, 0), a2, voffA);
            PG8_WAIT_V(8); PG8_WAIT_L(0); PG8_BAR; PG8_MMA(1, 0, At, B0); PG8_MMA(1, 1, At, B1); PG8_BAR; PG8_SCHED;
            PG8_LDB(B0, 1, 0); PG8_LDB(B1, 1, 1); PG8_SCHED; PG8_LDA(At, 1, 0); PG8_STAGE(PG8_SA(0, 1), a2 + hstep, voffA);
            PG8_WAIT_V(8); PG8_WAIT_L(0); PG8_BAR; PG8_MMA(0, 0, At, B0); PG8_MMA(0, 1, At, B1); PG8_BAR; PG8_SCHED;
            PG8_LDA(At, 1, 1); PG8_STAGE(PG8_SB(1, 0), b3, voffB); PG8_STAGE(PG8_SB(1, 1), b3 + hstep, voffB); PG8_STAGE(PG8_SA(1, 0), a3, voffA);
            PG8_WAIT_V(8); PG8_WAIT_L(0); PG8_BAR; PG8_MMA(1, 0, At, B0); PG8_MMA(1, 1, At, B1); PG8_BAR; PG8_SCHED;
            } else {
            PG8_LDB(B0, 0, 0); PG8_SCHED; PG8_LDA(At, 0, 0); PG8_STAGE(PG8_SA(1, 1), a1 + hstep, voffA);
            PG8_WAIT_L(8); PG8_BAR; PG8_WAIT_L(0); PG8_MMA(0, 0, At, B0); PG8_BAR; PG8_SCHED;
            PG8_LDB(B1, 0, 1); PG8_STAGE(PG8_SB(0, 0), b2, voffB);
            PG8_BAR; PG8_WAIT_L(0); PG8_MMA(0, 1, At, B1); PG8_BAR;
            PG8_LDA(At, 0, 1); PG8_STAGE(PG8_SA(0, 0), a2, voffA);
            PG8_BAR; PG8_WAIT_L(0); PG8_MMA(1, 0, At, B0); PG8_BAR; PG8_SCHED;
            PG8_STAGE(PG8_SB(0, 1), b2 + hstep, voffB);
            PG8_WAIT_V(6); PG8_BAR; PG8_MMA(1, 1, At, B1); PG8_BAR;
            PG8_LDB(B0, 1, 0); PG8_SCHED; PG8_LDA(At, 1, 0); PG8_STAGE(PG8_SA(0, 1), a2 + hstep, voffA);
            PG8_WAIT_L(8); PG8_BAR; PG8_WAIT_L(0); PG8_MMA(0, 0, At, B0); PG8_BAR; PG8_SCHED;
            PG8_LDB(B1, 1, 1); PG8_STAGE(PG8_SB(1, 0), b3, voffB);
            PG8_BAR; PG8_WAIT_L(0); PG8_MMA(0, 1, At, B1); PG8_BAR;
            PG8_LDA(At, 1, 1); PG8_STAGE(PG8_SA(1, 0), a3, voffA);
            PG8_BAR; PG8_WAIT_L(0); PG8_MMA(1, 0, At, B0); PG8_BAR; PG8_SCHED;
            PG8_STAGE(PG8_SB(1, 1), b3 + hstep, voffB);
            PG8_WAIT_V(6); PG8_BAR; PG8_MMA(1, 1, At, B1); PG8_BAR;
            }
        }
        if constexpr (ALIGN_EPI) { if (wr == 0) PG8_BAR; }
        if constexpr (F8) asm volatile("s_nop 15\n\ts_nop 15" ::: "memory");
        if constexpr (!Epi::AFTER_DRAIN) { E(acc, cur, wr, wc, fr, fq); S.done(cur); }
        if (!has_next) break;
#pragma unroll
        for (int a = 0; a < 2; ++a)
#pragma unroll
            for (int b = 0; b < 2; ++b)
#pragma unroll
                for (int m = 0; m < 4; ++m)
#pragma unroll
                    for (int n = 0; n < 2; ++n) acc[a][b][m][n] = (f32x4){0.f, 0.f, 0.f, 0.f};
        cur = nxt; cA = nA; cB = nB; ++ui;
        if constexpr (ALIGN_EPI) { if (wr == 1) PG8_BAR; }
    }
    PG8_WAIT_V(0);
    if constexpr (!ALIGN_EPI) { if (wr == 0) PG8_BAR; }
    PG8_BAR;
    if constexpr (Epi::AFTER_DRAIN) { E.fused(acc, cur, wr, wc, fr, fq, lds, wid, lane); S.done(cur); }
#undef PG8_SA
#undef PG8_SB
#undef PG8_STAGE
#undef PG8_LDA
#undef PG8_LDB
#undef PG8_MMA
#undef PG8_WAIT_V
#undef PG8_WAIT_L
#undef PG8_BAR
#undef PG8_SCHED
}
}

typedef const f32x4 (&AccRef)[2][2][4][2];

struct EpiIn {
    static constexpr bool PERM = true, AFTER_DRAIN = false;
    bf16_t *Q, *Kb, *V, *G; const LAS float* rtab;
    DI void operator()(AccRef acc, const pg8::Unit& u, int wr, int wc, int fr, int fq) const {
        const int pn = u.pn; bf16_t* base; int ld, colt; bool sig = false;
        if (pn < 4) { base = Q; ld = 1024; colt = pn * 256; }
        else if (pn < 7) { base = Kb; ld = 768; colt = (pn - 4) * 256; }
        else if (pn < 10) { base = V; ld = 768; colt = (pn - 7) * 256; }
        else { base = G; ld = 3072; colt = (pn - 10) * 256; sig = true; }
        const int row0 = u.pm * 256 + wr * 64 + fr, col0 = colt + wc * 32 + 8 * fq;
#pragma unroll
        for (int ai = 0; ai < 2; ++ai)
#pragma unroll
            for (int m = 0; m < 4; ++m) { bf16_t* rowp = base + (size_t)(row0 + ai * 128 + m * 16) * ld + col0;
                const float rs = rtab ? rtab[(u.ord & 1) * 256 + wr * 64 + fr + ai * 128 + m * 16] : 1.f;
#pragma unroll
                for (int bj = 0; bj < 2; ++bj) {
                    if (sig) {
                        const float rsn = rs * -1.4426950408889634f; unsigned q[8];
#pragma unroll
                        for (int j = 0; j < 4; ++j) {
                            q[j] = (unsigned)__builtin_amdgcn_rcpf(__builtin_amdgcn_exp2f(__builtin_fmaf(acc[ai][bj][m][0][j], rsn, -8.f)) + 0.00390720367431640625f);
                            q[4 + j] = (unsigned)__builtin_amdgcn_rcpf(__builtin_amdgcn_exp2f(__builtin_fmaf(acc[ai][bj][m][1][j], rsn, -8.f)) + 0.00390720367431640625f); }
                        u32x2 w; w.x = q[0] | (q[1] << 8) | (q[2] << 16) | (q[3] << 24); w.y = q[4] | (q[5] << 8) | (q[6] << 16) | (q[7] << 24);
                        *(u32x2*)((unsigned char*)G + (size_t)(row0 + ai * 128 + m * 16) * 3072 + col0 + bj * 128) = w; }
                    else { const f32x4 v0 = acc[ai][bj][m][0] * rs, v1 = acc[ai][bj][m][1] * rs;
                        u32x4 w; w.x = pk2(v0[0], v0[1]); w.y = pk2(v0[2], v0[3]); w.z = pk2(v1[0], v1[1]); w.w = pk2(v1[2], v1[3]);
                        *(u32x4*)(rowp + bj * 128) = w; } } }
    }
};

struct EpiGate {
    static constexpr bool PERM = true, AFTER_DRAIN = false, HAS_MID = true;
    const unsigned char* G; bf16_t* Mg;
    DI bool is_mid(int t) const { return t == 4 || t == 10; }
    static DI float gq(unsigned w, int k) { return (float)((w >> (8 * k)) & 0xffu) + 0.5f; }
    DI void mid(f32x4 (&acc)[2][2][4][2], const pg8::Unit& u, int t, int wr, int wc, int fr, int fq) const {
        int fr_o = fr; asm volatile("" : "+v"(fr_o));
        const int row0 = u.pm * 256 + wr * 64 + fr_o, col0 = u.pn * 256 + wc * 32 + 8 * fq, g0 = (t == 4) ? 0 : 1024;
#pragma unroll
        for (int ai = 0; ai < 2; ++ai) {
            __builtin_amdgcn_sched_barrier(0);
#pragma unroll
            for (int m = 0; m < 4; ++m) { const size_t ro = (size_t)(row0 + ai * 128 + m * 16) * 3072 + g0 + col0;
#pragma unroll
                for (int bj = 0; bj < 2; ++bj) { const u32x2 gn = *(const u32x2*)(G + ro + bj * 128), gd = *(const u32x2*)(G + ro + 1024 + bj * 128);
                    f32x4 r0, r1;
#pragma unroll
                    for (int k = 0; k < 4; ++k) { r0[k] = gq(gn.x, k) * __builtin_amdgcn_rcpf(gq(gd.x, k)); r1[k] = gq(gn.y, k) * __builtin_amdgcn_rcpf(gq(gd.y, k)); }
                    acc[ai][bj][m][0] = acc[ai][bj][m][0] * r0; acc[ai][bj][m][1] = acc[ai][bj][m][1] * r1; } } }
        __builtin_amdgcn_sched_barrier(0);
    }
    DI void operator()(AccRef acc, const pg8::Unit& u, int wr, int wc, int fr, int fq) const {
        const int row0 = u.pm * 256 + wr * 64 + fr, col0 = u.pn * 256 + wc * 32 + 8 * fq;
#pragma unroll
        for (int ai = 0; ai < 2; ++ai)
#pragma unroll
            for (int m = 0; m < 4; ++m) { const size_t row = (size_t)(row0 + ai * 128 + m * 16);
#pragma unroll
                for (int bj = 0; bj < 2; ++bj) { const int col = col0 + bj * 128;
                    const u32x2 g = *(const u32x2*)(G + row * 3072 + 2048 + col);
                    const f32x4 v0 = acc[ai][bj][m][0] * (1.f / 256.f), v1 = acc[ai][bj][m][1] * (1.f / 256.f);
                    u32x4 w;
                    w.x = pk2(gq(g.x, 0) * v0[0], gq(g.x, 1) * v0[1]); w.y = pk2(gq(g.x, 2) * v0[2], gq(g.x, 3) * v0[3]);
                    w.z = pk2(gq(g.y, 0) * v1[0], gq(g.y, 1) * v1[1]); w.w = pk2(gq(g.y, 2) * v1[2], gq(g.y, 3) * v1[3]);
                    *(u32x4*)(Mg + row * 1024 + col) = w; } }
    }
};

struct EpiResidN {
    static constexpr bool PERM = true, AFTER_DRAIN = false;
    const float* xin; float* xout; unsigned char* xb; float* ssq; int f8;
    DI void operator()(AccRef acc, const pg8::Unit& u, int wr, int wc, int fr, int fq) const {
        const int row0 = u.pm * 256 + wr * 64 + fr, col0 = u.pn * 256 + wc * 32 + 8 * fq;
#pragma unroll
        for (int ai = 0; ai < 2; ++ai)
#pragma unroll
            for (int m = 0; m < 4; ++m) { const int row = row0 + ai * 128 + m * 16; const size_t ro = (size_t)row * 1024; float ss = 0.f;
#pragma unroll
                for (int bj = 0; bj < 2; ++bj) { const size_t o = ro + col0 + bj * 128;
                    const f32x4 x0 = *(const f32x4*)(xin + o) + acc[ai][bj][m][0], x1 = *(const f32x4*)(xin + o + 4) + acc[ai][bj][m][1];
                    *(f32x4*)(xout + o) = x0; *(f32x4*)(xout + o + 4) = x1;
                    if (xb) { ss += ((x0[0] * x0[0] + x0[1] * x0[1]) + (x0[2] * x0[2] + x0[3] * x0[3])) + ((x1[0] * x1[0] + x1[1] * x1[1]) + (x1[2] * x1[2] + x1[3] * x1[3]));
                        if (f8) { int w0 = 0, w1 = 0; w0 = __builtin_amdgcn_cvt_pk_fp8_f32(x0[0], x0[1], w0, false); w0 = __builtin_amdgcn_cvt_pk_fp8_f32(x0[2], x0[3], w0, true);
                            w1 = __builtin_amdgcn_cvt_pk_fp8_f32(x1[0], x1[1], w1, false); w1 = __builtin_amdgcn_cvt_pk_fp8_f32(x1[2], x1[3], w1, true);
                            u32x2 w; w.x = (unsigned)w0; w.y = (unsigned)w1; *(u32x2*)(xb + o) = w; }
                        else { u32x4 w; w.x = pk2(x0[0], x0[1]); w.y = pk2(x0[2], x0[3]); w.z = pk2(x1[0], x1[1]); w.w = pk2(x1[2], x1[3]); *(u32x4*)(xb + 2 * o) = w; } } }
                if (xb) { ss += shx(ss, 16); ss += shx(ss, 32);
                    if (fq == 0) ssq[(size_t)row * 16 + 4 * u.pn + wc] = ss; } }
    }
};

struct EpiResid {
    static constexpr bool PERM = false, AFTER_DRAIN = false;
    const float* xin; float* xout;
    DI void operator()(AccRef acc, const pg8::Unit& u, int wr, int wc, int fr, int fq) const {
        const int row0 = u.pm * 256 + wr * 64 + fr, col0 = u.pn * 256 + wc * 32 + 4 * fq;
#pragma unroll
        for (int ai = 0; ai < 2; ++ai)
#pragma unroll
            for (int m = 0; m < 4; ++m) { const size_t ro = (size_t)(row0 + ai * 128 + m * 16) * 1024;
#pragma unroll
                for (int bj = 0; bj < 2; ++bj)
#pragma unroll
                    for (int n = 0; n < 2; ++n) { const size_t o = ro + col0 + bj * 128 + n * 16;
                        const f32x4 xv = *(const f32x4*)(xin + o); *(f32x4*)(xout + o) = xv + acc[ai][bj][m][n]; } }
    }
};

template <bool F8O>
struct EpiSwiglu {
    static constexpr bool PERM = true, AFTER_DRAIN = false;
    unsigned char* act; int ld; const LAS float* rtab;
    DI void operator()(AccRef acc, const pg8::Unit& u, int wr, int wc, int fr, int fq) const {
        const int row0 = u.pm * 256 + wr * 64 + fr, col0 = u.pn * 128 + wc * 32 + 8 * fq;
#pragma unroll
        for (int ai = 0; ai < 2; ++ai)
#pragma unroll
            for (int m = 0; m < 4; ++m) { const size_t eo = (size_t)(row0 + ai * 128 + m * 16) * ld + col0;
                const float rs = rtab ? rtab[(u.ord & 1) * 256 + wr * 64 + fr + ai * 128 + m * 16] : 1.f;
                const float rsn = rs * -1.4426950408889634f, irs2 = rtab ? __builtin_amdgcn_rcpf(rs * rs) : 1.f;
                float o[8];
#pragma unroll
                for (int n = 0; n < 2; ++n)
#pragma unroll
                    for (int j = 0; j < 4; ++j) { const float ga = acc[ai][0][m][n][j], ua = acc[ai][1][m][n][j];
                        const float e = __builtin_amdgcn_exp2f(ga * rsn); o[4 * n + j] = (ga * ua) * __builtin_amdgcn_rcpf(__builtin_fmaf(e, irs2, irs2)); }
                if constexpr (F8O) { int w0 = 0, w1 = 0;
                    w0 = __builtin_amdgcn_cvt_pk_fp8_f32(o[0], o[1], w0, false); w0 = __builtin_amdgcn_cvt_pk_fp8_f32(o[2], o[3], w0, true);
                    w1 = __builtin_amdgcn_cvt_pk_fp8_f32(o[4], o[5], w1, false); w1 = __builtin_amdgcn_cvt_pk_fp8_f32(o[6], o[7], w1, true);
                    u32x2 w; w.x = (unsigned)w0; w.y = (unsigned)w1; *(u32x2*)(act + eo) = w; }
                else { u32x4 w; w.x = pk2(o[0], o[1]); w.y = pk2(o[2], o[3]); w.z = pk2(o[4], o[5]); w.w = pk2(o[6], o[7]); *(u32x4*)(act + 2 * eo) = w; } }
    }
};

struct EpiMoeDown {
    static constexpr bool PERM = true, AFTER_DRAIN = false;
    const int* perm; const float* rgate; bf16_t* ybuf;
    DI void operator()(AccRef acc, const pg8::Unit& u, int wr, int wc, int fr, int fq) const {
        const int row0 = u.pm * 256 + wr * 64 + fr, col0 = u.pn * 256 + wc * 32 + 8 * fq;
#pragma unroll
        for (int ai = 0; ai < 2; ++ai)
#pragma unroll
            for (int m = 0; m < 4; ++m) { const int row = row0 + ai * 128 + m * 16; const int p = perm[row];
                if (p >= 0) { const float gt = rgate[row]; bf16_t* dst = ybuf + ((size_t)(p & 1) * NTOK + (size_t)(p >> 1)) * 1024 + col0;
#pragma unroll
                    for (int bj = 0; bj < 2; ++bj) { const f32x4 v0 = acc[ai][bj][m][0] * gt, v1 = acc[ai][bj][m][1] * gt;
                        u32x4 w; w.x = pk2(v0[0], v0[1]); w.y = pk2(v0[2], v0[3]); w.z = pk2(v1[0], v1[1]); w.w = pk2(v1[2], v1[3]);
                        *(u32x4*)(dst + bj * 128) = w; } } }
    }
};

#define LDS_WAIT() asm volatile("s_waitcnt lgkmcnt(0)" ::: "memory")

DI void prep_tile(const float* src, int src_ld, bool zero, unsigned char* dst, int dst_ld, float f8mul, const float* kg  , LAS bf16_t* t, int lane) {
#pragma unroll
    for (int i = 0; i < 16; ++i) { const int k = i * 4 + (lane >> 4), c = (lane & 15) * 4;
        f32x4 v = {0.f, 0.f, 0.f, 0.f}; if (!zero) v = *(const f32x4*)(src + (size_t)k * src_ld + c);
        if (kg) v = v * kg[k];
        u32x2 w; w.x = pk2(v[0], v[1]); w.y = pk2(v[2], v[3]); *(LAS u32x2*)(t + k * 68 + c) = w; }
    LDS_WAIT();
#pragma unroll
    for (int kc = 0; kc < 8; ++kc) { unsigned e[8];
#pragma unroll
        for (int j = 0; j < 8; ++j) e[j] = t[(8 * kc + j) * 68 + lane];
        if (f8mul != 0.f) { int w0 = 0, w1 = 0;
            w0 = __builtin_amdgcn_cvt_pk_fp8_f32(bflo(e[0]) * f8mul, bflo(e[1]) * f8mul, w0, false); w0 = __builtin_amdgcn_cvt_pk_fp8_f32(bflo(e[2]) * f8mul, bflo(e[3]) * f8mul, w0, true);
            w1 = __builtin_amdgcn_cvt_pk_fp8_f32(bflo(e[4]) * f8mul, bflo(e[5]) * f8mul, w1, false); w1 = __builtin_amdgcn_cvt_pk_fp8_f32(bflo(e[6]) * f8mul, bflo(e[7]) * f8mul, w1, true);
            u32x2 w; w.x = (unsigned)w0; w.y = (unsigned)w1; *(u32x2*)(dst + (size_t)lane * dst_ld + 8 * kc) = w; }
        else { u32x4 w; w.x = e[0] | (e[1] << 16); w.y = e[2] | (e[3] << 16); w.z = e[4] | (e[5] << 16); w.w = e[6] | (e[7] << 16);
            *(u32x4*)(dst + ((size_t)lane * dst_ld + 8 * kc) * 2) = w; } }
    LDS_WAIT();
}

struct Args { const float* in[12]; float* out; unsigned char* ws; int lo, hi; };
typedef Args Ptrs;

DI void prep_wg_tile(const float* src0, const float* src1, int src_ld, unsigned char* dst, int dst_ld, float f8mul, const float* kg, LAS bf16_t* t, int tid) {
    { const int c = (tid & 127) * 4, kk = tid >> 7;
      const float* sp; int dn;
      if (src1) { const int run = c >> 8, cc = c & 255; sp = (run ? src1 : src0) + cc; dn = ((cc >> 7) << 8) + (run << 7) + (cc & 127); } else { sp = src0 + c; dn = c; }
#pragma unroll
      for (int p = 0; p < 16; ++p) { const int k = 4 * p + kk; f32x4 v = *(const f32x4*)(sp + (size_t)k * src_ld);
          if (kg) v = v * kg[k];
          u32x2 w; w.x = pk2(v[0], v[1]); w.y = pk2(v[2], v[3]); *(LAS u32x2*)(t + k * 520 + (dn ^ (((k >> 3) & 7) << 3))) = w; } }
    __syncthreads();
    { const int kc = tid & 7;
#pragma unroll
      for (int i = 0; i < 8; ++i) { const int n = 64 * i + (tid >> 3); unsigned e[8];
#pragma unroll
          for (int j = 0; j < 8; ++j) e[j] = t[(8 * kc + j) * 520 + (n ^ (kc << 3))];
          if (f8mul != 0.f) { int w0 = 0, w1 = 0;
              w0 = __builtin_amdgcn_cvt_pk_fp8_f32(bflo(e[0]) * f8mul, bflo(e[1]) * f8mul, w0, false); w0 = __builtin_amdgcn_cvt_pk_fp8_f32(bflo(e[2]) * f8mul, bflo(e[3]) * f8mul, w0, true);
              w1 = __builtin_amdgcn_cvt_pk_fp8_f32(bflo(e[4]) * f8mul, bflo(e[5]) * f8mul, w1, false); w1 = __builtin_amdgcn_cvt_pk_fp8_f32(bflo(e[6]) * f8mul, bflo(e[7]) * f8mul, w1, true);
              u32x2 w; w.x = (unsigned)w0; w.y = (unsigned)w1; *(u32x2*)(dst + (size_t)n * dst_ld + 8 * kc) = w; }
          else { u32x4 w; w.x = e[0] | (e[1] << 16); w.y = e[2] | (e[3] << 16); w.z = e[4] | (e[5] << 16); w.w = e[6] | (e[7] << 16);
              *(u32x4*)(dst + ((size_t)n * dst_ld + 8 * kc) * 2) = w; } } }
    __syncthreads();
}

DI void phase_prep(const Ptrs& P, LAS unsigned char* lds, int tid) {
    LAS bf16_t* t = (LAS bf16_t*)(lds + LDS_SCR);
    constexpr int T0 = 4 * 176, T3 = T0 + 4 * 24, T4 = T3 + 4 * 32, T5 = T4 + 2 * 176, T6 = T5 + 2 * 88, T7 = T6 + 16 * 224, T8 = T7 + 16 * 112;
    for (int it = blockIdx.x; it < T8; it += gridDim.x) {
        const float* src; const float* src1 = nullptr; int src_ld; size_t wsb; size_t eo; int dst_ld; float f8mul = 0.f; const float* kg = nullptr;
        int r = it;
        if (r < T0) { const int L = r / 176, q = r % 176, kt = q / 11, nt = q % 11;
            src = P.in[2] + (size_t)L * 1024 * 5632 + (size_t)kt * 64 * 5632 + nt * 512; src_ld = 5632;
            wsb = WS_W_IN + (size_t)L * 5632 * 1024 * 2; eo = (size_t)(nt * 512) * 1024 + kt * 64; dst_ld = 1024; f8mul = ((F8_IN >> L) & 1) ? 32.f : 0.f;
            if (FUSE_NORM && (L & 1)) kg = P.in[1] + (size_t)L * 2048 + kt * 64; }
        else if (r < T3) { r -= T0; const int L = r / 24, q = r % 24, kt = q / 2, nt = q % 2;
            src = P.in[5] + (size_t)L * 768 * 1024 + (size_t)(kt * 64) * 1024 + nt * 512; src_ld = 1024;
            wsb = WS_W_BR; eo = ((size_t)L * 1024 + nt * 512) * 768 + kt * 64; dst_ld = 768; }
        else if (r < T4) { r -= T3; const int L = r / 32, q = r % 32, kt = q / 2, nt = q % 2;
            src = P.in[6] + (size_t)L * 1024 * 1024 + (size_t)(kt * 64) * 1024 + nt * 512; src_ld = 1024;
            wsb = WS_W_OUT; eo = ((size_t)L * 1024 + nt * 512) * 1024 + kt * 64; dst_ld = 1024; }
        else if (r < T5) { r -= T4; const int L = r / 176, q = r % 176, kt = q / 11, nt = q % 11;
            src = P.in[7] + (size_t)L * 1024 * 5632 + (size_t)(kt * 64) * 5632 + nt * 256; src1 = src + FF; src_ld = 5632;
            wsb = WS_W_FGU + (size_t)L * 5632 * 1024 * 2; eo = (size_t)(nt * 512) * 1024 + kt * 64; dst_ld = 1024; f8mul = ((F8_FFN >> L) & 1) ? 32.f : 0.f;
            if (FUSE_NORM) kg = P.in[1] + (size_t)(2 * L) * 2048 + 1024 + kt * 64; }
        else if (r < T6) { r -= T5; const int L = r / 88, q = r % 88, kt = q / 2, nt = q % 2;
            src = P.in[8] + (size_t)L * 2816 * 1024 + (size_t)(kt * 64) * 1024 + nt * 512; src_ld = 1024;
            wsb = WS_W_FDN + (size_t)L * 1024 * 2816 * 2; eo = (size_t)(nt * 512) * 2816 + kt * 64; dst_ld = 2816; f8mul = ((F8_FFN >> L) & 1) ? 64.f : 0.f; }
        else if (r < T7) { r -= T6; const int L = r / 224, q = r % 224, kt = q / 14, nt = q % 14;
            src = P.in[10] + (size_t)L * 1024 * 7168 + (size_t)(kt * 64) * 7168 + nt * 256; src1 = src + ED; src_ld = 7168;
            wsb = WS_W_MGU + (size_t)(L >> 3) * 8 * 7168 * 1024 * 2; eo = ((size_t)(L & 7) * 7168 + nt * 512) * 1024 + kt * 64; dst_ld = 1024; f8mul = ((F8_MOE >> (L >> 3)) & 1) ? 32.f : 0.f; }
        else { r -= T7; const int L = r / 112, q = r % 112, kt = q / 2, nt = q % 2;
            src = P.in[11] + (size_t)L * 3584 * 1024 + (size_t)(kt * 64) * 1024 + nt * 512; src_ld = 1024;
            wsb = WS_W_MDN + (size_t)(L >> 3) * 8 * 1024 * 3584 * 2; eo = ((size_t)(L & 7) * 1024 + nt * 512) * 3584 + kt * 64; dst_ld = 3584; f8mul = ((F8_MOE >> (L >> 3)) & 1) ? 64.f : 0.f; }
        prep_wg_tile(src, src1, src_ld, P.ws + wsb + eo * (f8mul != 0.f ? 1 : 2), dst_ld, f8mul, kg, t, tid);
    }
    const int gid = blockIdx.x * NTHR + tid;
    if (gid < 4096 * 32) { const int pos = gid >> 5, i = gid & 31; const float inv = powf(10000.f, -(float)(2 * i) / 64.f); float s, c; sincosf((float)pos * inv, &s, &c);
        ((f32x2*)(P.ws + WS_ROPE1))[gid] = (f32x2){c, s}; }
    if (gid < 64 * 16) { const int pos = gid >> 4, i = gid & 15; const float inv = powf(10000.f, -(float)(2 * i) / 32.f); float s, c; sincosf((float)pos * inv, &s, &c);
        ((f32x2*)(P.ws + WS_ROPEA))[gid] = (f32x2){c, s}; }
}

template <bool COMBINE, bool ROUTER, bool HF8>
DI void phase_norm(const float* xin, float* xout, const bf16_t* ybuf, const float* gain, bf16_t* H, const float* wrt, int* topi, float* topw, int* cnt, int* perm,
                   LAS unsigned char* lds, int tid) {
    const int wave = tid >> 6, lane = tid & 63, w = blockIdx.x;
    LAS float* wrl = (LAS float*)(lds + LDS_SCR);
    LAS int* cntl = (LAS int*)(lds + LDS_SCR + 32768);
    if (ROUTER) {
        for (int i = tid; i < 8192; i += NTHR) wrl[(i & 7) * 1024 + (i >> 3)] = wrt[i];
        if (tid < 8) cntl[tid] = 0;
        for (int i = tid; i < MROWS / NWG; i += NTHR) perm[w * (MROWS / NWG) + i] = -1;
        __syncthreads();
    }
    f32x4 g[4];
#pragma unroll
    for (int q = 0; q < 4; ++q) g[q] = *(const f32x4*)(gain + 256 * q + 4 * lane);
    for (int j = 0; j < 16; ++j) {
        const int row = w * 128 + wave * 16 + j; const size_t ro = (size_t)row * 1024;
        f32x4 v[4]; float ss = 0.f;
#pragma unroll
        for (int q = 0; q < 4; ++q) { v[q] = *(const f32x4*)(xin + ro + 256 * q + 4 * lane);
            if (COMBINE) { const u32x2 a = *(const u32x2*)(ybuf + ro + 256 * q + 4 * lane), b = *(const u32x2*)(ybuf + (size_t)NTOK * 1024 + ro + 256 * q + 4 * lane);
                v[q][0] += bflo(a.x) + bflo(b.x); v[q][1] += bfhi(a.x) + bfhi(b.x); v[q][2] += bflo(a.y) + bflo(b.y); v[q][3] += bfhi(a.y) + bfhi(b.y);
                *(f32x4*)(xout + ro + 256 * q + 4 * lane) = v[q]; }
            ss += (v[q][0] * v[q][0] + v[q][1] * v[q][1]) + (v[q][2] * v[q][2] + v[q][3] * v[q][3]); }
        const float rstd = 1.f / sqrtf(wave_sum(ss) * (1.f / 1024.f) + EPS);
#pragma unroll
        for (int q = 0; q < 4; ++q) { v[q] = v[q] * rstd * g[q];
            if constexpr (HF8) { int w = 0; w = __builtin_amdgcn_cvt_pk_fp8_f32(v[q][0], v[q][1], w, false); w = __builtin_amdgcn_cvt_pk_fp8_f32(v[q][2], v[q][3], w, true);
                *(int*)((unsigned char*)H + ro + 256 * q + 4 * lane) = w; }
            else { u32x2 o; o.x = pk2(v[q][0], v[q][1]); o.y = pk2(v[q][2], v[q][3]); *(u32x2*)(H + ro + 256 * q + 4 * lane) = o; } }
        if (ROUTER) {
            float lg[8];
#pragma unroll
            for (int e = 0; e < 8; ++e) { float a = 0.f;
#pragma unroll
                for (int q = 0; q < 4; ++q) { const f32x4 wv = *(const LAS f32x4*)(wrl + e * 1024 + 256 * q + 4 * lane); a += (v[q][0] * wv[0] + v[q][1] * wv[1]) + (v[q][2] * wv[2] + v[q][3] * wv[3]); }
                lg[e] = wave_sum(a); }
            float v0 = -3.0e38f; int e0 = 0;
#pragma unroll
            for (int e = 0; e < 8; ++e) if (lg[e] > v0) { v0 = lg[e]; e0 = e; }
            float v1 = -3.0e38f; int e1 = 0;
#pragma unroll
            for (int e = 0; e < 8; ++e) if (e != e0 && lg[e] > v1) { v1 = lg[e]; e1 = e; }
            if (lane == 0) { const float t = __expf(v1 - v0), w0 = 1.f / (1.f + t);
                topi[row * 2] = e0; topi[row * 2 + 1] = e1; topw[row * 2] = w0; topw[row * 2 + 1] = t * w0;
                atomicAdd((int*)(cntl + e0), 1); atomicAdd((int*)(cntl + e1), 1); }
        }
    }
    if (ROUTER) { __syncthreads(); if (tid < 8) cnt[w * 8 + tid] = cntl[tid]; }
}

DI void moe_totals(const int* cnt, volatile LAS int* misc, int tid) {
    const int e = tid >> 6, lane = tid & 63, w = blockIdx.x;
    int c[4]; int s4 = 0;
#pragma unroll
    for (int i = 0; i < 4; ++i) { c[i] = cnt[(4 * lane + i) * 8 + e]; s4 += c[i]; }
    int x = s4;
#pragma unroll
    for (int o = 1; o < 64; o <<= 1) { const int y = shup(x, o); if (lane >= o) x += y; }
    const int total = shidx(x, 63);
    int p = x - s4;
#pragma unroll
    for (int i = 0; i < 3; ++i) if (i < (w & 3)) p += c[i];
    p = shidx(p, w >> 2);
    if (lane == 0) { misc[e] = total; misc[8 + e] = p; }
    __syncthreads();
}

template <bool F8>
DI void phase_scatter(const int* cnt, const int* topi, const float* topw, const bf16_t* H, bf16_t* XS, int* perm, float* rgate, LAS unsigned char* lds, int tid) {
    const int wave = tid >> 6, lane = tid & 63, w = blockIdx.x;
    volatile LAS int* misc = (volatile LAS int*)(lds + LDS_MISC + 64);
    LAS int* posl = (LAS int*)(lds + LDS_SCR);
    moe_totals(cnt, misc, tid);
    { const int e = wave; int base = 0;
        for (int k = 0; k < e; ++k) base += ((misc[k] + 255) >> 8) << 8;
        int running = base + misc[8 + e];
        for (int pss = 0; pss < 2; ++pss) { const int j = 64 * pss + lane, tok = w * 128 + j;
            const int a0 = topi[tok * 2], a1 = topi[tok * 2 + 1]; const bool f0 = a0 == e, f1 = a1 == e, has = f0 || f1;
            const unsigned long long mask = __ballot(has); const int rank = __popcll(mask & ((1ull << lane) - 1ull));
            if (has) { const int pos = running + rank, slot = f1 ? 1 : 0; perm[pos] = tok * 2 + slot; rgate[pos] = topw[tok * 2 + slot]; posl[j * 2 + slot] = pos; }
            running += __popcll(mask); }
    }
    __syncthreads();
    for (int i = 0; i < 32; ++i) { const int pr = wave * 32 + i, pos = posl[pr], tok = w * 128 + (pr >> 1);
        if constexpr (F8) { *((u32x4*)((unsigned char*)XS + (size_t)pos * 1024) + lane) = *((const u32x4*)((const unsigned char*)H + (size_t)tok * 1024) + lane); }
        else { const u32x4* s = (const u32x4*)(H + (size_t)tok * 1024) + lane; u32x4* d = (u32x4*)(XS + (size_t)pos * 1024) + lane;
            const u32x4 a = s[0], b = s[64]; d[0] = a; d[64] = b; } }
}

DI void phase_final(const float* x, const bf16_t* ybuf, float* out, int tid) {
    const size_t n4 = (size_t)NTOK * 1024 / 4;
    for (size_t i = (size_t)blockIdx.x * NTHR + tid; i < n4; i += (size_t)gridDim.x * NTHR) {
        f32x4 v = ((const f32x4*)x)[i]; const u32x2 a = ((const u32x2*)ybuf)[i], b = ((const u32x2*)(ybuf + (size_t)NTOK * 1024))[i];
        v[0] += bflo(a.x) + bflo(b.x); v[1] += bfhi(a.x) + bfhi(b.x); v[2] += bflo(a.y) + bflo(b.y); v[3] += bfhi(a.y) + bfhi(b.y);
        ((f32x4*)out)[i] = v; }
}

struct QKRaw { u32x2 w[4]; };
DI void qk_load(QKRaw& R, const bf16_t* rowp, int lane, bool active) {
    const bf16_t* hp = rowp + (active ? (lane >> 2) * 64 + 4 * (lane & 3) : 0);
#pragma unroll
    for (int m = 0; m < 4; ++m) R.w[m] = *(const u32x2*)(hp + 16 * m);
}
DI void qk_finish(const QKRaw& R, bf16_t* rowp, int nh0, int nh1, const LAS float* gl  , int which, float scale, const LAS f32x2* r1l  , const LAS f32x2* ral  ,
                  int sl  , int s, int lane, bool active) {
    const int head = lane >> 2, q = lane & 3;
    const int br = head < nh0 ? 0 : (head < nh0 + nh1 ? 1 : 2);
    float v[4][4], ss = 0.f;
#pragma unroll
    for (int m = 0; m < 4; ++m) { const u32x2 w = R.w[m]; v[m][0] = bflo(w.x); v[m][1] = bfhi(w.x); v[m][2] = bflo(w.y); v[m][3] = bfhi(w.y);
        ss += (v[m][0] * v[m][0] + v[m][1] * v[m][1]) + (v[m][2] * v[m][2] + v[m][3] * v[m][3]); }
    ss += shx(ss, 1); ss += shx(ss, 2);
    const float rstd = 1.f / sqrtf(ss * (1.f / 64.f) + EPS);
    const LAS float* gp = gl + (br * 2 + which) * 64 + 4 * q;
    float o[4][4];
    f32x4 cs[4][2];
#pragma unroll
    for (int m = 0; m < 4; ++m) { const f32x4 g4 = *(const LAS f32x4*)(gp + 16 * m);
#pragma unroll
        for (int j = 0; j < 4; ++j) v[m][j] = v[m][j] * rstd * g4[j];
        const LAS f32x2* tp = (br == 2) ? r1l + sl * 32 + (m & 1) * 16 + 4 * q : ral + ((m < 2) ? (s >> 6) : (s & 63)) * 16 + 4 * q;
        cs[m][0] = *(const LAS f32x4*)tp; cs[m][1] = *(const LAS f32x4*)(tp + 2); }
#pragma unroll
    for (int m = 0; m < 4; ++m) { const bool first = (br == 2) ? (m < 2) : ((m & 1) == 0);
#pragma unroll
        for (int j = 0; j < 4; ++j) { const float pv = (br == 2) ? v[m ^ 2][j] : v[m ^ 1][j]; const float c = cs[m][j >> 1][2 * (j & 1)], sn = cs[m][j >> 1][2 * (j & 1) + 1];
            const float rot = first ? v[m][j] * c - pv * sn : v[m][j] * c + pv * sn;
            o[m][j] = ((br == 0) ? v[m][j] : rot) * scale; } }
    if (active) { bf16_t* hp = rowp + head * 64 + 4 * q;
#pragma unroll
        for (int m = 0; m < 4; ++m) { u32x2 w; w.x = pk2(o[m][0], o[m][1]); w.y = pk2(o[m][2], o[m][3]); *(u32x2*)(hp + 16 * m) = w; } }
}

DI void qk_rows_wave(const Ptrs& P, const LAS float* gl, const LAS f32x2* r1l, const LAS f32x2* ral, int wave, int lane) {
    bf16_t* Kb = (bf16_t*)(P.ws + WS_K);
    const int t0 = blockIdx.x * 128 + wave * 16;
    const bool act = lane < 48;
    QKRaw a0, a1, a2, a3, b0, b1, b2, b3;
    qk_load(a0, Kb + (size_t)t0 * 768, lane, act); qk_load(a1, Kb + (size_t)(t0 + 1) * 768, lane, act); qk_load(a2, Kb + (size_t)(t0 + 2) * 768, lane, act); qk_load(a3, Kb + (size_t)(t0 + 3) * 768, lane, act);
#pragma unroll 1
    for (int j = 0; j < 16; j += 4) { const int tok = t0 + j, tn = (j + 4 < 16) ? tok + 4 : tok, s = tok & (SEQ - 1), sl = wave * 16 + j;
        qk_load(b0, Kb + (size_t)tn * 768, lane, act); qk_load(b1, Kb + (size_t)(tn + 1) * 768, lane, act); qk_load(b2, Kb + (size_t)(tn + 2) * 768, lane, act); qk_load(b3, Kb + (size_t)(tn + 3) * 768, lane, act);
        qk_finish(a0, Kb + (size_t)tok * 768, 4, 2, gl, 1, 1.0f, r1l, ral, sl, s, lane, act);
        qk_finish(a1, Kb + (size_t)(tok + 1) * 768, 4, 2, gl, 1, 1.0f, r1l, ral, sl + 1, s + 1, lane, act);
        qk_finish(a2, Kb + (size_t)(tok + 2) * 768, 4, 2, gl, 1, 1.0f, r1l, ral, sl + 2, s + 2, lane, act);
        qk_finish(a3, Kb + (size_t)(tok + 3) * 768, 4, 2, gl, 1, 1.0f, r1l, ral, sl + 3, s + 3, lane, act);
        a0 = b0; a1 = b1; a2 = b2; a3 = b3; }
}
DI void v_units_wave(const Ptrs& P, LAS unsigned* L, int gw, int NGW, int lane) {
    const bf16_t* V = (const bf16_t*)(P.ws + WS_VRAW); bf16_t* Vt = (bf16_t*)(P.ws + WS_VT);
    u32x4 rw[8];
    { const int tt = gw / 12, hv = gw % 12; const bf16_t* src = V + (size_t)(tt * 64 + lane) * 768 + hv * 64;
#pragma unroll
      for (int c = 0; c < 8; ++c) rw[c] = *(const u32x4*)(src + c * 8); }
#pragma unroll 1
    for (int un = gw; un < 512 * 12; un += NGW) { const int tt = un / 12, hv = un % 12, tok0 = tt * 64, b = tok0 >> 12, s0 = tok0 & (SEQ - 1);
        const int g = hv < 6 ? 0 : ((hv - 6) >> 1), sh = 2 * g, dd = 1 << sh, Sd = SEQ >> sh, run = 64 >> sh;
        const int pos = (lane & (dd - 1)) * run + (lane >> sh);
#pragma unroll
        for (int c = 0; c < 8; ++c) { L[(4 * c + 0) * 68 + pos] = rw[c].x; L[(4 * c + 1) * 68 + pos] = rw[c].y; L[(4 * c + 2) * 68 + pos] = rw[c].z; L[(4 * c + 3) * 68 + pos] = rw[c].w; }
        { const int un2 = (un + NGW < 512 * 12) ? un + NGW : un; const int tt2 = un2 / 12, hv2 = un2 % 12; const bf16_t* src = V + (size_t)(tt2 * 64 + lane) * 768 + hv2 * 64;
#pragma unroll
          for (int c = 0; c < 8; ++c) rw[c] = *(const u32x4*)(src + c * 8); }
        LDS_WAIT();
        const int ch = lane & 7, p = 8 * ch;
        const size_t g1 = (size_t)(p >> (6 - sh)) * Sd + (s0 >> sh) + (p & (run - 1)), g2 = (size_t)((p + 4) >> (6 - sh)) * Sd + (s0 >> sh) + ((p + 4) & (run - 1));
#pragma unroll
        for (int i = 0; i < 8; ++i) { const int d = 8 * i + (lane >> 3), k = d >> 1;
            const u32x4 wa = *(const LAS u32x4*)(L + k * 68 + p), wb = *(const LAS u32x4*)(L + k * 68 + p + 4);
            const unsigned sel = (d & 1) ? 0x07060302u : 0x05040100u;
            u32x4 o; o.x = __builtin_amdgcn_perm(wa.y, wa.x, sel); o.y = __builtin_amdgcn_perm(wa.w, wa.z, sel); o.z = __builtin_amdgcn_perm(wb.y, wb.x, sel); o.w = __builtin_amdgcn_perm(wb.w, wb.z, sel);
            bf16_t* drow = Vt + ((size_t)(b * 12 + hv) * 64 + d) * SEQ;
            if (run >= 8) *(u32x4*)(drow + g1) = o;
            else { u32x2 t; t.x = o.x; t.y = o.y; *(u32x2*)(drow + g1) = t; t.x = o.z; t.y = o.w; *(u32x2*)(drow + g2) = t; } }
        LDS_WAIT();
    }
}
DI void phase_qkvprep(const Ptrs& P, int layer, LAS unsigned char* lds, int tid) {
    const int wave = tid >> 6, lane = tid & 63, gw = blockIdx.x * 8 + wave, NGW = gridDim.x * 8;
    LAS f32x4* r1l4 = (LAS f32x4*)(lds + LDS_SCR); LAS f32x4* ral4 = (LAS f32x4*)(lds + LDS_SCR + 32768); LAS float* gl = (LAS float*)(lds + LDS_SCR + 40960);
    const int s0 = (blockIdx.x * 128) & (SEQ - 1);
    const f32x4* r1g = (const f32x4*)(P.ws + WS_ROPE1) + (size_t)s0 * 16; const f32x4* rag = (const f32x4*)(P.ws + WS_ROPEA);
    for (int i = tid; i < 128 * 16; i += NTHR) r1l4[i] = r1g[i];
    for (int i = tid; i < 64 * 8; i += NTHR) ral4[i] = rag[i];
    if (tid < 384) gl[tid] = (P.in[3] + (size_t)layer * 384)[tid];
    __syncthreads();
    const LAS f32x2* r1l = (const LAS f32x2*)(lds + LDS_SCR); const LAS f32x2* ral = (const LAS f32x2*)(lds + LDS_SCR + 32768);
    LAS unsigned* L = (LAS unsigned*)(lds + LDS_SCR + 49152 + wave * 8704);
    if (wave < 4) { qk_rows_wave(P, gl, r1l, ral, wave, lane); v_units_wave(P, L, gw, NGW, lane); }
    else { v_units_wave(P, L, gw, NGW, lane); qk_rows_wave(P, gl, r1l, ral, wave, lane); }
}

#define XB_TMO      128
#define XB_XCNT(j)  (256  + 64 * (j))
#define XB_XSUB(j)  (1280 + 64 * (j))
#define XB_XGEN(j)  (2304 + 64 * (j))
#define XB_TOP      3328
#define XB_TOPGEN   3392
#define XCD_BAR_WORDS 3456
#define XB_SPIN_CAP (1u << 18)

__device__ __forceinline__ unsigned xb_ld(unsigned* p)              { return __hip_atomic_load(p, __ATOMIC_RELAXED, __HIP_MEMORY_SCOPE_AGENT); }
__device__ __forceinline__ unsigned xb_add(unsigned* p, unsigned v) { return __hip_atomic_fetch_add(p, v, __ATOMIC_RELAXED, __HIP_MEMORY_SCOPE_AGENT); }
__device__ __forceinline__ unsigned xb_xcc_id() { return (unsigned)__builtin_amdgcn_s_getreg((3 << 11) | 20) & 0xFu; }
#define XB_SPIN(cond, bar) do { unsigned _sp = 0; while (cond) { __builtin_amdgcn_s_sleep(1); \
    if ((++_sp & 255u) == 0u) { if (xb_ld(&(bar)[XB_TMO])) break; if (_sp > XB_SPIN_CAP) { atomicAdd(&(bar)[XB_TMO], 1u); break; } } } } while (0)

struct XcdBarrier {
    unsigned* bar; unsigned x;
    volatile LAS unsigned* st;
};

__device__ __forceinline__ XcdBarrier xcd_barrier_post(unsigned* bar, volatile LAS unsigned* st, int tid) {
    XcdBarrier b; b.bar = bar; b.x = xb_xcc_id(); b.st = st;
    if (tid == 0) (void)xb_add(&bar[XB_XCNT(b.x)], 1u);
    return b;
}
__device__ __forceinline__ void xcd_barrier_complete(unsigned* bar, unsigned x, unsigned& nloc, unsigned& nx) {
    const unsigned G = gridDim.x * gridDim.y * gridDim.z;
    unsigned sum, cnt, mine, sp = 0u;
    for (;;) {
        sum = 0u; cnt = 0u; mine = 0u;
#pragma unroll
        for (unsigned j = 0; j < 16; ++j) { const unsigned c = xb_ld(&bar[XB_XCNT(j)]); sum += c; cnt += (c > 0u) ? 1u : 0u; mine = (j == x) ? c : mine; }
        if (sum == G) break;
        __builtin_amdgcn_s_sleep(1);
        if ((++sp & 255u) == 0u) { if (xb_ld(&bar[XB_TMO])) break; if (sp > XB_SPIN_CAP) { atomicAdd(&bar[XB_TMO], 1u); break; } }
    }
    nloc = mine > 0u ? mine : 1u; nx = cnt > 0u ? cnt : 1u;
}

__device__ __forceinline__ void xcd_barrier(const XcdBarrier& b, int tid) {
    asm volatile("s_waitcnt vmcnt(0)" ::: "memory");
    __syncthreads();
    if (tid == 0) {
        unsigned* bar = b.bar;
        __builtin_amdgcn_s_waitcnt(0);
        unsigned nloc = b.st[0], nx = b.st[1];
        if (nloc == 0u) { xcd_barrier_complete(bar, b.x, nloc, nx); b.st[0] = nloc; b.st[1] = nx; }
        const unsigned old = xb_add(&bar[XB_XSUB(b.x)], 1u);
        const unsigned gen = old / nloc;
        if (old + 1u == (gen + 1u) * nloc) {
            __builtin_amdgcn_fence(__ATOMIC_RELEASE, "agent");
            asm volatile("s_waitcnt vmcnt(0)" ::: "memory");
            const unsigned og = xb_add(&bar[XB_TOP], 1u);
            const unsigned tg = og / nx;
            if (og + 1u == (tg + 1u) * nx) xb_add(&bar[XB_TOPGEN], 1u);
            else XB_SPIN(xb_ld(&bar[XB_TOPGEN]) == tg, bar);
            __builtin_amdgcn_fence(__ATOMIC_ACQUIRE, "agent");
            xb_add(&bar[XB_XGEN(b.x)], 1u);
            asm volatile("s_waitcnt vmcnt(0)" ::: "memory");
        } else {
            XB_SPIN(xb_ld(&bar[XB_XGEN(b.x)]) == gen, bar);
            __builtin_amdgcn_fence(__ATOMIC_ACQUIRE, "agent");
            asm volatile("s_waitcnt vmcnt(0)" ::: "memory");
        }
    }
    __syncthreads();
}

DI f32x16 mfma32(bf16x8 a, bf16x8 b, f32x16 c) { return __builtin_amdgcn_mfma_f32_32x32x16_bf16(a, b, c, 0, 0, 0); }
DI int pi32(int r) { return (r & 19) | ((r & 4) << 1) | ((r & 8) >> 1); }
DI int keyidx(int i, int hi) { return 16 * (i >> 3) + 8 * hi + (i & 7); }
DI bf16x8 pack8(const f32x16& x, int s) { u32x4 p; p.x = pk2(x[8 * s], x[8 * s + 1]); p.y = pk2(x[8 * s + 2], x[8 * s + 3]); p.z = pk2(x[8 * s + 4], x[8 * s + 5]); p.w = pk2(x[8 * s + 6], x[8 * s + 7]); return __builtin_bit_cast(bf16x8, p); }
DI f32x16 splat16(float v) { f32x16 z;
#pragma unroll
    for (int i = 0; i < 16; ++i) z[i] = v; return z; }
DI f32x16 zero16() { float z_ = 0.f; asm volatile("" : "+v"(z_)); return splat16(z_); }
template <int BR>
DI void q_prep(bf16x8 (&qf)[4], const bf16_t* qp  , const float* gq  , int hi, int s, const f32x2* rope1, const f32x2* ropea) {
    { int z_ = 0; asm volatile("" : "+v"(z_)); gq += z_; rope1 += z_; ropea += z_; }
    float v[4][8]; float ss = 0.f;
#pragma unroll
    for (int c = 0; c < 4; ++c) { const u32x4 w = *(const u32x4*)(qp + 16 * c);
        v[c][0] = bflo(w.x); v[c][1] = bfhi(w.x); v[c][2] = bflo(w.y); v[c][3] = bfhi(w.y); v[c][4] = bflo(w.z); v[c][5] = bfhi(w.z); v[c][6] = bflo(w.w); v[c][7] = bfhi(w.w);
#pragma unroll
        for (int j = 0; j < 8; ++j) ss += v[c][j] * v[c][j]; }
    ss += shx(ss, 32);
    const float rstd = 1.f / sqrtf(ss * (1.f / 64.f) + EPS);
#pragma unroll
    for (int c = 0; c < 4; ++c) { const f32x4 g0 = *(const f32x4*)(gq + 16 * c + 8 * hi), g1 = *(const f32x4*)(gq + 16 * c + 8 * hi + 4);
#pragma unroll
        for (int j = 0; j < 4; ++j) { v[c][j] *= rstd * g0[j]; v[c][4 + j] *= rstd * g1[j]; } }
    float o[4][8];
    if (BR == 0) {
#pragma unroll
        for (int c = 0; c < 4; ++c)
#pragma unroll
            for (int j = 0; j < 8; ++j) o[c][j] = v[c][j];
    } else {
#pragma unroll
        for (int pp = 0; pp < 2; ++pp) {
            const int cl = (BR == 2) ? pp : 2 * pp, ch = (BR == 2) ? pp + 2 : 2 * pp + 1;
            const f32x2* tp = (BR == 2) ? rope1 + s * 32 + 16 * pp + 8 * hi : ropea + ((pp == 0) ? (s >> 6) : (s & 63)) * 16 + 8 * hi;
#pragma unroll
            for (int j2 = 0; j2 < 4; ++j2) { const f32x4 t = *(const f32x4*)(tp + 2 * j2);
                o[cl][2 * j2] = v[cl][2 * j2] * t[0] - v[ch][2 * j2] * t[1]; o[ch][2 * j2] = v[ch][2 * j2] * t[0] + v[cl][2 * j2] * t[1];
                o[cl][2 * j2 + 1] = v[cl][2 * j2 + 1] * t[2] - v[ch][2 * j2 + 1] * t[3]; o[ch][2 * j2 + 1] = v[ch][2 * j2 + 1] * t[2] + v[cl][2 * j2 + 1] * t[3]; } }
    }
#pragma unroll
    for (int c = 0; c < 4; ++c) { u32x4 w; w.x = pk2(o[c][0] * QSCALE, o[c][1] * QSCALE); w.y = pk2(o[c][2] * QSCALE, o[c][3] * QSCALE); w.z = pk2(o[c][4] * QSCALE, o[c][5] * QSCALE); w.w = pk2(o[c][6] * QSCALE, o[c][7] * QSCALE);
        qf[c] = __builtin_bit_cast(bf16x8, w); }
}
struct QTab { const float* qkg; const f32x2* rope1; const f32x2* ropea; };
constexpr float SM_THR = 8.f;
DI float max16x2(const f32x16& a, const f32x16& b) {
    float m0 = fmaxf(fmaxf(a[0], a[1]), a[2]), m1 = fmaxf(fmaxf(b[0], b[1]), b[2]);
#pragma unroll
    for (int i = 3; i < 15; i += 2) { m0 = fmaxf(fmaxf(m0, a[i]), a[i + 1]); m1 = fmaxf(fmaxf(m1, b[i]), b[i + 1]); }
    return fmaxf(fmaxf(m0, m1), fmaxf(a[15], b[15]));
}
#define SOFTMAX_BODY(UPD_NEGM) \
    const float mx = max16x2(s0, s1); \
    if (__any(mx > SM_THR)) {                                          \
        float delta = fmaxf(fmaxf(mx, shx(mx, 32)), 0.f); asm volatile("" : "+v"(delta));     \
        const float alpha = __builtin_amdgcn_exp2f(-delta); \
        mref += delta; l *= alpha; UPD_NEGM \
        _Pragma("unroll") for (int i = 0; i < 16; ++i) { o0[i] *= alpha; o1[i] *= alpha; s0[i] -= delta; s1[i] -= delta; } \
    } \
    float sum0 = 0.f, sum1 = 0.f; \
    _Pragma("unroll") for (int i = 0; i < 16; ++i) { s0[i] = __builtin_amdgcn_exp2f(s0[i]); s1[i] = __builtin_amdgcn_exp2f(s1[i]); sum0 += s0[i]; sum1 += s1[i]; } \
    l += sum0 + sum1;
DI void softmax_lazy(f32x16& s0, f32x16& s1, float& mref, float& l, f32x16& o0, f32x16& o1) { SOFTMAX_BODY() }
DI void softmax_lazy(f32x16& s0, f32x16& s1, float& mref, f32x16& negm, float& l, f32x16& o0, f32x16& o1) { SOFTMAX_BODY(negm = splat16(-mref);) }
DI void store_o(bf16_t* op  , const f32x16& o0, const f32x16& o1, float l) {
    const float inv = 1.f / (l + shx(l, 32));
#pragma unroll
    for (int g = 0; g < 4; ++g) { u32x2 a, b;
        a.x = pk2(o0[4 * g] * inv, o0[4 * g + 1] * inv); a.y = pk2(o0[4 * g + 2] * inv, o0[4 * g + 3] * inv);
        b.x = pk2(o1[4 * g] * inv, o1[4 * g + 1] * inv); b.y = pk2(o1[4 * g + 2] * inv, o1[4 * g + 3] * inv);
        *(u32x2*)(op + 8 * g) = a; *(u32x2*)(op + 32 + 8 * g) = b; }
}

constexpr int GQ_KB = 128 * 144, GQ_VB = 64 * 272, GQ_BUF = GQ_KB + GQ_VB;
template <bool FAST>
DI void gqa_unit(LAS unsigned char* lds, const QTab& qt, const bf16_t* Q, const bf16_t* Kb, const bf16_t* Vt, bf16_t* OB, int b, int hq, int qb, int tid) {
    const int wave = tid >> 6, lane = tid & 63, r = lane & 31, hi = lane >> 5, kvh = hq / 3;
    const int qtok = b * SEQ + qb * 256 + wave * 32 + r;
    bf16x8 qf[4];
    q_prep<1>(qf, Q + (size_t)qtok * 1024 + (4 + hq) * 64 + 8 * hi, qt.qkg + 2 * 64, hi, qtok & (SEQ - 1), qt.rope1, qt.ropea);
    const int kr0 = tid >> 3, kc0 = tid & 7, vr0 = tid >> 4, vc0 = tid & 15;
    const bf16_t* kg = Kb + (size_t)(b * SEQ + kr0) * 768 + (4 + kvh) * 64 + kc0 * 8;
    const bf16_t* vg = Vt + ((size_t)(b * 12 + 4 + kvh) * 64 + vr0) * SEQ + vc0 * 8;
    const int ksoff = kr0 * 144 + kc0 * 16, vsoff = GQ_KB + vr0 * 272 + vc0 * 16;
    u32x4 ka = *(const u32x4*)kg, kb2 = *(const u32x4*)(kg + (size_t)64 * 768), va = *(const u32x4*)vg, vb2 = *(const u32x4*)(vg + (size_t)32 * SEQ);
    *(LAS u32x4*)(lds + ksoff) = ka; *(LAS u32x4*)(lds + ksoff + 64 * 144) = kb2; *(LAS u32x4*)(lds + vsoff) = va; *(LAS u32x4*)(lds + vsoff + 32 * 272) = vb2;
    __syncthreads();
    float mref = 0.f, l = 0.f; f32x16 o0 = zero16(), o1 = zero16(), negm = zero16(), lacc = zero16();
    const u32x4 ones_u = {0x3F803F80u, 0x3F803F80u, 0x3F803F80u, 0x3F803F80u}; const bf16x8 ones = __builtin_bit_cast(bf16x8, ones_u);
    const int koff = pi32(r) * 144 + hi * 16, voff = GQ_KB + r * 272 + hi * 16;
#define GQ_LDK(dst, base) do { _Pragma("unroll") for (int c_ = 0; c_ < 4; ++c_) { dst[c_] = *(const LAS bf16x8*)((base) + c_ * 32); dst[4 + c_] = *(const LAS bf16x8*)((base) + 32 * 144 + c_ * 32); } } while (0)
#define GQ_LDV(dst, base) do { _Pragma("unroll") for (int c_ = 0; c_ < 4; ++c_) { dst[c_] = *(const LAS bf16x8*)((base) + c_ * 32); dst[4 + c_] = *(const LAS bf16x8*)((base) + 32 * 272 + c_ * 32); } } while (0)
    for (int it = 0; it < 32; ++it) {
        const int cur = it & 1;
        if (it + 1 < 32) { const bf16_t* kn = kg + (size_t)(it + 1) * 128 * 768; const bf16_t* vn = vg + (it + 1) * 128;
            ka = *(const u32x4*)kn; kb2 = *(const u32x4*)(kn + (size_t)64 * 768); va = *(const u32x4*)vn; vb2 = *(const u32x4*)(vn + (size_t)32 * SEQ); }
        const LAS unsigned char* Bc = lds + cur * GQ_BUF;
        bf16x8 kf[8], vf[8], kf2[8];
        GQ_LDK(kf, Bc + koff);
        __builtin_amdgcn_sched_barrier(0);
        f32x16 s0 = FAST ? splat16(0.f) : negm, s1 = FAST ? splat16(0.f) : negm;
#pragma unroll
        for (int c = 0; c < 4; ++c) { s0 = mfma32(kf[c], qf[c], s0); s1 = mfma32(kf[4 + c], qf[c], s1); }
        GQ_LDV(vf, Bc + voff); if constexpr (FAST) GQ_LDK(kf2, Bc + 64 * 144 + koff);
        __builtin_amdgcn_sched_barrier(0);
        if constexpr (FAST) {
#pragma unroll
            for (int i = 0; i < 16; ++i) { s0[i] = __builtin_amdgcn_exp2f(s0[i]); s1[i] = __builtin_amdgcn_exp2f(s1[i]); } }
        else softmax_lazy(s0, s1, mref, negm, l, o0, o1);
#pragma unroll
        for (int s4 = 0; s4 < 4; ++s4) { const bf16x8 pf = pack8(s4 < 2 ? s0 : s1, s4 & 1); o0 = mfma32(vf[s4], pf, o0); o1 = mfma32(vf[4 + s4], pf, o1); if constexpr (FAST) lacc = mfma32(ones, pf, lacc); }
        if constexpr (!FAST) { __builtin_amdgcn_sched_barrier(0); GQ_LDK(kf2, Bc + 64 * 144 + koff); }
        s0 = FAST ? splat16(0.f) : negm; s1 = FAST ? splat16(0.f) : negm;
#pragma unroll
        for (int c = 0; c < 4; ++c) { s0 = mfma32(kf2[c], qf[c], s0); s1 = mfma32(kf2[4 + c], qf[c], s1); }
        GQ_LDV(vf, Bc + voff + 128);
        __builtin_amdgcn_sched_barrier(0);
        if constexpr (FAST) {
#pragma unroll
            for (int i = 0; i < 16; ++i) { s0[i] = __builtin_amdgcn_exp2f(s0[i]); s1[i] = __builtin_amdgcn_exp2f(s1[i]); } }
        else softmax_lazy(s0, s1, mref, negm, l, o0, o1);
#pragma unroll
        for (int s4 = 0; s4 < 4; ++s4) { const bf16x8 pf = pack8(s4 < 2 ? s0 : s1, s4 & 1); o0 = mfma32(vf[s4], pf, o0); o1 = mfma32(vf[4 + s4], pf, o1); if constexpr (FAST) lacc = mfma32(ones, pf, lacc); }
        if (it + 1 < 32) { LAS unsigned char* Bn = lds + (cur ^ 1) * GQ_BUF;
            *(LAS u32x4*)(Bn + ksoff) = ka; *(LAS u32x4*)(Bn + ksoff + 64 * 144) = kb2; *(LAS u32x4*)(Bn + vsoff) = va; *(LAS u32x4*)(Bn + vsoff + 32 * 272) = vb2; }
        __syncthreads();
    }
#undef GQ_LDK
#undef GQ_LDV
    if constexpr (FAST) store_o(OB + (size_t)qtok * 768 + hq * 64 + 4 * hi, o0, o1, 0.5f * lacc[0]);
    else store_o(OB + (size_t)qtok * 768 + hq * 64 + 4 * hi, o0, o1, l);
}

template <int NT>
DI void gqa3_wave(LAS unsigned char* lds, const QTab& qt, const bf16_t* Q, const bf16_t* Kb, const bf16_t* Vt, bf16_t* OB, int b, int kvh, int qblk, int wave, int lane) {
    const int r = lane & 31, hi = lane >> 5;
    const int tq0 = (NT == 2) ? 2 * wave : 8 + (wave - 4), hl = tq0 >> 2, hq = 3 * kvh + hl;
    int qtok[NT]; bf16x8 qf[NT][4]; f32x16 o0[NT], o1[NT]; float l[NT];
#pragma unroll
    for (int t = 0; t < NT; ++t) { qtok[t] = b * SEQ + qblk * 128 + ((tq0 + t) & 3) * 32 + r;
        q_prep<1>(qf[t], Q + (size_t)qtok[t] * 1024 + (4 + hq) * 64 + 8 * hi, qt.qkg + 2 * 64, hi, qtok[t] & (SEQ - 1), qt.rope1, qt.ropea);
        __builtin_amdgcn_sched_barrier(0); }
#pragma unroll
    for (int t = 0; t < NT; ++t) { o0[t] = zero16(); o1[t] = zero16(); l[t] = 0.f; }
    const int st = (wave & 3) * 64 + lane;
    const bf16_t* kg = Kb + (size_t)(b * SEQ + (st >> 3)) * 768 + (4 + kvh) * 64 + (st & 7) * 8;
    const bf16_t* vg = Vt + ((size_t)(b * 12 + 4 + kvh) * 64 + (st >> 4)) * SEQ + (st & 15) * 8;
    const int ksoff = (st >> 3) * 144 + (st & 7) * 16, vsoff = GQ_KB + (st >> 4) * 272 + (st & 15) * 16;
    u32x4 kq[4], vq[4];
#define G3_GLOAD(T_) do { _Pragma("unroll") for (int i_ = 0; i_ < 4; ++i_) { kq[i_] = *(const u32x4*)(kg + (size_t)((T_) * 128 + 32 * i_) * 768); vq[i_] = *(const u32x4*)(vg + (size_t)16 * i_ * SEQ + (T_) * 128); } } while (0)
#define G3_LSTORE(B_) do { LAS unsigned char* Bn_ = lds + (B_) * GQ_BUF; _Pragma("unroll") for (int i_ = 0; i_ < 4; ++i_) { *(LAS u32x4*)(Bn_ + ksoff + 32 * i_ * 144) = kq[i_]; *(LAS u32x4*)(Bn_ + vsoff + 16 * i_ * 272) = vq[i_]; } } while (0)
    if (NT == 1) { G3_GLOAD(0); G3_LSTORE(0); }
    __syncthreads();
    const int koff = pi32(r) * 144 + hi * 16, voff = GQ_KB + r * 272 + hi * 16;
#pragma unroll 1
    for (int it = 0; it < 32; ++it) {
        const int cur = it & 1;
        if (NT == 1 && it + 1 < 32) G3_GLOAD(it + 1);
        const LAS unsigned char* Bc = lds + cur * GQ_BUF;
#pragma unroll
        for (int hf = 0; hf < 2; ++hf) {
            bf16x8 kf[8], pf[NT][4];
#pragma unroll
            for (int c = 0; c < 4; ++c) { kf[c] = *(const LAS bf16x8*)(Bc + hf * 64 * 144 + koff + c * 32); kf[4 + c] = *(const LAS bf16x8*)(Bc + hf * 64 * 144 + koff + 32 * 144 + c * 32); }
#define G3_QK(t_, s0_, s1_) do { _Pragma("unroll") for (int c = 0; c < 4; ++c) { s0_ = mfma32(kf[c], qf[t_][c], s0_); s1_ = mfma32(kf[4 + c], qf[t_][c], s1_); } } while (0)
#define G3_SM(t_, s0_, s1_) do { float sum0 = 0.f, sum1 = 0.f; \
                _Pragma("unroll") for (int i = 0; i < 16; ++i) { s0_[i] = __builtin_amdgcn_exp2f(s0_[i]); s1_[i] = __builtin_amdgcn_exp2f(s1_[i]); sum0 += s0_[i]; sum1 += s1_[i]; } \
                l[t_] += sum0 + sum1; pf[t_][0] = pack8(s0_, 0); pf[t_][1] = pack8(s0_, 1); pf[t_][2] = pack8(s1_, 0); pf[t_][3] = pack8(s1_, 1); } while (0)
#define G3_LDV() do { _Pragma("unroll") for (int c = 0; c < 4; ++c) { vf[c] = *(const LAS bf16x8*)(Bc + voff + hf * 128 + c * 32); vf[4 + c] = *(const LAS bf16x8*)(Bc + voff + hf * 128 + 32 * 272 + c * 32); } } while (0)
#define G3_PV(t_) do { _Pragma("unroll") for (int s4 = 0; s4 < 4; ++s4) { o0[t_] = mfma32(vf[s4], pf[t_][s4], o0[t_]); o1[t_] = mfma32(vf[4 + s4], pf[t_][s4], o1[t_]); } } while (0)
            bf16x8 vf[8];
            if constexpr (NT == 2) {
                f32x16 sa0 = splat16(0.f), sa1 = splat16(0.f), sb0 = splat16(0.f), sb1 = splat16(0.f);
                bf16x8 vh[4];
#define G3_HSM(t_, s_, j_) do { float sum_ = 0.f; _Pragma("unroll") for (int i = 0; i < 16; ++i) { s_[i] = __builtin_amdgcn_exp2f(s_[i]); sum_ += s_[i]; } \
                l[t_] += sum_; pf[t_][2 * (j_)] = pack8(s_, 0); pf[t_][2 * (j_) + 1] = pack8(s_, 1); } while (0)
#define G3_FENCE() __builtin_amdgcn_sched_barrier(0)
#define G3_PIN(x_) asm volatile("" : "+v"(x_))
                G3_QK(0, sa0, sa1);
                G3_PIN(sa0); G3_PIN(sa1); G3_FENCE();
                G3_HSM(0, sa0, 0); _Pragma("unroll") for (int c = 0; c < 4; ++c) sb0 = mfma32(kf[c], qf[1][c], sb0);
                G3_PIN(sb0); G3_PIN(pf[0][0]); G3_PIN(pf[0][1]); G3_PIN(l[0]); G3_FENCE();
                G3_HSM(0, sa1, 1); _Pragma("unroll") for (int c = 0; c < 4; ++c) sb1 = mfma32(kf[4 + c], qf[1][c], sb1);
                G3_PIN(sb1); G3_PIN(pf[0][2]); G3_PIN(pf[0][3]); G3_PIN(l[0]); G3_FENCE();
                _Pragma("unroll") for (int c = 0; c < 4; ++c) vf[c] = *(const LAS bf16x8*)(Bc + voff + hf * 128 + c * 32);
                G3_HSM(1, sb0, 0); _Pragma("unroll") for (int s4 = 0; s4 < 4; ++s4) o0[0] = mfma32(vf[s4], pf[0][s4], o0[0]);
                G3_PIN(o0[0]); G3_PIN(pf[1][0]); G3_PIN(pf[1][1]); G3_PIN(l[1]); G3_FENCE();
                _Pragma("unroll") for (int c = 0; c < 4; ++c) vh[c] = *(const LAS bf16x8*)(Bc + voff + hf * 128 + 32 * 272 + c * 32);
                G3_HSM(1, sb1, 1); _Pragma("unroll") for (int s4 = 0; s4 < 4; ++s4) o1[0] = mfma32(vh[s4], pf[0][s4], o1[0]);
                G3_PIN(o1[0]); G3_PIN(pf[1][2]); G3_PIN(pf[1][3]); G3_PIN(l[1]); G3_FENCE();
                _Pragma("unroll") for (int s4 = 0; s4 < 4; ++s4) { o0[1] = mfma32(vf[s4], pf[1][s4], o0[1]); o1[1] = mfma32(vh[s4], pf[1][s4], o1[1]); }
                G3_PIN(o0[1]); G3_PIN(o1[1]); G3_FENCE();
#undef G3_PIN
#undef G3_HSM
#undef G3_FENCE
            } else {
                f32x16 sa0 = splat16(0.f), sa1 = splat16(0.f);
                G3_QK(0, sa0, sa1); G3_SM(0, sa0, sa1); G3_LDV(); G3_PV(0);
            }
#undef G3_QK
#undef G3_SM
#undef G3_LDV
#undef G3_PV
        }
        if (NT == 1 && it + 1 < 32) G3_LSTORE(cur ^ 1);
        __syncthreads();
    }
#undef G3_GLOAD
#undef G3_LSTORE
    { const int ln = lane_v(), r2 = ln & 31, hi2 = ln >> 5;
#pragma unroll
      for (int t = 0; t < NT; ++t) store_o(OB + (size_t)(b * SEQ + qblk * 128 + ((tq0 + t) & 3) * 32 + r2) * 768 + hq * 64 + 4 * hi2, o0[t], o1[t], l[t]); }
}

struct WTile { u32x4 k[4], v[4]; };
DI void wt_store(LAS unsigned char* wl, const WTile& T, int lane) {
#pragma unroll
    for (int i = 0; i < 4; ++i) { const int kr = 8 * i + (lane >> 3), vr = 16 * i + (lane >> 2);
        *(LAS u32x4*)(wl + kr * 128 + (((lane & 7) ^ ((kr >> 1) & 7)) << 4)) = T.k[i];
        *(LAS u32x4*)(wl + 4096 + vr * 64 + (((lane & 3) ^ ((vr >> 2) & 3)) << 4)) = T.v[i]; }
}
DI void wt_ldk(bf16x8 (&kf)[4], const LAS unsigned char* wl, int pr, int hi) {
#pragma unroll
    for (int c = 0; c < 4; ++c) kf[c] = *(const LAS bf16x8*)(wl + pr * 128 + (((2 * c + hi) ^ ((pr >> 1) & 7)) << 4));
}
DI void wt_ldv(bf16x8 (&vf)[4], const LAS unsigned char* wl, int r, int hi) {
#pragma unroll
    for (int dt = 0; dt < 2; ++dt)
#pragma unroll
        for (int sk = 0; sk < 2; ++sk) { const int row = 32 * dt + r; vf[2 * dt + sk] = *(const LAS bf16x8*)(wl + 4096 + row * 64 + (((2 * sk + hi) ^ ((row >> 2) & 3)) << 4)); }
}
DI void softmax_lazy1(f32x16& s, float& mref, float& l, f32x16& o0, f32x16& o1) {
    float mx = fmaxf(fmaxf(s[0], s[1]), s[2]);
#pragma unroll
    for (int i = 3; i < 15; i += 2) mx = fmaxf(fmaxf(mx, s[i]), s[i + 1]);
    mx = fmaxf(mx, s[15]);
    if (__any(mx > SM_THR)) {
        float delta = fmaxf(fmaxf(mx, shx(mx, 32)), 0.f); asm volatile("" : "+v"(delta));
        const float alpha = __builtin_amdgcn_exp2f(-delta);
        mref += delta; l *= alpha;
#pragma unroll
        for (int i = 0; i < 16; ++i) { o0[i] *= alpha; o1[i] *= alpha; s[i] -= delta; }
    }
    float sum = 0.f;
#pragma unroll
    for (int i = 0; i < 16; ++i) { s[i] = __builtin_amdgcn_exp2f(s[i]); sum += s[i]; }
    l += sum;
}
DI void pv_step(f32x16& o0, f32x16& o1, const f32x16& p, const bf16x8 (&vf)[4]) {
    const bf16x8 p0 = pack8(p, 0), p1 = pack8(p, 1);
    o0 = mfma32(vf[0], p0, o0); o1 = mfma32(vf[2], p0, o1); o0 = mfma32(vf[1], p1, o0); o1 = mfma32(vf[3], p1, o1);
}

DI void na_unit(LAS unsigned char* wl, const QTab& qt, const LAS float* biasl, const bf16_t* Q, const bf16_t* Kb, const bf16_t* Vt, bf16_t* OA, int b, int rp, int h, int a, int lane) {
    const int r = lane & 31, hi = lane >> 5, pr = pi32(r);
    const int grow = 2 * rp + (r >> 4), qcol = 16 * a + (r & 15), qtok = b * SEQ + grow * 64 + qcol;
    bf16x8 qf[4];
    q_prep<0>(qf, Q + (size_t)qtok * 1024 + h * 64 + 8 * hi, qt.qkg, hi, 0, qt.rope1, qt.ropea);
    const int rs = min(max(grow - 4, 0), 56), cs = min(max(qcol - 8, 0), 48);
    const int krs = min(max(2 * rp - 4, 0), 56), nk = min(max(2 * rp - 3, 0), 56) + 8 - krs, kc0 = min(max(16 * a - 8, 0), 32);
    const bf16_t* kp = Kb + (size_t)(b * SEQ + krs * 64 + kc0 + (lane >> 3)) * 768 + h * 64 + (lane & 7) * 8;
    const bf16_t* vp = Vt + ((size_t)(b * 12 + h) * 64 + (lane >> 2)) * SEQ + krs * 64 + kc0 + (lane & 3) * 8;
    float mref = 0.f, l = 0.f; f32x16 o0 = zero16(), o1 = zero16();
    WTile T;
#pragma unroll
    for (int i = 0; i < 4; ++i) { T.k[i] = *(const u32x4*)(kp + (size_t)8 * i * 768); T.v[i] = *(const u32x4*)(vp + (size_t)16 * i * SEQ); }
    wt_store(wl, T, lane);
#pragma unroll 1
    for (int st = 0; st < nk; ++st) {
        if (st + 1 < nk) { const int n = st + 1;
#pragma unroll
            for (int i = 0; i < 4; ++i) { T.k[i] = *(const u32x4*)(kp + (size_t)(64 * n + 8 * i) * 768); T.v[i] = *(const u32x4*)(vp + (size_t)16 * i * SEQ + 64 * n); } }
        bf16x8 kf[4], vf[4];
        wt_ldk(kf, wl, pr, hi);
        f32x16 sc = splat16(0.f);
#pragma unroll
        for (int c = 0; c < 4; ++c) sc = mfma32(kf[c], qf[c], sc);
        wt_ldv(vf, wl, r, hi);
        const int kr = krs + st; const bool rowok = (kr >= rs) && (kr < rs + 8);
        const LAS float* brow = biasl + (h * 15 + min(max(kr - grow + 7, 0), 14)) * 31 + 15 - qcol;
#pragma unroll
        for (int i = 0; i < 16; ++i) { const int c0 = kc0 + keyidx(i, hi);
            const bool v0 = rowok && (c0 >= cs) && (c0 < cs + 16);
            const float b0 = brow[v0 ? c0 : qcol];
            sc[i] = v0 ? sc[i] + (b0 - mref) : -1e30f; }
        softmax_lazy1(sc, mref, l, o0, o1);
        pv_step(o0, o1, sc, vf);
        if (st + 1 < nk) wt_store(wl, T, lane);
    }
    store_o(OA + (size_t)qtok * 768 + h * 64 + 4 * hi, o0, o1, l);
}

#define DIL_ISSUE(G_, KS_, T_) do { \
    constexpr int sh_ = 2 * (G_), Sd_ = SEQ >> sh_, dd_ = 1 << sh_; const int hk_ = 6 + 2 * (G_) + hs, rd_ = r16 & (dd_ - 1); \
    const bf16_t* kb_ = Kb + (size_t)(b * SEQ + rd_) * 768 + hk_ * 64 + (lane & 7) * 8; \
    const bf16_t* vb_ = Vt + ((size_t)(b * 12 + hk_) * 64 + (lane >> 2)) * SEQ + rd_ * Sd_ + min(max((KS_) + 8 * (lane & 3), 0), Sd_ - 8); \
    _Pragma("unroll") for (int i_ = 0; i_ < 4; ++i_) { const int ik_ = min(max((KS_) + 8 * i_ + (lane >> 3), 0), Sd_ - 1); \
        T_.k[i_] = *(const u32x4*)(kb_ + (size_t)(ik_ << sh_) * 768); T_.v[i_] = *(const u32x4*)(vb_ + (size_t)16 * i_ * SEQ); } } while (0)

template <int G>
DI void dil_group(LAS unsigned char* wl, const QTab& qt, WTile& T, const bf16_t* Q, const bf16_t* Kb, const bf16_t* Vt, int b, int hs, int r16, int ib, int qtok, int lane,
                  float& mref, float& l, f32x16& o0, f32x16& o1) {
    constexpr int sh = 2 * G, Sd = SEQ >> sh, step = 16 >> sh;
    const int r = lane & 31, hi = lane >> 5, pr = pi32(r);
    bf16x8 qf[4];
    q_prep<2>(qf, Q + (size_t)qtok * 1024 + (10 + 2 * G + hs) * 64 + 8 * hi, qt.qkg + 4 * 64, hi, qtok & (SEQ - 1), qt.rope1, qt.ropea);
    const int qd = r16 >> sh, iq = qd + step * (32 * ib + r);
    const int lo = qd + step * 32 * ib - 64, hiend = qd + step * (32 * ib + 31) + 64;
#pragma unroll 1
    for (int ks = (lo >> 5) << 5; ks <= hiend; ks += 32) {
        const bool more = ks + 32 <= hiend;
        if (more) DIL_ISSUE(G, ks + 32, T);
        else if (G < 2) { constexpr int G1 = G < 2 ? G + 1 : 2, sh1 = 2 * G1, step1 = 16 >> sh1; const int lo1 = (r16 >> sh1) + step1 * 32 * ib - 64; DIL_ISSUE(G1, (lo1 >> 5) << 5, T); }
        bf16x8 kf[4], vf[4];
        wt_ldk(kf, wl, pr, hi);
        f32x16 sc = splat16(0.f);
#pragma unroll
        for (int c = 0; c < 4; ++c) sc = mfma32(kf[c], qf[c], sc);
        wt_ldv(vf, wl, r, hi);
#pragma unroll
        for (int i = 0; i < 16; ++i) { const int a0 = ks + keyidx(i, hi);
            const bool v0 = (a0 >= 0) && (a0 < Sd) && (abs(a0 - iq) <= 64);
            sc[i] = v0 ? sc[i] - mref : -1e30f; }
        softmax_lazy1(sc, mref, l, o0, o1);
        pv_step(o0, o1, sc, vf);
        if (more || G < 2) wt_store(wl, T, lane);
    }
}
DI void dil_unit(LAS unsigned char* wl, const QTab& qt, const bf16_t* Q, const bf16_t* Kb, const bf16_t* Vt, bf16_t* OC, int b, int hs, int r16, int ib, int lane) {
    const int r = lane & 31, hi = lane >> 5;
    const int qtok = b * SEQ + r16 + 16 * (32 * ib + r);
    float mref = 0.f, l = 0.f; f32x16 o0 = zero16(), o1 = zero16();
    WTile T;
    { const int lo0 = r16 + 16 * 32 * ib - 64; DIL_ISSUE(0, (lo0 >> 5) << 5, T); wt_store(wl, T, lane); }
    dil_group<0>(wl, qt, T, Q, Kb, Vt, b, hs, r16, ib, qtok, lane, mref, l, o0, o1);
    dil_group<1>(wl, qt, T, Q, Kb, Vt, b, hs, r16, ib, qtok, lane, mref, l, o0, o1);
    dil_group<2>(wl, qt, T, Q, Kb, Vt, b, hs, r16, ib, qtok, lane, mref, l, o0, o1);
    store_o(OC + (size_t)qtok * 768 + hs * 64 + 4 * hi, o0, o1, l);
}

DI void phase_attn(const Ptrs& P, int layer, LAS unsigned char* lds, int tid) {
    const int wave = __builtin_amdgcn_readfirstlane(tid >> 6), lane = tid & 63, c = blockIdx.x;
    const bf16_t* Q = (const bf16_t*)(P.ws + WS_Q); const bf16_t* Kb = (const bf16_t*)(P.ws + WS_K); const bf16_t* Vt = (const bf16_t*)(P.ws + WS_VT);
    bf16_t* OA = (bf16_t*)(P.ws + WS_OALL); bf16_t* OB = OA + 256; bf16_t* OC = OA + 640;
    const QTab qt{P.in[3] + (size_t)layer * 384, (const f32x2*)(P.ws + WS_ROPE1), (const f32x2*)(P.ws + WS_ROPEA)};
    bool gqa_fast;
    { float gq = fabsf(qt.qkg[2 * 64 + lane]), gk = fabsf(qt.qkg[3 * 64 + lane]);
#pragma unroll
      for (int o = 1; o < 64; o <<= 1) { gq = fmaxf(gq, shx(gq, o)); gk = fmaxf(gk, shx(gk, o)); }
      gqa_fast = __builtin_amdgcn_readfirstlane((int)(64.f * QSCALE * gq * gk < 60.f)) != 0; }
    LAS float* biasl = (LAS float*)(lds + LDS_MISC + 1024);
    LAS unsigned char* wl = lds + LDS_SCR + wave * 16384;
    { const float* rpb = P.in[4] + (size_t)layer * 4 * 15 * 31;
      for (int i = tid; i < 4 * 15 * 31; i += NTHR) biasl[i] = rpb[i] * LOG2E; }
    __syncthreads();
#ifndef NO_NA
    int cx = (c & 7) * 32 + (c >> 3); asm volatile("" : "+s"(cx));
    RP(16) for (int u = 0; u < 2; ++u) na_unit(wl, qt, biasl, Q, Kb, Vt, OA, cx >> 5, cx & 31, wave >> 1, 2 * (wave & 1) + u, lane);
#endif
#ifndef NO_DIL
    RP(17) { const int w = cx * 8 + wave; dil_unit(wl, qt, Q, Kb, Vt, OC, w >> 8, (w >> 7) & 1, (w >> 3) & 15, w & 7, lane); }
    __syncthreads();
#endif
#ifndef NO_GQA
    { const int xcd = c & 7, loc = c >> 3;
      if (gqa_fast) { RP(18) for (int i = 0; i < 2; ++i) { const int j = loc + 32 * i, pair = 2 * xcd + (j >> 5), qblk = j & 31;
          if (wave < 4) gqa3_wave<2>(lds + LDS_SCR, qt, Q, Kb, Vt, OB, pair >> 1, pair & 1, qblk, wave, lane_v());
          else gqa3_wave<1>(lds + LDS_SCR, qt, Q, Kb, Vt, OB, pair >> 1, pair & 1, qblk, wave, lane_v()); } }
      else { for (int i = 0; i < 3; ++i) { const int j = loc + 32 * i, pair = 2 * xcd + j / 48, jj = j % 48;
          const int tid2 = (wave << 6) | lane_v();
          gqa_unit<false>(lds + LDS_SCR, qt, Q, Kb, Vt, OB, pair >> 1, (pair & 1) * 3 + jj / 16, jj & 15, tid2); } } }
#endif
}


__global__ void __launch_bounds__(NTHR, 2) mk_fwd(Args a) {
    extern __shared__ __attribute__((aligned(16))) unsigned char lds_raw[];
    LAS unsigned char* lds = (LAS unsigned char*)lds_raw;
    const int tid0 = threadIdx.x;
    const int wid_s = __builtin_amdgcn_readfirstlane(tid0 >> 6);
#define OTID() ({ int l_; asm volatile("v_mbcnt_lo_u32_b32 %0, -1, 0\n\tv_mbcnt_hi_u32_b32 %0, -1, %0" : "=v"(l_)); (wid_s << 6) | l_; })
    for (int i = tid0; i < 256; i += NTHR) ((LAS unsigned*)(lds + LDS_MISC))[i] = 0u;
    __syncthreads();
#define P a
#define ws (a.ws)
    const bool multi = (a.hi - a.lo) > 1;
    XcdBarrier bar; bar.bar = (unsigned*)ws + CW_BAR; bar.x = 0; bar.st = (volatile LAS unsigned*)(lds + LDS_MISC);
    if (multi) bar = xcd_barrier_post((unsigned*)ws + CW_BAR, (volatile LAS unsigned*)(lds + LDS_MISC), tid0);
#define RUN(s) (a.lo <= (s) && (s) < a.hi)

#if TSEL >= 0
    unsigned long long* tsb = (unsigned long long*)(ws + WS_CTL + 262144); int tsi = 0;
#define TSTAMP() do { if (blockIdx.x == 0 && OTID() == 0) tsb[tsi] = __builtin_amdgcn_s_memrealtime(); ++tsi; } while (0)
    TSTAMP();
#else
#define TSTAMP() do { } while (0)
#endif
#define SEAM() do { if (multi) xcd_barrier(bar, OTID()); TSTAMP(); } while (0)
#define H ((bf16_t*)(ws + WS_H))
#define YB ((bf16_t*)(ws + WS_YBUF))
#define ACT ((bf16_t*)(ws + WS_ACT))
#define XS ((bf16_t*)(ws + WS_XS))
#define topi ((int*)(ws + WS_TOPI))
#define topw ((float*)(ws + WS_TOPW))
#define perm ((int*)(ws + WS_PERM))
#define rgate ((float*)(ws + WS_RGATE))
#define cnt ((int*)(ws + WS_CNT))
#define G ((int)gridDim.x)
#define c ((int)blockIdx.x)

    if (PM(0) && RUN(0)) { RP(0) phase_prep(P, lds, OTID()); SEAM(); }

    for (int L = 0; L < DEPTH; ++L) {
        const int base = 1 + 10 * L;
        const bool moe = (L & 1) != 0;
        const float* xcur = (L == 0) ? P.in[0] : (const float*)P.out;
        const float* gains = P.in[1] + (size_t)L * 2 * 1024;
        const bool fuse1 = FUSE_NORM && (L & 1);
        const bool f8in = ((F8_IN >> L) & 1) != 0;
        if (PM(1) && RUN(base + 0) && !fuse1) {
            if (L == 2) { if (f8in) phase_norm<true, false, true>(P.out, P.out, YB, gains, H, nullptr, nullptr, nullptr, nullptr, nullptr, lds, OTID());
                          else phase_norm<true, false, false>(P.out, P.out, YB, gains, H, nullptr, nullptr, nullptr, nullptr, nullptr, lds, OTID()); }
            else { if (f8in) RP(1) phase_norm<false, false, true>(xcur, nullptr, nullptr, gains, H, nullptr, nullptr, nullptr, nullptr, nullptr, lds, OTID());
                   else RP(1) phase_norm<false, false, false>(xcur, nullptr, nullptr, gains, H, nullptr, nullptr, nullptr, nullptr, nullptr, lds, OTID()); }
            SEAM(); }
        if (PM(2) && RUN(base + 1)) {
            pg8::Gemm g{H, (const bf16_t*)(ws + WS_W_IN + (size_t)L * INW * 1024 * 2), f8in ? 512 : 1024, 0x7A7A7A7A}; pg8::StaticOrderR S; S.init(NTOK, INW, G, c); S.ssq = fuse1 ? (const float*)(ws + WS_SSQ) : nullptr; S.tab = (LAS float*)(lds + LDS_MISC + 1024); S.wid = wid_s;
            EpiIn E{(bf16_t*)(ws + WS_Q), (bf16_t*)(ws + WS_K), (bf16_t*)(ws + WS_VRAW), (bf16_t*)(ws + WS_G), fuse1 ? (const LAS float*)(lds + LDS_MISC + 1024) : nullptr};
            if (f8in) RP(2) pg8::gemm_phase<EpiIn, pg8::StaticOrderR, true, true, true>(lds + LDS_SCR, g, S, E, OTID());
            else RP(2) pg8::gemm_phase<EpiIn, pg8::StaticOrderR, true, true, false>(lds + LDS_SCR, g, S, E, OTID());
            SEAM(); }
        if (PM(3) && RUN(base + 2)) { phase_qkvprep(P, L, lds, OTID()); SEAM(); }
        if (PM(4) && RUN(base + 3)) { RP(4) phase_attn(P, L, lds, OTID()); SEAM(); }
        if (PM(5) && RUN(base + 4)) {
            pg8::Gemm g{(const bf16_t*)(ws + WS_OALL), (const bf16_t*)(ws + WS_W_BR) + (size_t)L * 1024 * 768, 768, 0}; pg8::StaticOrder S; S.init(NTOK, 1024, G, c);
            EpiGate E{(const unsigned char*)(ws + WS_G), (bf16_t*)(ws + WS_MERGED)};
            RP(5) pg8::gemm_phase<EpiGate, pg8::StaticOrder, true, true>(lds + LDS_SCR, g, S, E, OTID());
            SEAM(); }
        if (PM(6) && RUN(base + 5)) {
            pg8::Gemm g{(const bf16_t*)(ws + WS_MERGED), (const bf16_t*)(ws + WS_W_OUT) + (size_t)L * 1024 * 1024, 1024, 0}; pg8::StaticOrder S; S.init(NTOK, 1024, G, c);
            const bool fuse2 = FUSE_NORM && !moe;
            EpiResidN E{xcur, P.out, fuse2 ? (unsigned char*)H : nullptr, (float*)(ws + WS_SSQ), (int)((F8_FFN >> (L >> 1)) & 1)};
            pg8::gemm_phase<EpiResidN, pg8::StaticOrder, true, true>(lds + LDS_SCR, g, S, E, OTID());
            SEAM(); }
        if (!moe) {
            const int di = L >> 1; const bool f8d = ((F8_FFN >> di) & 1) != 0;
            if (PM(7) && RUN(base + 6) && !FUSE_NORM) {
                if (f8d) RP(7) phase_norm<false, false, true>(P.out, nullptr, nullptr, gains + 1024, H, nullptr, nullptr, nullptr, nullptr, nullptr, lds, OTID());
                else RP(7) phase_norm<false, false, false>(P.out, nullptr, nullptr, gains + 1024, H, nullptr, nullptr, nullptr, nullptr, nullptr, lds, OTID());
                SEAM(); }
            if (PM(8) && RUN(base + 7)) {
                pg8::StaticOrderR S; S.init(NTOK, 2 * FF, G, c); S.ssq = FUSE_NORM ? (const float*)(ws + WS_SSQ) : nullptr; S.tab = (LAS float*)(lds + LDS_MISC + 1024); S.wid = wid_s;
                if (f8d) { pg8::Gemm g{H, (const bf16_t*)(ws + WS_W_FGU + (size_t)di * 2 * FF * 1024 * 2), 512, 0x7A7A7A7A}; EpiSwiglu<true> E{(unsigned char*)ACT, FF, FUSE_NORM ? (const LAS float*)(lds + LDS_MISC + 1024) : nullptr};
                    RP(8) pg8::gemm_phase<EpiSwiglu<true>, pg8::StaticOrderR, true, true, true>(lds + LDS_SCR, g, S, E, OTID()); }
                else { pg8::Gemm g{H, (const bf16_t*)(ws + WS_W_FGU + (size_t)di * 2 * FF * 1024 * 2), 1024, 0}; EpiSwiglu<false> E{(unsigned char*)ACT, FF, FUSE_NORM ? (const LAS float*)(lds + LDS_MISC + 1024) : nullptr};
                    RP(8) pg8::gemm_phase<EpiSwiglu<false>, pg8::StaticOrderR, true, true, false>(lds + LDS_SCR, g, S, E, OTID()); }
                SEAM(); }
            if (PM(9) && RUN(base + 8)) {
                pg8::StaticOrder S; S.init(NTOK, 1024, G, c); EpiResidN E{P.out, P.out, FUSE_NORM ? (unsigned char*)H : nullptr, (float*)(ws + WS_SSQ), (int)((F8_IN >> (L + 1)) & 1)};
                if (f8d) { pg8::Gemm g{ACT, (const bf16_t*)(ws + WS_W_FDN + (size_t)di * 1024 * FF * 2), FF / 2, 0x79797979};
                    pg8::gemm_phase<EpiResidN, pg8::StaticOrder, true, true, true>(lds + LDS_SCR, g, S, E, OTID()); }
                else { pg8::Gemm g{ACT, (const bf16_t*)(ws + WS_W_FDN + (size_t)di * 1024 * FF * 2), FF, 0};
                    pg8::gemm_phase<EpiResidN, pg8::StaticOrder, true, true, false>(lds + LDS_SCR, g, S, E, OTID()); }
                SEAM(); }
        } else {
            const int li = L >> 1;
            const bool f8 = ((F8_MOE >> li) & 1) != 0;
            if (PM(10) && RUN(base + 6)) {
                if (f8) RP(10) phase_norm<false, true, true>(P.out, nullptr, nullptr, gains + 1024, H, P.in[9] + (size_t)li * 1024 * 8, topi, topw, cnt, perm, lds, OTID());
                else RP(10) phase_norm<false, true, false>(P.out, nullptr, nullptr, gains + 1024, H, P.in[9] + (size_t)li * 1024 * 8, topi, topw, cnt, perm, lds, OTID());
                SEAM(); }
            if (PM(11) && RUN(base + 7)) {
                if (f8) RP(11) phase_scatter<true>(cnt, topi, topw, H, XS, perm, rgate, lds, OTID());
                else RP(11) phase_scatter<false>(cnt, topi, topw, H, XS, perm, rgate, lds, OTID());
                SEAM(); }
            if ((PM(12) || PM(13)) && (RUN(base + 8) || RUN(base + 9))) {
                volatile LAS int* misc = (volatile LAS int*)(lds + LDS_MISC + 64);
                moe_totals(cnt, misc, OTID());
                pg8::GroupedOrder S; S.c8 = c & 7; S.loc = c >> 3; S.per = G >> 3;
                S.tp[0] = 0;
#pragma unroll
                for (int e = 0; e < 8; ++e) S.tp[e + 1] = S.tp[e] + ((__builtin_amdgcn_readfirstlane(misc[e]) + 255) >> 8);
                if (PM(12) && RUN(base + 8)) {
                    S.nN = 2 * ED / 256; S.cb = 7;
                    if (f8) { S.bstride = (long)2 * ED * 1024;
                        pg8::Gemm g{XS, (const bf16_t*)(ws + WS_W_MGU + (size_t)li * 8 * 2 * ED * 1024 * 2), 512, 0x7A7A7A7A};
                        EpiSwiglu<true> E{(unsigned char*)ACT, ED, nullptr};
                        RP(12) pg8::gemm_phase<EpiSwiglu<true>, pg8::GroupedOrder, true, true, true>(lds + LDS_SCR, g, S, E, OTID()); }
                    else { S.bstride = (long)2 * ED * 1024 * 2;
                        pg8::Gemm g{XS, (const bf16_t*)(ws + WS_W_MGU + (size_t)li * 8 * 2 * ED * 1024 * 2), 1024, 0};
                        EpiSwiglu<false> E{(unsigned char*)ACT, ED, nullptr};
                        RP(12) pg8::gemm_phase<EpiSwiglu<false>, pg8::GroupedOrder, true, true, false>(lds + LDS_SCR, g, S, E, OTID()); }
                    SEAM(); }
                if (PM(13) && RUN(base + 9)) {
                    S.nN = 4; S.cb = 4;
                    EpiMoeDown E{perm, rgate, YB};
                    if (f8) { S.bstride = (long)1024 * ED;
                        pg8::Gemm g{ACT, (const bf16_t*)(ws + WS_W_MDN + (size_t)li * 8 * 1024 * ED * 2), ED / 2, 0x79797979};
                        RP(13) pg8::gemm_phase<EpiMoeDown, pg8::GroupedOrder, true, true, true>(lds + LDS_SCR, g, S, E, OTID()); }
                    else { S.bstride = (long)1024 * ED * 2;
                        pg8::Gemm g{ACT, (const bf16_t*)(ws + WS_W_MDN + (size_t)li * 8 * 1024 * ED * 2), ED, 0};
                        RP(13) pg8::gemm_phase<EpiMoeDown, pg8::GroupedOrder, true, true, false>(lds + LDS_SCR, g, S, E, OTID()); }
                    SEAM(); }
            }
        }
    }
    if (PM(14) && RUN(41)) phase_final(P.out, YB, P.out, OTID());
#if TSEL >= 0
    xcd_barrier(bar, OTID()); TSTAMP();
    if (blockIdx.x == 0 && OTID() == 0) { asm volatile("s_waitcnt vmcnt(0)" ::: "memory"); const unsigned long long d = tsb[TSEL + 1] - tsb[TSEL]; P.out[0] += (float)d * (0.01f * 0.25f); }
#endif
#undef RUN
#undef SEAM
#undef P
#undef ws
#undef H
#undef YB
#undef ACT
#undef XS
#undef topi
#undef topw
#undef perm
#undef rgate
#undef cnt
#undef G
#undef c
}

#if MK_DEBUG
DI unsigned hsh(unsigned x) { x ^= x >> 16; x *= 0x7feb352du; x ^= x >> 15; x *= 0x846ca68bu; x ^= x >> 16; return x; }
DI void rep(unsigned* ctl, int slot, float got, float ref, float scale) { float e = fabsf(got - ref) / (fabsf(ref) + scale); if (!(e == e) || e > 1e30f) e = 1e30f; atomicMax(ctl + CW_ERR + slot, __float_as_uint(e)); }
DI float dotbf(const bf16_t* a, const bf16_t* b, int K, int lane) { float s = 0.f; for (int k = lane; k < K; k += 64) s += bf2f(a[k]) * bf2f(b[k]); return wave_sum(s); }
DI float rbf(float x) { return bflo(pk2(x, 0.f) & 0xffffu); }

__global__ void chk_prep(Args a) {
    unsigned* ctl = (unsigned*)a.ws; const unsigned h0 = hsh(blockIdx.x * 64 + threadIdx.x + 1);
    unsigned h = h0;
#define NXT() (h = hsh(h + 0x9e3779b9u))
    { const int L = NXT() % 4, n = NXT() % 5632, k = NXT() % 1024; rep(ctl, 0, bf2f(((const bf16_t*)(a.ws + WS_W_IN))[((size_t)L * 5632 + n) * 1024 + k]), rbf(a.in[2][((size_t)L * 1024 + k) * 5632 + n]), 1e-3f); }
    { const int L = NXT() % 4, n = NXT() % 1024, k = NXT() % 768; rep(ctl, 0, bf2f(((const bf16_t*)(a.ws + WS_W_BR))[((size_t)L * 1024 + n) * 768 + k]), rbf(a.in[5][((size_t)L * 768 + k) * 1024 + n]), 1e-3f); }
    { const int L = NXT() % 4, n = NXT() % 1024, k = NXT() % 1024; rep(ctl, 0, bf2f(((const bf16_t*)(a.ws + WS_W_OUT))[((size_t)L * 1024 + n) * 1024 + k]), rbf(a.in[6][((size_t)L * 1024 + k) * 1024 + n]), 1e-3f); }
    { const int L = NXT() % 2, n = NXT() % 5632, k = NXT() % 1024, pn = n >> 8, j = n & 255, cc = j < 128 ? pn * 128 + j : FF + pn * 128 + j - 128;
      rep(ctl, 0, bf2f(((const bf16_t*)(a.ws + WS_W_FGU))[((size_t)L * 5632 + n) * 1024 + k]), rbf(a.in[7][((size_t)L * 1024 + k) * 5632 + cc]), 1e-3f); }
    { const int L = NXT() % 2, n = NXT() % 1024, k = NXT() % 2816; rep(ctl, 0, bf2f(((const bf16_t*)(a.ws + WS_W_FDN))[((size_t)L * 1024 + n) * 2816 + k]), rbf(a.in[8][((size_t)L * 2816 + k) * 1024 + n]), 1e-3f); }
    { const int L = NXT() % 16, n = NXT() % 7168, k = NXT() % 1024, pn = n >> 8, j = n & 255, cc = j < 128 ? pn * 128 + j : ED + pn * 128 + j - 128;
      rep(ctl, 0, bf2f(((const bf16_t*)(a.ws + WS_W_MGU))[((size_t)L * 7168 + n) * 1024 + k]), rbf(a.in[10][((size_t)L * 1024 + k) * 7168 + cc]), 1e-3f); }
    { const int L = NXT() % 16, n = NXT() % 1024, k = NXT() % 3584; rep(ctl, 0, bf2f(((const bf16_t*)(a.ws + WS_W_MDN))[((size_t)L * 1024 + n) * 3584 + k]), rbf(a.in[11][((size_t)L * 3584 + k) * 1024 + n]), 1e-3f); }
#undef NXT
}
__global__ void chk_norm(Args a, const float* xin, const float* gain, int comb, int slot) {
    unsigned* ctl = (unsigned*)a.ws; const int lane = threadIdx.x; const int row = blockIdx.x == 0 ? 0 : (blockIdx.x == 1 ? NTOK - 1 : hsh(blockIdx.x * 7 + slot) % NTOK);
    const bf16_t* H = (const bf16_t*)(a.ws + WS_H); const bf16_t* yb = (const bf16_t*)(a.ws + WS_YBUF);
    float v[16], ss = 0.f;
    for (int j = 0; j < 16; ++j) { const int cidx = lane + 64 * j; float x = xin[(size_t)row * 1024 + cidx];
        if (comb) { x += bf2f(yb[(size_t)row * 1024 + cidx]) + bf2f(yb[((size_t)NTOK + row) * 1024 + cidx]); rep(ctl, slot, a.out[(size_t)row * 1024 + cidx], x, 1e-2f); }
        v[j] = x; ss += x * x; }
    const float rstd = 1.f / sqrtf(wave_sum(ss) / 1024.f + EPS);
    for (int j = 0; j < 16; ++j) { const int cidx = lane + 64 * j; rep(ctl, slot, bf2f(H[(size_t)row * 1024 + cidx]), v[j] * rstd * gain[cidx], 2e-2f); }
}
__global__ void chk_gemm_in(Args a, int L) {
    unsigned* ctl = (unsigned*)a.ws; const int lane = threadIdx.x; unsigned h = hsh(blockIdx.x + 77 * L + 5);
    const int row = blockIdx.x < 4 ? (blockIdx.x & 1 ? NTOK - 1 : 0) : h % NTOK; h = hsh(h + 1); const int col = blockIdx.x < 2 ? 0 : (blockIdx.x < 4 ? INW - 1 : h % INW);
    const float d = dotbf((const bf16_t*)(a.ws + WS_H) + (size_t)row * 1024, (const bf16_t*)(a.ws + WS_W_IN) + ((size_t)L * INW + col) * 1024, 1024, lane);
    float got;
    if (col < 1024) got = bf2f(((const bf16_t*)(a.ws + WS_Q))[(size_t)row * 1024 + col]);
    else if (col < 1792) got = bf2f(((const bf16_t*)(a.ws + WS_K))[(size_t)row * 768 + col - 1024]);
    else if (col < 2560) got = bf2f(((const bf16_t*)(a.ws + WS_VRAW))[(size_t)row * 768 + col - 1792]);
    else got = ((float)((const unsigned char*)(a.ws + WS_G))[(size_t)row * 3072 + col - 2560] + 0.5f) * (1.f / 256.f);
    const float ref = col < 2560 ? d : 1.f / (1.f + expf(-d));
    if (lane == 0) rep(ctl, 2, got, ref, 5e-2f);
}
__global__ void chk_qk(Args a, int L) {
    unsigned* ctl = (unsigned*)a.ws; const int j = threadIdx.x; unsigned h = hsh(blockIdx.x + 131 * L + 9);
    const int tok = blockIdx.x == 0 ? 0 : (blockIdx.x == 1 ? NTOK - 1 : h % NTOK); h = hsh(h + 1); const int isk = 1; h = hsh(h + 1); const int head = h % 12;
    const int col = (isk ? 1024 : 0) + head * 64 + j;
    const bf16_t* hr = (const bf16_t*)(a.ws + WS_H) + (size_t)tok * 1024; const bf16_t* wr = (const bf16_t*)(a.ws + WS_W_IN) + ((size_t)L * INW + col) * 1024;
    float d = 0.f; for (int k = 0; k < 1024; ++k) d += bf2f(hr[k]) * bf2f(wr[k]);
    d = rbf(d);
    const float rstd = 1.f / sqrtf(wave_sum(d * d) / 64.f + EPS);
    const int br = isk ? (head < 4 ? 0 : (head < 6 ? 1 : 2)) : (head < 4 ? 0 : (head < 10 ? 1 : 2));
    const float y = d * rstd * a.in[3][((size_t)(L * 3 + br) * 2 + isk) * 64 + j];
    const int s = tok & 4095; float o = y;
    if (br == 2) { const int i = j & 31; const float ang = (float)s * powf(10000.f, -(float)(2 * i) / 64.f); const float p = __shfl_xor(y, 32); o = j < 32 ? y * cosf(ang) - p * sinf(ang) : y * cosf(ang) + p * sinf(ang); }
    if (br == 1) { const int i = j & 15; const float pos = (float)((j < 32) ? (s >> 6) : (s & 63)); const float ang = pos * powf(10000.f, -(float)(2 * i) / 32.f); const float p = __shfl_xor(y, 16);
        o = (j & 16) == 0 ? y * cosf(ang) - p * sinf(ang) : y * cosf(ang) + p * sinf(ang); }
    if (!isk) o *= QSCALE;
    const float got = isk ? bf2f(((const bf16_t*)(a.ws + WS_K))[(size_t)tok * 768 + head * 64 + j]) : bf2f(((const bf16_t*)(a.ws + WS_Q))[(size_t)tok * 1024 + head * 64 + j]);
    rep(ctl, 3, got, o, 3e-2f);
}
__global__ void chk_vt(Args a) {
    unsigned* ctl = (unsigned*)a.ws; unsigned h = hsh(blockIdx.x * 64 + threadIdx.x + 3);
    const int b = h % 8; h = hsh(h + 1); const int hv = h % 12; h = hsh(h + 1); const int d = h % 64; h = hsh(h + 1); const int s = h % 4096;
    const int g = hv < 6 ? 0 : (hv - 6) >> 1, dd = 1 << (2 * g), Sd = 4096 / dd, pos = (s % dd) * Sd + s / dd;
    rep(ctl, 4, bf2f(((const bf16_t*)(a.ws + WS_VT))[((size_t)(b * 12 + hv) * 64 + d) * 4096 + pos]), bf2f(((const bf16_t*)(a.ws + WS_VRAW))[(size_t)(b * 4096 + s) * 768 + hv * 64 + d]), 1e-3f);
}
DI float dot64(const bf16_t* x, const bf16_t* y) { float s = 0.f; for (int k = 0; k < 64; ++k) s += bf2f(x[k]) * bf2f(y[k]); return s; }
DI float dot64q(const float* x, const bf16_t* y) { float s = 0.f; for (int k = 0; k < 64; ++k) s += x[k] * bf2f(y[k]); return s; }
DI float chk_qn(const Args& a, int L, int tok, int head, int t) {
    const float d = bf2f(((const bf16_t*)(a.ws + WS_Q))[(size_t)tok * 1024 + head * 64 + t]);
    const float rstd = 1.f / sqrtf(wave_sum(d * d) / 64.f + EPS);
    const int br = head < 4 ? 0 : (head < 10 ? 1 : 2);
    const float y = d * rstd * a.in[3][((size_t)(L * 3 + br) * 2 + 0) * 64 + t];
    const int s = tok & 4095; float o = y;
    if (br == 2) { const int i = t & 31; const float ang = (float)s * powf(10000.f, -(float)(2 * i) / 64.f); const float p = __shfl_xor(y, 32); o = t < 32 ? y * cosf(ang) - p * sinf(ang) : y * cosf(ang) + p * sinf(ang); }
    if (br == 1) { const int i = t & 15; const float pos = (float)((t < 32) ? (s >> 6) : (s & 63)); const float ang = pos * powf(10000.f, -(float)(2 * i) / 32.f); const float p = __shfl_xor(y, 16);
        o = (t & 16) == 0 ? y * cosf(ang) - p * sinf(ang) : y * cosf(ang) + p * sinf(ang); }
    return rbf(o * QSCALE);
}
__global__ void chk_na(Args a, int L) {
    __shared__ float p[128]; __shared__ float qn[64]; unsigned* ctl = (unsigned*)a.ws; const int t = threadIdx.x; unsigned h = hsh(blockIdx.x + 31 * L + 11);
    const int tok = blockIdx.x == 0 ? 0 : (blockIdx.x == 1 ? NTOK - 1 : h % NTOK); h = hsh(h + 1); const int hd = h % 4;
    const int b = tok >> 12, s = tok & 4095, gr = s >> 6, cq = s & 63, rs = min(max(gr - 4, 0), 56), cs = min(max(cq - 8, 0), 48);
    const bf16_t* Kb = (const bf16_t*)(a.ws + WS_K); const bf16_t* V = (const bf16_t*)(a.ws + WS_VRAW);
    qn[t] = chk_qn(a, L, tok, hd, t); __syncthreads();
    float mx = -1e30f;
    for (int q = 0; q < 2; ++q) { const int idx = t + 64 * q, kr = rs + idx / 16, ck = cs + idx % 16, kt = b * 4096 + kr * 64 + ck;
        const float sc = dot64q(qn, Kb + (size_t)kt * 768 + hd * 64) + LOG2E * a.in[4][(((size_t)L * 4 + hd) * 15 + (kr - gr + 7)) * 31 + (ck - cq + 15)];
        p[idx] = sc; mx = fmaxf(mx, sc); }
    for (int o = 1; o < 64; o <<= 1) mx = fmaxf(mx, __shfl_xor(mx, o));
    __syncthreads();
    float sum = 0.f, acc = 0.f;
    for (int idx = 0; idx < 128; ++idx) { const int kr = rs + idx / 16, ck = cs + idx % 16, kt = b * 4096 + kr * 64 + ck; const float e = exp2f(p[idx] - mx); sum += e; acc += e * bf2f(V[(size_t)kt * 768 + hd * 64 + t]); }
    rep(ctl, 5, bf2f(((const bf16_t*)(a.ws + WS_OALL))[(size_t)tok * 768 + hd * 64 + t]), acc / sum, 3e-2f);
}
__global__ void chk_dil(Args a, int L) {
    __shared__ float p[3][192]; __shared__ float qn[3][64]; unsigned* ctl = (unsigned*)a.ws; const int t = threadIdx.x; unsigned h = hsh(blockIdx.x + 37 * L + 13);
    const int tok = blockIdx.x == 0 ? 0 : (blockIdx.x == 1 ? NTOK - 1 : (blockIdx.x == 2 ? 4095 : (blockIdx.x == 3 ? 4096 + 70 : h % NTOK))); h = hsh(h + 1); const int hs = h & 1;
    const int b = tok >> 12, s = tok & 4095;
    const bf16_t* Kb = (const bf16_t*)(a.ws + WS_K); const bf16_t* V = (const bf16_t*)(a.ws + WS_VRAW);
    for (int g = 0; g < 3; ++g) qn[g][t] = chk_qn(a, L, tok, 10 + 2 * g + hs, t);
    __syncthreads();
    float lse[3], og[3];
    for (int g = 0; g < 3; ++g) { const int dd = 1 << (2 * g), hq = 10 + 2 * g + hs, hk = 6 + 2 * g + hs; float mx = -1e30f;
        for (int q = 0; q < 3; ++q) { const int idx = t + 64 * q; if (idx < 129) { const int pos = s + dd * (idx - 64); float sc = -1e30f;
            if (pos >= 0 && pos < 4096) sc = dot64q(qn[g], Kb + (size_t)(b * 4096 + pos) * 768 + hk * 64);
            p[g][idx] = sc; mx = fmaxf(mx, sc); } }
        for (int o = 1; o < 64; o <<= 1) mx = fmaxf(mx, __shfl_xor(mx, o));
        __syncthreads();
        float sum = 0.f, acc = 0.f;
        for (int idx = 0; idx < 129; ++idx) { const int pos = s + dd * (idx - 64); if (pos >= 0 && pos < 4096) { const float e = exp2f(p[g][idx] - mx); sum += e; acc += e * bf2f(V[(size_t)(b * 4096 + pos) * 768 + hk * 64 + t]); } }
        lse[g] = mx + log2f(sum); og[g] = acc / sum; }
    const float M = fmaxf(lse[0], fmaxf(lse[1], lse[2])); const float w0 = exp2f(lse[0] - M), w1 = exp2f(lse[1] - M), w2 = exp2f(lse[2] - M);
    rep(ctl, 6, bf2f(((const bf16_t*)(a.ws + WS_OALL))[(size_t)tok * 768 + 640 + hs * 64 + t]), (w0 * og[0] + w1 * og[1] + w2 * og[2]) / (w0 + w1 + w2), 3e-2f);
}
__global__ void chk_gqa(Args a, int L) {
    __shared__ float p[4096]; __shared__ float qn[64]; unsigned* ctl = (unsigned*)a.ws; const int t = threadIdx.x; unsigned h = hsh(blockIdx.x + 41 * L + 17);
    const int tok = blockIdx.x == 0 ? 0 : (blockIdx.x == 1 ? NTOK - 1 : h % NTOK); h = hsh(h + 1); const int hq = h % 6, kvh = hq / 3, b = tok >> 12;
    const bf16_t* Kb = (const bf16_t*)(a.ws + WS_K); const bf16_t* V = (const bf16_t*)(a.ws + WS_VRAW);
    qn[t] = chk_qn(a, L, tok, 4 + hq, t); __syncthreads();
    float mx = -1e30f;
    for (int k = t; k < 4096; k += 64) { const float sc = dot64q(qn, Kb + (size_t)(b * 4096 + k) * 768 + (4 + kvh) * 64); p[k] = sc; mx = fmaxf(mx, sc); }
    for (int o = 1; o < 64; o <<= 1) mx = fmaxf(mx, __shfl_xor(mx, o));
    __syncthreads();
    float sum = 0.f, acc = 0.f;
    for (int k = 0; k < 4096; ++k) { const float e = exp2f(p[k] - mx); sum += e; acc += e * bf2f(V[(size_t)(b * 4096 + k) * 768 + (4 + kvh) * 64 + t]); }
    rep(ctl, 7, bf2f(((const bf16_t*)(a.ws + WS_OALL))[(size_t)tok * 768 + 256 + hq * 64 + t]), acc / sum, 3e-2f);
}
__global__ void chk_gate(Args a, int L) {
    unsigned* ctl = (unsigned*)a.ws; const int lane = threadIdx.x; unsigned h = hsh(blockIdx.x + 43 * L + 19);
    const int row = blockIdx.x < 2 ? (blockIdx.x ? NTOK - 1 : 0) : h % NTOK; h = hsh(h + 1); const int col = blockIdx.x < 2 ? (blockIdx.x ? 1023 : 0) : h % 1024;
    const bf16_t* orow = (const bf16_t*)(a.ws + WS_OALL) + (size_t)row * 768; const bf16_t* wrow = (const bf16_t*)(a.ws + WS_W_BR) + ((size_t)L * 1024 + col) * 768;
    const float ya = dotbf(orow, wrow, 256, lane), yb = dotbf(orow + 256, wrow + 256, 384, lane), yc = dotbf(orow + 640, wrow + 640, 128, lane);
    const unsigned char* G = (const unsigned char*)(a.ws + WS_G) + (size_t)row * 3072;
    const float ref = (((float)G[col] + 0.5f) * ya + ((float)G[1024 + col] + 0.5f) * yb + ((float)G[2048 + col] + 0.5f) * yc) * (1.f / 256.f);
    if (lane == 0) rep(ctl, 8, bf2f(((const bf16_t*)(a.ws + WS_MERGED))[(size_t)row * 1024 + col]), ref, 5e-2f);
}
__global__ void chk_resid(Args a, const float* xold, const bf16_t* A, const bf16_t* Bt, int K, int slot) {
    unsigned* ctl = (unsigned*)a.ws; const int lane = threadIdx.x; unsigned h = hsh(blockIdx.x + 47 * slot + 23);
    const int row = blockIdx.x < 2 ? (blockIdx.x ? NTOK - 1 : 0) : h % NTOK; h = hsh(h + 1); const int col = blockIdx.x < 2 ? (blockIdx.x ? 1023 : 0) : h % 1024;
    const float d = dotbf(A + (size_t)row * K, Bt + (size_t)col * K, K, lane);
    if (lane == 0) rep(ctl, slot, a.out[(size_t)row * 1024 + col], xold[(size_t)row * 1024 + col] + d, 5e-2f);
}
__global__ void chk_router(Args a, const float* gain, const float* wr) {
    unsigned* ctl = (unsigned*)a.ws; const int lane = threadIdx.x; const int row = blockIdx.x == 0 ? 0 : (blockIdx.x == 1 ? NTOK - 1 : hsh(blockIdx.x + 29) % NTOK);
    float v[16], ss = 0.f;
    for (int j = 0; j < 16; ++j) { v[j] = a.out[(size_t)row * 1024 + lane + 64 * j]; ss += v[j] * v[j]; }
    const float rstd = 1.f / sqrtf(wave_sum(ss) / 1024.f + EPS);
    float lg[8];
    for (int e = 0; e < 8; ++e) { float s = 0.f; for (int j = 0; j < 16; ++j) { const int k = lane + 64 * j; s += v[j] * rstd * gain[k] * wr[k * 8 + e]; } lg[e] = wave_sum(s); }
    int e0 = 0; for (int e = 1; e < 8; ++e) if (lg[e] > lg[e0]) e0 = e;
    int e1 = e0 == 0 ? 1 : 0; for (int e = 0; e < 8; ++e) if (e != e0 && lg[e] > lg[e1]) e1 = e;
    float third = -1e30f; for (int e = 0; e < 8; ++e) if (e != e0 && e != e1) third = fmaxf(third, lg[e]);
    const int* topi = (const int*)(a.ws + WS_TOPI); const float* topw = (const float*)(a.ws + WS_TOPW);
    if (lane == 0) { const bool clear = (lg[e0] - lg[e1] > 1e-3f) && (lg[e1] - third > 1e-3f);
        if (clear) { rep(ctl, 13, (float)topi[row * 2], (float)e0, 1e-3f); rep(ctl, 13, (float)topi[row * 2 + 1], (float)e1, 1e-3f);
            const float t = expf(lg[e1] - lg[e0]); rep(ctl, 13, topw[row * 2], 1.f / (1.f + t), 1e-2f); rep(ctl, 13, topw[row * 2 + 1], t / (1.f + t), 1e-2f); } }
}
__global__ void chk_up(Args a, const bf16_t* A, const bf16_t* Wt, int ffd, int slot) {
    unsigned* ctl = (unsigned*)a.ws; const int lane = threadIdx.x; unsigned h = hsh(blockIdx.x + 53 * slot + 3);
    const int row = blockIdx.x < 2 ? (blockIdx.x ? NTOK - 1 : 0) : h % NTOK; h = hsh(h + 1); const int j = blockIdx.x < 2 ? (blockIdx.x ? ffd - 1 : 0) : h % ffd;
    const int pn = j >> 7, jj = j & 127;
    const float g = dotbf(A + (size_t)row * 1024, Wt + (size_t)(256 * pn + jj) * 1024, 1024, lane), u = dotbf(A + (size_t)row * 1024, Wt + (size_t)(256 * pn + 128 + jj) * 1024, 1024, lane);
    if (lane == 0) rep(ctl, slot, bf2f(((const bf16_t*)(a.ws + WS_ACT))[(size_t)row * ffd + j]), g / (1.f + expf(-g)) * u, 3e-2f);
}
__global__ void chk_scatter(Args a) {
    unsigned* ctl = (unsigned*)a.ws; const int lane = threadIdx.x; const int* cnt = (const int*)(a.ws + WS_CNT); const int* perm = (const int*)(a.ws + WS_PERM);
    const int* topi = (const int*)(a.ws + WS_TOPI); const float* topw = (const float*)(a.ws + WS_TOPW); const float* rg = (const float*)(a.ws + WS_RGATE);
    int tot[8], base[9]; base[0] = 0;
    for (int e = 0; e < 8; ++e) { int s = 0; for (int w = lane; w < 256; w += 64) s += cnt[w * 8 + e]; for (int o = 1; o < 64; o <<= 1) s += __shfl_xor(s, o); tot[e] = s; base[e + 1] = base[e] + ((s + 255) >> 8 << 8); }
    if (blockIdx.x == 0) { int sum = 0; for (int e = 0; e < 8; ++e) sum += tot[e]; if (lane == 0) rep(ctl, 14, (float)sum, 65536.f, 1e-3f);
        unsigned long long cs = 0; int nv = 0; for (int i = lane; i < MROWS; i += 64) { const int p = perm[i]; if (p >= 0) { cs += (unsigned long long)p; ++nv; } }
        for (int o = 1; o < 64; o <<= 1) { cs += __shfl_xor(cs, o); nv += __shfl_xor(nv, o); }
        if (lane == 0) { rep(ctl, 14, (float)nv, 65536.f, 1e-3f); rep(ctl, 14, (float)(cs == 65536ull * 65535ull / 2ull), 1.f, 1e-3f); } }
    const int pos = hsh(blockIdx.x + 5) % MROWS; const int p = perm[pos];
    int e = 0; for (int k = 1; k < 8; ++k) e += pos >= base[k];
    const bool inr = pos < base[e] + tot[e];
    if (lane == 0) rep(ctl, 14, (float)(p >= 0), (float)inr, 1e-3f);
    if (p >= 0 && inr) { const int tok = p >> 1, slot = p & 1;
        if (lane == 0) { rep(ctl, 14, (float)topi[tok * 2 + slot], (float)e, 1e-3f); rep(ctl, 14, rg[pos], topw[tok * 2 + slot], 1e-3f); }
        for (int j = 0; j < 16; ++j) rep(ctl, 14, bf2f(((const bf16_t*)(a.ws + WS_XS))[(size_t)pos * 1024 + lane + 64 * j]), bf2f(((const bf16_t*)(a.ws + WS_H))[(size_t)tok * 1024 + lane + 64 * j]), 1e-3f); }
}
__global__ void chk_moe(Args a, int li, int down) {
    unsigned* ctl = (unsigned*)a.ws; const int lane = threadIdx.x; const int* perm = (const int*)(a.ws + WS_PERM); const int* topi = (const int*)(a.ws + WS_TOPI); const float* rg = (const float*)(a.ws + WS_RGATE);
    unsigned h = hsh(blockIdx.x + 59 * down + 7); int pos = h % MROWS; while (perm[pos] < 0) pos = (pos + 1) % MROWS;
    const int p = perm[pos], tok = p >> 1, slot = p & 1, e = topi[tok * 2 + slot]; h = hsh(h + 1);
    if (!down) { const int j = h % ED, pn = j >> 7, jj = j & 127; const bf16_t* Wt = (const bf16_t*)(a.ws + WS_W_MGU) + (size_t)(li * 8 + e) * 2 * ED * 1024; const bf16_t* A = (const bf16_t*)(a.ws + WS_XS) + (size_t)pos * 1024;
        const float g = dotbf(A, Wt + (size_t)(256 * pn + jj) * 1024, 1024, lane), u = dotbf(A, Wt + (size_t)(256 * pn + 128 + jj) * 1024, 1024, lane);
        if (lane == 0) rep(ctl, 15, bf2f(((const bf16_t*)(a.ws + WS_ACT))[(size_t)pos * ED + j]), g / (1.f + expf(-g)) * u, 3e-2f); }
    else { const int col = h % 1024; const float d = dotbf((const bf16_t*)(a.ws + WS_ACT) + (size_t)pos * ED, (const bf16_t*)(a.ws + WS_W_MDN) + ((size_t)(li * 8 + e) * 1024 + col) * ED, ED, lane);
        if (lane == 0) rep(ctl, 16, bf2f(((const bf16_t*)(a.ws + WS_YBUF))[((size_t)slot * NTOK + tok) * 1024 + col]), rg[pos] * d, 3e-2f); }
}
__global__ void chk_final(Args a, const float* xold) {
    unsigned* ctl = (unsigned*)a.ws; const size_t i = hsh(blockIdx.x * 64 + threadIdx.x + 9) % ((size_t)NTOK * 1024); const bf16_t* yb = (const bf16_t*)(a.ws + WS_YBUF);
    rep(ctl, 18, a.out[i], xold[i] + bf2f(yb[i]) + bf2f(yb[(size_t)NTOK * 1024 + i]), 1e-2f);
}
__global__ void chk_report(Args a) {
    const unsigned* ctl = (const unsigned*)a.ws; int code = -1;
    for (int s = 18; s >= 0; --s) { const float e = __uint_as_float(ctl[CW_ERR + s]); const float tol = (s == 0 || s == 4 || s == 14) ? 1e-3f : 0.08f; if (e > tol) code = s; }
    if (code >= 0) { float v = 10.f; for (int k = 0; k < code; ++k) v *= 10.f;
        for (size_t i = (size_t)blockIdx.x * blockDim.x + threadIdx.x; i < (size_t)NTOK * 1024; i += (size_t)gridDim.x * blockDim.x) a.out[i] = v; }
}
#endif

extern "C" void kernel_launch(void* const* d_in, const int* in_sizes, int n_in, void* d_out, int out_size, void* d_ws, size_t ws_size, hipStream_t stream) {
    static int ready = 0;
    if (ready == 0) {
        ready = -1;
        if (n_in != 12 || out_size != NTOK * 1024 || ws_size < WS_END + (MK_DEBUG ? (size_t)128 * MiB : 0)) { fprintf(stderr, "kernel_launch: unexpected shapes / workspace (%d inputs, out %d, ws %zu)\n", n_in, out_size, ws_size); return; }
        if (hipFuncSetAttribute((const void*)mk_fwd, hipFuncAttributeMaxDynamicSharedMemorySize, LDS_BYTES) != hipSuccess) { fprintf(stderr, "kernel_launch: hipFuncSetAttribute failed\n"); return; }
        int per_cu = 0; (void)hipOccupancyMaxActiveBlocksPerMultiprocessor(&per_cu, (const void*)mk_fwd, NTHR, LDS_BYTES); (void)hipGetLastError();
        if (per_cu < 1) fprintf(stderr, "kernel_launch: occupancy query says %d blocks per CU\n", per_cu);
        ready = 1;
    }
    if (ready < 0) return;
    (void)hipMemsetAsync((char*)d_ws + WS_CTL, 0, CTL_ZERO_BYTES, stream);
    Args a{};
    for (int i = 0; i < 12; ++i) a.in[i] = (const float*)d_in[i];
    a.out = (float*)d_out; a.ws = (unsigned char*)d_ws;
#if !MK_DEBUG
    a.lo = 0; a.hi = 42;
    hipLaunchKernelGGL(mk_fwd, dim3(NWG), dim3(NTHR), LDS_BYTES, stream, a);
#else
    unsigned char* ws = (unsigned char*)d_ws; float* snap = (float*)(ws + WS_DBG);
    const int NS = 96;
    for (int s = 0; s < 42; ++s) {
        const int L = (s - 1) / 10, k = (s - 1) % 10; const bool moe = (L & 1) != 0;
        if (s >= 1 && s < 41 && !moe && k == 9) continue;
        const bool snapx = (s == 41) || (s >= 1 && s < 41 && ((k == 0 && L == 2) || (k == 8 && !moe) || (k == 5 && L > 0)));
        if (snapx) (void)hipMemcpyAsync(snap, d_out, (size_t)NTOK * 1024 * 4, hipMemcpyDeviceToDevice, stream);
        a.lo = s; a.hi = s + 1;
        hipLaunchKernelGGL(mk_fwd, dim3(NWG), dim3(NTHR), LDS_BYTES, stream, a);
        if (s == 0) { hipLaunchKernelGGL(chk_prep, dim3(64), dim3(64), 0, stream, a); continue; }
        if (s == 41) { hipLaunchKernelGGL(chk_final, dim3(64), dim3(64), 0, stream, a, (const float*)snap); continue; }
        const float* gains = (const float*)d_in[1] + (size_t)L * 2048; const float* xin0 = (const float*)d_in[0];
        switch (k) {
        case 0: hipLaunchKernelGGL(chk_norm, dim3(NS), dim3(64), 0, stream, a, L == 0 ? xin0 : (L == 2 ? (const float*)snap : (const float*)d_out), gains, L == 2 ? 1 : 0, L == 2 ? 17 : 1); break;
        case 1: hipLaunchKernelGGL(chk_gemm_in, dim3(NS), dim3(64), 0, stream, a, L); break;
        case 2: hipLaunchKernelGGL(chk_qk, dim3(NS), dim3(64), 0, stream, a, L); hipLaunchKernelGGL(chk_vt, dim3(NS), dim3(64), 0, stream, a); break;
        case 3: hipLaunchKernelGGL(chk_na, dim3(NS), dim3(64), 0, stream, a, L); hipLaunchKernelGGL(chk_dil, dim3(NS), dim3(64), 0, stream, a, L); hipLaunchKernelGGL(chk_gqa, dim3(32), dim3(64), 0, stream, a, L); break;
        case 4: hipLaunchKernelGGL(chk_gate, dim3(NS), dim3(64), 0, stream, a, L); break;
        case 5: hipLaunchKernelGGL(chk_resid, dim3(NS), dim3(64), 0, stream, a, L == 0 ? xin0 : (const float*)snap, (const bf16_t*)(ws + WS_MERGED), (const bf16_t*)(ws + WS_W_OUT) + (size_t)L * 1024 * 1024, 1024, 9); break;
        case 6: if (!moe) hipLaunchKernelGGL(chk_norm, dim3(NS), dim3(64), 0, stream, a, (const float*)d_out, gains + 1024, 0, 10);
                else { hipLaunchKernelGGL(chk_norm, dim3(NS), dim3(64), 0, stream, a, (const float*)d_out, gains + 1024, 0, 10);
                       hipLaunchKernelGGL(chk_router, dim3(NS), dim3(64), 0, stream, a, gains + 1024, (const float*)d_in[9] + (size_t)(L >> 1) * 8192); } break;
        case 7: if (!moe) hipLaunchKernelGGL(chk_up, dim3(NS), dim3(64), 0, stream, a, (const bf16_t*)(ws + WS_H), (const bf16_t*)(ws + WS_W_FGU) + (size_t)(L >> 1) * 2 * FF * 1024, FF, 11);
                else hipLaunchKernelGGL(chk_scatter, dim3(NS), dim3(64), 0, stream, a); break;
        case 8: if (!moe) hipLaunchKernelGGL(chk_resid, dim3(NS), dim3(64), 0, stream, a, (const float*)snap, (const bf16_t*)(ws + WS_ACT), (const bf16_t*)(ws + WS_W_FDN) + (size_t)(L >> 1) * 1024 * FF, FF, 12);
                else hipLaunchKernelGGL(chk_moe, dim3(NS), dim3(64), 0, stream, a, L >> 1, 0); break;
        case 9: hipLaunchKernelGGL(chk_moe, dim3(NS), dim3(64), 0, stream, a, L >> 1, 1); break;
        }
    }
    hipLaunchKernelGGL(chk_report, dim3(1024), dim3(256), 0, stream, a);
#endif
}
```

```cpp
#include <hip/hip_runtime.h>
#include <cstdint>
#include <cstdio>

#ifndef MK_DEBUG
#define MK_DEBUG 0
#endif

#ifndef PHM
#define PHM 0xFFFFFFFFu
#endif
#define PM(k) ((PHM >> (k)) & 1u)
#ifndef REPM
#define REPM 0u
#endif
#define RP(k) for (int rp_ = 0; rp_ <= (int)((REPM >> (k)) & 1u); ++rp_)
#ifndef F8_IN
#define F8_IN 12
#endif
#ifndef F8_FFN
#define F8_FFN 2
#endif
#ifndef F8_MOE
#define F8_MOE 3
#endif
#ifndef FUSE_NORM
#define FUSE_NORM 1
#endif
#if MK_DEBUG
#undef FUSE_NORM
#define FUSE_NORM 0
#undef F8_IN
#undef F8_FFN
#undef F8_MOE
#define F8_IN 0
#define F8_FFN 0
#define F8_MOE 0
#endif
#ifndef TSEL
#define TSEL -1
#endif
#define DI __device__ __forceinline__
#define LAS __attribute__((address_space(3)))
#define GAS __attribute__((address_space(1)))

typedef unsigned short bf16_t;
typedef short bf16x8 __attribute__((ext_vector_type(8)));
typedef float f32x2 __attribute__((ext_vector_type(2)));
typedef float f32x4 __attribute__((ext_vector_type(4)));
typedef float f32x16 __attribute__((ext_vector_type(16)));
typedef unsigned u32x2 __attribute__((ext_vector_type(2)));
typedef unsigned u32x4 __attribute__((ext_vector_type(4)));
typedef __bf16 bf16x2_t __attribute__((ext_vector_type(2)));

constexpr int NB = 8, SEQ = 4096, DM = 1024, NTOK = NB * SEQ, DEPTH = 4;
constexpr int INW = 5632, FF = 2816, ED = 3584, NE = 8;
constexpr int MROWS = 2 * NTOK + NE * 256;
constexpr float EPS = 1e-6f;
constexpr float QSCALE = 0.125f * 1.4426950408889634f;
constexpr float LOG2E = 1.4426950408889634f;
constexpr int NWG = 256, NTHR = 512;

constexpr size_t MiB = 1u << 20;
constexpr size_t WS_CTL = 0, CTL_ZERO_BYTES = 1 * MiB;
constexpr size_t WS_ROPE1 = 1 * MiB;
constexpr size_t WS_ROPEA = 2 * MiB;
constexpr size_t WS_TOPI = 3 * MiB;
constexpr size_t WS_TOPW = 3 * MiB + 512 * 1024;
constexpr size_t WS_PERM = 4 * MiB;
constexpr size_t WS_RGATE = 4 * MiB + 512 * 1024;
constexpr size_t WS_CNT = 5 * MiB;
constexpr size_t WS_SSQ = 6 * MiB;
constexpr size_t WS_W_IN = 8 * MiB;
constexpr size_t WS_W_BR = 52 * MiB;
constexpr size_t WS_W_OUT = 59 * MiB;
constexpr size_t WS_W_FGU = 67 * MiB;
constexpr size_t WS_W_FDN = 89 * MiB;
constexpr size_t WS_W_MGU = 100 * MiB;
constexpr size_t WS_W_MDN = 324 * MiB;
constexpr size_t WS_H = 436 * MiB;
constexpr size_t WS_XS = 500 * MiB;
constexpr size_t WS_YBUF = 632 * MiB;
constexpr size_t WS_Q = 760 * MiB;
constexpr size_t WS_K = 824 * MiB;
constexpr size_t WS_VRAW = 872 * MiB;
constexpr size_t WS_VT = 920 * MiB;
constexpr size_t WS_G = 968 * MiB;
constexpr size_t WS_OALL = 1160 * MiB;
constexpr size_t WS_MERGED = 1216 * MiB;
constexpr size_t WS_ACT = 760 * MiB;
constexpr size_t WS_END = 1280 * MiB;
constexpr size_t WS_DBG = 1280 * MiB;
static_assert(WS_ACT + (size_t)MROWS * ED * 2 <= WS_END, "act overlay");
static_assert(WS_W_MDN + (size_t)2 * 8 * 1024 * 3584 * 2 <= WS_H, "weights");

constexpr int CW_BAR = 4096;
constexpr int CW_ERR = 32768;

constexpr int LDS_SCR = 0, LDS_SCR_BYTES = 131072;
constexpr int LDS_MISC = 131072;
constexpr int LDS_BYTES = 131072 + 1024 + 8192;

DI unsigned pk2(float lo, float hi) { f32x2 v = {lo, hi}; bf16x2_t b = __builtin_convertvector(v, bf16x2_t); return __builtin_bit_cast(unsigned, b); }
DI float bflo(unsigned w) { return __uint_as_float(w << 16); }
DI float bfhi(unsigned w) { return __uint_as_float(w & 0xffff0000u); }
DI float bf2f(bf16_t u) { return __uint_as_float((unsigned)u << 16); }
DI int lane_v() { int l; asm volatile("v_mbcnt_lo_u32_b32 %0, -1, 0\n\tv_mbcnt_hi_u32_b32 %0, -1, %0" : "=v"(l)); return l; }
DI float shx(float v, int m) { return __builtin_bit_cast(float, __builtin_amdgcn_ds_bpermute((lane_v() ^ m) << 2, __builtin_bit_cast(int, v))); }
DI int shx(int v, int m) { return __builtin_amdgcn_ds_bpermute((lane_v() ^ m) << 2, v); }
DI int shup(int v, int o) { return __builtin_amdgcn_ds_bpermute((lane_v() - o) << 2, v); }
DI int shidx(int v, int src) { return __builtin_amdgcn_ds_bpermute(src << 2, v); }
DI float wave_sum(float v) {
#pragma unroll
    for (int o = 1; o < 64; o <<= 1) v += shx(v, o);
    return v;
}
DI float sigmoidf_(float x) { return __builtin_amdgcn_rcpf(1.f + __builtin_amdgcn_exp2f(x * -1.4426950408889634f)); }

namespace pg8 {
#define PG8_LAS __attribute__((address_space(3)))
constexpr int BM = 256, BK = 64, HALF = 128, HTB = HALF * BK * 2, STAGE_BYTES = 8 * HTB, NXCD = 8, WGM = 8;
__host__ __device__ __forceinline__ int lds_byte(int r, int c) { const int st = (r >> 4) * 2 + (c >> 5), rr = r & 15, cc = c & 31, ob = rr * 64 + cc * 2; return st * 1024 + (ob ^ (((ob >> 9) & 1) << 5)); }
__host__ __device__ __forceinline__ void stage_rc(int b, int& R, int& C) { const int st = b / 1024, sb = b % 1024, swz = sb ^ (((sb >> 9) & 1) << 5); R = (st >> 1) * 16 + swz / 64; C = (st & 1) * 32 + (swz % 64) / 2; }
__host__ __device__ __forceinline__ int perm32(int rho) { const int n = rho >> 4, i = rho & 15; return 8 * (i >> 2) + 4 * n + (i & 3); }

struct Unit { int pm, pn; long bo; int ord; };
struct Gemm { const bf16_t* A; const bf16_t* Bt; int K; int sclB; };
typedef int v4i_t __attribute__((ext_vector_type(4)));
typedef int v8i_t __attribute__((ext_vector_type(8)));
__device__ __forceinline__ void mfma_f8(f32x4& acc, v8i_t b, v8i_t a, int sclb) {
    asm volatile("v_mfma_scale_f32_16x16x128_f8f6f4 %0, %1, %2, %0, %3, %4 op_sel_hi:[0,0,0]" : "+v"(acc) : "v"(b), "v"(a), "v"(sclb), "v"(0x7F7F7F7F));
}
__device__ __forceinline__ v8i_t cat8(bf16x8 lo, bf16x8 hi) { return __builtin_shufflevector(__builtin_bit_cast(v4i_t, lo), __builtin_bit_cast(v4i_t, hi), 0, 1, 2, 3, 4, 5, 6, 7); }

struct StaticOrder {
    int nM, nN, nwg, G, c;
    __host__ __device__ void init(int M, int N, int G_, int c_) { nM = M / BM; nN = N / BM; nwg = nM * nN; G = G_; c = c_; }
    __host__ __device__ bool next(int i, Unit& u) const {
        const long L = (long)i * G + c; if (L >= nwg) return false;
        int wgid = (int)L; { const int q = nwg / NXCD, r = nwg % NXCD, xcd = wgid % NXCD, off = wgid / NXCD; wgid = (xcd < r ? xcd * (q + 1) : r * (q + 1) + (xcd - r) * q) + off; }
        const int nig = WGM * nN, gid = wgid / nig, fm = gid * WGM, gsz = (nM - fm) < WGM ? (nM - fm) : WGM;
        u.pm = fm + ((wgid % nig) % gsz); u.pn = (wgid % nig) / gsz; u.bo = 0; u.ord = i; return true;
    }
    __device__ __forceinline__ void a_ready(const Unit&) const {}
    __device__ __forceinline__ void done(const Unit&) const {}
};
struct StaticOrderR : StaticOrder {
    const float* ssq; PG8_LAS float* tab; int wid;
    __device__ __forceinline__ void a_ready(const Unit& u) const {
        if (ssq) { int t_; asm volatile("v_mbcnt_lo_u32_b32 %0, -1, 0\n\tv_mbcnt_hi_u32_b32 %0, -1, %0" : "=v"(t_)); const int w_ = wid;
            if (w_ < 4) { const int rr = w_ * 64 + t_; const f32x4* p = (const f32x4*)(ssq + (size_t)(u.pm * 256 + rr) * 16); const f32x4 a = p[0], b = p[1], c2 = p[2], d = p[3];
                const float s_ = ((a[0] + a[1]) + (a[2] + a[3])) + ((b[0] + b[1]) + (b[2] + b[3])) + ((c2[0] + c2[1]) + (c2[2] + c2[3])) + ((d[0] + d[1]) + (d[2] + d[3]));
                tab[(u.ord & 1) * 256 + rr] = 1.f / sqrtf(s_ * (1.f / 1024.f) + 1e-6f); } }
    }
};
struct GroupedOrder {
    int nN, c8, loc, per; int tp[9]; long bstride; int cb;
    __device__ __forceinline__ bool next(int i, Unit& u) const {
        const int R = (tp[8] - c8 + 7) >> 3;
        const int j = loc + per * i; if (j >= R * nN) return false;
        const int g = j / (4 * nN), w = j - g * 4 * nN, rg = min(4, R - 4 * g);
        const int blk = rg * cb, pc = w / blk, rem = w - pc * blk, col = rem / rg, row = rem - col * rg;
        const int pm = c8 + 8 * (4 * g + row);
        u.pm = pm; u.pn = pc * cb + col; u.ord = i;
        int e = 0;
#pragma unroll
        for (int k = 1; k < 8; ++k) e += (pm >= tp[k]) ? 1 : 0;
        u.bo = (long)e * bstride; return true;
    }
    __device__ __forceinline__ void a_ready(const Unit&) const {}
    __device__ __forceinline__ void done(const Unit&) const {}
};

template <class T, class = void> struct has_mid { static constexpr bool value = false; };
template <class T> struct has_mid<T, decltype((void)T::HAS_MID)> { static constexpr bool value = T::HAS_MID; };
template <class Epi, class Sched, bool ALIGN_EPI = false, bool SP2 = false, bool F8 = false>
__device__ __forceinline__ void gemm_phase(PG8_LAS unsigned char* lds, const Gemm g, const Sched& S, const Epi& E, int tid_in) {
    int tid_o = tid_in; asm volatile("" : "+v"(tid_o));
    const int tid = tid_o, wid = __builtin_amdgcn_readfirstlane(tid >> 6), lane = tid & 63, wr = wid >> 2, wc = wid & 3, fr = lane & 15, fq = lane >> 4;
    const int K = g.K, nt = K / BK;
    unsigned voffA[2], voffB[2];
#pragma unroll
    for (int i = 0; i < 2; ++i) { int R, C; stage_rc(tid * 16 + i * 8192, R, C); const int Rb = Epi::PERM ? ((R & ~31) + perm32(R & 31)) : R;
        voffA[i] = (unsigned)(R * K + C) * 2u; voffB[i] = (unsigned)(Rb * K + C) * 2u; }
    const size_t kstep = (size_t)(BK * 2);
    const size_t hstep = (size_t)HALF * K * 2;
    const size_t tstep = 2 * hstep;
    const unsigned ldsw = (unsigned)wid * 1024u;
    const int aoff = lds_byte(wr * 64 + fr, fq * 8), boff = lds_byte(wc * 32 + fr, fq * 8);
#define PG8_SA(b, h) (((b) * 2 + (h)) * HTB)
#define PG8_SB(b, h) ((4 + (b) * 2 + (h)) * HTB)
#define PG8_STAGE(bufoff, gbase, voff) do { _Pragma("unroll") for (int _i = 0; _i < 2; ++_i) \
        __builtin_amdgcn_global_load_lds((const unsigned*)((const char*)(gbase) + (voff)[_i]), (PG8_LAS unsigned*)(lds + (bufoff) + ldsw + _i * 8192), 16, 0, 0); } while (0)
#define PG8_LDA(dst, b, h) do { _Pragma("unroll") for (int m = 0; m < 4; ++m) _Pragma("unroll") for (int k = 0; k < 2; ++k) dst[m][k] = *(const PG8_LAS bf16x8*)(lds + PG8_SA(b, h) + aoff + m * 2048 + k * 1024); } while (0)
#define PG8_LDB(dst, b, h) do { _Pragma("unroll") for (int n = 0; n < 2; ++n) _Pragma("unroll") for (int k = 0; k < 2; ++k) dst[n][k] = *(const PG8_LAS bf16x8*)(lds + PG8_SB(b, h) + boff + n * 2048 + k * 1024); } while (0)
#define PG8_MMA(ai, bj, At, Bt) do { __builtin_amdgcn_s_setprio(1); _Pragma("unroll") for (int m = 0; m < 4; ++m) _Pragma("unroll") for (int n = 0; n < 2; ++n) { \
        if constexpr (F8) mfma_f8(acc[ai][bj][m][n], cat8(Bt[n][0], Bt[n][1]), cat8(At[m][0], At[m][1]), g.sclB); \
        else { _Pragma("unroll") for (int k = 0; k < 2; ++k) acc[ai][bj][m][n] = __builtin_amdgcn_mfma_f32_16x16x32_bf16(Bt[n][k], At[m][k], acc[ai][bj][m][n], 0, 0, 0); } } __builtin_amdgcn_s_setprio(0); } while (0)
#define PG8_WAIT_V(n) asm volatile("s_waitcnt vmcnt(" #n ")" ::: "memory")
#define PG8_WAIT_L(n) asm volatile("s_waitcnt lgkmcnt(" #n ")" ::: "memory")
#define PG8_BAR __builtin_amdgcn_s_barrier()
#define PG8_SCHED __builtin_amdgcn_sched_barrier(0)
    Unit cur, nxt; int ui = 0;
    if (!S.next(0, cur)) return;
    f32x4 acc[2][2][4][2];
#pragma unroll
    for (int a = 0; a < 2; ++a)
#pragma unroll
        for (int b = 0; b < 2; ++b)
#pragma unroll
            for (int m = 0; m < 4; ++m)
#pragma unroll
                for (int n = 0; n < 2; ++n) acc[a][b][m][n] = (f32x4){0.f, 0.f, 0.f, 0.f};
    bf16x8 At[4][2], B0[2][2], B1[2][2];
    const char* cA = (const char*)g.A + (size_t)cur.pm * tstep; const char* cB = (const char*)g.Bt + cur.bo + (size_t)cur.pn * tstep;
    S.a_ready(cur);
    if constexpr (SP2) {
        PG8_STAGE(PG8_SB(0, 0), cB, voffB); PG8_STAGE(PG8_SB(0, 1), cB + hstep, voffB); PG8_STAGE(PG8_SA(0, 0), cA, voffA); PG8_STAGE(PG8_SA(0, 1), cA + hstep, voffA);
        if (wr == 1) PG8_BAR;
        PG8_WAIT_V(2); PG8_BAR;
        PG8_STAGE(PG8_SB(1, 0), cB + kstep, voffB); PG8_STAGE(PG8_SA(1, 0), cA + kstep, voffA); PG8_STAGE(PG8_SB(1, 1), cB + hstep + kstep, voffB);
        PG8_WAIT_V(6); PG8_BAR;
    } else {
        PG8_STAGE(PG8_SB(0, 0), cB, voffB); PG8_STAGE(PG8_SA(0, 0), cA, voffA); PG8_STAGE(PG8_SB(0, 1), cB + hstep, voffB); PG8_STAGE(PG8_SA(0, 1), cA + hstep, voffA);
        if (wr == 1) PG8_BAR;
        PG8_WAIT_V(4); PG8_BAR;
        PG8_STAGE(PG8_SB(1, 0), cB + kstep, voffB); PG8_STAGE(PG8_SA(1, 0), cA + kstep, voffA); PG8_STAGE(PG8_SB(1, 1), cB + hstep + kstep, voffB);
        PG8_WAIT_V(6); PG8_BAR;
    }
    for (;;) {
        const bool has_next = S.next(ui + 1, nxt);
        const char* nA = has_next ? (const char*)g.A + (size_t)nxt.pm * tstep : cA; const char* nB = has_next ? (const char*)g.Bt + nxt.bo + (size_t)nxt.pn * tstep : cB;
        for (int t = 0; t < nt; t += 2) {
            if constexpr (has_mid<Epi>::value) { if (E.is_mid(t)) { if (wr == 0) PG8_BAR; E.mid(acc, cur, t, wr, wc, fr, fq); if (wr == 1) PG8_BAR; } }
            const bool last = (t == nt - 2);
            const char* a1 = cA + (size_t)(t + 1) * kstep;
            const char* a2 = last ? nA : cA + (size_t)(t + 2) * kstep; const char* b2 = last ? nB : cB + (size_t)(t + 2) * kstep;
            const char* a3 = a2 + kstep; const char* b3 = b2 + kstep;
            if (last && has_next) S.a_ready(nxt);
            if constexpr (SP2) {
            PG8_LDB(B0, 0, 0); PG8_LDB(B1, 0, 1); PG8_SCHED; PG8_LDA(At, 0, 0); PG8_STAGE(PG8_SA(1, 1), a1 + hstep, voffA);
            PG8_WAIT_V(8); PG8_WAIT_L(0); PG8_BAR; PG8_MMA(0, 0, At, B0); PG8_MMA(0, 1, At, B1); PG8_BAR; PG8_SCHED;
            PG8_LDA(At, 0, 1); PG8_STAGE(PG8_SB(0, 0), b2, voffB); PG8_STAGE(PG8_SB(0, 1), b2 + hstep, voffB); PG8_STAGE(PG8_SA(0, 0), a2, voffA);
            PG8_WAIT_V(8); PG8_WAIT_L(0); PG8_BAR; PG8_MMA(1, 0, At, B0); PG8_MMA(1, 1, At, B1); PG8_BAR; PG8_SCHED;
            PG8_LDB(B0, 1, 0); PG8_LDB(B1, 1, 1); PG8_SCHED; PG8_LDA(At, 1, 0); PG8_STAGE(PG8_SA(0, 1), a2 + hstep, voffA);
            PG8_WAIT_V(8); PG8_WAIT_L(0); PG8_BAR; PG8_MMA(0, 0, At, B0); PG8_MMA(0, 1, At, B1); PG8_BAR; PG8_SCHED;
            PG8_LDA(At, 1, 1); PG8_STAGE(PG8_SB(1, 0), b3, voffB); PG8_STAGE(PG8_SB(1, 1), b3 + hstep, voffB); PG8_STAGE(PG8_SA(1, 0), a3, voffA);
            PG8_WAIT_V(8); PG8_WAIT_L(0); PG8_BAR; PG8_MMA(1, 0, At, B0); PG8_MMA(1, 1, At, B1); PG8_BAR; PG8_SCHED;
            } else {
            PG8_LDB(B0, 0, 0); PG8_SCHED; PG8_LDA(At, 0, 0); PG8_STAGE(PG8_SA(1, 1), a1 + hstep, voffA);
            PG8_WAIT_L(8); PG8_BAR; PG8_WAIT_L(0); PG8_MMA(0, 0, At, B0); PG8_BAR; PG8_SCHED;
            PG8_LDB(B1, 0, 1); PG8_STAGE(PG8_SB(0, 0), b2, voffB);
            PG8_BAR; PG8_WAIT_L(0); PG8_MMA(0, 1, At, B1); PG8_BAR;
            PG8_LDA(At, 0, 1); PG8_STAGE(PG8_SA(0, 0), a2, voffA);
            PG8_BAR; PG8_WAIT_L(0); PG8_MMA(1, 0, At, B0); PG8_BAR; PG8_SCHED;
            PG8_STAGE(PG8_SB(0, 1), b2 + hstep, voffB);
            PG8_WAIT_V(6); PG8_BAR; PG8_MMA(1, 1, At, B1); PG8_BAR;
            PG8_LDB(B0, 1, 0); PG8_SCHED; PG8_LDA(At, 1, 0); PG8_STAGE(PG8_SA(0, 1), a2 + hstep, voffA);
            PG8_WAIT_L(8); PG8_BAR; PG8_WAIT_L(0); PG8_MMA(0, 0, At, B0); PG8_BAR; PG8_SCHED;
            PG8_LDB(B1, 1, 1); PG8_STAGE(PG8_SB(1, 0), b3, voffB);
            PG8_BAR; PG8_WAIT_L(0); PG8_MMA(0, 1, At, B1); PG8_BAR;
            PG8_LDA(At, 1, 1); PG8_STAGE(PG8_SA(1, 0), a3, voffA);
            PG8_BAR; PG8_WAIT_L(0); PG8_MMA(1, 0, At, B0); PG8_BAR; PG8_SCHED;
            PG8_STAGE(PG8_SB(1, 1), b3 + hstep, voffB);
            PG8_WAIT_V(6); PG8_BAR; PG8_MMA(1, 1, At, B1); PG8_BAR;
            }
        }
        if constexpr (ALIGN_EPI) { if (wr == 0) PG8_BAR; }
        if constexpr (F8) asm volatile("s_nop 15\n\ts_nop 15" ::: "memory");
        if constexpr (!Epi::AFTER_DRAIN) { E(acc, cur, wr, wc, fr, fq); S.done(cur); }
        if (!has_next) break;
#pragma unroll
        for (int a = 0; a < 2; ++a)
#pragma unroll
            for (int b = 0; b < 2; ++b)
#pragma unroll
                for (int m = 0; m < 4; ++m)
#pragma unroll
                    for (int n = 0; n < 2; ++n) acc[a][b][m][n] = (f32x4){0.f, 0.f, 0.f, 0.f};
        cur = nxt; cA = nA; cB = nB; ++ui;
        if constexpr (ALIGN_EPI) { if (wr == 1) PG8_BAR; }
    }
    PG8_WAIT_V(0);
    if constexpr (!ALIGN_EPI) { if (wr == 0) PG8_BAR; }
    PG8_BAR;
    if constexpr (Epi::AFTER_DRAIN) { E.fused(acc, cur, wr, wc, fr, fq, lds, wid, lane); S.done(cur); }
#undef PG8_SA
#undef PG8_SB
#undef PG8_STAGE
#undef PG8_LDA
#undef PG8_LDB
#undef PG8_MMA
#undef PG8_WAIT_V
#undef PG8_WAIT_L
#undef PG8_BAR
#undef PG8_SCHED
}
}

typedef const f32x4 (&AccRef)[2][2][4][2];

struct EpiIn {
    static constexpr bool PERM = true, AFTER_DRAIN = false;
    bf16_t *Q, *Kb, *V, *G; const LAS float* rtab;
    DI void operator()(AccRef acc, const pg8::Unit& u, int wr, int wc, int fr, int fq) const {
        const int pn = u.pn; bf16_t* base; int ld, colt; bool sig = false;
        if (pn < 4) { base = Q; ld = 1024; colt = pn * 256; }
        else if (pn < 7) { base = Kb; ld = 768; colt = (pn - 4) * 256; }
        else if (pn < 10) { base = V; ld = 768; colt = (pn - 7) * 256; }
        else { base = G; ld = 3072; colt = (pn - 10) * 256; sig = true; }
        const int row0 = u.pm * 256 + wr * 64 + fr, col0 = colt + wc * 32 + 8 * fq;
#pragma unroll
        for (int ai = 0; ai < 2; ++ai)
#pragma unroll
            for (int m = 0; m < 4; ++m) { bf16_t* rowp = base + (size_t)(row0 + ai * 128 + m * 16) * ld + col0;
                const float rs = rtab ? rtab[(u.ord & 1) * 256 + wr * 64 + fr + ai * 128 + m * 16] : 1.f;
#pragma unroll
                for (int bj = 0; bj < 2; ++bj) {
                    if (sig) {
                        const float rsn = rs * -1.4426950408889634f; unsigned q[8];
#pragma unroll
                        for (int j = 0; j < 4; ++j) {
                            q[j] = (unsigned)__builtin_amdgcn_rcpf(__builtin_amdgcn_exp2f(__builtin_fmaf(acc[ai][bj][m][0][j], rsn, -8.f)) + 0.00390720367431640625f);
                            q[4 + j] = (unsigned)__builtin_amdgcn_rcpf(__builtin_amdgcn_exp2f(__builtin_fmaf(acc[ai][bj][m][1][j], rsn, -8.f)) + 0.00390720367431640625f); }
                        u32x2 w; w.x = q[0] | (q[1] << 8) | (q[2] << 16) | (q[3] << 24); w.y = q[4] | (q[5] << 8) | (q[6] << 16) | (q[7] << 24);
                        *(u32x2*)((unsigned char*)G + (size_t)(row0 + ai * 128 + m * 16) * 3072 + col0 + bj * 128) = w; }
                    else { const f32x4 v0 = acc[ai][bj][m][0] * rs, v1 = acc[ai][bj][m][1] * rs;
                        u32x4 w; w.x = pk2(v0[0], v0[1]); w.y = pk2(v0[2], v0[3]); w.z = pk2(v1[0], v1[1]); w.w = pk2(v1[2], v1[3]);
                        *(u32x4*)(rowp + bj * 128) = w; } } }
    }
};

struct EpiGate {
    static constexpr bool PERM = true, AFTER_DRAIN = false, HAS_MID = true;
    const unsigned char* G; bf16_t* Mg;
    DI bool is_mid(int t) const { return t == 4 || t == 10; }
    static DI float gq(unsigned w, int k) { return (float)((w >> (8 * k)) & 0xffu) + 0.5f; }
    DI void mid(f32x4 (&acc)[2][2][4][2], const pg8::Unit& u, int t, int wr, int wc, int fr, int fq) const {
        int fr_o = fr; asm volatile("" : "+v"(fr_o));
        const int row0 = u.pm * 256 + wr * 64 + fr_o, col0 = u.pn * 256 + wc * 32 + 8 * fq, g0 = (t == 4) ? 0 : 1024;
#pragma unroll
        for (int ai = 0; ai < 2; ++ai) {
            __builtin_amdgcn_sched_barrier(0);
#pragma unroll
            for (int m = 0; m < 4; ++m) { const size_t ro = (size_t)(row0 + ai * 128 + m * 16) * 3072 + g0 + col0;
#pragma unroll
                for (int bj = 0; bj < 2; ++bj) { const u32x2 gn = *(const u32x2*)(G + ro + bj * 128), gd = *(const u32x2*)(G + ro + 1024 + bj * 128);
                    f32x4 r0, r1;
#pragma unroll
                    for (int k = 0; k < 4; ++k) { r0[k] = gq(gn.x, k) * __builtin_amdgcn_rcpf(gq(gd.x, k)); r1[k] = gq(gn.y, k) * __builtin_amdgcn_rcpf(gq(gd.y, k)); }
                    acc[ai][bj][m][0] = acc[ai][bj][m][0] * r0; acc[ai][bj][m][1] = acc[ai][bj][m][1] * r1; } } }
        __builtin_amdgcn_sched_barrier(0);
    }
    DI void operator()(AccRef acc, const pg8::Unit& u, int wr, int wc, int fr, int fq) const {
        const int row0 = u.pm * 256 + wr * 64 + fr, col0 = u.pn * 256 + wc * 32 + 8 * fq;
#pragma unroll
        for (int ai = 0; ai < 2; ++ai)
#pragma unroll
            for (int m = 0; m < 4; ++m) { const size_t row = (size_t)(row0 + ai * 128 + m * 16);
#pragma unroll
                for (int bj = 0; bj < 2; ++bj) { const int col = col0 + bj * 128;
                    const u32x2 g = *(const u32x2*)(G + row * 3072 + 2048 + col);
                    const f32x4 v0 = acc[ai][bj][m][0] * (1.f / 256.f), v1 = acc[ai][bj][m][1] * (1.f / 256.f);
                    u32x4 w;
                    w.x = pk2(gq(g.x, 0) * v0[0], gq(g.x, 1) * v0[1]); w.y = pk2(gq(g.x, 2) * v0[2], gq(g.x, 3) * v0[3]);
                    w.z = pk2(gq(g.y, 0) * v1[0], gq(g.y, 1) * v1[1]); w.w = pk2(gq(g.y, 2) * v1[2], gq(g.y, 3) * v1[3]);
                    *(u32x4*)(Mg + row * 1024 + col) = w; } }
    }
};

struct EpiResidN {
    static constexpr bool PERM = true, AFTER_DRAIN = false;
    const float* xin; float* xout; unsigned char* xb; float* ssq; int f8;
    DI void operator()(AccRef acc, const pg8::Unit& u, int wr, int wc, int fr, int fq) const {
        const int row0 = u.pm * 256 + wr * 64 + fr, col0 = u.pn * 256 + wc * 32 + 8 * fq;
#pragma unroll
        for (int ai = 0; ai < 2; ++ai)
#pragma unroll
            for (int m = 0; m < 4; ++m) { const int row = row0 + ai * 128 + m * 16; const size_t ro = (size_t)row * 1024; float ss = 0.f;
#pragma unroll
                for (int bj = 0; bj < 2; ++bj) { const size_t o = ro + col0 + bj * 128;
                    const f32x4 x0 = *(const f32x4*)(xin + o) + acc[ai][bj][m][0], x1 = *(const f32x4*)(xin + o + 4) + acc[ai][bj][m][1];
                    *(f32x4*)(xout + o) = x0; *(f32x4*)(xout + o + 4) = x1;
                    if (xb) { ss += ((x0[0] * x0[0] + x0[1] * x0[1]) + (x0[2] * x0[2] + x0[3] * x0[3])) + ((x1[0] * x1[0] + x1[1] * x1[1]) + (x1[2] * x1[2] + x1[3] * x1[3]));
                        if (f8) { int w0 = 0, w1 = 0; w0 = __builtin_amdgcn_cvt_pk_fp8_f32(x0[0], x0[1], w0, false); w0 = __builtin_amdgcn_cvt_pk_fp8_f32(x0[2], x0[3], w0, true);
                            w1 = __builtin_amdgcn_cvt_pk_fp8_f32(x1[0], x1[1], w1, false); w1 = __builtin_amdgcn_cvt_pk_fp8_f32(x1[2], x1[3], w1, true);
                            u32x2 w; w.x = (unsigned)w0; w.y = (unsigned)w1; *(u32x2*)(xb + o) = w; }
                        else { u32x4 w; w.x = pk2(x0[0], x0[1]); w.y = pk2(x0[2], x0[3]); w.z = pk2(x1[0], x1[1]); w.w = pk2(x1[2], x1[3]); *(u32x4*)(xb + 2 * o) = w; } } }
                if (xb) { ss += shx(ss, 16); ss += shx(ss, 32);
                    if (fq == 0) ssq[(size_t)row * 16 + 4 * u.pn + wc] = ss; } }
    }
};

struct EpiResid {
    static constexpr bool PERM = false, AFTER_DRAIN = false;
    const float* xin; float* xout;
    DI void operator()(AccRef acc, const pg8::Unit& u, int wr, int wc, int fr, int fq) const {
        const int row0 = u.pm * 256 + wr * 64 + fr, col0 = u.pn * 256 + wc * 32 + 4 * fq;
#pragma unroll
        for (int ai = 0; ai < 2; ++ai)
#pragma unroll
            for (int m = 0; m < 4; ++m) { const size_t ro = (size_t)(row0 + ai * 128 + m * 16) * 1024;
#pragma unroll
                for (int bj = 0; bj < 2; ++bj)
#pragma unroll
                    for (int n = 0; n < 2; ++n) { const size_t o = ro + col0 + bj * 128 + n * 16;
                        const f32x4 xv = *(const f32x4*)(xin + o); *(f32x4*)(xout + o) = xv + acc[ai][bj][m][n]; } }
    }
};

template <bool F8O>
struct EpiSwiglu {
    static constexpr bool PERM = true, AFTER_DRAIN = false;
    unsigned char* act; int ld; const LAS float* rtab;
    DI void operator()(AccRef acc, const pg8::Unit& u, int wr, int wc, int fr, int fq) const {
        const int row0 = u.pm * 256 + wr * 64 + fr, col0 = u.pn * 128 + wc * 32 + 8 * fq;
#pragma unroll
        for (int ai = 0; ai < 2; ++ai)
#pragma unroll
            for (int m = 0; m < 4; ++m) { const size_t eo = (size_t)(row0 + ai * 128 + m * 16) * ld + col0;
                const float rs = rtab ? rtab[(u.ord & 1) * 256 + wr * 64 + fr + ai * 128 + m * 16] : 1.f;
                const float rsn = rs * -1.4426950408889634f, irs2 = rtab ? __builtin_amdgcn_rcpf(rs * rs) : 1.f;
                float o[8];
#pragma unroll
                for (int n = 0; n < 2; ++n)
#pragma unroll
                    for (int j = 0; j < 4; ++j) { const float ga = acc[ai][0][m][n][j], ua = acc[ai][1][m][n][j];
                        const float e = __builtin_amdgcn_exp2f(ga * rsn); o[4 * n + j] = (ga * ua) * __builtin_amdgcn_rcpf(__builtin_fmaf(e, irs2, irs2)); }
                if constexpr (F8O) { int w0 = 0, w1 = 0;
                    w0 = __builtin_amdgcn_cvt_pk_fp8_f32(o[0], o[1], w0, false); w0 = __builtin_amdgcn_cvt_pk_fp8_f32(o[2], o[3], w0, true);
                    w1 = __builtin_amdgcn_cvt_pk_fp8_f32(o[4], o[5], w1, false); w1 = __builtin_amdgcn_cvt_pk_fp8_f32(o[6], o[7], w1, true);
                    u32x2 w; w.x = (unsigned)w0; w.y = (unsigned)w1; *(u32x2*)(act + eo) = w; }
                else { u32x4 w; w.x = pk2(o[0], o[1]); w.y = pk2(o[2], o[3]); w.z = pk2(o[4], o[5]); w.w = pk2(o[6], o[7]); *(u32x4*)(act + 2 * eo) = w; } }
    }
};

struct EpiMoeDown {
    static constexpr bool PERM = true, AFTER_DRAIN = false;
    const int* perm; const float* rgate; bf16_t* ybuf;
    DI void operator()(AccRef acc, const pg8::Unit& u, int wr, int wc, int fr, int fq) const {
        const int row0 = u.pm * 256 + wr * 64 + fr, col0 = u.pn * 256 + wc * 32 + 8 * fq;
#pragma unroll
        for (int ai = 0; ai < 2; ++ai)
#pragma unroll
            for (int m = 0; m < 4; ++m) { const int row = row0 + ai * 128 + m * 16; const int p = perm[row];
                if (p >= 0) { const float gt = rgate[row]; bf16_t* dst = ybuf + ((size_t)(p & 1) * NTOK + (size_t)(p >> 1)) * 1024 + col0;
#pragma unroll
                    for (int bj = 0; bj < 2; ++bj) { const f32x4 v0 = acc[ai][bj][m][0] * gt, v1 = acc[ai][bj][m][1] * gt;
                        u32x4 w; w.x = pk2(v0[0], v0[1]); w.y = pk2(v0[2], v0[3]); w.z = pk2(v1[0], v1[1]); w.w = pk2(v1[2], v1[3]);
                        *(u32x4*)(dst + bj * 128) = w; } } }
    }
};

#define LDS_WAIT() asm volatile("s_waitcnt lgkmcnt(0)" ::: "memory")

DI void prep_tile(const float* src, int src_ld, bool zero, unsigned char* dst, int dst_ld, float f8mul, const float* kg  , LAS bf16_t* t, int lane) {
#pragma unroll
    for (int i = 0; i < 16; ++i) { const int k = i * 4 + (lane >> 4), c = (lane & 15) * 4;
        f32x4 v = {0.f, 0.f, 0.f, 0.f}; if (!zero) v = *(const f32x4*)(src + (size_t)k * src_ld + c);
        if (kg) v = v * kg[k];
        u32x2 w; w.x = pk2(v[0], v[1]); w.y = pk2(v[2], v[3]); *(LAS u32x2*)(t + k * 68 + c) = w; }
    LDS_WAIT();
#pragma unroll
    for (int kc = 0; kc < 8; ++kc) { unsigned e[8];
#pragma unroll
        for (int j = 0; j < 8; ++j) e[j] = t[(8 * kc + j) * 68 + lane];
        if (f8mul != 0.f) { int w0 = 0, w1 = 0;
            w0 = __builtin_amdgcn_cvt_pk_fp8_f32(bflo(e[0]) * f8mul, bflo(e[1]) * f8mul, w0, false); w0 = __builtin_amdgcn_cvt_pk_fp8_f32(bflo(e[2]) * f8mul, bflo(e[3]) * f8mul, w0, true);
            w1 = __builtin_amdgcn_cvt_pk_fp8_f32(bflo(e[4]) * f8mul, bflo(e[5]) * f8mul, w1, false); w1 = __builtin_amdgcn_cvt_pk_fp8_f32(bflo(e[6]) * f8mul, bflo(e[7]) * f8mul, w1, true);
            u32x2 w; w.x = (unsigned)w0; w.y = (unsigned)w1; *(u32x2*)(dst + (size_t)lane * dst_ld + 8 * kc) = w; }
        else { u32x4 w; w.x = e[0] | (e[1] << 16); w.y = e[2] | (e[3] << 16); w.z = e[4] | (e[5] << 16); w.w = e[6] | (e[7] << 16);
            *(u32x4*)(dst + ((size_t)lane * dst_ld + 8 * kc) * 2) = w; } }
    LDS_WAIT();
}

struct Args { const float* in[12]; float* out; unsigned char* ws; int lo, hi; };
typedef Args Ptrs;

DI void prep_wg_tile(const float* src0, const float* src1, int src_ld, unsigned char* dst, int dst_ld, float f8mul, const float* kg, LAS bf16_t* t, int tid) {
    { const int c = (tid & 127) * 4, kk = tid >> 7;
      const float* sp; int dn;
      if (src1) { const int run = c >> 8, cc = c & 255; sp = (run ? src1 : src0) + cc; dn = ((cc >> 7) << 8) + (run << 7) + (cc & 127); } else { sp = src0 + c; dn = c; }
#pragma unroll
      for (int p = 0; p < 16; ++p) { const int k = 4 * p + kk; f32x4 v = *(const f32x4*)(sp + (size_t)k * src_ld);
          if (kg) v = v * kg[k];
          u32x2 w; w.x = pk2(v[0], v[1]); w.y = pk2(v[2], v[3]); *(LAS u32x2*)(t + k * 520 + (dn ^ (((k >> 3) & 7) << 3))) = w; } }
    __syncthreads();
    { const int kc = tid & 7;
#pragma unroll
      for (int i = 0; i < 8; ++i) { const int n = 64 * i + (tid >> 3); unsigned e[8];
#pragma unroll
          for (int j = 0; j < 8; ++j) e[j] = t[(8 * kc + j) * 520 + (n ^ (kc << 3))];
          if (f8mul != 0.f) { int w0 = 0, w1 = 0;
              w0 = __builtin_amdgcn_cvt_pk_fp8_f32(bflo(e[0]) * f8mul, bflo(e[1]) * f8mul, w0, false); w0 = __builtin_amdgcn_cvt_pk_fp8_f32(bflo(e[2]) * f8mul, bflo(e[3]) * f8mul, w0, true);
              w1 = __builtin_amdgcn_cvt_pk_fp8_f32(bflo(e[4]) * f8mul, bflo(e[5]) * f8mul, w1, false); w1 = __builtin_amdgcn_cvt_pk_fp8_f32(bflo(e[6]) * f8mul, bflo(e[7]) * f8mul, w1, true);
              u32x2 w; w.x = (unsigned)w0; w.y = (unsigned)w1; *(u32x2*)(dst + (size_t)n * dst_ld + 8 * kc) = w; }
          else { u32x4 w; w.x = e[0] | (e[1] << 16); w.y = e[2] | (e[3] << 16); w.z = e[4] | (e[5] << 16); w.w = e[6] | (e[7] << 16);
              *(u32x4*)(dst + ((size_t)n * dst_ld + 8 * kc) * 2) = w; } } }
    __syncthreads();
}

DI void phase_prep(const Ptrs& P, LAS unsigned char* lds, int tid) {
    LAS bf16_t* t = (LAS bf16_t*)(lds + LDS_SCR);
    constexpr int T0 = 4 * 176, T3 = T0 + 4 * 24, T4 = T3 + 4 * 32, T5 = T4 + 2 * 176, T6 = T5 + 2 * 88, T7 = T6 + 16 * 224, T8 = T7 + 16 * 112;
    for (int it = blockIdx.x; it < T8; it += gridDim.x) {
        const float* src; const float* src1 = nullptr; int src_ld; size_t wsb; size_t eo; int dst_ld; float f8mul = 0.f; const float* kg = nullptr;
        int r = it;
        if (r < T0) { const int L = r / 176, q = r % 176, kt = q / 11, nt = q % 11;
            src = P.in[2] + (size_t)L * 1024 * 5632 + (size_t)kt * 64 * 5632 + nt * 512; src_ld = 5632;
            wsb = WS_W_IN + (size_t)L * 5632 * 1024 * 2; eo = (size_t)(nt * 512) * 1024 + kt * 64; dst_ld = 1024; f8mul = ((F8_IN >> L) & 1) ? 32.f : 0.f;
            if (FUSE_NORM && (L & 1)) kg = P.in[1] + (size_t)L * 2048 + kt * 64; }
        else if (r < T3) { r -= T0; const int L = r / 24, q = r % 24, kt = q / 2, nt = q % 2;
            src = P.in[5] + (size_t)L * 768 * 1024 + (size_t)(kt * 64) * 1024 + nt * 512; src_ld = 1024;
            wsb = WS_W_BR; eo = ((size_t)L * 1024 + nt * 512) * 768 + kt * 64; dst_ld = 768; }
        else if (r < T4) { r -= T3; const int L = r / 32, q = r % 32, kt = q / 2, nt = q % 2;
            src = P.in[6] + (size_t)L * 1024 * 1024 + (size_t)(kt * 64) * 1024 + nt * 512; src_ld = 1024;
            wsb = WS_W_OUT; eo = ((size_t)L * 1024 + nt * 512) * 1024 + kt * 64; dst_ld = 1024; }
        else if (r < T5) { r -= T4; const int L = r / 176, q = r % 176, kt = q / 11, nt = q % 11;
            src = P.in[7] + (size_t)L * 1024 * 5632 + (size_t)(kt * 64) * 5632 + nt * 256; src1 = src + FF; src_ld = 5632;
            wsb = WS_W_FGU + (size_t)L * 5632 * 1024 * 2; eo = (size_t)(nt * 512) * 1024 + kt * 64; dst_ld = 1024; f8mul = ((F8_FFN >> L) & 1) ? 32.f : 0.f;
            if (FUSE_NORM) kg = P.in[1] + (size_t)(2 * L) * 2048 + 1024 + kt * 64; }
        else if (r < T6) { r -= T5; const int L = r / 88, q = r % 88, kt = q / 2, nt = q % 2;
            src = P.in[8] + (size_t)L * 2816 * 1024 + (size_t)(kt * 64) * 1024 + nt * 512; src_ld = 1024;
            wsb = WS_W_FDN + (size_t)L * 1024 * 2816 * 2; eo = (size_t)(nt * 512) * 2816 + kt * 64; dst_ld = 2816; f8mul = ((F8_FFN >> L) & 1) ? 64.f : 0.f; }
        else if (r < T7) { r -= T6; const int L = r / 224, q = r % 224, kt = q / 14, nt = q % 14;
            src = P.in[10] + (size_t)L * 1024 * 7168 + (size_t)(kt * 64) * 7168 + nt * 256; src1 = src + ED; src_ld = 7168;
            wsb = WS_W_MGU + (size_t)(L >> 3) * 8 * 7168 * 1024 * 2; eo = ((size_t)(L & 7) * 7168 + nt * 512) * 1024 + kt * 64; dst_ld = 1024; f8mul = ((F8_MOE >> (L >> 3)) & 1) ? 32.f : 0.f; }
        else { r -= T7; const int L = r / 112, q = r % 112, kt = q / 2, nt = q % 2;
            src = P.in[11] + (size_t)L * 3584 * 1024 + (size_t)(kt * 64) * 1024 + nt * 512; src_ld = 1024;
            wsb = WS_W_MDN + (size_t)(L >> 3) * 8 * 1024 * 3584 * 2; eo = ((size_t)(L & 7) * 1024 + nt * 512) * 3584 + kt * 64; dst_ld = 3584; f8mul = ((F8_MOE >> (L >> 3)) & 1) ? 64.f : 0.f; }
        prep_wg_tile(src, src1, src_ld, P.ws + wsb + eo * (f8mul != 0.f ? 1 : 2), dst_ld, f8mul, kg, t, tid);
    }
    const int gid = blockIdx.x * NTHR + tid;
    if (gid < 4096 * 32) { const int pos = gid >> 5, i = gid & 31; const float inv = powf(10000.f, -(float)(2 * i) / 64.f); float s, c; sincosf((float)pos * inv, &s, &c);
        ((f32x2*)(P.ws + WS_ROPE1))[gid] = (f32x2){c, s}; }
    if (gid < 64 * 16) { const int pos = gid >> 4, i = gid & 15; const float inv = powf(10000.f, -(float)(2 * i) / 32.f); float s, c; sincosf((float)pos * inv, &s, &c);
        ((f32x2*)(P.ws + WS_ROPEA))[gid] = (f32x2){c, s}; }
}

template <bool COMBINE, bool ROUTER, bool HF8>
DI void phase_norm(const float* xin, float* xout, const bf16_t* ybuf, const float* gain, bf16_t* H, const float* wrt, int* topi, float* topw, int* cnt, int* perm,
                   LAS unsigned char* lds, int tid) {
    const int wave = tid >> 6, lane = tid & 63, w = blockIdx.x;
    LAS float* wrl = (LAS float*)(lds + LDS_SCR);
    LAS int* cntl = (LAS int*)(lds + LDS_SCR + 32768);
    if (ROUTER) {
        for (int i = tid; i < 8192; i += NTHR) wrl[(i & 7) * 1024 + (i >> 3)] = wrt[i];
        if (tid < 8) cntl[tid] = 0;
        for (int i = tid; i < MROWS / NWG; i += NTHR) perm[w * (MROWS / NWG) + i] = -1;
        __syncthreads();
    }
    f32x4 g[4];
#pragma unroll
    for (int q = 0; q < 4; ++q) g[q] = *(const f32x4*)(gain + 256 * q + 4 * lane);
    for (int j = 0; j < 16; ++j) {
        const int row = w * 128 + wave * 16 + j; const size_t ro = (size_t)row * 1024;
        f32x4 v[4]; float ss = 0.f;
#pragma unroll
        for (int q = 0; q < 4; ++q) { v[q] = *(const f32x4*)(xin + ro + 256 * q + 4 * lane);
            if (COMBINE) { const u32x2 a = *(const u32x2*)(ybuf + ro + 256 * q + 4 * lane), b = *(const u32x2*)(ybuf + (size_t)NTOK * 1024 + ro + 256 * q + 4 * lane);
                v[q][0] += bflo(a.x) + bflo(b.x); v[q][1] += bfhi(a.x) + bfhi(b.x); v[q][2] += bflo(a.y) + bflo(b.y); v[q][3] += bfhi(a.y) + bfhi(b.y);
                *(f32x4*)(xout + ro + 256 * q + 4 * lane) = v[q]; }
            ss += (v[q][0] * v[q][0] + v[q][1] * v[q][1]) + (v[q][2] * v[q][2] + v[q][3] * v[q][3]); }
        const float rstd = 1.f / sqrtf(wave_sum(ss) * (1.f / 1024.f) + EPS);
#pragma unroll
        for (int q = 0; q < 4; ++q) { v[q] = v[q] * rstd * g[q];
            if constexpr (HF8) { int w = 0; w = __builtin_amdgcn_cvt_pk_fp8_f32(v[q][0], v[q][1], w, false); w = __builtin_amdgcn_cvt_pk_fp8_f32(v[q][2], v[q][3], w, true);
                *(int*)((unsigned char*)H + ro + 256 * q + 4 * lane) = w; }
            else { u32x2 o; o.x = pk2(v[q][0], v[q][1]); o.y = pk2(v[q][2], v[q][3]); *(u32x2*)(H + ro + 256 * q + 4 * lane) = o; } }
        if (ROUTER) {
            float lg[8];
#pragma unroll
            for (int e = 0; e < 8; ++e) { float a = 0.f;
#pragma unroll
                for (int q = 0; q < 4; ++q) { const f32x4 wv = *(const LAS f32x4*)(wrl + e * 1024 + 256 * q + 4 * lane); a += (v[q][0] * wv[0] + v[q][1] * wv[1]) + (v[q][2] * wv[2] + v[q][3] * wv[3]); }
                lg[e] = wave_sum(a); }
            float v0 = -3.0e38f; int e0 = 0;
#pragma unroll
            for (int e = 0; e < 8; ++e) if (lg[e] > v0) { v0 = lg[e]; e0 = e; }
            float v1 = -3.0e38f; int e1 = 0;
#pragma unroll
            for (int e = 0; e < 8; ++e) if (e != e0 && lg[e] > v1) { v1 = lg[e]; e1 = e; }
            if (lane == 0) { const float t = __expf(v1 - v0), w0 = 1.f / (1.f + t);
                topi[row * 2] = e0; topi[row * 2 + 1] = e1; topw[row * 2] = w0; topw[row * 2 + 1] = t * w0;
                atomicAdd((int*)(cntl + e0), 1); atomicAdd((int*)(cntl + e1), 1); }
        }
    }
    if (ROUTER) { __syncthreads(); if (tid < 8) cnt[w * 8 + tid] = cntl[tid]; }
}

DI void moe_totals(const int* cnt, volatile LAS int* misc, int tid) {
    const int e = tid >> 6, lane = tid & 63, w = blockIdx.x;
    int c[4]; int s4 = 0;
#pragma unroll
    for (int i = 0; i < 4; ++i) { c[i] = cnt[(4 * lane + i) * 8 + e]; s4 += c[i]; }
    int x = s4;
#pragma unroll
    for (int o = 1; o < 64; o <<= 1) { const int y = shup(x, o); if (lane >= o) x += y; }
    const int total = shidx(x, 63);
    int p = x - s4;
#pragma unroll
    for (int i = 0; i < 3; ++i) if (i < (w & 3)) p += c[i];
    p = shidx(p, w >> 2);
    if (lane == 0) { misc[e] = total; misc[8 + e] = p; }
    __syncthreads();
}

template <bool F8>
DI void phase_scatter(const int* cnt, const int* topi, const float* topw, const bf16_t* H, bf16_t* XS, int* perm, float* rgate, LAS unsigned char* lds, int tid) {
    const int wave = tid >> 6, lane = tid & 63, w = blockIdx.x;
    volatile LAS int* misc = (volatile LAS int*)(lds + LDS_MISC + 64);
    LAS int* posl = (LAS int*)(lds + LDS_SCR);
    moe_totals(cnt, misc, tid);
    { const int e = wave; int base = 0;
        for (int k = 0; k < e; ++k) base += ((misc[k] + 255) >> 8) << 8;
        int running = base + misc[8 + e];
        for (int pss = 0; pss < 2; ++pss) { const int j = 64 * pss + lane, tok = w * 128 + j;
            const int a0 = topi[tok * 2], a1 = topi[tok * 2 + 1]; const bool f0 = a0 == e, f1 = a1 == e, has = f0 || f1;
            const unsigned long long mask = __ballot(has); const int rank = __popcll(mask & ((1ull << lane) - 1ull));
            if (has) { const int pos = running + rank, slot = f1 ? 1 : 0; perm[pos] = tok * 2 + slot; rgate[pos] = topw[tok * 2 + slot]; posl[j * 2 + slot] = pos; }
            running += __popcll(mask); }
    }
    __syncthreads();
    for (int i = 0; i < 32; ++i) { const int pr = wave * 32 + i, pos = posl[pr], tok = w * 128 + (pr >> 1);
        if constexpr (F8) { *((u32x4*)((unsigned char*)XS + (size_t)pos * 1024) + lane) = *((const u32x4*)((const unsigned char*)H + (size_t)tok * 1024) + lane); }
        else { const u32x4* s = (const u32x4*)(H + (size_t)tok * 1024) + lane; u32x4* d = (u32x4*)(XS + (size_t)pos * 1024) + lane;
            const u32x4 a = s[0], b = s[64]; d[0] = a; d[64] = b; } }
}

DI void phase_final(const float* x, const bf16_t* ybuf, float* out, int tid) {
    const size_t n4 = (size_t)NTOK * 1024 / 4;
    for (size_t i = (size_t)blockIdx.x * NTHR + tid; i < n4; i += (size_t)gridDim.x * NTHR) {
        f32x4 v = ((const f32x4*)x)[i]; const u32x2 a = ((const u32x2*)ybuf)[i], b = ((const u32x2*)(ybuf + (size_t)NTOK * 1024))[i];
        v[0] += bflo(a.x) + bflo(b.x); v[1] += bfhi(a.x) + bfhi(b.x); v[2] += bflo(a.y) + bflo(b.y); v[3] += bfhi(a.y) + bfhi(b.y);
        ((f32x4*)out)[i] = v; }
}

struct QKRaw { u32x2 w[4]; };
DI void qk_load(QKRaw& R, const bf16_t* rowp, int lane, bool active) {
    const bf16_t* hp = rowp + (active ? (lane >> 2) * 64 + 4 * (lane & 3) : 0);
#pragma unroll
    for (int m = 0; m < 4; ++m) R.w[m] = *(const u32x2*)(hp + 16 * m);
}
DI void qk_finish(const QKRaw& R, bf16_t* rowp, int nh0, int nh1, const LAS float* gl  , int which, float scale, const LAS f32x2* r1l  , const LAS f32x2* ral  ,
                  int sl  , int s, int lane, bool active) {
    const int head = lane >> 2, q = lane & 3;
    const int br = head < nh0 ? 0 : (head < nh0 + nh1 ? 1 : 2);
    float v[4][4], ss = 0.f;
#pragma unroll
    for (int m = 0; m < 4; ++m) { const u32x2 w = R.w[m]; v[m][0] = bflo(w.x); v[m][1] = bfhi(w.x); v[m][2] = bflo(w.y); v[m][3] = bfhi(w.y);
        ss += (v[m][0] * v[m][0] + v[m][1] * v[m][1]) + (v[m][2] * v[m][2] + v[m][3] * v[m][3]); }
    ss += shx(ss, 1); ss += shx(ss, 2);
    const float rstd = 1.f / sqrtf(ss * (1.f / 64.f) + EPS);
    const LAS float* gp = gl + (br * 2 + which) * 64 + 4 * q;
    float o[4][4];
    f32x4 cs[4][2];
#pragma unroll
    for (int m = 0; m < 4; ++m) { const f32x4 g4 = *(const LAS f32x4*)(gp + 16 * m);
#pragma unroll
        for (int j = 0; j < 4; ++j) v[m][j] = v[m][j] * rstd * g4[j];
        const LAS f32x2* tp = (br == 2) ? r1l + sl * 32 + (m & 1) * 16 + 4 * q : ral + ((m < 2) ? (s >> 6) : (s & 63)) * 16 + 4 * q;
        cs[m][0] = *(const LAS f32x4*)tp; cs[m][1] = *(const LAS f32x4*)(tp + 2); }
#pragma unroll
    for (int m = 0; m < 4; ++m) { const bool first = (br == 2) ? (m < 2) : ((m & 1) == 0);
#pragma unroll
        for (int j = 0; j < 4; ++j) { const float pv = (br == 2) ? v[m ^ 2][j] : v[m ^ 1][j]; const float c = cs[m][j >> 1][2 * (j & 1)], sn = cs[m][j >> 1][2 * (j & 1) + 1];
            const float rot = first ? v[m][j] * c - pv * sn : v[m][j] * c + pv * sn;
            o[m][j] = ((br == 0) ? v[m][j] : rot) * scale; } }
    if (active) { bf16_t* hp = rowp + head * 64 + 4 * q;
#pragma unroll
        for (int m = 0; m < 4; ++m) { u32x2 w; w.x = pk2(o[m][0], o[m][1]); w.y = pk2(o[m][2], o[m][3]); *(u32x2*)(hp + 16 * m) = w; } }
}

DI void qk_rows_wave(const Ptrs& P, const LAS float* gl, const LAS f32x2* r1l, const LAS f32x2* ral, int wave, int lane) {
    bf16_t* Kb = (bf16_t*)(P.ws + WS_K);
    const int t0 = blockIdx.x * 128 + wave * 16;
    const bool act = lane < 48;
    QKRaw a0, a1, a2, a3, b0, b1, b2, b3;
    qk_load(a0, Kb + (size_t)t0 * 768, lane, act); qk_load(a1, Kb + (size_t)(t0 + 1) * 768, lane, act); qk_load(a2, Kb + (size_t)(t0 + 2) * 768, lane, act); qk_load(a3, Kb + (size_t)(t0 + 3) * 768, lane, act);
#pragma unroll 1
    for (int j = 0; j < 16; j += 4) { const int tok = t0 + j, tn = (j + 4 < 16) ? tok + 4 : tok, s = tok & (SEQ - 1), sl = wave * 16 + j;
        qk_load(b0, Kb + (size_t)tn * 768, lane, act); qk_load(b1, Kb + (size_t)(tn + 1) * 768, lane, act); qk_load(b2, Kb + (size_t)(tn + 2) * 768, lane, act); qk_load(b3, Kb + (size_t)(tn + 3) * 768, lane, act);
        qk_finish(a0, Kb + (size_t)tok * 768, 4, 2, gl, 1, 1.0f, r1l, ral, sl, s, lane, act);
        qk_finish(a1, Kb + (size_t)(tok + 1) * 768, 4, 2, gl, 1, 1.0f, r1l, ral, sl + 1, s + 1, lane, act);
        qk_finish(a2, Kb + (size_t)(tok + 2) * 768, 4, 2, gl, 1, 1.0f, r1l, ral, sl + 2, s + 2, lane, act);
        qk_finish(a3, Kb + (size_t)(tok + 3) * 768, 4, 2, gl, 1, 1.0f, r1l, ral, sl + 3, s + 3, lane, act);
        a0 = b0; a1 = b1; a2 = b2; a3 = b3; }
}
DI void v_units_wave(const Ptrs& P, LAS unsigned* L, int gw, int NGW, int lane) {
    const bf16_t* V = (const bf16_t*)(P.ws + WS_VRAW); bf16_t* Vt = (bf16_t*)(P.ws + WS_VT);
    u32x4 rw[8];
    { const int tt = gw / 12, hv = gw % 12; const bf16_t* src = V + (size_t)(tt * 64 + lane) * 768 + hv * 64;
#pragma unroll
      for (int c = 0; c < 8; ++c) rw[c] = *(const u32x4*)(src + c * 8); }
#pragma unroll 1
    for (int un = gw; un < 512 * 12; un += NGW) { const int tt = un / 12, hv = un % 12, tok0 = tt * 64, b = tok0 >> 12, s0 = tok0 & (SEQ - 1);
        const int g = hv < 6 ? 0 : ((hv - 6) >> 1), sh = 2 * g, dd = 1 << sh, Sd = SEQ >> sh, run = 64 >> sh;
        const int pos = (lane & (dd - 1)) * run + (lane >> sh);
#pragma unroll
        for (int c = 0; c < 8; ++c) { L[(4 * c + 0) * 68 + pos] = rw[c].x; L[(4 * c + 1) * 68 + pos] = rw[c].y; L[(4 * c + 2) * 68 + pos] = rw[c].z; L[(4 * c + 3) * 68 + pos] = rw[c].w; }
        { const int un2 = (un + NGW < 512 * 12) ? un + NGW : un; const int tt2 = un2 / 12, hv2 = un2 % 12; const bf16_t* src = V + (size_t)(tt2 * 64 + lane) * 768 + hv2 * 64;
#pragma unroll
          for (int c = 0; c < 8; ++c) rw[c] = *(const u32x4*)(src + c * 8); }
        LDS_WAIT();
        const int ch = lane & 7, p = 8 * ch;
        const size_t g1 = (size_t)(p >> (6 - sh)) * Sd + (s0 >> sh) + (p & (run - 1)), g2 = (size_t)((p + 4) >> (6 - sh)) * Sd + (s0 >> sh) + ((p + 4) & (run - 1));
#pragma unroll
        for (int i = 0; i < 8; ++i) { const int d = 8 * i + (lane >> 3), k = d >> 1;
            const u32x4 wa = *(const LAS u32x4*)(L + k * 68 + p), wb = *(const LAS u32x4*)(L + k * 68 + p + 4);
            const unsigned sel = (d & 1) ? 0x07060302u : 0x05040100u;
            u32x4 o; o.x = __builtin_amdgcn_perm(wa.y, wa.x, sel); o.y = __builtin_amdgcn_perm(wa.w, wa.z, sel); o.z = __builtin_amdgcn_perm(wb.y, wb.x, sel); o.w = __builtin_amdgcn_perm(wb.w, wb.z, sel);
            bf16_t* drow = Vt + ((size_t)(b * 12 + hv) * 64 + d) * SEQ;
            if (run >= 8) *(u32x4*)(drow + g1) = o;
            else { u32x2 t; t.x = o.x; t.y = o.y; *(u32x2*)(drow + g1) = t; t.x = o.z; t.y = o.w; *(u32x2*)(drow + g2) = t; } }
        LDS_WAIT();
    }
}
DI void phase_qkvprep(const Ptrs& P, int layer, LAS unsigned char* lds, int tid) {
    const int wave = tid >> 6, lane = tid & 63, gw = blockIdx.x * 8 + wave, NGW = gridDim.x * 8;
    LAS f32x4* r1l4 = (LAS f32x4*)(lds + LDS_SCR); LAS f32x4* ral4 = (LAS f32x4*)(lds + LDS_SCR + 32768); LAS float* gl = (LAS float*)(lds + LDS_SCR + 40960);
    const int s0 = (blockIdx.x * 128) & (SEQ - 1);
    const f32x4* r1g = (const f32x4*)(P.ws + WS_ROPE1) + (size_t)s0 * 16; const f32x4* rag = (const f32x4*)(P.ws + WS_ROPEA);
    for (int i = tid; i < 128 * 16; i += NTHR) r1l4[i] = r1g[i];
    for (int i = tid; i < 64 * 8; i += NTHR) ral4[i] = rag[i];
    if (tid < 384) gl[tid] = (P.in[3] + (size_t)layer * 384)[tid];
    __syncthreads();
    const LAS f32x2* r1l = (const LAS f32x2*)(lds + LDS_SCR); const LAS f32x2* ral = (const LAS f32x2*)(lds + LDS_SCR + 32768);
    LAS unsigned* L = (LAS unsigned*)(lds + LDS_SCR + 49152 + wave * 8704);
    if (wave < 4) { qk_rows_wave(P, gl, r1l, ral, wave, lane); v_units_wave(P, L, gw, NGW, lane); }
    else { v_units_wave(P, L, gw, NGW, lane); qk_rows_wave(P, gl, r1l, ral, wave, lane); }
}

#define XB_TMO      128
#define XB_XCNT(j)  (256  + 64 * (j))
#define XB_XSUB(j)  (1280 + 64 * (j))
#define XB_XGEN(j)  (2304 + 64 * (j))
#define XB_TOP      3328
#define XB_TOPGEN   3392
#define XCD_BAR_WORDS 3456
#define XB_SPIN_CAP (1u << 18)

__device__ __forceinline__ unsigned xb_ld(unsigned* p)              { return __hip_atomic_load(p, __ATOMIC_RELAXED, __HIP_MEMORY_SCOPE_AGENT); }
__device__ __forceinline__ unsigned xb_add(unsigned* p, unsigned v) { return __hip_atomic_fetch_add(p, v, __ATOMIC_RELAXED, __HIP_MEMORY_SCOPE_AGENT); }
__device__ __forceinline__ unsigned xb_xcc_id() { return (unsigned)__builtin_amdgcn_s_getreg((3 << 11) | 20) & 0xFu; }
#define XB_SPIN(cond, bar) do { unsigned _sp = 0; while (cond) { __builtin_amdgcn_s_sleep(1); \
    if ((++_sp & 255u) == 0u) { if (xb_ld(&(bar)[XB_TMO])) break; if (_sp > XB_SPIN_CAP) { atomicAdd(&(bar)[XB_TMO], 1u); break; } } } } while (0)

struct XcdBarrier {
    unsigned* bar; unsigned x;
    volatile LAS unsigned* st;
};

__device__ __forceinline__ XcdBarrier xcd_barrier_post(unsigned* bar, volatile LAS unsigned* st, int tid) {
    XcdBarrier b; b.bar = bar; b.x = xb_xcc_id(); b.st = st;
    if (tid == 0) (void)xb_add(&bar[XB_XCNT(b.x)], 1u);
    return b;
}
__device__ __forceinline__ void xcd_barrier_complete(unsigned* bar, unsigned x, unsigned& nloc, unsigned& nx) {
    const unsigned G = gridDim.x * gridDim.y * gridDim.z;
    unsigned sum, cnt, mine, sp = 0u;
    for (;;) {
        sum = 0u; cnt = 0u; mine = 0u;
#pragma unroll
        for (unsigned j = 0; j < 16; ++j) { const unsigned c = xb_ld(&bar[XB_XCNT(j)]); sum += c; cnt += (c > 0u) ? 1u : 0u; mine = (j == x) ? c : mine; }
        if (sum == G) break;
        __builtin_amdgcn_s_sleep(1);
        if ((++sp & 255u) == 0u) { if (xb_ld(&bar[XB_TMO])) break; if (sp > XB_SPIN_CAP) { atomicAdd(&bar[XB_TMO], 1u); break; } }
    }
    nloc = mine > 0u ? mine : 1u; nx = cnt > 0u ? cnt : 1u;
}

__device__ __forceinline__ void xcd_barrier(const XcdBarrier& b, int tid) {
    asm volatile("s_waitcnt vmcnt(0)" ::: "memory");
    __syncthreads();
    if (tid == 0) {
        unsigned* bar = b.bar;
        __builtin_amdgcn_s_waitcnt(0);
        unsigned nloc = b.st[0], nx = b.st[1];
        if (nloc == 0u) { xcd_barrier_complete(bar, b.x, nloc, nx); b.st[0] = nloc; b.st[1] = nx; }
        const unsigned old = xb_add(&bar[XB_XSUB(b.x)], 1u);
        const unsigned gen = old / nloc;
        if (old + 1u == (gen + 1u) * nloc) {
            __builtin_amdgcn_fence(__ATOMIC_RELEASE, "agent");
            asm volatile("s_waitcnt vmcnt(0)" ::: "memory");
            const unsigned og = xb_add(&bar[XB_TOP], 1u);
            const unsigned tg = og / nx;
            if (og + 1u == (tg + 1u) * nx) xb_add(&bar[XB_TOPGEN], 1u);
            else XB_SPIN(xb_ld(&bar[XB_TOPGEN]) == tg, bar);
            __builtin_amdgcn_fence(__ATOMIC_ACQUIRE, "agent");
            xb_add(&bar[XB_XGEN(b.x)], 1u);
            asm volatile("s_waitcnt vmcnt(0)" ::: "memory");
        } else {
            XB_SPIN(xb_ld(&bar[XB_XGEN(b.x)]) == gen, bar);
            __builtin_amdgcn_fence(__ATOMIC_ACQUIRE, "agent");
            asm volatile("s_waitcnt vmcnt(0)" ::: "memory");
        }
    }
    __syncthreads();
}

DI f32x16 mfma32(bf16x8 a, bf16x8 b, f32x16 c) { return __builtin_amdgcn_mfma_f32_32x32x16_bf16(a, b, c, 0, 0, 0); }
DI int pi32(int r) { return (r & 19) | ((r & 4) << 1) | ((r & 8) >> 1); }
DI int keyidx(int i, int hi) { return 16 * (i >> 3) + 8 * hi + (i & 7); }
DI bf16x8 pack8(const f32x16& x, int s) { u32x4 p; p.x = pk2(x[8 * s], x[8 * s + 1]); p.y = pk2(x[8 * s + 2], x[8 * s + 3]); p.z = pk2(x[8 * s + 4], x[8 * s + 5]); p.w = pk2(x[8 * s + 6], x[8 * s + 7]); return __builtin_bit_cast(bf16x8, p); }
DI f32x16 splat16(float v) { f32x16 z;
#pragma unroll
    for (int i = 0; i < 16; ++i) z[i] = v; return z; }
DI f32x16 zero16() { float z_ = 0.f; asm volatile("" : "+v"(z_)); return splat16(z_); }
template <int BR>
DI void q_prep(bf16x8 (&qf)[4], const bf16_t* qp  , const float* gq  , int hi, int s, const f32x2* rope1, const f32x2* ropea) {
    { int z_ = 0; asm volatile("" : "+v"(z_)); gq += z_; rope1 += z_; ropea += z_; }
    float v[4][8]; float ss = 0.f;
#pragma unroll
    for (int c = 0; c < 4; ++c) { const u32x4 w = *(const u32x4*)(qp + 16 * c);
        v[c][0] = bflo(w.x); v[c][1] = bfhi(w.x); v[c][2] = bflo(w.y); v[c][3] = bfhi(w.y); v[c][4] = bflo(w.z); v[c][5] = bfhi(w.z); v[c][6] = bflo(w.w); v[c][7] = bfhi(w.w);
#pragma unroll
        for (int j = 0; j < 8; ++j) ss += v[c][j] * v[c][j]; }
    ss += shx(ss, 32);
    const float rstd = 1.f / sqrtf(ss * (1.f / 64.f) + EPS);
#pragma unroll
    for (int c = 0; c < 4; ++c) { const f32x4 g0 = *(const f32x4*)(gq + 16 * c + 8 * hi), g1 = *(const f32x4*)(gq + 16 * c + 8 * hi + 4);
#pragma unroll
        for (int j = 0; j < 4; ++j) { v[c][j] *= rstd * g0[j]; v[c][4 + j] *= rstd * g1[j]; } }
    float o[4][8];
    if (BR == 0) {
#pragma unroll
        for (int c = 0; c < 4; ++c)
#pragma unroll
            for (int j = 0; j < 8; ++j) o[c][j] = v[c][j];
    } else {
#pragma unroll
        for (int pp = 0; pp < 2; ++pp) {
            const int cl = (BR == 2) ? pp : 2 * pp, ch = (BR == 2) ? pp + 2 : 2 * pp + 1;
            const f32x2* tp = (BR == 2) ? rope1 + s * 32 + 16 * pp + 8 * hi : ropea + ((pp == 0) ? (s >> 6) : (s & 63)) * 16 + 8 * hi;
#pragma unroll
            for (int j2 = 0; j2 < 4; ++j2) { const f32x4 t = *(const f32x4*)(tp + 2 * j2);
                o[cl][2 * j2] = v[cl][2 * j2] * t[0] - v[ch][2 * j2] * t[1]; o[ch][2 * j2] = v[ch][2 * j2] * t[0] + v[cl][2 * j2] * t[1];
                o[cl][2 * j2 + 1] = v[cl][2 * j2 + 1] * t[2] - v[ch][2 * j2 + 1] * t[3]; o[ch][2 * j2 + 1] = v[ch][2 * j2 + 1] * t[2] + v[cl][2 * j2 + 1] * t[3]; } }
    }
#pragma unroll
    for (int c = 0; c < 4; ++c) { u32x4 w; w.x = pk2(o[c][0] * QSCALE, o[c][1] * QSCALE); w.y = pk2(o[c][2] * QSCALE, o[c][3] * QSCALE); w.z = pk2(o[c][4] * QSCALE, o[c][5] * QSCALE); w.w = pk2(o[c][6] * QSCALE, o[c][7] * QSCALE);
        qf[c] = __builtin_bit_cast(bf16x8, w); }
}
struct QTab { const float* qkg; const f32x2* rope1; const f32x2* ropea; };
constexpr float SM_THR = 8.f;
DI float max16x2(const f32x16& a, const f32x16& b) {
    float m0 = fmaxf(fmaxf(a[0], a[1]), a[2]), m1 = fmaxf(fmaxf(b[0], b[1]), b[2]);
#pragma unroll
    for (int i = 3; i < 15; i += 2) { m0 = fmaxf(fmaxf(m0, a[i]), a[i + 1]); m1 = fmaxf(fmaxf(m1, b[i]), b[i + 1]); }
    return fmaxf(fmaxf(m0, m1), fmaxf(a[15], b[15]));
}
#define SOFTMAX_BODY(UPD_NEGM) \
    const float mx = max16x2(s0, s1); \
    if (__any(mx > SM_THR)) {                                          \
        float delta = fmaxf(fmaxf(mx, shx(mx, 32)), 0.f); asm volatile("" : "+v"(delta));     \
        const float alpha = __builtin_amdgcn_exp2f(-delta); \
        mref += delta; l *= alpha; UPD_NEGM \
        _Pragma("unroll") for (int i = 0; i < 16; ++i) { o0[i] *= alpha; o1[i] *= alpha; s0[i] -= delta; s1[i] -= delta; } \
    } \
    float sum0 = 0.f, sum1 = 0.f; \
    _Pragma("unroll") for (int i = 0; i < 16; ++i) { s0[i] = __builtin_amdgcn_exp2f(s0[i]); s1[i] = __builtin_amdgcn_exp2f(s1[i]); sum0 += s0[i]; sum1 += s1[i]; } \
    l += sum0 + sum1;
DI void softmax_lazy(f32x16& s0, f32x16& s1, float& mref, float& l, f32x16& o0, f32x16& o1) { SOFTMAX_BODY() }
DI void softmax_lazy(f32x16& s0, f32x16& s1, float& mref, f32x16& negm, float& l, f32x16& o0, f32x16& o1) { SOFTMAX_BODY(negm = splat16(-mref);) }
DI void store_o(bf16_t* op  , const f32x16& o0, const f32x16& o1, float l) {
    const float inv = 1.f / (l + shx(l, 32));
#pragma unroll
    for (int g = 0; g < 4; ++g) { u32x2 a, b;
        a.x = pk2(o0[4 * g] * inv, o0[4 * g + 1] * inv); a.y = pk2(o0[4 * g + 2] * inv, o0[4 * g + 3] * inv);
        b.x = pk2(o1[4 * g] * inv, o1[4 * g + 1] * inv); b.y = pk2(o1[4 * g + 2] * inv, o1[4 * g + 3] * inv);
        *(u32x2*)(op + 8 * g) = a; *(u32x2*)(op + 32 + 8 * g) = b; }
}

constexpr int GQ_KB = 128 * 144, GQ_VB = 64 * 272, GQ_BUF = GQ_KB + GQ_VB;
template <bool FAST>
DI void gqa_unit(LAS unsigned char* lds, const QTab& qt, const bf16_t* Q, const bf16_t* Kb, const bf16_t* Vt, bf16_t* OB, int b, int hq, int qb, int tid) {
    const int wave = tid >> 6, lane = tid & 63, r = lane & 31, hi = lane >> 5, kvh = hq / 3;
    const int qtok = b * SEQ + qb * 256 + wave * 32 + r;
    bf16x8 qf[4];
    q_prep<1>(qf, Q + (size_t)qtok * 1024 + (4 + hq) * 64 + 8 * hi, qt.qkg + 2 * 64, hi, qtok & (SEQ - 1), qt.rope1, qt.ropea);
    const int kr0 = tid >> 3, kc0 = tid & 7, vr0 = tid >> 4, vc0 = tid & 15;
    const bf16_t* kg = Kb + (size_t)(b * SEQ + kr0) * 768 + (4 + kvh) * 64 + kc0 * 8;
    const bf16_t* vg = Vt + ((size_t)(b * 12 + 4 + kvh) * 64 + vr0) * SEQ + vc0 * 8;
    const int ksoff = kr0 * 144 + kc0 * 16, vsoff = GQ_KB + vr0 * 272 + vc0 * 16;
    u32x4 ka = *(const u32x4*)kg, kb2 = *(const u32x4*)(kg + (size_t)64 * 768), va = *(const u32x4*)vg, vb2 = *(const u32x4*)(vg + (size_t)32 * SEQ);
    *(LAS u32x4*)(lds + ksoff) = ka; *(LAS u32x4*)(lds + ksoff + 64 * 144) = kb2; *(LAS u32x4*)(lds + vsoff) = va; *(LAS u32x4*)(lds + vsoff + 32 * 272) = vb2;
    __syncthreads();
    float mref = 0.f, l = 0.f; f32x16 o0 = zero16(), o1 = zero16(), negm = zero16(), lacc = zero16();
    const u32x4 ones_u = {0x3F803F80u, 0x3F803F80u, 0x3F803F80u, 0x3F803F80u}; const bf16x8 ones = __builtin_bit_cast(bf16x8, ones_u);
    const int koff = pi32(r) * 144 + hi * 16, voff = GQ_KB + r * 272 + hi * 16;
#define GQ_LDK(dst, base) do { _Pragma("unroll") for (int c_ = 0; c_ < 4; ++c_) { dst[c_] = *(const LAS bf16x8*)((base) + c_ * 32); dst[4 + c_] = *(const LAS bf16x8*)((base) + 32 * 144 + c_ * 32); } } while (0)
#define GQ_LDV(dst, base) do { _Pragma("unroll") for (int c_ = 0; c_ < 4; ++c_) { dst[c_] = *(const LAS bf16x8*)((base) + c_ * 32); dst[4 + c_] = *(const LAS bf16x8*)((base) + 32 * 272 + c_ * 32); } } while (0)
    for (int it = 0; it < 32; ++it) {
        const int cur = it & 1;
        if (it + 1 < 32) { const bf16_t* kn = kg + (size_t)(it + 1) * 128 * 768; const bf16_t* vn = vg + (it + 1) * 128;
            ka = *(const u32x4*)kn; kb2 = *(const u32x4*)(kn + (size_t)64 * 768); va = *(const u32x4*)vn; vb2 = *(const u32x4*)(vn + (size_t)32 * SEQ); }
        const LAS unsigned char* Bc = lds + cur * GQ_BUF;
        bf16x8 kf[8], vf[8], kf2[8];
        GQ_LDK(kf, Bc + koff);
        __builtin_amdgcn_sched_barrier(0);
        f32x16 s0 = FAST ? splat16(0.f) : negm, s1 = FAST ? splat16(0.f) : negm;
#pragma unroll
        for (int c = 0; c < 4; ++c) { s0 = mfma32(kf[c], qf[c], s0); s1 = mfma32(kf[4 + c], qf[c], s1); }
        GQ_LDV(vf, Bc + voff); if constexpr (FAST) GQ_LDK(kf2, Bc + 64 * 144 + koff);
        __builtin_amdgcn_sched_barrier(0);
        if constexpr (FAST) {
#pragma unroll
            for (int i = 0; i < 16; ++i) { s0[i] = __builtin_amdgcn_exp2f(s0[i]); s1[i] = __builtin_amdgcn_exp2f(s1[i]); } }
        else softmax_lazy(s0, s1, mref, negm, l, o0, o1);
#pragma unroll
        for (int s4 = 0; s4 < 4; ++s4) { const bf16x8 pf = pack8(s4 < 2 ? s0 : s1, s4 & 1); o0 = mfma32(vf[s4], pf, o0); o1 = mfma32(vf[4 + s4], pf, o1); if constexpr (FAST) lacc = mfma32(ones, pf, lacc); }
        if constexpr (!FAST) { __builtin_amdgcn_sched_barrier(0); GQ_LDK(kf2, Bc + 64 * 144 + koff); }
        s0 = FAST ? splat16(0.f) : negm; s1 = FAST ? splat16(0.f) : negm;
#pragma unroll
        for (int c = 0; c < 4; ++c) { s0 = mfma32(kf2[c], qf[c], s0); s1 = mfma32(kf2[4 + c], qf[c], s1); }
        GQ_LDV(vf, Bc + voff + 128);
        __builtin_amdgcn_sched_barrier(0);
        if constexpr (FAST) {
#pragma unroll
            for (int i = 0; i < 16; ++i) { s0[i] = __builtin_amdgcn_exp2f(s0[i]); s1[i] = __builtin_amdgcn_exp2f(s1[i]); } }
        else softmax_lazy(s0, s1, mref, negm, l, o0, o1);
#pragma unroll
        for (int s4 = 0; s4 < 4; ++s4) { const bf16x8 pf = pack8(s4 < 2 ? s0 : s1, s4 & 1); o0 = mfma32(vf[s4], pf, o0); o1 = mfma32(vf[4 + s4], pf, o1); if constexpr (FAST) lacc = mfma32(ones, pf, lacc); }
        if (it + 1 < 32) { LAS unsigned char* Bn = lds + (cur ^ 1) * GQ_BUF;
            *(LAS u32x4*)(Bn + ksoff) = ka; *(LAS u32x4*)(Bn + ksoff + 64 * 144) = kb2; *(LAS u32x4*)(Bn + vsoff) = va; *(LAS u32x4*)(Bn + vsoff + 32 * 272) = vb2; }
        __syncthreads();
    }
#undef GQ_LDK
#undef GQ_LDV
    if constexpr (FAST) store_o(OB + (size_t)qtok * 768 + hq * 64 + 4 * hi, o0, o1, 0.5f * lacc[0]);
    else store_o(OB + (size_t)qtok * 768 + hq * 64 + 4 * hi, o0, o1, l);
}

template <int NT>
DI void gqa3_wave(LAS unsigned char* lds, const QTab& qt, const bf16_t* Q, const bf16_t* Kb, const bf16_t* Vt, bf16_t* OB, int b, int kvh, int qblk, int wave, int lane) {
    const int r = lane & 31, hi = lane >> 5;
    const int tq0 = (NT == 2) ? 2 * wave : 8 + (wave - 4), hl = tq0 >> 2, hq = 3 * kvh + hl;
    int qtok[NT]; bf16x8 qf[NT][4]; f32x16 o0[NT], o1[NT]; float l[NT];
#pragma unroll
    for (int t = 0; t < NT; ++t) { qtok[t] = b * SEQ + qblk * 128 + ((tq0 + t) & 3) * 32 + r;
        q_prep<1>(qf[t], Q + (size_t)qtok[t] * 1024 + (4 + hq) * 64 + 8 * hi, qt.qkg + 2 * 64, hi, qtok[t] & (SEQ - 1), qt.rope1, qt.ropea);
        __builtin_amdgcn_sched_barrier(0); }
#pragma unroll
    for (int t = 0; t < NT; ++t) { o0[t] = zero16(); o1[t] = zero16(); l[t] = 0.f; }
    const int st = (wave & 3) * 64 + lane;
    const bf16_t* kg = Kb + (size_t)(b * SEQ + (st >> 3)) * 768 + (4 + kvh) * 64 + (st & 7) * 8;
    const bf16_t* vg = Vt + ((size_t)(b * 12 + 4 + kvh) * 64 + (st >> 4)) * SEQ + (st & 15) * 8;
    const int ksoff = (st >> 3) * 144 + (st & 7) * 16, vsoff = GQ_KB + (st >> 4) * 272 + (st & 15) * 16;
    u32x4 kq[4], vq[4];
#define G3_GLOAD(T_) do { _Pragma("unroll") for (int i_ = 0; i_ < 4; ++i_) { kq[i_] = *(const u32x4*)(kg + (size_t)((T_) * 128 + 32 * i_) * 768); vq[i_] = *(const u32x4*)(vg + (size_t)16 * i_ * SEQ + (T_) * 128); } } while (0)
#define G3_LSTORE(B_) do { LAS unsigned char* Bn_ = lds + (B_) * GQ_BUF; _Pragma("unroll") for (int i_ = 0; i_ < 4; ++i_) { *(LAS u32x4*)(Bn_ + ksoff + 32 * i_ * 144) = kq[i_]; *(LAS u32x4*)(Bn_ + vsoff + 16 * i_ * 272) = vq[i_]; } } while (0)
    if (NT == 1) { G3_GLOAD(0); G3_LSTORE(0); }
    __syncthreads();
    const int koff = pi32(r) * 144 + hi * 16, voff = GQ_KB + r * 272 + hi * 16;
#pragma unroll 1
    for (int it = 0; it < 32; ++it) {
        const int cur = it & 1;
        if (NT == 1 && it + 1 < 32) G3_GLOAD(it + 1);
        const LAS unsigned char* Bc = lds + cur * GQ_BUF;
#pragma unroll
        for (int hf = 0; hf < 2; ++hf) {
            bf16x8 kf[8], pf[NT][4];
#pragma unroll
            for (int c = 0; c < 4; ++c) { kf[c] = *(const LAS bf16x8*)(Bc + hf * 64 * 144 + koff + c * 32); kf[4 + c] = *(const LAS bf16x8*)(Bc + hf * 64 * 144 + koff + 32 * 144 + c * 32); }
#define G3_QK(t_, s0_, s1_) do { _Pragma("unroll") for (int c = 0; c < 4; ++c) { s0_ = mfma32(kf[c], qf[t_][c], s0_); s1_ = mfma32(kf[4 + c], qf[t_][c], s1_); } } while (0)
#define G3_SM(t_, s0_, s1_) do { float sum0 = 0.f, sum1 = 0.f; \
                _Pragma("unroll") for (int i = 0; i < 16; ++i) { s0_[i] = __builtin_amdgcn_exp2f(s0_[i]); s1_[i] = __builtin_amdgcn_exp2f(s1_[i]); sum0 += s0_[i]; sum1 += s1_[i]; } \
                l[t_] += sum0 + sum1; pf[t_][0] = pack8(s0_, 0); pf[t_][1] = pack8(s0_, 1); pf[t_][2] = pack8(s1_, 0); pf[t_][3] = pack8(s1_, 1); } while (0)
#define G3_LDV() do { _Pragma("unroll") for (int c = 0; c < 4; ++c) { vf[c] = *(const LAS bf16x8*)(Bc + voff + hf * 128 + c * 32); vf[4 + c] = *(const LAS bf16x8*)(Bc + voff + hf * 128 + 32 * 272 + c * 32); } } while (0)
#define G3_PV(t_) do { _Pragma("unroll") for (int s4 = 0; s4 < 4; ++s4) { o0[t_] = mfma32(vf[s4], pf[t_][s4], o0[t_]); o1[t_] = mfma32(vf[4 + s4], pf[t_][s4], o1[t_]); } } while (0)
            bf16x8 vf[8];
            if constexpr (NT == 2) {
                f32x16 sa0 = splat16(0.f), sa1 = splat16(0.f), sb0 = splat16(0.f), sb1 = splat16(0.f);
                bf16x8 vh[4];
#define G3_HSM(t_, s_, j_) do { float sum_ = 0.f; _Pragma("unroll") for (int i = 0; i < 16; ++i) { s_[i] = __builtin_amdgcn_exp2f(s_[i]); sum_ += s_[i]; } \
                l[t_] += sum_; pf[t_][2 * (j_)] = pack8(s_, 0); pf[t_][2 * (j_) + 1] = pack8(s_, 1); } while (0)
#define G3_FENCE() __builtin_amdgcn_sched_barrier(0)
#define G3_PIN(x_) asm volatile("" : "+v"(x_))
                G3_QK(0, sa0, sa1);
                G3_PIN(sa0); G3_PIN(sa1); G3_FENCE();
                G3_HSM(0, sa0, 0); _Pragma("unroll") for (int c = 0; c < 4; ++c) sb0 = mfma32(kf[c], qf[1][c], sb0);
                G3_PIN(sb0); G3_PIN(pf[0][0]); G3_PIN(pf[0][1]); G3_PIN(l[0]); G3_FENCE();
                G3_HSM(0, sa1, 1); _Pragma("unroll") for (int c = 0; c < 4; ++c) sb1 = mfma32(kf[4 + c], qf[1][c], sb1);
                G3_PIN(sb1); G3_PIN(pf[0][2]); G3_PIN(pf[0][3]); G3_PIN(l[0]); G3_FENCE();
                _Pragma("unroll") for (int c = 0; c < 4; ++c) vf[c] = *(const LAS bf16x8*)(Bc + voff + hf * 128 + c * 32);
                G3_HSM(1, sb0, 0); _Pragma("unroll") for (int s4 = 0; s4 < 4; ++s4) o0[0] = mfma32(vf[s4], pf[0][s4], o0[0]);
                G3_PIN(o0[0]); G3_PIN(pf[1][0]); G3_PIN(pf[1][1]); G3_PIN(l[1]); G3_FENCE();
                _Pragma("unroll") for (int c = 0; c < 4; ++c) vh[c] = *(const LAS bf16x8*)(Bc + voff + hf * 128 + 32 * 272 + c * 32);
                G3_HSM(1, sb1, 1); _Pragma("unroll") for (int s4 = 0; s4 < 4; ++s4) o1[0] = mfma32(vh[s4], pf[0][s4], o1[0]);
                G3_PIN(o1[0]); G3_PIN(pf[1][2]); G3_PIN(pf[1][3]); G3_PIN(l[1]); G3_FENCE();
                _Pragma("unroll") for (int s4 = 0; s4 < 4; ++s4) { o0[1] = mfma32(vf[s4], pf[1][s4], o0[1]); o1[1] = mfma32(vh[s4], pf[1][s4], o1[1]); }
                G3_PIN(o0[1]); G3_PIN(o1[1]); G3_FENCE();
#undef G3_PIN
#undef G3_HSM
#undef G3_FENCE
            } else {
                f32x16 sa0 = splat16(0.f), sa1 = splat16(0.f);
                G3_QK(0, sa0, sa1); G3_SM(0, sa0, sa1); G3_LDV(); G3_PV(0);
            }
#undef G3_QK
#undef G3_SM
#undef G3_LDV
#undef G3_PV
        }
        if (NT == 1 && it + 1 < 32) G3_LSTORE(cur ^ 1);
        __syncthreads();
    }
#undef G3_GLOAD
#undef G3_LSTORE
    { const int ln = lane_v(), r2 = ln & 31, hi2 = ln >> 5;
#pragma unroll
      for (int t = 0; t < NT; ++t) store_o(OB + (size_t)(b * SEQ + qblk * 128 + ((tq0 + t) & 3) * 32 + r2) * 768 + hq * 64 + 4 * hi2, o0[t], o1[t], l[t]); }
}

struct WTile { u32x4 k[4], v[4]; };
DI void wt_store(LAS unsigned char* wl, const WTile& T, int lane) {
#pragma unroll
    for (int i = 0; i < 4; ++i) { const int kr = 8 * i + (lane >> 3), vr = 16 * i + (lane >> 2);
        *(LAS u32x4*)(wl + kr * 128 + (((lane & 7) ^ ((kr >> 1) & 7)) << 4)) = T.k[i];
        *(LAS u32x4*)(wl + 4096 + vr * 64 + (((lane & 3) ^ ((vr >> 2) & 3)) << 4)) = T.v[i]; }
}
DI void wt_ldk(bf16x8 (&kf)[4], const LAS unsigned char* wl, int pr, int hi) {
#pragma unroll
    for (int c = 0; c < 4; ++c) kf[c] = *(const LAS bf16x8*)(wl + pr * 128 + (((2 * c + hi) ^ ((pr >> 1) & 7)) << 4));
}
DI void wt_ldv(bf16x8 (&vf)[4], const LAS unsigned char* wl, int r, int hi) {
#pragma unroll
    for (int dt = 0; dt < 2; ++dt)
#pragma unroll
        for (int sk = 0; sk < 2; ++sk) { const int row = 32 * dt + r; vf[2 * dt + sk] = *(const LAS bf16x8*)(wl + 4096 + row * 64 + (((2 * sk + hi) ^ ((row >> 2) & 3)) << 4)); }
}
DI void softmax_lazy1(f32x16& s, float& mref, float& l, f32x16& o0, f32x16& o1) {
    float mx = fmaxf(fmaxf(s[0], s[1]), s[2]);
#pragma unroll
    for (int i = 3; i < 15; i += 2) mx = fmaxf(fmaxf(mx, s[i]), s[i + 1]);
    mx = fmaxf(mx, s[15]);
    if (__any(mx > SM_THR)) {
        float delta = fmaxf(fmaxf(mx, shx(mx, 32)), 0.f); asm volatile("" : "+v"(delta));
        const float alpha = __builtin_amdgcn_exp2f(-delta);
        mref += delta; l *= alpha;
#pragma unroll
        for (int i = 0; i < 16; ++i) { o0[i] *= alpha; o1[i] *= alpha; s[i] -= delta; }
    }
    float sum = 0.f;
#pragma unroll
    for (int i = 0; i < 16; ++i) { s[i] = __builtin_amdgcn_exp2f(s[i]); sum += s[i]; }
    l += sum;
}
DI void pv_step(f32x16& o0, f32x16& o1, const f32x16& p, const bf16x8 (&vf)[4]) {
    const bf16x8 p0 = pack8(p, 0), p1 = pack8(p, 1);
    o0 = mfma32(vf[0], p0, o0); o1 = mfma32(vf[2], p0, o1); o0 = mfma32(vf[1], p1, o0); o1 = mfma32(vf[3], p1, o1);
}

DI void na_unit(LAS unsigned char* wl, const QTab& qt, const LAS float* biasl, const bf16_t* Q, const bf16_t* Kb, const bf16_t* Vt, bf16_t* OA, int b, int rp, int h, int a, int lane) {
    const int r = lane & 31, hi = lane >> 5, pr = pi32(r);
    const int grow = 2 * rp + (r >> 4), qcol = 16 * a + (r & 15), qtok = b * SEQ + grow * 64 + qcol;
    bf16x8 qf[4];
    q_prep<0>(qf, Q + (size_t)qtok * 1024 + h * 64 + 8 * hi, qt.qkg, hi, 0, qt.rope1, qt.ropea);
    const int rs = min(max(grow - 4, 0), 56), cs = min(max(qcol - 8, 0), 48);
    const int krs = min(max(2 * rp - 4, 0), 56), nk = min(max(2 * rp - 3, 0), 56) + 8 - krs, kc0 = min(max(16 * a - 8, 0), 32);
    const bf16_t* kp = Kb + (size_t)(b * SEQ + krs * 64 + kc0 + (lane >> 3)) * 768 + h * 64 + (lane & 7) * 8;
    const bf16_t* vp = Vt + ((size_t)(b * 12 + h) * 64 + (lane >> 2)) * SEQ + krs * 64 + kc0 + (lane & 3) * 8;
    float mref = 0.f, l = 0.f; f32x16 o0 = zero16(), o1 = zero16();
    WTile T;
#pragma unroll
    for (int i = 0; i < 4; ++i) { T.k[i] = *(const u32x4*)(kp + (size_t)8 * i * 768); T.v[i] = *(const u32x4*)(vp + (size_t)16 * i * SEQ); }
    wt_store(wl, T, lane);
#pragma unroll 1
    for (int st = 0; st < nk; ++st) {
        if (st + 1 < nk) { const int n = st + 1;
#pragma unroll
            for (int i = 0; i < 4; ++i) { T.k[i] = *(const u32x4*)(kp + (size_t)(64 * n + 8 * i) * 768); T.v[i] = *(const u32x4*)(vp + (size_t)16 * i * SEQ + 64 * n); } }
        bf16x8 kf[4], vf[4];
        wt_ldk(kf, wl, pr, hi);
        f32x16 sc = splat16(0.f);
#pragma unroll
        for (int c = 0; c < 4; ++c) sc = mfma32(kf[c], qf[c], sc);
        wt_ldv(vf, wl, r, hi);
        const int kr = krs + st; const bool rowok = (kr >= rs) && (kr < rs + 8);
        const LAS float* brow = biasl + (h * 15 + min(max(kr - grow + 7, 0), 14)) * 31 + 15 - qcol;
#pragma unroll
        for (int i = 0; i < 16; ++i) { const int c0 = kc0 + keyidx(i, hi);
            const bool v0 = rowok && (c0 >= cs) && (c0 < cs + 16);
            const float b0 = brow[v0 ? c0 : qcol];
            sc[i] = v0 ? sc[i] + (b0 - mref) : -1e30f; }
        softmax_lazy1(sc, mref, l, o0, o1);
        pv_step(o0, o1, sc, vf);
        if (st + 1 < nk) wt_store(wl, T, lane);
    }
    store_o(OA + (size_t)qtok * 768 + h * 64 + 4 * hi, o0, o1, l);
}

#define DIL_ISSUE(G_, KS_, T_) do { \
    constexpr int sh_ = 2 * (G_), Sd_ = SEQ >> sh_, dd_ = 1 << sh_; const int hk_ = 6 + 2 * (G_) + hs, rd_ = r16 & (dd_ - 1); \
    const bf16_t* kb_ = Kb + (size_t)(b * SEQ + rd_) * 768 + hk_ * 64 + (lane & 7) * 8; \
    const bf16_t* vb_ = Vt + ((size_t)(b * 12 + hk_) * 64 + (lane >> 2)) * SEQ + rd_ * Sd_ + min(max((KS_) + 8 * (lane & 3), 0), Sd_ - 8); \
    _Pragma("unroll") for (int i_ = 0; i_ < 4; ++i_) { const int ik_ = min(max((KS_) + 8 * i_ + (lane >> 3), 0), Sd_ - 1); \
        T_.k[i_] = *(const u32x4*)(kb_ + (size_t)(ik_ << sh_) * 768); T_.v[i_] = *(const u32x4*)(vb_ + (size_t)16 * i_ * SEQ); } } while (0)

template <int G>
DI void dil_group(LAS unsigned char* wl, const QTab& qt, WTile& T, const bf16_t* Q, const bf16_t* Kb, const bf16_t* Vt, int b, int hs, int r16, int ib, int qtok, int lane,
                  float& mref, float& l, f32x16& o0, f32x16& o1) {
    constexpr int sh = 2 * G, Sd = SEQ >> sh, step = 16 >> sh;
    const int r = lane & 31, hi = lane >> 5, pr = pi32(r);
    bf16x8 qf[4];
    q_prep<2>(qf, Q + (size_t)qtok * 1024 + (10 + 2 * G + hs) * 64 + 8 * hi, qt.qkg + 4 * 64, hi, qtok & (SEQ - 1), qt.rope1, qt.ropea);
    const int qd = r16 >> sh, iq = qd + step * (32 * ib + r);
    const int lo = qd + step * 32 * ib - 64, hiend = qd + step * (32 * ib + 31) + 64;
#pragma unroll 1
    for (int ks = (lo >> 5) << 5; ks <= hiend; ks += 32) {
        const bool more = ks + 32 <= hiend;
        if (more) DIL_ISSUE(G, ks + 32, T);
        else if (G < 2) { constexpr int G1 = G < 2 ? G + 1 : 2, sh1 = 2 * G1, step1 = 16 >> sh1; const int lo1 = (r16 >> sh1) + step1 * 32 * ib - 64; DIL_ISSUE(G1, (lo1 >> 5) << 5, T); }
        bf16x8 kf[4], vf[4];
        wt_ldk(kf, wl, pr, hi);
        f32x16 sc = splat16(0.f);
#pragma unroll
        for (int c = 0; c < 4; ++c) sc = mfma32(kf[c], qf[c], sc);
        wt_ldv(vf, wl, r, hi);
#pragma unroll
        for (int i = 0; i < 16; ++i) { const int a0 = ks + keyidx(i, hi);
            const bool v0 = (a0 >= 0) && (a0 < Sd) && (abs(a0 - iq) <= 64);
            sc[i] = v0 ? sc[i] - mref : -1e30f; }
        softmax_lazy1(sc, mref, l, o0, o1);
        pv_step(o0, o1, sc, vf);
        if (more || G < 2) wt_store(wl, T, lane);
    }
}
DI void dil_unit(LAS unsigned char* wl, const QTab& qt, const bf16_t* Q, const bf16_t* Kb, const bf16_t* Vt, bf16_t* OC, int b, int hs, int r16, int ib, int lane) {
    const int r = lane & 31, hi = lane >> 5;
    const int qtok = b * SEQ + r16 + 16 * (32 * ib + r);
    float mref = 0.f, l = 0.f; f32x16 o0 = zero16(), o1 = zero16();
    WTile T;
    { const int lo0 = r16 + 16 * 32 * ib - 64; DIL_ISSUE(0, (lo0 >> 5) << 5, T); wt_store(wl, T, lane); }
    dil_group<0>(wl, qt, T, Q, Kb, Vt, b, hs, r16, ib, qtok, lane, mref, l, o0, o1);
    dil_group<1>(wl, qt, T, Q, Kb, Vt, b, hs, r16, ib, qtok, lane, mref, l, o0, o1);
    dil_group<2>(wl, qt, T, Q, Kb, Vt, b, hs, r16, ib, qtok, lane, mref, l, o0, o1);
    store_o(OC + (size_t)qtok * 768 + hs * 64 + 4 * hi, o0, o1, l);
}

DI void phase_attn(const Ptrs& P, int layer, LAS unsigned char* lds, int tid) {
    const int wave = __builtin_amdgcn_readfirstlane(tid >> 6), lane = tid & 63, c = blockIdx.x;
    const bf16_t* Q = (const bf16_t*)(P.ws + WS_Q); const bf16_t* Kb = (const bf16_t*)(P.ws + WS_K); const bf16_t* Vt = (const bf16_t*)(P.ws + WS_VT);
    bf16_t* OA = (bf16_t*)(P.ws + WS_OALL); bf16_t* OB = OA + 256; bf16_t* OC = OA + 640;
    const QTab qt{P.in[3] + (size_t)layer * 384, (const f32x2*)(P.ws + WS_ROPE1), (const f32x2*)(P.ws + WS_ROPEA)};
    bool gqa_fast;
    { float gq = fabsf(qt.qkg[2 * 64 + lane]), gk = fabsf(qt.qkg[3 * 64 + lane]);
#pragma unroll
      for (int o = 1; o < 64; o <<= 1) { gq = fmaxf(gq, shx(gq, o)); gk = fmaxf(gk, shx(gk, o)); }
      gqa_fast = __builtin_amdgcn_readfirstlane((int)(64.f * QSCALE * gq * gk < 60.f)) != 0; }
    LAS float* biasl = (LAS float*)(lds + LDS_MISC + 1024);
    LAS unsigned char* wl = lds + LDS_SCR + wave * 16384;
    { const float* rpb = P.in[4] + (size_t)layer * 4 * 15 * 31;
      for (int i = tid; i < 4 * 15 * 31; i += NTHR) biasl[i] = rpb[i] * LOG2E; }
    __syncthreads();
#ifndef NO_NA
    int cx = (c & 7) * 32 + (c >> 3); asm volatile("" : "+s"(cx));
    RP(16) for (int u = 0; u < 2; ++u) na_unit(wl, qt, biasl, Q, Kb, Vt, OA, cx >> 5, cx & 31, wave >> 1, 2 * (wave & 1) + u, lane);
#endif
#ifndef NO_DIL
    RP(17) { const int w = cx * 8 + wave; dil_unit(wl, qt, Q, Kb, Vt, OC, w >> 8, (w >> 7) & 1, (w >> 3) & 15, w & 7, lane); }
    __syncthreads();
#endif
#ifndef NO_GQA
    { const int xcd = c & 7, loc = c >> 3;
      if (gqa_fast) { RP(18) for (int i = 0; i < 2; ++i) { const int j = loc + 32 * i, pair = 2 * xcd + (j >> 5), qblk = j & 31;
          if (wave < 4) gqa3_wave<2>(lds + LDS_SCR, qt, Q, Kb, Vt, OB, pair >> 1, pair & 1, qblk, wave, lane_v());
          else gqa3_wave<1>(lds + LDS_SCR, qt, Q, Kb, Vt, OB, pair >> 1, pair & 1, qblk, wave, lane_v()); } }
      else { for (int i = 0; i < 3; ++i) { const int j = loc + 32 * i, pair = 2 * xcd + j / 48, jj = j % 48;
          const int tid2 = (wave << 6) | lane_v();
          gqa_unit<false>(lds + LDS_SCR, qt, Q, Kb, Vt, OB, pair >> 1, (pair & 1) * 3 + jj / 16, jj & 15, tid2); } } }
#endif
}


__global__ void __launch_bounds__(NTHR, 2) mk_fwd(Args a) {
    extern __shared__ __attribute__((aligned(16))) unsigned char lds_raw[];
    LAS unsigned char* lds = (LAS unsigned char*)lds_raw;
    const int tid0 = threadIdx.x;
    const int wid_s = __builtin_amdgcn_readfirstlane(tid0 >> 6);
#define OTID() ({ int l_; asm volatile("v_mbcnt_lo_u32_b32 %0, -1, 0\n\tv_mbcnt_hi_u32_b32 %0, -1, %0" : "=v"(l_)); (wid_s << 6) | l_; })
    for (int i = tid0; i < 256; i += NTHR) ((LAS unsigned*)(lds + LDS_MISC))[i] = 0u;
    __syncthreads();
#define P a
#define ws (a.ws)
    const bool multi = (a.hi - a.lo) > 1;
    XcdBarrier bar; bar.bar = (unsigned*)ws + CW_BAR; bar.x = 0; bar.st = (volatile LAS unsigned*)(lds + LDS_MISC);
    if (multi) bar = xcd_barrier_post((unsigned*)ws + CW_BAR, (volatile LAS unsigned*)(lds + LDS_MISC), tid0);
#define RUN(s) (a.lo <= (s) && (s) < a.hi)

#if TSEL >= 0
    unsigned long long* tsb = (unsigned long long*)(ws + WS_CTL + 262144); int tsi = 0;
#define TSTAMP() do { if (blockIdx.x == 0 && OTID() == 0) tsb[tsi] = __builtin_amdgcn_s_memrealtime(); ++tsi; } while (0)
    TSTAMP();
#else
#define TSTAMP() do { } while (0)
#endif
#define SEAM() do { if (multi) xcd_barrier(bar, OTID()); TSTAMP(); } while (0)
#define H ((bf16_t*)(ws + WS_H))
#define YB ((bf16_t*)(ws + WS_YBUF))
#define ACT ((bf16_t*)(ws + WS_ACT))
#define XS ((bf16_t*)(ws + WS_XS))
#define topi ((int*)(ws + WS_TOPI))
#define topw ((float*)(ws + WS_TOPW))
#define perm ((int*)(ws + WS_PERM))
#define rgate ((float*)(ws + WS_RGATE))
#define cnt ((int*)(ws + WS_CNT))
#define G ((int)gridDim.x)
#define c ((int)blockIdx.x)

    if (PM(0) && RUN(0)) { RP(0) phase_prep(P, lds, OTID()); SEAM(); }

    for (int L = 0; L < DEPTH; ++L) {
        const int base = 1 + 10 * L;
        const bool moe = (L & 1) != 0;
        const float* xcur = (L == 0) ? P.in[0] : (const float*)P.out;
        const float* gains = P.in[1] + (size_t)L * 2 * 1024;
        const bool fuse1 = FUSE_NORM && (L & 1);
        const bool f8in = ((F8_IN >> L) & 1) != 0;
        if (PM(1) && RUN(base + 0) && !fuse1) {
            if (L == 2) { if (f8in) phase_norm<true, false, true>(P.out, P.out, YB, gains, H, nullptr, nullptr, nullptr, nullptr, nullptr, lds, OTID());
                          else phase_norm<true, false, false>(P.out, P.out, YB, gains, H, nullptr, nullptr, nullptr, nullptr, nullptr, lds, OTID()); }
            else { if (f8in) RP(1) phase_norm<false, false, true>(xcur, nullptr, nullptr, gains, H, nullptr, nullptr, nullptr, nullptr, nullptr, lds, OTID());
                   else RP(1) phase_norm<false, false, false>(xcur, nullptr, nullptr, gains, H, nullptr, nullptr, nullptr, nullptr, nullptr, lds, OTID()); }
            SEAM(); }
        if (PM(2) && RUN(base + 1)) {
            pg8::Gemm g{H, (const bf16_t*)(ws + WS_W_IN + (size_t)L * INW * 1024 * 2), f8in ? 512 : 1024, 0x7A7A7A7A}; pg8::StaticOrderR S; S.init(NTOK, INW, G, c); S.ssq = fuse1 ? (const float*)(ws + WS_SSQ) : nullptr; S.tab = (LAS float*)(lds + LDS_MISC + 1024); S.wid = wid_s;
            EpiIn E{(bf16_t*)(ws + WS_Q), (bf16_t*)(ws + WS_K), (bf16_t*)(ws + WS_VRAW), (bf16_t*)(ws + WS_G), fuse1 ? (const LAS float*)(lds + LDS_MISC + 1024) : nullptr};
            if (f8in) RP(2) pg8::gemm_phase<EpiIn, pg8::StaticOrderR, true, true, true>(lds + LDS_SCR, g, S, E, OTID());
            else RP(2) pg8::gemm_phase<EpiIn, pg8::StaticOrderR, true, true, false>(lds + LDS_SCR, g, S, E, OTID());
            SEAM(); }
        if (PM(3) && RUN(base + 2)) { phase_qkvprep(P, L, lds, OTID()); SEAM(); }
        if (PM(4) && RUN(base + 3)) { RP(4) phase_attn(P, L, lds, OTID()); SEAM(); }
        if (PM(5) && RUN(base + 4)) {
            pg8::Gemm g{(const bf16_t*)(ws + WS_OALL), (const bf16_t*)(ws + WS_W_BR) + (size_t)L * 1024 * 768, 768, 0}; pg8::StaticOrder S; S.init(NTOK, 1024, G, c);
            EpiGate E{(const unsigned char*)(ws + WS_G), (bf16_t*)(ws + WS_MERGED)};
            RP(5) pg8::gemm_phase<EpiGate, pg8::StaticOrder, true, true>(lds + LDS_SCR, g, S, E, OTID());
            SEAM(); }
        if (PM(6) && RUN(base + 5)) {
            pg8::Gemm g{(const bf16_t*)(ws + WS_MERGED), (const bf16_t*)(ws + WS_W_OUT) + (size_t)L * 1024 * 1024, 1024, 0}; pg8::StaticOrder S; S.init(NTOK, 1024, G, c);
            const bool fuse2 = FUSE_NORM && !moe;
            EpiResidN E{xcur, P.out, fuse2 ? (unsigned char*)H : nullptr, (float*)(ws + WS_SSQ), (int)((F8_FFN >> (L >> 1)) & 1)};
            pg8::gemm_phase<EpiResidN, pg8::StaticOrder, true, true>(lds + LDS_SCR, g, S, E, OTID());
            SEAM(); }
        if (!moe) {
            const int di = L >> 1; const bool f8d = ((F8_FFN >> di) & 1) != 0;
            if (PM(7) && RUN(base + 6) && !FUSE_NORM) {
                if (f8d) RP(7) phase_norm<false, false, true>(P.out, nullptr, nullptr, gains + 1024, H, nullptr, nullptr, nullptr, nullptr, nullptr, lds, OTID());
                else RP(7) phase_norm<false, false, false>(P.out, nullptr, nullptr, gains + 1024, H, nullptr, nullptr, nullptr, nullptr, nullptr, lds, OTID());
                SEAM(); }
            if (PM(8) && RUN(base + 7)) {
                pg8::StaticOrderR S; S.init(NTOK, 2 * FF, G, c); S.ssq = FUSE_NORM ? (const float*)(ws + WS_SSQ) : nullptr; S.tab = (LAS float*)(lds + LDS_MISC + 1024); S.wid = wid_s;
                if (f8d) { pg8::Gemm g{H, (const bf16_t*)(ws + WS_W_FGU + (size_t)di * 2 * FF * 1024 * 2), 512, 0x7A7A7A7A}; EpiSwiglu<true> E{(unsigned char*)ACT, FF, FUSE_NORM ? (const LAS float*)(lds + LDS_MISC + 1024) : nullptr};
                    RP(8) pg8::gemm_phase<EpiSwiglu<true>, pg8::StaticOrderR, true, true, true>(lds + LDS_SCR, g, S, E, OTID()); }
                else { pg8::Gemm g{H, (const bf16_t*)(ws + WS_W_FGU + (size_t)di * 2 * FF * 1024 * 2), 1024, 0}; EpiSwiglu<false> E{(unsigned char*)ACT, FF, FUSE_NORM ? (const LAS float*)(lds + LDS_MISC + 1024) : nullptr};
                    RP(8) pg8::gemm_phase<EpiSwiglu<false>, pg8::StaticOrderR, true, true, false>(lds + LDS_SCR, g, S, E, OTID()); }
                SEAM(); }
            if (PM(9) && RUN(base + 8)) {
                pg8::StaticOrder S; S.init(NTOK, 1024, G, c); EpiResidN E{P.out, P.out, FUSE_NORM ? (unsigned char*)H : nullptr, (float*)(ws + WS_SSQ), (int)((F8_IN >> (L + 1)) & 1)};
                if (f8d) { pg8::Gemm g{ACT, (const bf16_t*)(ws + WS_W_FDN + (size_t)di * 1024 * FF * 2), FF / 2, 0x79797979};
                    pg8::gemm_phase<EpiResidN, pg8::StaticOrder, true, true, true>(lds + LDS_SCR, g, S, E, OTID()); }
                else { pg8::Gemm g{ACT, (const bf16_t*)(ws + WS_W_FDN + (size_t)di * 1024 * FF * 2), FF, 0};
                    pg8::gemm_phase<EpiResidN, pg8::StaticOrder, true, true, false>(lds + LDS_SCR, g, S, E, OTID()); }
                SEAM(); }
        } else {
            const int li = L >> 1;
            const bool f8 = ((F8_MOE >> li) & 1) != 0;
            if (PM(10) && RUN(base + 6)) {
                if (f8) RP(10) phase_norm<false, true, true>(P.out, nullptr, nullptr, gains + 1024, H, P.in[9] + (size_t)li * 1024 * 8, topi, topw, cnt, perm, lds, OTID());
                else RP(10) phase_norm<false, true, false>(P.out, nullptr, nullptr, gains + 1024, H, P.in[9] + (size_t)li * 1024 * 8, topi, topw, cnt, perm, lds, OTID());
                SEAM(); }
            if (PM(11) && RUN(base + 7)) {
                if (f8) RP(11) phase_scatter<true>(cnt, topi, topw, H, XS, perm, rgate, lds, OTID());
                else RP(11) phase_scatter<false>(cnt, topi, topw, H, XS, perm, rgate, lds, OTID());
                SEAM(); }
            if ((PM(12) || PM(13)) && (RUN(base + 8) || RUN(base + 9))) {
                volatile LAS int* misc = (volatile LAS int*)(lds + LDS_MISC + 64);
                moe_totals(cnt, misc, OTID());
                pg8::GroupedOrder S; S.c8 = c & 7; S.loc = c >> 3; S.per = G >> 3;
                S.tp[0] = 0;
#pragma unroll
                for (int e = 0; e < 8; ++e) S.tp[e + 1] = S.tp[e] + ((__builtin_amdgcn_readfirstlane(misc[e]) + 255) >> 8);
                if (PM(12) && RUN(base + 8)) {
                    S.nN = 2 * ED / 256; S.cb = 7;
                    if (f8) { S.bstride = (long)2 * ED * 1024;
                        pg8::Gemm g{XS, (const bf16_t*)(ws + WS_W_MGU + (size_t)li * 8 * 2 * ED * 1024 * 2), 512, 0x7A7A7A7A};
                        EpiSwiglu<true> E{(unsigned char*)ACT, ED, nullptr};
                        RP(12) pg8::gemm_phase<EpiSwiglu<true>, pg8::GroupedOrder, true, true, true>(lds + LDS_SCR, g, S, E, OTID()); }
                    else { S.bstride = (long)2 * ED * 1024 * 2;
                        pg8::Gemm g{XS, (const bf16_t*)(ws + WS_W_MGU + (size_t)li * 8 * 2 * ED * 1024 * 2), 1024, 0};
                        EpiSwiglu<false> E{(unsigned char*)ACT, ED, nullptr};
                        RP(12) pg8::gemm_phase<EpiSwiglu<false>, pg8::GroupedOrder, true, true, false>(lds + LDS_SCR, g, S, E, OTID()); }
                    SEAM(); }
                if (PM(13) && RUN(base + 9)) {
                    S.nN = 4; S.cb = 4;
                    EpiMoeDown E{perm, rgate, YB};
                    if (f8) { S.bstride = (long)1024 * ED;
                        pg8::Gemm g{ACT, (const bf16_t*)(ws + WS_W_MDN + (size_t)li * 8 * 1024 * ED * 2), ED / 2, 0x79797979};
                        RP(13) pg8::gemm_phase<EpiMoeDown, pg8::GroupedOrder, true, true, true>(lds + LDS_SCR, g, S, E, OTID()); }
                    else { S.bstride = (long)1024 * ED * 2;
                        pg8::Gemm g{ACT, (const bf16_t*)(ws + WS_W_MDN + (size_t)li * 8 * 1024 * ED * 2), ED, 0};
                        RP(13) pg8::gemm_phase<EpiMoeDown, pg8::GroupedOrder, true, true, false>(lds + LDS_SCR, g, S, E, OTID()); }
                    SEAM(); }
            }
        }
    }
    if (PM(14) && RUN(41)) phase_final(P.out, YB, P.out, OTID());
#if TSEL >= 0
    xcd_barrier(bar, OTID()); TSTAMP();
    if (blockIdx.x == 0 && OTID() == 0) { asm volatile("s_waitcnt vmcnt(0)" ::: "memory"); const unsigned long long d = tsb[TSEL + 1] - tsb[TSEL]; P.out[0] += (float)d * (0.01f * 0.25f); }
#endif
#undef RUN
#undef SEAM
#undef P
#undef ws
#undef H
#undef YB
#undef ACT
#undef XS
#undef topi
#undef topw
#undef perm
#undef rgate
#undef cnt
#undef G
#undef c
}

#if MK_DEBUG
DI unsigned hsh(unsigned x) { x ^= x >> 16; x *= 0x7feb352du; x ^= x >> 15; x *= 0x846ca68bu; x ^= x >> 16; return x; }
DI void rep(unsigned* ctl, int slot, float got, float ref, float scale) { float e = fabsf(got - ref) / (fabsf(ref) + scale); if (!(e == e) || e > 1e30f) e = 1e30f; atomicMax(ctl + CW_ERR + slot, __float_as_uint(e)); }
DI float dotbf(const bf16_t* a, const bf16_t* b, int K, int lane) { float s = 0.f; for (int k = lane; k < K; k += 64) s += bf2f(a[k]) * bf2f(b[k]); return wave_sum(s); }
DI float rbf(float x) { return bflo(pk2(x, 0.f) & 0xffffu); }

__global__ void chk_prep(Args a) {
    unsigned* ctl = (unsigned*)a.ws; const unsigned h0 = hsh(blockIdx.x * 64 + threadIdx.x + 1);
    unsigned h = h0;
#define NXT() (h = hsh(h + 0x9e3779b9u))
    { const int L = NXT() % 4, n = NXT() % 5632, k = NXT() % 1024; rep(ctl, 0, bf2f(((const bf16_t*)(a.ws + WS_W_IN))[((size_t)L * 5632 + n) * 1024 + k]), rbf(a.in[2][((size_t)L * 1024 + k) * 5632 + n]), 1e-3f); }
    { const int L = NXT() % 4, n = NXT() % 1024, k = NXT() % 768; rep(ctl, 0, bf2f(((const bf16_t*)(a.ws + WS_W_BR))[((size_t)L * 1024 + n) * 768 + k]), rbf(a.in[5][((size_t)L * 768 + k) * 1024 + n]), 1e-3f); }
    { const int L = NXT() % 4, n = NXT() % 1024, k = NXT() % 1024; rep(ctl, 0, bf2f(((const bf16_t*)(a.ws + WS_W_OUT))[((size_t)L * 1024 + n) * 1024 + k]), rbf(a.in[6][((size_t)L * 1024 + k) * 1024 + n]), 1e-3f); }
    { const int L = NXT() % 2, n = NXT() % 5632, k = NXT() % 1024, pn = n >> 8, j = n & 255, cc = j < 128 ? pn * 128 + j : FF + pn * 128 + j - 128;
      rep(ctl, 0, bf2f(((const bf16_t*)(a.ws + WS_W_FGU))[((size_t)L * 5632 + n) * 1024 + k]), rbf(a.in[7][((size_t)L * 1024 + k) * 5632 + cc]), 1e-3f); }
    { const int L = NXT() % 2, n = NXT() % 1024, k = NXT() % 2816; rep(ctl, 0, bf2f(((const bf16_t*)(a.ws + WS_W_FDN))[((size_t)L * 1024 + n) * 2816 + k]), rbf(a.in[8][((size_t)L * 2816 + k) * 1024 + n]), 1e-3f); }
    { const int L = NXT() % 16, n = NXT() % 7168, k = NXT() % 1024, pn = n >> 8, j = n & 255, cc = j < 128 ? pn * 128 + j : ED + pn * 128 + j - 128;
      rep(ctl, 0, bf2f(((const bf16_t*)(a.ws + WS_W_MGU))[((size_t)L * 7168 + n) * 1024 + k]), rbf(a.in[10][((size_t)L * 1024 + k) * 7168 + cc]), 1e-3f); }
    { const int L = NXT() % 16, n = NXT() % 1024, k = NXT() % 3584; rep(ctl, 0, bf2f(((const bf16_t*)(a.ws + WS_W_MDN))[((size_t)L * 1024 + n) * 3584 + k]), rbf(a.in[11][((size_t)L * 3584 + k) * 1024 + n]), 1e-3f); }
#undef NXT
}
__global__ void chk_norm(Args a, const float* xin, const float* gain, int comb, int slot) {
    unsigned* ctl = (unsigned*)a.ws; const int lane = threadIdx.x; const int row = blockIdx.x == 0 ? 0 : (blockIdx.x == 1 ? NTOK - 1 : hsh(blockIdx.x * 7 + slot) % NTOK);
    const bf16_t* H = (const bf16_t*)(a.ws + WS_H); const bf16_t* yb = (const bf16_t*)(a.ws + WS_YBUF);
    float v[16], ss = 0.f;
    for (int j = 0; j < 16; ++j) { const int cidx = lane + 64 * j; float x = xin[(size_t)row * 1024 + cidx];
        if (comb) { x += bf2f(yb[(size_t)row * 1024 + cidx]) + bf2f(yb[((size_t)NTOK + row) * 1024 + cidx]); rep(ctl, slot, a.out[(size_t)row * 1024 + cidx], x, 1e-2f); }
        v[j] = x; ss += x * x; }
    const float rstd = 1.f / sqrtf(wave_sum(ss) / 1024.f + EPS);
    for (int j = 0; j < 16; ++j) { const int cidx = lane + 64 * j; rep(ctl, slot, bf2f(H[(size_t)row * 1024 + cidx]), v[j] * rstd * gain[cidx], 2e-2f); }
}
__global__ void chk_gemm_in(Args a, int L) {
    unsigned* ctl = (unsigned*)a.ws; const int lane = threadIdx.x; unsigned h = hsh(blockIdx.x + 77 * L + 5);
    const int row = blockIdx.x < 4 ? (blockIdx.x & 1 ? NTOK - 1 : 0) : h % NTOK; h = hsh(h + 1); const int col = blockIdx.x < 2 ? 0 : (blockIdx.x < 4 ? INW - 1 : h % INW);
    const float d = dotbf((const bf16_t*)(a.ws + WS_H) + (size_t)row * 1024, (const bf16_t*)(a.ws + WS_W_IN) + ((size_t)L * INW + col) * 1024, 1024, lane);
    float got;
    if (col < 1024) got = bf2f(((const bf16_t*)(a.ws + WS_Q))[(size_t)row * 1024 + col]);
    else if (col < 1792) got = bf2f(((const bf16_t*)(a.ws + WS_K))[(size_t)row * 768 + col - 1024]);
    else if (col < 2560) got = bf2f(((const bf16_t*)(a.ws + WS_VRAW))[(size_t)row * 768 + col - 1792]);
    else got = ((float)((const unsigned char*)(a.ws + WS_G))[(size_t)row * 3072 + col - 2560] + 0.5f) * (1.f / 256.f);
    const float ref = col < 2560 ? d : 1.f / (1.f + expf(-d));
    if (lane == 0) rep(ctl, 2, got, ref, 5e-2f);
}
__global__ void chk_qk(Args a, int L) {
    unsigned* ctl = (unsigned*)a.ws; const int j = threadIdx.x; unsigned h = hsh(blockIdx.x + 131 * L + 9);
    const int tok = blockIdx.x == 0 ? 0 : (blockIdx.x == 1 ? NTOK - 1 : h % NTOK); h = hsh(h + 1); const int isk = 1; h = hsh(h + 1); const int head = h % 12;
    const int col = (isk ? 1024 : 0) + head * 64 + j;
    const bf16_t* hr = (const bf16_t*)(a.ws + WS_H) + (size_t)tok * 1024; const bf16_t* wr = (const bf16_t*)(a.ws + WS_W_IN) + ((size_t)L * INW + col) * 1024;
    float d = 0.f; for (int k = 0; k < 1024; ++k) d += bf2f(hr[k]) * bf2f(wr[k]);
    d = rbf(d);
    const float rstd = 1.f / sqrtf(wave_sum(d * d) / 64.f + EPS);
    const int br = isk ? (head < 4 ? 0 : (head < 6 ? 1 : 2)) : (head < 4 ? 0 : (head < 10 ? 1 : 2));
    const float y = d * rstd * a.in[3][((size_t)(L * 3 + br) * 2 + isk) * 64 + j];
    const int s = tok & 4095; float o = y;
    if (br == 2) { const int i = j & 31; const float ang = (float)s * powf(10000.f, -(float)(2 * i) / 64.f); const float p = __shfl_xor(y, 32); o = j < 32 ? y * cosf(ang) - p * sinf(ang) : y * cosf(ang) + p * sinf(ang); }
    if (br == 1) { const int i = j & 15; const float pos = (float)((j < 32) ? (s >> 6) : (s & 63)); const float ang = pos * powf(10000.f, -(float)(2 * i) / 32.f); const float p = __shfl_xor(y, 16);
        o = (j & 16) == 0 ? y * cosf(ang) - p * sinf(ang) : y * cosf(ang) + p * sinf(ang); }
    if (!isk) o *= QSCALE;
    const float got = isk ? bf2f(((const bf16_t*)(a.ws + WS_K))[(size_t)tok * 768 + head * 64 + j]) : bf2f(((const bf16_t*)(a.ws + WS_Q))[(size_t)tok * 1024 + head * 64 + j]);
    rep(ctl, 3, got, o, 3e-2f);
}
__global__ void chk_vt(Args a) {
    unsigned* ctl = (unsigned*)a.ws; unsigned h = hsh(blockIdx.x * 64 + threadIdx.x + 3);
    const int b = h % 8; h = hsh(h + 1); const int hv = h % 12; h = hsh(h + 1); const int d = h % 64; h = hsh(h + 1); const int s = h % 4096;
    const int g = hv < 6 ? 0 : (hv - 6) >> 1, dd = 1 << (2 * g), Sd = 4096 / dd, pos = (s % dd) * Sd + s / dd;
    rep(ctl, 4, bf2f(((const bf16_t*)(a.ws + WS_VT))[((size_t)(b * 12 + hv) * 64 + d) * 4096 + pos]), bf2f(((const bf16_t*)(a.ws + WS_VRAW))[(size_t)(b * 4096 + s) * 768 + hv * 64 + d]), 1e-3f);
}
DI float dot64(const bf16_t* x, const bf16_t* y) { float s = 0.f; for (int k = 0; k < 64; ++k) s += bf2f(x[k]) * bf2f(y[k]); return s; }
DI float dot64q(const float* x, const bf16_t* y) { float s = 0.f; for (int k = 0; k < 64; ++k) s += x[k] * bf2f(y[k]); return s; }
DI float chk_qn(const Args& a, int L, int tok, int head, int t) {
    const float d = bf2f(((const bf16_t*)(a.ws + WS_Q))[(size_t)tok * 1024 + head * 64 + t]);
    const float rstd = 1.f / sqrtf(wave_sum(d * d) / 64.f + EPS);
    const int br = head < 4 ? 0 : (head < 10 ? 1 : 2);
    const float y = d * rstd * a.in[3][((size_t)(L * 3 + br) * 2 + 0) * 64 + t];
    const int s = tok & 4095; float o = y;
    if (br == 2) { const int i = t & 31; const float ang = (float)s * powf(10000.f, -(float)(2 * i) / 64.f); const float p = __shfl_xor(y, 32); o = t < 32 ? y * cosf(ang) - p * sinf(ang) : y * cosf(ang) + p * sinf(ang); }
    if (br == 1) { const int i = t & 15; const float pos = (float)((t < 32) ? (s >> 6) : (s & 63)); const float ang = pos * powf(10000.f, -(float)(2 * i) / 32.f); const float p = __shfl_xor(y, 16);
        o = (t & 16) == 0 ? y * cosf(ang) - p * sinf(ang) : y * cosf(ang) + p * sinf(ang); }
    return rbf(o * QSCALE);
}
__global__ void chk_na(Args a, int L) {
    __shared__ float p[128]; __shared__ float qn[64]; unsigned* ctl = (unsigned*)a.ws; const int t = threadIdx.x; unsigned h = hsh(blockIdx.x + 31 * L + 11);
    const int tok = blockIdx.x == 0 ? 0 : (blockIdx.x == 1 ? NTOK - 1 : h % NTOK); h = hsh(h + 1); const int hd = h % 4;
    const int b = tok >> 12, s = tok & 4095, gr = s >> 6, cq = s & 63, rs = min(max(gr - 4, 0), 56), cs = min(max(cq - 8, 0), 48);
    const bf16_t* Kb = (const bf16_t*)(a.ws + WS_K); const bf16_t* V = (const bf16_t*)(a.ws + WS_VRAW);
    qn[t] = chk_qn(a, L, tok, hd, t); __syncthreads();
    float mx = -1e30f;
    for (int q = 0; q < 2; ++q) { const int idx = t + 64 * q, kr = rs + idx / 16, ck = cs + idx % 16, kt = b * 4096 + kr * 64 + ck;
        const float sc = dot64q(qn, Kb + (size_t)kt * 768 + hd * 64) + LOG2E * a.in[4][(((size_t)L * 4 + hd) * 15 + (kr - gr + 7)) * 31 + (ck - cq + 15)];
        p[idx] = sc; mx = fmaxf(mx, sc); }
    for (int o = 1; o < 64; o <<= 1) mx = fmaxf(mx, __shfl_xor(mx, o));
    __syncthreads();
    float sum = 0.f, acc = 0.f;
    for (int idx = 0; idx < 128; ++idx) { const int kr = rs + idx / 16, ck = cs + idx % 16, kt = b * 4096 + kr * 64 + ck; const float e = exp2f(p[idx] - mx); sum += e; acc += e * bf2f(V[(size_t)kt * 768 + hd * 64 + t]); }
    rep(ctl, 5, bf2f(((const bf16_t*)(a.ws + WS_OALL))[(size_t)tok * 768 + hd * 64 + t]), acc / sum, 3e-2f);
}
__global__ void chk_dil(Args a, int L) {
    __shared__ float p[3][192]; __shared__ float qn[3][64]; unsigned* ctl = (unsigned*)a.ws; const int t = threadIdx.x; unsigned h = hsh(blockIdx.x + 37 * L + 13);
    const int tok = blockIdx.x == 0 ? 0 : (blockIdx.x == 1 ? NTOK - 1 : (blockIdx.x == 2 ? 4095 : (blockIdx.x == 3 ? 4096 + 70 : h % NTOK))); h = hsh(h + 1); const int hs = h & 1;
    const int b = tok >> 12, s = tok & 4095;
    const bf16_t* Kb = (const bf16_t*)(a.ws + WS_K); const bf16_t* V = (const bf16_t*)(a.ws + WS_VRAW);
    for (int g = 0; g < 3; ++g) qn[g][t] = chk_qn(a, L, tok, 10 + 2 * g + hs, t);
    __syncthreads();
    float lse[3], og[3];
    for (int g = 0; g < 3; ++g) { const int dd = 1 << (2 * g), hq = 10 + 2 * g + hs, hk = 6 + 2 * g + hs; float mx = -1e30f;
        for (int q = 0; q < 3; ++q) { const int idx = t + 64 * q; if (idx < 129) { const int pos = s + dd * (idx - 64); float sc = -1e30f;
            if (pos >= 0 && pos < 4096) sc = dot64q(qn[g], Kb + (size_t)(b * 4096 + pos) * 768 + hk * 64);
            p[g][idx] = sc; mx = fmaxf(mx, sc); } }
        for (int o = 1; o < 64; o <<= 1) mx = fmaxf(mx, __shfl_xor(mx, o));
        __syncthreads();
        float sum = 0.f, acc = 0.f;
        for (int idx = 0; idx < 129; ++idx) { const int pos = s + dd * (idx - 64); if (pos >= 0 && pos < 4096) { const float e = exp2f(p[g][idx] - mx); sum += e; acc += e * bf2f(V[(size_t)(b * 4096 + pos) * 768 + hk * 64 + t]); } }
        lse[g] = mx + log2f(sum); og[g] = acc / sum; }
    const float M = fmaxf(lse[0], fmaxf(lse[1], lse[2])); const float w0 = exp2f(lse[0] - M), w1 = exp2f(lse[1] - M), w2 = exp2f(lse[2] - M);
    rep(ctl, 6, bf2f(((const bf16_t*)(a.ws + WS_OALL))[(size_t)tok * 768 + 640 + hs * 64 + t]), (w0 * og[0] + w1 * og[1] + w2 * og[2]) / (w0 + w1 + w2), 3e-2f);
}
__global__ void chk_gqa(Args a, int L) {
    __shared__ float p[4096]; __shared__ float qn[64]; unsigned* ctl = (unsigned*)a.ws; const int t = threadIdx.x; unsigned h = hsh(blockIdx.x + 41 * L + 17);
    const int tok = blockIdx.x == 0 ? 0 : (blockIdx.x == 1 ? NTOK - 1 : h % NTOK); h = hsh(h + 1); const int hq = h % 6, kvh = hq / 3, b = tok >> 12;
    const bf16_t* Kb = (const bf16_t*)(a.ws + WS_K); const bf16_t* V = (const bf16_t*)(a.ws + WS_VRAW);
    qn[t] = chk_qn(a, L, tok, 4 + hq, t); __syncthreads();
    float mx = -1e30f;
    for (int k = t; k < 4096; k += 64) { const float sc = dot64q(qn, Kb + (size_t)(b * 4096 + k) * 768 + (4 + kvh) * 64); p[k] = sc; mx = fmaxf(mx, sc); }
    for (int o = 1; o < 64; o <<= 1) mx = fmaxf(mx, __shfl_xor(mx, o));
    __syncthreads();
    float sum = 0.f, acc = 0.f;
    for (int k = 0; k < 4096; ++k) { const float e = exp2f(p[k] - mx); sum += e; acc += e * bf2f(V[(size_t)(b * 4096 + k) * 768 + (4 + kvh) * 64 + t]); }
    rep(ctl, 7, bf2f(((const bf16_t*)(a.ws + WS_OALL))[(size_t)tok * 768 + 256 + hq * 64 + t]), acc / sum, 3e-2f);
}
__global__ void chk_gate(Args a, int L) {
    unsigned* ctl = (unsigned*)a.ws; const int lane = threadIdx.x; unsigned h = hsh(blockIdx.x + 43 * L + 19);
    const int row = blockIdx.x < 2 ? (blockIdx.x ? NTOK - 1 : 0) : h % NTOK; h = hsh(h + 1); const int col = blockIdx.x < 2 ? (blockIdx.x ? 1023 : 0) : h % 1024;
    const bf16_t* orow = (const bf16_t*)(a.ws + WS_OALL) + (size_t)row * 768; const bf16_t* wrow = (const bf16_t*)(a.ws + WS_W_BR) + ((size_t)L * 1024 + col) * 768;
    const float ya = dotbf(orow, wrow, 256, lane), yb = dotbf(orow + 256, wrow + 256, 384, lane), yc = dotbf(orow + 640, wrow + 640, 128, lane);
    const unsigned char* G = (const unsigned char*)(a.ws + WS_G) + (size_t)row * 3072;
    const float ref = (((float)G[col] + 0.5f) * ya + ((float)G[1024 + col] + 0.5f) * yb + ((float)G[2048 + col] + 0.5f) * yc) * (1.f / 256.f);
    if (lane == 0) rep(ctl, 8, bf2f(((const bf16_t*)(a.ws + WS_MERGED))[(size_t)row * 1024 + col]), ref, 5e-2f);
}
__global__ void chk_resid(Args a, const float* xold, const bf16_t* A, const bf16_t* Bt, int K, int slot) {
    unsigned* ctl = (unsigned*)a.ws; const int lane = threadIdx.x; unsigned h = hsh(blockIdx.x + 47 * slot + 23);
    const int row = blockIdx.x < 2 ? (blockIdx.x ? NTOK - 1 : 0) : h % NTOK; h = hsh(h + 1); const int col = blockIdx.x < 2 ? (blockIdx.x ? 1023 : 0) : h % 1024;
    const float d = dotbf(A + (size_t)row * K, Bt + (size_t)col * K, K, lane);
    if (lane == 0) rep(ctl, slot, a.out[(size_t)row * 1024 + col], xold[(size_t)row * 1024 + col] + d, 5e-2f);
}
__global__ void chk_router(Args a, const float* gain, const float* wr) {
    unsigned* ctl = (unsigned*)a.ws; const int lane = threadIdx.x; const int row = blockIdx.x == 0 ? 0 : (blockIdx.x == 1 ? NTOK - 1 : hsh(blockIdx.x + 29) % NTOK);
    float v[16], ss = 0.f;
    for (int j = 0; j < 16; ++j) { v[j] = a.out[(size_t)row * 1024 + lane + 64 * j]; ss += v[j] * v[j]; }
    const float rstd = 1.f / sqrtf(wave_sum(ss) / 1024.f + EPS);
    float lg[8];
    for (int e = 0; e < 8; ++e) { float s = 0.f; for (int j = 0; j < 16; ++j) { const int k = lane + 64 * j; s += v[j] * rstd * gain[k] * wr[k * 8 + e]; } lg[e] = wave_sum(s); }
    int e0 = 0; for (int e = 1; e < 8; ++e) if (lg[e] > lg[e0]) e0 = e;
    int e1 = e0 == 0 ? 1 : 0; for (int e = 0; e < 8; ++e) if (e != e0 && lg[e] > lg[e1]) e1 = e;
    float third = -1e30f; for (int e = 0; e < 8; ++e) if (e != e0 && e != e1) third = fmaxf(third, lg[e]);
    const int* topi = (const int*)(a.ws + WS_TOPI); const float* topw = (const float*)(a.ws + WS_TOPW);
    if (lane == 0) { const bool clear = (lg[e0] - lg[e1] > 1e-3f) && (lg[e1] - third > 1e-3f);
        if (clear) { rep(ctl, 13, (float)topi[row * 2], (float)e0, 1e-3f); rep(ctl, 13, (float)topi[row * 2 + 1], (float)e1, 1e-3f);
            const float t = expf(lg[e1] - lg[e0]); rep(ctl, 13, topw[row * 2], 1.f / (1.f + t), 1e-2f); rep(ctl, 13, topw[row * 2 + 1], t / (1.f + t), 1e-2f); } }
}
__global__ void chk_up(Args a, const bf16_t* A, const bf16_t* Wt, int ffd, int slot) {
    unsigned* ctl = (unsigned*)a.ws; const int lane = threadIdx.x; unsigned h = hsh(blockIdx.x + 53 * slot + 3);
    const int row = blockIdx.x < 2 ? (blockIdx.x ? NTOK - 1 : 0) : h % NTOK; h = hsh(h + 1); const int j = blockIdx.x < 2 ? (blockIdx.x ? ffd - 1 : 0) : h % ffd;
    const int pn = j >> 7, jj = j & 127;
    const float g = dotbf(A + (size_t)row * 1024, Wt + (size_t)(256 * pn + jj) * 1024, 1024, lane), u = dotbf(A + (size_t)row * 1024, Wt + (size_t)(256 * pn + 128 + jj) * 1024, 1024, lane);
    if (lane == 0) rep(ctl, slot, bf2f(((const bf16_t*)(a.ws + WS_ACT))[(size_t)row * ffd + j]), g / (1.f + expf(-g)) * u, 3e-2f);
}
__global__ void chk_scatter(Args a) {
    unsigned* ctl = (unsigned*)a.ws; const int lane = threadIdx.x; const int* cnt = (const int*)(a.ws + WS_CNT); const int* perm = (const int*)(a.ws + WS_PERM);
    const int* topi = (const int*)(a.ws + WS_TOPI); const float* topw = (const float*)(a.ws + WS_TOPW); const float* rg = (const float*)(a.ws + WS_RGATE);
    int tot[8], base[9]; base[0] = 0;
    for (int e = 0; e < 8; ++e) { int s = 0; for (int w = lane; w < 256; w += 64) s += cnt[w * 8 + e]; for (int o = 1; o < 64; o <<= 1) s += __shfl_xor(s, o); tot[e] = s; base[e + 1] = base[e] + ((s + 255) >> 8 << 8); }
    if (blockIdx.x == 0) { int sum = 0; for (int e = 0; e < 8; ++e) sum += tot[e]; if (lane == 0) rep(ctl, 14, (float)sum, 65536.f, 1e-3f);
        unsigned long long cs = 0; int nv = 0; for (int i = lane; i < MROWS; i += 64) { const int p = perm[i]; if (p >= 0) { cs += (unsigned long long)p; ++nv; } }
        for (int o = 1; o < 64; o <<= 1) { cs += __shfl_xor(cs, o); nv += __shfl_xor(nv, o); }
        if (lane == 0) { rep(ctl, 14, (float)nv, 65536.f, 1e-3f); rep(ctl, 14, (float)(cs == 65536ull * 65535ull / 2ull), 1.f, 1e-3f); } }
    const int pos = hsh(blockIdx.x + 5) % MROWS; const int p = perm[pos];
    int e = 0; for (int k = 1; k < 8; ++k) e += pos >= base[k];
    const bool inr = pos < base[e] + tot[e];
    if (lane == 0) rep(ctl, 14, (float)(p >= 0), (float)inr, 1e-3f);
    if (p >= 0 && inr) { const int tok = p >> 1, slot = p & 1;
        if (lane == 0) { rep(ctl, 14, (float)topi[tok * 2 + slot], (float)e, 1e-3f); rep(ctl, 14, rg[pos], topw[tok * 2 + slot], 1e-3f); }
        for (int j = 0; j < 16; ++j) rep(ctl, 14, bf2f(((const bf16_t*)(a.ws + WS_XS))[(size_t)pos * 1024 + lane + 64 * j]), bf2f(((const bf16_t*)(a.ws + WS_H))[(size_t)tok * 1024 + lane + 64 * j]), 1e-3f); }
}
__global__ void chk_moe(Args a, int li, int down) {
    unsigned* ctl = (unsigned*)a.ws; const int lane = threadIdx.x; const int* perm = (const int*)(a.ws + WS_PERM); const int* topi = (const int*)(a.ws + WS_TOPI); const float* rg = (const float*)(a.ws + WS_RGATE);
    unsigned h = hsh(blockIdx.x + 59 * down + 7); int pos = h % MROWS; while (perm[pos] < 0) pos = (pos + 1) % MROWS;
    const int p = perm[pos], tok = p >> 1, slot = p & 1, e = topi[tok * 2 + slot]; h = hsh(h + 1);
    if (!down) { const int j = h % ED, pn = j >> 7, jj = j & 127; const bf16_t* Wt = (const bf16_t*)(a.ws + WS_W_MGU) + (size_t)(li * 8 + e) * 2 * ED * 1024; const bf16_t* A = (const bf16_t*)(a.ws + WS_XS) + (size_t)pos * 1024;
        const float g = dotbf(A, Wt + (size_t)(256 * pn + jj) * 1024, 1024, lane), u = dotbf(A, Wt + (size_t)(256 * pn + 128 + jj) * 1024, 1024, lane);
        if (lane == 0) rep(ctl, 15, bf2f(((const bf16_t*)(a.ws + WS_ACT))[(size_t)pos * ED + j]), g / (1.f + expf(-g)) * u, 3e-2f); }
    else { const int col = h % 1024; const float d = dotbf((const bf16_t*)(a.ws + WS_ACT) + (size_t)pos * ED, (const bf16_t*)(a.ws + WS_W_MDN) + ((size_t)(li * 8 + e) * 1024 + col) * ED, ED, lane);
        if (lane == 0) rep(ctl, 16, bf2f(((const bf16_t*)(a.ws + WS_YBUF))[((size_t)slot * NTOK + tok) * 1024 + col]), rg[pos] * d, 3e-2f); }
}
__global__ void chk_final(Args a, const float* xold) {
    unsigned* ctl = (unsigned*)a.ws; const size_t i = hsh(blockIdx.x * 64 + threadIdx.x + 9) % ((size_t)NTOK * 1024); const bf16_t* yb = (const bf16_t*)(a.ws + WS_YBUF);
    rep(ctl, 18, a.out[i], xold[i] + bf2f(yb[i]) + bf2f(yb[(size_t)NTOK * 1024 + i]), 1e-2f);
}
__global__ void chk_report(Args a) {
    const unsigned* ctl = (const unsigned*)a.ws; int code = -1;
    for (int s = 18; s >= 0; --s) { const float e = __uint_as_float(ctl[CW_ERR + s]); const float tol = (s == 0 || s == 4 || s == 14) ? 1e-3f : 0.08f; if (e > tol) code = s; }
    if (code >= 0) { float v = 10.f; for (int k = 0; k < code; ++k) v *= 10.f;
        for (size_t i = (size_t)blockIdx.x * blockDim.x + threadIdx.x; i < (size_t)NTOK * 1024; i += (size_t)gridDim.x * blockDim.x) a.out[i] = v; }
}
#endif

extern "C" void kernel_launch(void* const* d_in, const int* in_sizes, int n_in, void* d_out, int out_size, void* d_ws, size_t ws_size, hipStream_t stream) {
    static int ready = 0;
    if (ready == 0) {
        ready = -1;
        if (n_in != 12 || out_size != NTOK * 1024 || ws_size < WS_END + (MK_DEBUG ? (size_t)128 * MiB : 0)) { fprintf(stderr, "kernel_launch: unexpected shapes / workspace (%d inputs, out %d, ws %zu)\n", n_in, out_size, ws_size); return; }
        if (hipFuncSetAttribute((const void*)mk_fwd, hipFuncAttributeMaxDynamicSharedMemorySize, LDS_BYTES) != hipSuccess) { fprintf(stderr, "kernel_launch: hipFuncSetAttribute failed\n"); return; }
        int per_cu = 0; (void)hipOccupancyMaxActiveBlocksPerMultiprocessor(&per_cu, (const void*)mk_fwd, NTHR, LDS_BYTES); (void)hipGetLastError();
        if (per_cu < 1) fprintf(stderr, "kernel_launch: occupancy query says %d blocks per CU\n", per_cu);
        ready = 1;
    }
    if (ready < 0) return;
    (void)hipMemsetAsync((char*)d_ws + WS_CTL, 0, CTL_ZERO_BYTES, stream);
    Args a{};
    for (int i = 0; i < 12; ++i) a.in[i] = (const float*)d_in[i];
    a.out = (float*)d_out; a.ws = (unsigned char*)d_ws;
#if !MK_DEBUG
    a.lo = 0; a.hi = 42;
    hipLaunchKernelGGL(mk_fwd, dim3(NWG), dim3(NTHR), LDS_BYTES, stream, a);
#else
    unsigned char* ws = (unsigned char*)d_ws; float* snap = (float*)(ws + WS_DBG);
    const int NS = 96;
    for (int s = 0; s < 42; ++s) {
        const int L = (s - 1) / 10, k = (s - 1) % 10; const bool moe = (L & 1) != 0;
        if (s >= 1 && s < 41 && !moe && k == 9) continue;
        const bool snapx = (s == 41) || (s >= 1 && s < 41 && ((k == 0 && L == 2) || (k == 8 && !moe) || (k == 5 && L > 0)));
        if (snapx) (void)hipMemcpyAsync(snap, d_out, (size_t)NTOK * 1024 * 4, hipMemcpyDeviceToDevice, stream);
        a.lo = s; a.hi = s + 1;
        hipLaunchKernelGGL(mk_fwd, dim3(NWG), dim3(NTHR), LDS_BYTES, stream, a);
        if (s == 0) { hipLaunchKernelGGL(chk_prep, dim3(64), dim3(64), 0, stream, a); continue; }
        if (s == 41) { hipLaunchKernelGGL(chk_final, dim3(64), dim3(64), 0, stream, a, (const float*)snap); continue; }
        const float* gains = (const float*)d_in[1] + (size_t)L * 2048; const float* xin0 = (const float*)d_in[0];
        switch (k) {
        case 0: hipLaunchKernelGGL(chk_norm, dim3(NS), dim3(64), 0, stream, a, L == 0 ? xin0 : (L == 2 ? (const float*)snap : (const float*)d_out), gains, L == 2 ? 1 : 0, L == 2 ? 17 : 1); break;
        case 1: hipLaunchKernelGGL(chk_gemm_in, dim3(NS), dim3(64), 0, stream, a, L); break;
        case 2: hipLaunchKernelGGL(chk_qk, dim3(NS), dim3(64), 0, stream, a, L); hipLaunchKernelGGL(chk_vt, dim3(NS), dim3(64), 0, stream, a); break;
        case 3: hipLaunchKernelGGL(chk_na, dim3(NS), dim3(64), 0, stream, a, L); hipLaunchKernelGGL(chk_dil, dim3(NS), dim3(64), 0, stream, a, L); hipLaunchKernelGGL(chk_gqa, dim3(32), dim3(64), 0, stream, a, L); break;
        case 4: hipLaunchKernelGGL(chk_gate, dim3(NS), dim3(64), 0, stream, a, L); break;
        case 5: hipLaunchKernelGGL(chk_resid, dim3(NS), dim3(64), 0, stream, a, L == 0 ? xin0 : (const float*)snap, (const bf16_t*)(ws + WS_MERGED), (const bf16_t*)(ws + WS_W_OUT) + (size_t)L * 1024 * 1024, 1024, 9); break;
        case 6: if (!moe) hipLaunchKernelGGL(chk_norm, dim3(NS), dim3(64), 0, stream, a, (const float*)d_out, gains + 1024, 0, 10);
                else { hipLaunchKernelGGL(chk_norm, dim3(NS), dim3(64), 0, stream, a, (const float*)d_out, gains + 1024, 0, 10);
                       hipLaunchKernelGGL(chk_router, dim3(NS), dim3(64), 0, stream, a, gains + 1024, (const float*)d_in[9] + (size_t)(L >> 1) * 8192); } break;
        case 7: if (!moe) hipLaunchKernelGGL(chk_up, dim3(NS), dim3(64), 0, stream, a, (const bf16_t*)(ws + WS_H), (const bf16_t*)(ws + WS_W_FGU) + (size_t)(L >> 1) * 2 * FF * 1024, FF, 11);
                else hipLaunchKernelGGL(chk_scatter, dim3(NS), dim3(64), 0, stream, a); break;
        case 8: if (!moe) hipLaunchKernelGGL(chk_resid, dim3(NS), dim3(64), 0, stream, a, (const float*)snap, (const bf16_t*)(ws + WS_ACT), (const bf16_t*)(ws + WS_W_FDN) + (size_t)(L >> 1) * 1024 * FF, FF, 12);
                else hipLaunchKernelGGL(chk_moe, dim3(NS), dim3(64), 0, stream, a, L >> 1, 0); break;
        case 9: hipLaunchKernelGGL(chk_moe, dim3(NS), dim3(64), 0, stream, a, L >> 1, 1); break;
        }
    }
    hipLaunchKernelGGL(chk_report, dim3(1024), dim3(256), 0, stream, a);
#endif
}
```

```cpp
#include <hip/hip_runtime.h>
#include <cstdint>
#include <cstdio>

#ifndef MK_DEBUG
#define MK_DEBUG 0
#endif

#ifndef PHM
#define PHM 0xFFFFFFFFu
#endif
#define PM(k) ((PHM >> (k)) & 1u)
#ifndef REPM
#define REPM 0u
#endif
#define RP(k) for (int rp_ = 0; rp_ <= (int)((REPM >> (k)) & 1u); ++rp_)
#ifndef F8_IN
#define F8_IN 15
#endif
#ifndef F8_FFN
#define F8_FFN 2
#endif
#ifndef F8_MOE
#define F8_MOE 3
#endif
#ifndef FUSE_NORM
#define FUSE_NORM 1
#endif
#if MK_DEBUG
#undef FUSE_NORM
#define FUSE_NORM 0
#undef F8_IN
#undef F8_FFN
#undef F8_MOE
#define F8_IN 0
#define F8_FFN 0
#define F8_MOE 0
#endif
#ifndef TSEL
#define TSEL -1
#endif
#define DI __device__ __forceinline__
#define LAS __attribute__((address_space(3)))
#define GAS __attribute__((address_space(1)))

typedef unsigned short bf16_t;
typedef short bf16x8 __attribute__((ext_vector_type(8)));
typedef float f32x2 __attribute__((ext_vector_type(2)));
typedef float f32x4 __attribute__((ext_vector_type(4)));
typedef float f32x16 __attribute__((ext_vector_type(16)));
typedef unsigned u32x2 __attribute__((ext_vector_type(2)));
typedef unsigned u32x4 __attribute__((ext_vector_type(4)));
typedef __bf16 bf16x2_t __attribute__((ext_vector_type(2)));

constexpr int NB = 8, SEQ = 4096, DM = 1024, NTOK = NB * SEQ, DEPTH = 4;
constexpr int INW = 5632, FF = 2816, ED = 3584, NE = 8;
constexpr int MROWS = 2 * NTOK + NE * 256;
constexpr float EPS = 1e-6f;
constexpr float QSCALE = 0.125f * 1.4426950408889634f;
constexpr float LOG2E = 1.4426950408889634f;
constexpr int NWG = 256, NTHR = 512;

constexpr size_t MiB = 1u << 20;
constexpr size_t WS_CTL = 0, CTL_ZERO_BYTES = 1 * MiB;
constexpr size_t WS_ROPE1 = 1 * MiB;
constexpr size_t WS_ROPEA = 2 * MiB;
constexpr size_t WS_TOPI = 3 * MiB;
constexpr size_t WS_TOPW = 3 * MiB + 512 * 1024;
constexpr size_t WS_PERM = 4 * MiB;
constexpr size_t WS_RGATE = 4 * MiB + 512 * 1024;
constexpr size_t WS_CNT = 5 * MiB;
constexpr size_t WS_SSQ = 6 * MiB;
constexpr size_t WS_W_IN = 8 * MiB;
constexpr size_t WS_W_BR = 52 * MiB;
constexpr size_t WS_W_OUT = 59 * MiB;
constexpr size_t WS_W_FGU = 67 * MiB;
constexpr size_t WS_W_FDN = 89 * MiB;
constexpr size_t WS_W_MGU = 100 * MiB;
constexpr size_t WS_W_MDN = 324 * MiB;
constexpr size_t WS_H = 436 * MiB;
constexpr size_t WS_XS = 500 * MiB;
constexpr size_t WS_YBUF = 632 * MiB;
constexpr size_t WS_Q = 760 * MiB;
constexpr size_t WS_K = 824 * MiB;
constexpr size_t WS_VRAW = 872 * MiB;
constexpr size_t WS_VT = 920 * MiB;
constexpr size_t WS_G = 968 * MiB;
constexpr size_t WS_OALL = 1160 * MiB;
constexpr size_t WS_MERGED = 1216 * MiB;
constexpr size_t WS_ACT = 760 * MiB;
constexpr size_t WS_END = 1280 * MiB;
constexpr size_t WS_DBG = 1280 * MiB;
static_assert(WS_ACT + (size_t)MROWS * ED * 2 <= WS_END, "act overlay");
static_assert(WS_W_MDN + (size_t)2 * 8 * 1024 * 3584 * 2 <= WS_H, "weights");

constexpr int CW_BAR = 4096;
constexpr int CW_ERR = 32768;

constexpr int LDS_SCR = 0, LDS_SCR_BYTES = 131072;
constexpr int LDS_MISC = 131072;
constexpr int LDS_BYTES = 131072 + 1024 + 8192;

DI unsigned pk2(float lo, float hi) { f32x2 v = {lo, hi}; bf16x2_t b = __builtin_convertvector(v, bf16x2_t); return __builtin_bit_cast(unsigned, b); }
DI float bflo(unsigned w) { return __uint_as_float(w << 16); }
DI float bfhi(unsigned w) { return __uint_as_float(w & 0xffff0000u); }
DI float bf2f(bf16_t u) { return __uint_as_float((unsigned)u << 16); }
DI int lane_v() { int l; asm volatile("v_mbcnt_lo_u32_b32 %0, -1, 0\n\tv_mbcnt_hi_u32_b32 %0, -1, %0" : "=v"(l)); return l; }
DI float shx(float v, int m) { return __builtin_bit_cast(float, __builtin_amdgcn_ds_bpermute((lane_v() ^ m) << 2, __builtin_bit_cast(int, v))); }
DI int shx(int v, int m) { return __builtin_amdgcn_ds_bpermute((lane_v() ^ m) << 2, v); }
DI int shup(int v, int o) { return __builtin_amdgcn_ds_bpermute((lane_v() - o) << 2, v); }
DI int shidx(int v, int src) { return __builtin_amdgcn_ds_bpermute(src << 2, v); }
DI float wave_sum(float v) {
#pragma unroll
    for (int o = 1; o < 64; o <<= 1) v += shx(v, o);
    return v;
}
DI float sigmoidf_(float x) { return __builtin_amdgcn_rcpf(1.f + __builtin_amdgcn_exp2f(x * -1.4426950408889634f)); }

namespace pg8 {
#define PG8_LAS __attribute__((address_space(3)))
constexpr int BM = 256, BK = 64, HALF = 128, HTB = HALF * BK * 2, STAGE_BYTES = 8 * HTB, NXCD = 8, WGM = 8;
__host__ __device__ __forceinline__ int lds_byte(int r, int c) { const int st = (r >> 4) * 2 + (c >> 5), rr = r & 15, cc = c & 31, ob = rr * 64 + cc * 2; return st * 1024 + (ob ^ (((ob >> 9) & 1) << 5)); }
__host__ __device__ __forceinline__ void stage_rc(int b, int& R, int& C) { const int st = b / 1024, sb = b % 1024, swz = sb ^ (((sb >> 9) & 1) << 5); R = (st >> 1) * 16 + swz / 64; C = (st & 1) * 32 + (swz % 64) / 2; }
__host__ __device__ __forceinline__ int perm32(int rho) { const int n = rho >> 4, i = rho & 15; return 8 * (i >> 2) + 4 * n + (i & 3); }

struct Unit { int pm, pn; long bo; int ord; };
struct Gemm { const bf16_t* A; const bf16_t* Bt; int K; int sclB; };
typedef int v4i_t __attribute__((ext_vector_type(4)));
typedef int v8i_t __attribute__((ext_vector_type(8)));
__device__ __forceinline__ void mfma_f8(f32x4& acc, v8i_t b, v8i_t a, int sclb) {
    asm volatile("v_mfma_scale_f32_16x16x128_f8f6f4 %0, %1, %2, %0, %3, %4 op_sel_hi:[0,0,0]" : "+v"(acc) : "v"(b), "v"(a), "v"(sclb), "v"(0x7F7F7F7F));
}
__device__ __forceinline__ v8i_t cat8(bf16x8 lo, bf16x8 hi) { return __builtin_shufflevector(__builtin_bit_cast(v4i_t, lo), __builtin_bit_cast(v4i_t, hi), 0, 1, 2, 3, 4, 5, 6, 7); }

struct StaticOrder {
    int nM, nN, nwg, G, c;
    __host__ __device__ void init(int M, int N, int G_, int c_) { nM = M / BM; nN = N / BM; nwg = nM * nN; G = G_; c = c_; }
    __host__ __device__ bool next(int i, Unit& u) const {
        const long L = (long)i * G + c; if (L >= nwg) return false;
        int wgid = (int)L; { const int q = nwg / NXCD, r = nwg % NXCD, xcd = wgid % NXCD, off = wgid / NXCD; wgid = (xcd < r ? xcd * (q + 1) : r * (q + 1) + (xcd - r) * q) + off; }
        const int nig = WGM * nN, gid = wgid / nig, fm = gid * WGM, gsz = (nM - fm) < WGM ? (nM - fm) : WGM;
        u.pm = fm + ((wgid % nig) % gsz); u.pn = (wgid % nig) / gsz; u.bo = 0; u.ord = i; return true;
    }
    __device__ __forceinline__ void a_ready(const Unit&) const {}
    __device__ __forceinline__ void done(const Unit&) const {}
};
struct StaticOrderR : StaticOrder {
    const float* ssq; PG8_LAS float* tab; int wid;
    __device__ __forceinline__ void a_ready(const Unit& u) const {
        if (ssq) { int t_; asm volatile("v_mbcnt_lo_u32_b32 %0, -1, 0\n\tv_mbcnt_hi_u32_b32 %0, -1, %0" : "=v"(t_)); const int w_ = wid;
            if (w_ < 4) { const int rr = w_ * 64 + t_; const f32x4* p = (const f32x4*)(ssq + (size_t)(u.pm * 256 + rr) * 16); const f32x4 a = p[0], b = p[1], c2 = p[2], d = p[3];
                const float s_ = ((a[0] + a[1]) + (a[2] + a[3])) + ((b[0] + b[1]) + (b[2] + b[3])) + ((c2[0] + c2[1]) + (c2[2] + c2[3])) + ((d[0] + d[1]) + (d[2] + d[3]));
                tab[(u.ord & 1) * 256 + rr] = 1.f / sqrtf(s_ * (1.f / 1024.f) + 1e-6f); } }
    }
};
struct GroupedOrder {
    int nN, c8, loc, per; int tp[9]; long bstride; int cb;
    __device__ __forceinline__ bool next(int i, Unit& u) const {
        const int R = (tp[8] - c8 + 7) >> 3;
        const int j = loc + per * i; if (j >= R * nN) return false;
        const int g = j / (4 * nN), w = j - g * 4 * nN, rg = min(4, R - 4 * g);
        const int blk = rg * cb, pc = w / blk, rem = w - pc * blk, col = rem / rg, row = rem - col * rg;
        const int pm = c8 + 8 * (4 * g + row);
        u.pm = pm; u.pn = pc * cb + col; u.ord = i;
        int e = 0;
#pragma unroll
        for (int k = 1; k < 8; ++k) e += (pm >= tp[k]) ? 1 : 0;
        u.bo = (long)e * bstride; return true;
    }
    __device__ __forceinline__ void a_ready(const Unit&) const {}
    __device__ __forceinline__ void done(const Unit&) const {}
};

template <class T, class = void> struct has_mid { static constexpr bool value = false; };
template <class T> struct has_mid<T, decltype((void)T::HAS_MID)> { static constexpr bool value = T::HAS_MID; };
template <class Epi, class Sched, bool ALIGN_EPI = false, bool SP2 = false, bool F8 = false>
__device__ __forceinline__ void gemm_phase(PG8_LAS unsigned char* lds, const Gemm g, const Sched& S, const Epi& E, int tid_in) {
    int tid_o = tid_in; asm volatile("" : "+v"(tid_o));
    const int tid = tid_o, wid = __builtin_amdgcn_readfirstlane(tid >> 6), lane = tid & 63, wr = wid >> 2, wc = wid & 3, fr = lane & 15, fq = lane >> 4;
    const int K = g.K, nt = K / BK;
    unsigned voffA[2], voffB[2];
#pragma unroll
    for (int i = 0; i < 2; ++i) { int R, C; stage_rc(tid * 16 + i * 8192, R, C); const int Rb = Epi::PERM ? ((R & ~31) + perm32(R & 31)) : R;
        voffA[i] = (unsigned)(R * K + C) * 2u; voffB[i] = (unsigned)(Rb * K + C) * 2u; }
    const size_t kstep = (size_t)(BK * 2);
    const size_t hstep = (size_t)HALF * K * 2;
    const size_t tstep = 2 * hstep;
    const unsigned ldsw = (unsigned)wid * 1024u;
    const int aoff = lds_byte(wr * 64 + fr, fq * 8), boff = lds_byte(wc * 32 + fr, fq * 8);
#define PG8_SA(b, h) (((b) * 2 + (h)) * HTB)
#define PG8_SB(b, h) ((4 + (b) * 2 + (h)) * HTB)
#define PG8_STAGE(bufoff, gbase, voff) do { _Pragma("unroll") for (int _i = 0; _i < 2; ++_i) \
        __builtin_amdgcn_global_load_lds((const unsigned*)((const char*)(gbase) + (voff)[_i]), (PG8_LAS unsigned*)(lds + (bufoff) + ldsw + _i * 8192), 16, 0, 0); } while (0)
#define PG8_LDA(dst, b, h) do { _Pragma("unroll") for (int m = 0; m < 4; ++m) _Pragma("unroll") for (int k = 0; k < 2; ++k) dst[m][k] = *(const PG8_LAS bf16x8*)(lds + PG8_SA(b, h) + aoff + m * 2048 + k * 1024); } while (0)
#define PG8_LDB(dst, b, h) do { _Pragma("unroll") for (int n = 0; n < 2; ++n) _Pragma("unroll") for (int k = 0; k < 2; ++k) dst[n][k] = *(const PG8_LAS bf16x8*)(lds + PG8_SB(b, h) + boff + n * 2048 + k * 1024); } while (0)
#define PG8_MMA(ai, bj, At, Bt) do { __builtin_amdgcn_s_setprio(1); _Pragma("unroll") for (int m = 0; m < 4; ++m) _Pragma("unroll") for (int n = 0; n < 2; ++n) { \
        if constexpr (F8) mfma_f8(acc[ai][bj][m][n], cat8(Bt[n][0], Bt[n][1]), cat8(At[m][0], At[m][1]), g.sclB); \
        else { _Pragma("unroll") for (int k = 0; k < 2; ++k) acc[ai][bj][m][n] = __builtin_amdgcn_mfma_f32_16x16x32_bf16(Bt[n][k], At[m][k], acc[ai][bj][m][n], 0, 0, 0); } } __builtin_amdgcn_s_setprio(0); } while (0)
#define PG8_WAIT_V(n) asm volatile("s_waitcnt vmcnt(" #n ")" ::: "memory")
#define PG8_WAIT_L(n) asm volatile("s_waitcnt lgkmcnt(" #n ")" ::: "memory")
#define PG8_BAR __builtin_amdgcn_s_barrier()
#define PG8_SCHED __builtin_amdgcn_sched_barrier(0)
    Unit cur, nxt; int ui = 0;
    if (!S.next(0, cur)) return;
    f32x4 acc[2][2][4][2];
#pragma unroll
    for (int a = 0; a < 2; ++a)
#pragma unroll
        for (int b = 0; b < 2; ++b)
#pragma unroll
            for (int m = 0; m < 4; ++m)
#pragma unroll
                for (int n = 0; n < 2; ++n) acc[a][b][m][n] = (f32x4){0.f, 0.f, 0.f, 0.f};
    bf16x8 At[4][2], B0[2][2], B1[2][2];
    const char* cA = (const char*)g.A + (size_t)cur.pm * tstep; const char* cB = (const char*)g.Bt + cur.bo + (size_t)cur.pn * tstep;
    S.a_ready(cur);
    if constexpr (SP2) {
        PG8_STAGE(PG8_SB(0, 0), cB, voffB); PG8_STAGE(PG8_SB(0, 1), cB + hstep, voffB); PG8_STAGE(PG8_SA(0, 0), cA, voffA); PG8_STAGE(PG8_SA(0, 1), cA + hstep, voffA);
        if (wr == 1) PG8_BAR;
        PG8_WAIT_V(2); PG8_BAR;
        PG8_STAGE(PG8_SB(1, 0), cB + kstep, voffB); PG8_STAGE(PG8_SA(1, 0), cA + kstep, voffA); PG8_STAGE(PG8_SB(1, 1), cB + hstep + kstep, voffB);
        PG8_WAIT_V(6); PG8_BAR;
    } else {
        PG8_STAGE(PG8_SB(0, 0), cB, voffB); PG8_STAGE(PG8_SA(0, 0), cA, voffA); PG8_STAGE(PG8_SB(0, 1), cB + hstep, voffB); PG8_STAGE(PG8_SA(0, 1), cA + hstep, voffA);
        if (wr == 1) PG8_BAR;
        PG8_WAIT_V(4); PG8_BAR;
        PG8_STAGE(PG8_SB(1, 0), cB + kstep, voffB); PG8_STAGE(PG8_SA(1, 0), cA + kstep, voffA); PG8_STAGE(PG8_SB(1, 1), cB + hstep + kstep, voffB);
        PG8_WAIT_V(6); PG8_BAR;
    }
    for (;;) {
        const bool has_next = S.next(ui + 1, nxt);
        const char* nA = has_next ? (const char*)g.A + (size_t)nxt.pm * tstep : cA; const char* nB = has_next ? (const char*)g.Bt + nxt.bo + (size_t)nxt.pn * tstep : cB;
        for (int t = 0; t < nt; t += 2) {
            if constexpr (has_mid<Epi>::value) { if (E.is_mid(t)) { if (wr == 0) PG8_BAR; E.mid(acc, cur, t, wr, wc, fr, fq); if (wr == 1) PG8_BAR; } }
            const bool last = (t == nt - 2);
            const char* a1 = cA + (size_t)(t + 1) * kstep;
            const char* a2 = last ? nA : cA + (size_t)(t + 2) * kstep; const char* b2 = last ? nB : cB + (size_t)(t + 2) * kstep;
            const char* a3 = a2 + kstep; const char* b3 = b2 + kstep;
            if (last && has_next) S.a_ready(nxt);
            if constexpr (SP2) {
            PG8_LDB(B0, 0, 0); PG8_LDB(B1, 0, 1); PG8_SCHED; PG8_LDA(At, 0, 0); PG8_STAGE(PG8_SA(1, 1), a1 + hstep, voffA);
            PG8_WAIT_V(8); PG8_WAIT_L(0); PG8_BAR; PG8_MMA(0, 0, At, B0); PG8_MMA(0, 1, At, B1); PG8_BAR; PG8_SCHED;
            PG8_LDA(At, 0, 1); PG8_STAGE(PG8_SB(0, 0), b2, voffB); PG8_STAGE(PG8_SB(0, 1), b2 + hstep, voffB); PG8_STAGE(PG8_SA(0, 0), a2, voffA);
            PG8_WAIT_V(8); PG8_WAIT_L(0); PG8_BAR; PG8_MMA(1, 0, At, B0); PG8_MMA(1, 1, At, B1); PG8_BAR; PG8_SCHED;
            PG8_LDB(B0, 1, 0); PG8_LDB(B1, 1, 1); PG8_SCHED; PG8_LDA(At, 1, 0); PG8_STAGE(PG8_SA(0, 1), a2 + hstep, voffA);
            PG8_WAIT_V(8); PG8_WAIT_L(0); PG8_BAR; PG8_MMA(0, 0, At, B0); PG8_MMA(0, 1, At, B1); PG8_BAR; PG8_SCHED;
            PG8_LDA(At, 1, 1); PG8_STAGE(PG8_SB(1, 0), b3, voffB); PG8_STAGE(PG8_SB(1, 1), b3 + hstep, voffB); PG8_STAGE(PG8_SA(1, 0), a3, voffA);
            PG8_WAIT_V(8); PG8_WAIT_L(0); PG8_BAR; PG8_MMA(1, 0, At, B0); PG8_MMA(1, 1, At, B1); PG8_BAR; PG8_SCHED;
            } else {
            PG8_LDB(B0, 0, 0); PG8_SCHED; PG8_LDA(At, 0, 0); PG8_STAGE(PG8_SA(1, 1), a1 + hstep, voffA);
            PG8_WAIT_L(8); PG8_BAR; PG8_WAIT_L(0); PG8_MMA(0, 0, At, B0); PG8_BAR; PG8_SCHED;
            PG8_LDB(B1, 0, 1); PG8_STAGE(PG8_SB(0, 0), b2, voffB);
            PG8_BAR; PG8_WAIT_L(0); PG8_MMA(0, 1, At, B1); PG8_BAR;
            PG8_LDA(At, 0, 1); PG8_STAGE(PG8_SA(0, 0), a2, voffA);
            PG8_BAR; PG8_WAIT_L(0); PG8_MMA(1, 0, At, B0); PG8_BAR; PG8_SCHED;
            PG8_STAGE(PG8_SB(0, 1), b2 + hstep, voffB);
            PG8_WAIT_V(6); PG8_BAR; PG8_MMA(1, 1, At, B1); PG8_BAR;
            PG8_LDB(B0, 1, 0); PG8_SCHED; PG8_LDA(At, 1, 0); PG8_STAGE(PG8_SA(0, 1), a2 + hstep, voffA);
            PG8_WAIT_L(8); PG8_BAR; PG8_WAIT_L(0); PG8_MMA(0, 0, At, B0); PG8_BAR; PG8_SCHED;
            PG8_LDB(B1, 1, 1); PG8_STAGE(PG8_SB(1, 0), b3, voffB);
            PG8_BAR; PG8_WAIT_L(0); PG8_MMA(0, 1, At, B1); PG8_BAR;
            PG8_LDA(At, 1, 1); PG8_STAGE(PG8_SA(1, 0), a3, voffA);
            PG8_BAR; PG8_WAIT_L(0); PG8_MMA(1, 0, At, B0); PG8_BAR; PG8_SCHED;
            PG8_STAGE(PG8_SB(1, 1), b3 + hstep, voffB);
            PG8_WAIT_V(6); PG8_BAR; PG8_MMA(1, 1, At, B1); PG8_BAR;
            }
        }
        if constexpr (ALIGN_EPI) { if (wr == 0) PG8_BAR; }
        if constexpr (F8) asm volatile("s_nop 15\n\ts_nop 15" ::: "memory");
        if constexpr (!Epi::AFTER_DRAIN) { E(acc, cur, wr, wc, fr, fq); S.done(cur); }
        if (!has_next) break;
#pragma unroll
        for (int a = 0; a < 2; ++a)
#pragma unroll
            for (int b = 0; b < 2; ++b)
#pragma unroll
                for (int m = 0; m < 4; ++m)
#pragma unroll
                    for (int n = 0; n < 2; ++n) acc[a][b][m][n] = (f32x4){0.f, 0.f, 0.f, 0.f};
        cur = nxt; cA = nA; cB = nB; ++ui;
        if constexpr (ALIGN_EPI) { if (wr == 1) PG8_BAR; }
    }
    PG8_WAIT_V(0);
    if constexpr (!ALIGN_EPI) { if (wr == 0) PG8_BAR; }
    PG8_BAR;
    if constexpr (Epi::AFTER_DRAIN) { E.fused(acc, cur, wr, wc, fr, fq, lds, wid, lane); S.done(cur); }
#undef PG8_SA
#undef PG8_SB
#undef PG8_STAGE
#undef PG8_LDA
#undef PG8_LDB
#undef PG8_MMA
#undef PG8_WAIT_V
#undef PG8_WAIT_L
#undef PG8_BAR
#undef PG8_SCHED
}
}

typedef const f32x4 (&AccRef)[2][2][4][2];

struct EpiIn {
    static constexpr bool PERM = true, AFTER_DRAIN = false;
    bf16_t *Q, *Kb, *V, *G; const LAS float* rtab;
    DI void operator()(AccRef acc, const pg8::Unit& u, int wr, int wc, int fr, int fq) const {
        const int pn = u.pn; bf16_t* base; int ld, colt; bool sig = false;
        if (pn < 4) { base = Q; ld = 1024; colt = pn * 256; }
        else if (pn < 7) { base = Kb; ld = 768; colt = (pn - 4) * 256; }
        else if (pn < 10) { base = V; ld = 768; colt = (pn - 7) * 256; }
        else { base = G; ld = 3072; colt = (pn - 10) * 256; sig = true; }
        const int row0 = u.pm * 256 + wr * 64 + fr, col0 = colt + wc * 32 + 8 * fq;
#pragma unroll
        for (int ai = 0; ai < 2; ++ai)
#pragma unroll
            for (int m = 0; m < 4; ++m) { bf16_t* rowp = base + (size_t)(row0 + ai * 128 + m * 16) * ld + col0;
                const float rs = rtab ? rtab[(u.ord & 1) * 256 + wr * 64 + fr + ai * 128 + m * 16] : 1.f;
#pragma unroll
                for (int bj = 0; bj < 2; ++bj) {
                    if (sig) {
                        const float rsn = rs * -1.4426950408889634f; unsigned q[8];
#pragma unroll
                        for (int j = 0; j < 4; ++j) {
                            q[j] = (unsigned)__builtin_amdgcn_rcpf(__builtin_amdgcn_exp2f(__builtin_fmaf(acc[ai][bj][m][0][j], rsn, -8.f)) + 0.00390720367431640625f);
                            q[4 + j] = (unsigned)__builtin_amdgcn_rcpf(__builtin_amdgcn_exp2f(__builtin_fmaf(acc[ai][bj][m][1][j], rsn, -8.f)) + 0.00390720367431640625f); }
                        u32x2 w; w.x = q[0] | (q[1] << 8) | (q[2] << 16) | (q[3] << 24); w.y = q[4] | (q[5] << 8) | (q[6] << 16) | (q[7] << 24);
                        *(u32x2*)((unsigned char*)G + (size_t)(row0 + ai * 128 + m * 16) * 3072 + col0 + bj * 128) = w; }
                    else { const f32x4 v0 = acc[ai][bj][m][0] * rs, v1 = acc[ai][bj][m][1] * rs;
                        u32x4 w; w.x = pk2(v0[0], v0[1]); w.y = pk2(v0[2], v0[3]); w.z = pk2(v1[0], v1[1]); w.w = pk2(v1[2], v1[3]);
                        *(u32x4*)(rowp + bj * 128) = w; } } }
    }
};

struct EpiGate {
    static constexpr bool PERM = true, AFTER_DRAIN = false, HAS_MID = true;
    const unsigned char* G; bf16_t* Mg;
    DI bool is_mid(int t) const { return t == 4 || t == 10; }
    static DI float gq(unsigned w, int k) { return (float)((w >> (8 * k)) & 0xffu) + 0.5f; }
    DI void mid(f32x4 (&acc)[2][2][4][2], const pg8::Unit& u, int t, int wr, int wc, int fr, int fq) const {
        int fr_o = fr; asm volatile("" : "+v"(fr_o));
        const int row0 = u.pm * 256 + wr * 64 + fr_o, col0 = u.pn * 256 + wc * 32 + 8 * fq, g0 = (t == 4) ? 0 : 1024;
#pragma unroll
        for (int ai = 0; ai < 2; ++ai) {
            __builtin_amdgcn_sched_barrier(0);
#pragma unroll
            for (int m = 0; m < 4; ++m) { const size_t ro = (size_t)(row0 + ai * 128 + m * 16) * 3072 + g0 + col0;
#pragma unroll
                for (int bj = 0; bj < 2; ++bj) { const u32x2 gn = *(const u32x2*)(G + ro + bj * 128), gd = *(const u32x2*)(G + ro + 1024 + bj * 128);
                    f32x4 r0, r1;
#pragma unroll
                    for (int k = 0; k < 4; ++k) { r0[k] = gq(gn.x, k) * __builtin_amdgcn_rcpf(gq(gd.x, k)); r1[k] = gq(gn.y, k) * __builtin_amdgcn_rcpf(gq(gd.y, k)); }
                    acc[ai][bj][m][0] = acc[ai][bj][m][0] * r0; acc[ai][bj][m][1] = acc[ai][bj][m][1] * r1; } } }
        __builtin_amdgcn_sched_barrier(0);
    }
    DI void operator()(AccRef acc, const pg8::Unit& u, int wr, int wc, int fr, int fq) const {
        const int row0 = u.pm * 256 + wr * 64 + fr, col0 = u.pn * 256 + wc * 32 + 8 * fq;
#pragma unroll
        for (int ai = 0; ai < 2; ++ai)
#pragma unroll
            for (int m = 0; m < 4; ++m) { const size_t row = (size_t)(row0 + ai * 128 + m * 16);
#pragma unroll
                for (int bj = 0; bj < 2; ++bj) { const int col = col0 + bj * 128;
                    const u32x2 g = *(const u32x2*)(G + row * 3072 + 2048 + col);
                    const f32x4 v0 = acc[ai][bj][m][0] * (1.f / 256.f), v1 = acc[ai][bj][m][1] * (1.f / 256.f);
                    u32x4 w;
                    w.x = pk2(gq(g.x, 0) * v0[0], gq(g.x, 1) * v0[1]); w.y = pk2(gq(g.x, 2) * v0[2], gq(g.x, 3) * v0[3]);
                    w.z = pk2(gq(g.y, 0) * v1[0], gq(g.y, 1) * v1[1]); w.w = pk2(gq(g.y, 2) * v1[2], gq(g.y, 3) * v1[3]);
                    *(u32x4*)(Mg + row * 1024 + col) = w; } }
    }
};

struct EpiResidN {
    static constexpr bool PERM = true, AFTER_DRAIN = false;
    const float* xin; float* xout; unsigned char* xb; float* ssq; int f8;
    DI void operator()(AccRef acc, const pg8::Unit& u, int wr, int wc, int fr, int fq) const {
        const int row0 = u.pm * 256 + wr * 64 + fr, col0 = u.pn * 256 + wc * 32 + 8 * fq;
#pragma unroll
        for (int ai = 0; ai < 2; ++ai)
#pragma unroll
            for (int m = 0; m < 4; ++m) { const int row = row0 + ai * 128 + m * 16; const size_t ro = (size_t)row * 1024; float ss = 0.f;
#pragma unroll
                for (int bj = 0; bj < 2; ++bj) { const size_t o = ro + col0 + bj * 128;
                    const f32x4 x0 = *(const f32x4*)(xin + o) + acc[ai][bj][m][0], x1 = *(const f32x4*)(xin + o + 4) + acc[ai][bj][m][1];
                    *(f32x4*)(xout + o) = x0; *(f32x4*)(xout + o + 4) = x1;
                    if (xb) { ss += ((x0[0] * x0[0] + x0[1] * x0[1]) + (x0[2] * x0[2] + x0[3] * x0[3])) + ((x1[0] * x1[0] + x1[1] * x1[1]) + (x1[2] * x1[2] + x1[3] * x1[3]));
                        if (f8) { int w0 = 0, w1 = 0; w0 = __builtin_amdgcn_cvt_pk_fp8_f32(x0[0], x0[1], w0, false); w0 = __builtin_amdgcn_cvt_pk_fp8_f32(x0[2], x0[3], w0, true);
                            w1 = __builtin_amdgcn_cvt_pk_fp8_f32(x1[0], x1[1], w1, false); w1 = __builtin_amdgcn_cvt_pk_fp8_f32(x1[2], x1[3], w1, true);
                            u32x2 w; w.x = (unsigned)w0; w.y = (unsigned)w1; *(u32x2*)(xb + o) = w; }
                        else { u32x4 w; w.x = pk2(x0[0], x0[1]); w.y = pk2(x0[2], x0[3]); w.z = pk2(x1[0], x1[1]); w.w = pk2(x1[2], x1[3]); *(u32x4*)(xb + 2 * o) = w; } } }
                if (xb) { ss += shx(ss, 16); ss += shx(ss, 32);
                    if (fq == 0) ssq[(size_t)row * 16 + 4 * u.pn + wc] = ss; } }
    }
};

struct EpiResid {
    static constexpr bool PERM = false, AFTER_DRAIN = false;
    const float* xin; float* xout;
    DI void operator()(AccRef acc, const pg8::Unit& u, int wr, int wc, int fr, int fq) const {
        const int row0 = u.pm * 256 + wr * 64 + fr, col0 = u.pn * 256 + wc * 32 + 4 * fq;
#pragma unroll
        for (int ai = 0; ai < 2; ++ai)
#pragma unroll
            for (int m = 0; m < 4; ++m) { const size_t ro = (size_t)(row0 + ai * 128 + m * 16) * 1024;
#pragma unroll
                for (int bj = 0; bj < 2; ++bj)
#pragma unroll
                    for (int n = 0; n < 2; ++n) { const size_t o = ro + col0 + bj * 128 + n * 16;
                        const f32x4 xv = *(const f32x4*)(xin + o); *(f32x4*)(xout + o) = xv + acc[ai][bj][m][n]; } }
    }
};

template <bool F8O>
struct EpiSwiglu {
    static constexpr bool PERM = true, AFTER_DRAIN = false;
    unsigned char* act; int ld; const LAS float* rtab;
    DI void operator()(AccRef acc, const pg8::Unit& u, int wr, int wc, int fr, int fq) const {
        const int row0 = u.pm * 256 + wr * 64 + fr, col0 = u.pn * 128 + wc * 32 + 8 * fq;
#pragma unroll
        for (int ai = 0; ai < 2; ++ai)
#pragma unroll
            for (int m = 0; m < 4; ++m) { const size_t eo = (size_t)(row0 + ai * 128 + m * 16) * ld + col0;
                const float rs = rtab ? rtab[(u.ord & 1) * 256 + wr * 64 + fr + ai * 128 + m * 16] : 1.f;
                const float rsn = rs * -1.4426950408889634f, irs2 = rtab ? __builtin_amdgcn_rcpf(rs * rs) : 1.f;
                float o[8];
#pragma unroll
                for (int n = 0; n < 2; ++n)
#pragma unroll
                    for (int j = 0; j < 4; ++j) { const float ga = acc[ai][0][m][n][j], ua = acc[ai][1][m][n][j];
                        const float e = __builtin_amdgcn_exp2f(ga * rsn); o[4 * n + j] = (ga * ua) * __builtin_amdgcn_rcpf(__builtin_fmaf(e, irs2, irs2)); }
                if constexpr (F8O) { int w0 = 0, w1 = 0;
                    w0 = __builtin_amdgcn_cvt_pk_fp8_f32(o[0], o[1], w0, false); w0 = __builtin_amdgcn_cvt_pk_fp8_f32(o[2], o[3], w0, true);
                    w1 = __builtin_amdgcn_cvt_pk_fp8_f32(o[4], o[5], w1, false); w1 = __builtin_amdgcn_cvt_pk_fp8_f32(o[6], o[7], w1, true);
                    u32x2 w; w.x = (unsigned)w0; w.y = (unsigned)w1; *(u32x2*)(act + eo) = w; }
                else { u32x4 w; w.x = pk2(o[0], o[1]); w.y = pk2(o[2], o[3]); w.z = pk2(o[4], o[5]); w.w = pk2(o[6], o[7]); *(u32x4*)(act + 2 * eo) = w; } }
    }
};

struct EpiMoeDown {
    static constexpr bool PERM = true, AFTER_DRAIN = false;
    const int* perm; const float* rgate; bf16_t* ybuf;
    DI void operator()(AccRef acc, const pg8::Unit& u, int wr, int wc, int fr, int fq) const {
        const int row0 = u.pm * 256 + wr * 64 + fr, col0 = u.pn * 256 + wc * 32 + 8 * fq;
#pragma unroll
        for (int ai = 0; ai < 2; ++ai)
#pragma unroll
            for (int m = 0; m < 4; ++m) { const int row = row0 + ai * 128 + m * 16; const int p = perm[row];
                if (p >= 0) { const float gt = rgate[row]; bf16_t* dst = ybuf + ((size_t)(p & 1) * NTOK + (size_t)(p >> 1)) * 1024 + col0;
#pragma unroll
                    for (int bj = 0; bj < 2; ++bj) { const f32x4 v0 = acc[ai][bj][m][0] * gt, v1 = acc[ai][bj][m][1] * gt;
                        u32x4 w; w.x = pk2(v0[0], v0[1]); w.y = pk2(v0[2], v0[3]); w.z = pk2(v1[0], v1[1]); w.w = pk2(v1[2], v1[3]);
                        *(u32x4*)(dst + bj * 128) = w; } } }
    }
};

#define LDS_WAIT() asm volatile("s_waitcnt lgkmcnt(0)" ::: "memory")

DI void prep_tile(const float* src, int src_ld, bool zero, unsigned char* dst, int dst_ld, float f8mul, const float* kg  , LAS bf16_t* t, int lane) {
#pragma unroll
    for (int i = 0; i < 16; ++i) { const int k = i * 4 + (lane >> 4), c = (lane & 15) * 4;
        f32x4 v = {0.f, 0.f, 0.f, 0.f}; if (!zero) v = *(const f32x4*)(src + (size_t)k * src_ld + c);
        if (kg) v = v * kg[k];
        u32x2 w; w.x = pk2(v[0], v[1]); w.y = pk2(v[2], v[3]); *(LAS u32x2*)(t + k * 68 + c) = w; }
    LDS_WAIT();
#pragma unroll
    for (int kc = 0; kc < 8; ++kc) { unsigned e[8];
#pragma unroll
        for (int j = 0; j < 8; ++j) e[j] = t[(8 * kc + j) * 68 + lane];
        if (f8mul != 0.f) { int w0 = 0, w1 = 0;
            w0 = __builtin_amdgcn_cvt_pk_fp8_f32(bflo(e[0]) * f8mul, bflo(e[1]) * f8mul, w0, false); w0 = __builtin_amdgcn_cvt_pk_fp8_f32(bflo(e[2]) * f8mul, bflo(e[3]) * f8mul, w0, true);
            w1 = __builtin_amdgcn_cvt_pk_fp8_f32(bflo(e[4]) * f8mul, bflo(e[5]) * f8mul, w1, false); w1 = __builtin_amdgcn_cvt_pk_fp8_f32(bflo(e[6]) * f8mul, bflo(e[7]) * f8mul, w1, true);
            u32x2 w; w.x = (unsigned)w0; w.y = (unsigned)w1; *(u32x2*)(dst + (size_t)lane * dst_ld + 8 * kc) = w; }
        else { u32x4 w; w.x = e[0] | (e[1] << 16); w.y = e[2] | (e[3] << 16); w.z = e[4] | (e[5] << 16); w.w = e[6] | (e[7] << 16);
            *(u32x4*)(dst + ((size_t)lane * dst_ld + 8 * kc) * 2) = w; } }
    LDS_WAIT();
}

struct Args { const float* in[12]; float* out; unsigned char* ws; int lo, hi; };
typedef Args Ptrs;

DI void prep_wg_tile(const float* src0, const float* src1, int src_ld, unsigned char* dst, int dst_ld, float f8mul, const float* kg, LAS bf16_t* t, int tid) {
    { const int c = (tid & 127) * 4, kk = tid >> 7;
      const float* sp; int dn;
      if (src1) { const int run = c >> 8, cc = c & 255; sp = (run ? src1 : src0) + cc; dn = ((cc >> 7) << 8) + (run << 7) + (cc & 127); } else { sp = src0 + c; dn = c; }
#pragma unroll
      for (int p = 0; p < 16; ++p) { const int k = 4 * p + kk; f32x4 v = *(const f32x4*)(sp + (size_t)k * src_ld);
          if (kg) v = v * kg[k];
          u32x2 w; w.x = pk2(v[0], v[1]); w.y = pk2(v[2], v[3]); *(LAS u32x2*)(t + k * 520 + (dn ^ (((k >> 3) & 7) << 3))) = w; } }
    __syncthreads();
    { const int kc = tid & 7;
#pragma unroll
      for (int i = 0; i < 8; ++i) { const int n = 64 * i + (tid >> 3); unsigned e[8];
#pragma unroll
          for (int j = 0; j < 8; ++j) e[j] = t[(8 * kc + j) * 520 + (n ^ (kc << 3))];
          if (f8mul != 0.f) { int w0 = 0, w1 = 0;
              w0 = __builtin_amdgcn_cvt_pk_fp8_f32(bflo(e[0]) * f8mul, bflo(e[1]) * f8mul, w0, false); w0 = __builtin_amdgcn_cvt_pk_fp8_f32(bflo(e[2]) * f8mul, bflo(e[3]) * f8mul, w0, true);
              w1 = __builtin_amdgcn_cvt_pk_fp8_f32(bflo(e[4]) * f8mul, bflo(e[5]) * f8mul, w1, false); w1 = __builtin_amdgcn_cvt_pk_fp8_f32(bflo(e[6]) * f8mul, bflo(e[7]) * f8mul, w1, true);
              u32x2 w; w.x = (unsigned)w0; w.y = (unsigned)w1; *(u32x2*)(dst + (size_t)n * dst_ld + 8 * kc) = w; }
          else { u32x4 w; w.x = e[0] | (e[1] << 16); w.y = e[2] | (e[3] << 16); w.z = e[4] | (e[5] << 16); w.w = e[6] | (e[7] << 16);
              *(u32x4*)(dst + ((size_t)n * dst_ld + 8 * kc) * 2) = w; } } }
    __syncthreads();
}

DI void phase_prep(const Ptrs& P, LAS unsigned char* lds, int tid) {
    LAS bf16_t* t = (LAS bf16_t*)(lds + LDS_SCR);
    constexpr int T0 = 4 * 176, T3 = T0 + 4 * 24, T4 = T3 + 4 * 32, T5 = T4 + 2 * 176, T6 = T5 + 2 * 88, T7 = T6 + 16 * 224, T8 = T7 + 16 * 112;
    for (int it = blockIdx.x; it < T8; it += gridDim.x) {
        const float* src; const float* src1 = nullptr; int src_ld; size_t wsb; size_t eo; int dst_ld; float f8mul = 0.f; const float* kg = nullptr;
        int r = it;
        if (r < T0) { const int L = r / 176, q = r % 176, kt = q / 11, nt = q % 11;
            src = P.in[2] + (size_t)L * 1024 * 5632 + (size_t)kt * 64 * 5632 + nt * 512; src_ld = 5632;
            wsb = WS_W_IN + (size_t)L * 5632 * 1024 * 2; eo = (size_t)(nt * 512) * 1024 + kt * 64; dst_ld = 1024; f8mul = ((F8_IN >> L) & 1) ? 32.f : 0.f;
            if (FUSE_NORM && (L & 1)) kg = P.in[1] + (size_t)L * 2048 + kt * 64; }
        else if (r < T3) { r -= T0; const int L = r / 24, q = r % 24, kt = q / 2, nt = q % 2;
            src = P.in[5] + (size_t)L * 768 * 1024 + (size_t)(kt * 64) * 1024 + nt * 512; src_ld = 1024;
            wsb = WS_W_BR; eo = ((size_t)L * 1024 + nt * 512) * 768 + kt * 64; dst_ld = 768; }
        else if (r < T4) { r -= T3; const int L = r / 32, q = r % 32, kt = q / 2, nt = q % 2;
            src = P.in[6] + (size_t)L * 1024 * 1024 + (size_t)(kt * 64) * 1024 + nt * 512; src_ld = 1024;
            wsb = WS_W_OUT; eo = ((size_t)L * 1024 + nt * 512) * 1024 + kt * 64; dst_ld = 1024; }
        else if (r < T5) { r -= T4; const int L = r / 176, q = r % 176, kt = q / 11, nt = q % 11;
            src = P.in[7] + (size_t)L * 1024 * 5632 + (size_t)(kt * 64) * 5632 + nt * 256; src1 = src + FF; src_ld = 5632;
            wsb = WS_W_FGU + (size_t)L * 5632 * 1024 * 2; eo = (size_t)(nt * 512) * 1024 + kt * 64; dst_ld = 1024; f8mul = ((F8_FFN >> L) & 1) ? 32.f : 0.f;
            if (FUSE_NORM) kg = P.in[1] + (size_t)(2 * L) * 2048 + 1024 + kt * 64; }
        else if (r < T6) { r -= T5; const int L = r / 88, q = r % 88, kt = q / 2, nt = q % 2;
            src = P.in[8] + (size_t)L * 2816 * 1024 + (size_t)(kt * 64) * 1024 + nt * 512; src_ld = 1024;
            wsb = WS_W_FDN + (size_t)L * 1024 * 2816 * 2; eo = (size_t)(nt * 512) * 2816 + kt * 64; dst_ld = 2816; f8mul = ((F8_FFN >> L) & 1) ? 64.f : 0.f; }
        else if (r < T7) { r -= T6; const int L = r / 224, q = r % 224, kt = q / 14, nt = q % 14;
            src = P.in[10] + (size_t)L * 1024 * 7168 + (size_t)(kt * 64) * 7168 + nt * 256; src1 = src + ED; src_ld = 7168;
            wsb = WS_W_MGU + (size_t)(L >> 3) * 8 * 7168 * 1024 * 2; eo = ((size_t)(L & 7) * 7168 + nt * 512) * 1024 + kt * 64; dst_ld = 1024; f8mul = ((F8_MOE >> (L >> 3)) & 1) ? 32.f : 0.f; }
        else { r -= T7; const int L = r / 112, q = r % 112, kt = q / 2, nt = q % 2;
            src = P.in[11] + (size_t)L * 3584 * 1024 + (size_t)(kt * 64) * 1024 + nt * 512; src_ld = 1024;
            wsb = WS_W_MDN + (size_t)(L >> 3) * 8 * 1024 * 3584 * 2; eo = ((size_t)(L & 7) * 1024 + nt * 512) * 3584 + kt * 64; dst_ld = 3584; f8mul = ((F8_MOE >> (L >> 3)) & 1) ? 64.f : 0.f; }
        prep_wg_tile(src, src1, src_ld, P.ws + wsb + eo * (f8mul != 0.f ? 1 : 2), dst_ld, f8mul, kg, t, tid);
    }
    const int gid = blockIdx.x * NTHR + tid;
    if (gid < 4096 * 32) { const int pos = gid >> 5, i = gid & 31; const float inv = powf(10000.f, -(float)(2 * i) / 64.f); float s, c; sincosf((float)pos * inv, &s, &c);
        ((f32x2*)(P.ws + WS_ROPE1))[gid] = (f32x2){c, s}; }
    if (gid < 64 * 16) { const int pos = gid >> 4, i = gid & 15; const float inv = powf(10000.f, -(float)(2 * i) / 32.f); float s, c; sincosf((float)pos * inv, &s, &c);
        ((f32x2*)(P.ws + WS_ROPEA))[gid] = (f32x2){c, s}; }
}

template <bool COMBINE, bool ROUTER, bool HF8>
DI void phase_norm(const float* xin, float* xout, const bf16_t* ybuf, const float* gain, bf16_t* H, const float* wrt, int* topi, float* topw, int* cnt, int* perm,
                   LAS unsigned char* lds, int tid) {
    const int wave = tid >> 6, lane = tid & 63, w = blockIdx.x;
    LAS float* wrl = (LAS float*)(lds + LDS_SCR);
    LAS int* cntl = (LAS int*)(lds + LDS_SCR + 32768);
    if (ROUTER) {
        for (int i = tid; i < 8192; i += NTHR) wrl[(i & 7) * 1024 + (i >> 3)] = wrt[i];
        if (tid < 8) cntl[tid] = 0;
        for (int i = tid; i < MROWS / NWG; i += NTHR) perm[w * (MROWS / NWG) + i] = -1;
        __syncthreads();
    }
    f32x4 g[4];
#pragma unroll
    for (int q = 0; q < 4; ++q) g[q] = *(const f32x4*)(gain + 256 * q + 4 * lane);
    for (int j = 0; j < 16; ++j) {
        const int row = w * 128 + wave * 16 + j; const size_t ro = (size_t)row * 1024;
        f32x4 v[4]; float ss = 0.f;
#pragma unroll
        for (int q = 0; q < 4; ++q) { v[q] = *(const f32x4*)(xin + ro + 256 * q + 4 * lane);
            if (COMBINE) { const u32x2 a = *(const u32x2*)(ybuf + ro + 256 * q + 4 * lane), b = *(const u32x2*)(ybuf + (size_t)NTOK * 1024 + ro + 256 * q + 4 * lane);
                v[q][0] += bflo(a.x) + bflo(b.x); v[q][1] += bfhi(a.x) + bfhi(b.x); v[q][2] += bflo(a.y) + bflo(b.y); v[q][3] += bfhi(a.y) + bfhi(b.y);
                *(f32x4*)(xout + ro + 256 * q + 4 * lane) = v[q]; }
            ss += (v[q][0] * v[q][0] + v[q][1] * v[q][1]) + (v[q][2] * v[q][2] + v[q][3] * v[q][3]); }
        const float rstd = 1.f / sqrtf(wave_sum(ss) * (1.f / 1024.f) + EPS);
#pragma unroll
        for (int q = 0; q < 4; ++q) { v[q] = v[q] * rstd * g[q];
            if constexpr (HF8) { int w = 0; w = __builtin_amdgcn_cvt_pk_fp8_f32(v[q][0], v[q][1], w, false); w = __builtin_amdgcn_cvt_pk_fp8_f32(v[q][2], v[q][3], w, true);
                *(int*)((unsigned char*)H + ro + 256 * q + 4 * lane) = w; }
            else { u32x2 o; o.x = pk2(v[q][0], v[q][1]); o.y = pk2(v[q][2], v[q][3]); *(u32x2*)(H + ro + 256 * q + 4 * lane) = o; } }
        if (ROUTER) {
            float lg[8];
#pragma unroll
            for (int e = 0; e < 8; ++e) { float a = 0.f;
#pragma unroll
                for (int q = 0; q < 4; ++q) { const f32x4 wv = *(const LAS f32x4*)(wrl + e * 1024 + 256 * q + 4 * lane); a += (v[q][0] * wv[0] + v[q][1] * wv[1]) + (v[q][2] * wv[2] + v[q][3] * wv[3]); }
                lg[e] = wave_sum(a); }
            float v0 = -3.0e38f; int e0 = 0;
#pragma unroll
            for (int e = 0; e < 8; ++e) if (lg[e] > v0) { v0 = lg[e]; e0 = e; }
            float v1 = -3.0e38f; int e1 = 0;
#pragma unroll
            for (int e = 0; e < 8; ++e) if (e != e0 && lg[e] > v1) { v1 = lg[e]; e1 = e; }
            if (lane == 0) { const float t = __expf(v1 - v0), w0 = 1.f / (1.f + t);
                topi[row * 2] = e0; topi[row * 2 + 1] = e1; topw[row * 2] = w0; topw[row * 2 + 1] = t * w0;
                atomicAdd((int*)(cntl + e0), 1); atomicAdd((int*)(cntl + e1), 1); }
        }
    }
    if (ROUTER) { __syncthreads(); if (tid < 8) cnt[w * 8 + tid] = cntl[tid]; }
}

DI void moe_totals(const int* cnt, volatile LAS int* misc, int tid) {
    const int e = tid >> 6, lane = tid & 63, w = blockIdx.x;
    int c[4]; int s4 = 0;
#pragma unroll
    for (int i = 0; i < 4; ++i) { c[i] = cnt[(4 * lane + i) * 8 + e]; s4 += c[i]; }
    int x = s4;
#pragma unroll
    for (int o = 1; o < 64; o <<= 1) { const int y = shup(x, o); if (lane >= o) x += y; }
    const int total = shidx(x, 63);
    int p = x - s4;
#pragma unroll
    for (int i = 0; i < 3; ++i) if (i < (w & 3)) p += c[i];
    p = shidx(p, w >> 2);
    if (lane == 0) { misc[e] = total; misc[8 + e] = p; }
    __syncthreads();
}

template <bool F8>
DI void phase_scatter(const int* cnt, const int* topi, const float* topw, const bf16_t* H, bf16_t* XS, int* perm, float* rgate, LAS unsigned char* lds, int tid) {
    const int wave = tid >> 6, lane = tid & 63, w = blockIdx.x;
    volatile LAS int* misc = (volatile LAS int*)(lds + LDS_MISC + 64);
    LAS int* posl = (LAS int*)(lds + LDS_SCR);
    moe_totals(cnt, misc, tid);
    { const int e = wave; int base = 0;
        for (int k = 0; k < e; ++k) base += ((misc[k] + 255) >> 8) << 8;
        int running = base + misc[8 + e];
        for (int pss = 0; pss < 2; ++pss) { const int j = 64 * pss + lane, tok = w * 128 + j;
            const int a0 = topi[tok * 2], a1 = topi[tok * 2 + 1]; const bool f0 = a0 == e, f1 = a1 == e, has = f0 || f1;
            const unsigned long long mask = __ballot(has); const int rank = __popcll(mask & ((1ull << lane) - 1ull));
            if (has) { const int pos = running + rank, slot = f1 ? 1 : 0; perm[pos] = tok * 2 + slot; rgate[pos] = topw[tok * 2 + slot]; posl[j * 2 + slot] = pos; }
            running += __popcll(mask); }
    }
    __syncthreads();
    for (int i = 0; i < 32; ++i) { const int pr = wave * 32 + i, pos = posl[pr], tok = w * 128 + (pr >> 1);
        if constexpr (F8) { *((u32x4*)((unsigned char*)XS + (size_t)pos * 1024) + lane) = *((const u32x4*)((const unsigned char*)H + (size_t)tok * 1024) + lane); }
        else { const u32x4* s = (const u32x4*)(H + (size_t)tok * 1024) + lane; u32x4* d = (u32x4*)(XS + (size_t)pos * 1024) + lane;
            const u32x4 a = s[0], b = s[64]; d[0] = a; d[64] = b; } }
}

DI void phase_final(const float* x, const bf16_t* ybuf, float* out, int tid) {
    const size_t n4 = (size_t)NTOK * 1024 / 4;
    for (size_t i = (size_t)blockIdx.x * NTHR + tid; i < n4; i += (size_t)gridDim.x * NTHR) {
        f32x4 v = ((const f32x4*)x)[i]; const u32x2 a = ((const u32x2*)ybuf)[i], b = ((const u32x2*)(ybuf + (size_t)NTOK * 1024))[i];
        v[0] += bflo(a.x) + bflo(b.x); v[1] += bfhi(a.x) + bfhi(b.x); v[2] += bflo(a.y) + bflo(b.y); v[3] += bfhi(a.y) + bfhi(b.y);
        ((f32x4*)out)[i] = v; }
}

struct QKRaw { u32x2 w[4]; };
DI void qk_load(QKRaw& R, const bf16_t* rowp, int lane, bool active) {
    const bf16_t* hp = rowp + (active ? (lane >> 2) * 64 + 4 * (lane & 3) : 0);
#pragma unroll
    for (int m = 0; m < 4; ++m) R.w[m] = *(const u32x2*)(hp + 16 * m);
}
DI void qk_finish(const QKRaw& R, bf16_t* rowp, int nh0, int nh1, const LAS float* gl  , int which, float scale, const LAS f32x2* r1l  , const LAS f32x2* ral  ,
                  int sl  , int s, int lane, bool active) {
    const int head = lane >> 2, q = lane & 3;
    const int br = head < nh0 ? 0 : (head < nh0 + nh1 ? 1 : 2);
    float v[4][4], ss = 0.f;
#pragma unroll
    for (int m = 0; m < 4; ++m) { const u32x2 w = R.w[m]; v[m][0] = bflo(w.x); v[m][1] = bfhi(w.x); v[m][2] = bflo(w.y); v[m][3] = bfhi(w.y);
        ss += (v[m][0] * v[m][0] + v[m][1] * v[m][1]) + (v[m][2] * v[m][2] + v[m][3] * v[m][3]); }
    ss += shx(ss, 1); ss += shx(ss, 2);
    const float rstd = 1.f / sqrtf(ss * (1.f / 64.f) + EPS);
    const LAS float* gp = gl + (br * 2 + which) * 64 + 4 * q;
    float o[4][4];
    f32x4 cs[4][2];
#pragma unroll
    for (int m = 0; m < 4; ++m) { const f32x4 g4 = *(const LAS f32x4*)(gp + 16 * m);
#pragma unroll
        for (int j = 0; j < 4; ++j) v[m][j] = v[m][j] * rstd * g4[j];
        const LAS f32x2* tp = (br == 2) ? r1l + sl * 32 + (m & 1) * 16 + 4 * q : ral + ((m < 2) ? (s >> 6) : (s & 63)) * 16 + 4 * q;
        cs[m][0] = *(const LAS f32x4*)tp; cs[m][1] = *(const LAS f32x4*)(tp + 2); }
#pragma unroll
    for (int m = 0; m < 4; ++m) { const bool first = (br == 2) ? (m < 2) : ((m & 1) == 0);
#pragma unroll
        for (int j = 0; j < 4; ++j) { const float pv = (br == 2) ? v[m ^ 2][j] : v[m ^ 1][j]; const float c = cs[m][j >> 1][2 * (j & 1)], sn = cs[m][j >> 1][2 * (j & 1) + 1];
            const float rot = first ? v[m][j] * c - pv * sn : v[m][j] * c + pv * sn;
            o[m][j] = ((br == 0) ? v[m][j] : rot) * scale; } }
    if (active) { bf16_t* hp = rowp + head * 64 + 4 * q;
#pragma unroll
        for (int m = 0; m < 4; ++m) { u32x2 w; w.x = pk2(o[m][0], o[m][1]); w.y = pk2(o[m][2], o[m][3]); *(u32x2*)(hp + 16 * m) = w; } }
}

DI void qk_rows_wave(const Ptrs& P, const LAS float* gl, const LAS f32x2* r1l, const LAS f32x2* ral, int wave, int lane) {
    bf16_t* Kb = (bf16_t*)(P.ws + WS_K);
    const int t0 = blockIdx.x * 128 + wave * 16;
    const bool act = lane < 48;
    QKRaw a0, a1, a2, a3, b0, b1, b2, b3;
    qk_load(a0, Kb + (size_t)t0 * 768, lane, act); qk_load(a1, Kb + (size_t)(t0 + 1) * 768, lane, act); qk_load(a2, Kb + (size_t)(t0 + 2) * 768, lane, act); qk_load(a3, Kb + (size_t)(t0 + 3) * 768, lane, act);
#pragma unroll 1
    for (int j = 0; j < 16; j += 4) { const int tok = t0 + j, tn = (j + 4 < 16) ? tok + 4 : tok, s = tok & (SEQ - 1), sl = wave * 16 + j;
        qk_load(b0, Kb + (size_t)tn * 768, lane, act); qk_load(b1, Kb + (size_t)(tn + 1) * 768, lane, act); qk_load(b2, Kb + (size_t)(tn + 2) * 768, lane, act); qk_load(b3, Kb + (size_t)(tn + 3) * 768, lane, act);
        qk_finish(a0, Kb + (size_t)tok * 768, 4, 2, gl, 1, 1.0f, r1l, ral, sl, s, lane, act);
        qk_finish(a1, Kb + (size_t)(tok + 1) * 768, 4, 2, gl, 1, 1.0f, r1l, ral, sl + 1, s + 1, lane, act);
        qk_finish(a2, Kb + (size_t)(tok + 2) * 768, 4, 2, gl, 1, 1.0f, r1l, ral, sl + 2, s + 2, lane, act);
        qk_finish(a3, Kb + (size_t)(tok + 3) * 768, 4, 2, gl, 1, 1.0f, r1l, ral, sl + 3, s + 3, lane, act);
        a0 = b0; a1 = b1; a2 = b2; a3 = b3; }
}
DI void v_units_wave(const Ptrs& P, LAS unsigned* L, int gw, int NGW, int lane) {
    const bf16_t* V = (const bf16_t*)(P.ws + WS_VRAW); bf16_t* Vt = (bf16_t*)(P.ws + WS_VT);
    u32x4 rw[8];
    { const int tt = gw / 12, hv = gw % 12; const bf16_t* src = V + (size_t)(tt * 64 + lane) * 768 + hv * 64;
#pragma unroll
      for (int c = 0; c < 8; ++c) rw[c] = *(const u32x4*)(src + c * 8); }
#pragma unroll 1
    for (int un = gw; un < 512 * 12; un += NGW) { const int tt = un / 12, hv = un % 12, tok0 = tt * 64, b = tok0 >> 12, s0 = tok0 & (SEQ - 1);
        const int g = hv < 6 ? 0 : ((hv - 6) >> 1), sh = 2 * g, dd = 1 << sh, Sd = SEQ >> sh, run = 64 >> sh;
        const int pos = (lane & (dd - 1)) * run + (lane >> sh);
#pragma unroll
        for (int c = 0; c < 8; ++c) { L[(4 * c + 0) * 68 + pos] = rw[c].x; L[(4 * c + 1) * 68 + pos] = rw[c].y; L[(4 * c + 2) * 68 + pos] = rw[c].z; L[(4 * c + 3) * 68 + pos] = rw[c].w; }
        { const int un2 = (un + NGW < 512 * 12) ? un + NGW : un; const int tt2 = un2 / 12, hv2 = un2 % 12; const bf16_t* src = V + (size_t)(tt2 * 64 + lane) * 768 + hv2 * 64;
#pragma unroll
          for (int c = 0; c < 8; ++c) rw[c] = *(const u32x4*)(src + c * 8); }
        LDS_WAIT();
        const int ch = lane & 7, p = 8 * ch;
        const size_t g1 = (size_t)(p >> (6 - sh)) * Sd + (s0 >> sh) + (p & (run - 1)), g2 = (size_t)((p + 4) >> (6 - sh)) * Sd + (s0 >> sh) + ((p + 4) & (run - 1));
#pragma unroll
        for (int i = 0; i < 8; ++i) { const int d = 8 * i + (lane >> 3), k = d >> 1;
            const u32x4 wa = *(const LAS u32x4*)(L + k * 68 + p), wb = *(const LAS u32x4*)(L + k * 68 + p + 4);
            const unsigned sel = (d & 1) ? 0x07060302u : 0x05040100u;
            u32x4 o; o.x = __builtin_amdgcn_perm(wa.y, wa.x, sel); o.y = __builtin_amdgcn_perm(wa.w, wa.z, sel); o.z = __builtin_amdgcn_perm(wb.y, wb.x, sel); o.w = __builtin_amdgcn_perm(wb.w, wb.z, sel);
            bf16_t* drow = Vt + ((size_t)(b * 12 + hv) * 64 + d) * SEQ;
            if (run >= 8) *(u32x4*)(drow + g1) = o;
            else { u32x2 t; t.x = o.x; t.y = o.y; *(u32x2*)(drow + g1) = t; t.x = o.z; t.y = o.w; *(u32x2*)(drow + g2) = t; } }
        LDS_WAIT();
    }
}
DI void phase_qkvprep(const Ptrs& P, int layer, LAS unsigned char* lds, int tid) {
    const int wave = tid >> 6, lane = tid & 63, gw = blockIdx.x * 8 + wave, NGW = gridDim.x * 8;
    LAS f32x4* r1l4 = (LAS f32x4*)(lds + LDS_SCR); LAS f32x4* ral4 = (LAS f32x4*)(lds + LDS_SCR + 32768); LAS float* gl = (LAS float*)(lds + LDS_SCR + 40960);
    const int s0 = (blockIdx.x * 128) & (SEQ - 1);
    const f32x4* r1g = (const f32x4*)(P.ws + WS_ROPE1) + (size_t)s0 * 16; const f32x4* rag = (const f32x4*)(P.ws + WS_ROPEA);
    for (int i = tid; i < 128 * 16; i += NTHR) r1l4[i] = r1g[i];
    for (int i = tid; i < 64 * 8; i += NTHR) ral4[i] = rag[i];
    if (tid < 384) gl[tid] = (P.in[3] + (size_t)layer * 384)[tid];
    __syncthreads();
    const LAS f32x2* r1l = (const LAS f32x2*)(lds + LDS_SCR); const LAS f32x2* ral = (const LAS f32x2*)(lds + LDS_SCR + 32768);
    LAS unsigned* L = (LAS unsigned*)(lds + LDS_SCR + 49152 + wave * 8704);
    if (wave < 4) { qk_rows_wave(P, gl, r1l, ral, wave, lane); v_units_wave(P, L, gw, NGW, lane); }
    else { v_units_wave(P, L, gw, NGW, lane); qk_rows_wave(P, gl, r1l, ral, wave, lane); }
}

#define XB_TMO      128
#define XB_XCNT(j)  (256  + 64 * (j))
#define XB_XSUB(j)  (1280 + 64 * (j))
#define XB_XGEN(j)  (2304 + 64 * (j))
#define XB_TOP      3328
#define XB_TOPGEN   3392
#define XCD_BAR_WORDS 3456
#define XB_SPIN_CAP (1u << 18)

__device__ __forceinline__ unsigned xb_ld(unsigned* p)              { return __hip_atomic_load(p, __ATOMIC_RELAXED, __HIP_MEMORY_SCOPE_AGENT); }
__device__ __forceinline__ unsigned xb_add(unsigned* p, unsigned v) { return __hip_atomic_fetch_add(p, v, __ATOMIC_RELAXED, __HIP_MEMORY_SCOPE_AGENT); }
__device__ __forceinline__ unsigned xb_xcc_id() { return (unsigned)__builtin_amdgcn_s_getreg((3 << 11) | 20) & 0xFu; }
#define XB_SPIN(cond, bar) do { unsigned _sp = 0; while (cond) { __builtin_amdgcn_s_sleep(1); \
    if ((++_sp & 255u) == 0u) { if (xb_ld(&(bar)[XB_TMO])) break; if (_sp > XB_SPIN_CAP) { atomicAdd(&(bar)[XB_TMO], 1u); break; } } } } while (0)

struct XcdBarrier {
    unsigned* bar; unsigned x;
    volatile LAS unsigned* st;
};

__device__ __forceinline__ XcdBarrier xcd_barrier_post(unsigned* bar, volatile LAS unsigned* st, int tid) {
    XcdBarrier b; b.bar = bar; b.x = xb_xcc_id(); b.st = st;
    if (tid == 0) (void)xb_add(&bar[XB_XCNT(b.x)], 1u);
    return b;
}
__device__ __forceinline__ void xcd_barrier_complete(unsigned* bar, unsigned x, unsigned& nloc, unsigned& nx) {
    const unsigned G = gridDim.x * gridDim.y * gridDim.z;
    unsigned sum, cnt, mine, sp = 0u;
    for (;;) {
        sum = 0u; cnt = 0u; mine = 0u;
#pragma unroll
        for (unsigned j = 0; j < 16; ++j) { const unsigned c = xb_ld(&bar[XB_XCNT(j)]); sum += c; cnt += (c > 0u) ? 1u : 0u; mine = (j == x) ? c : mine; }
        if (sum == G) break;
        __builtin_amdgcn_s_sleep(1);
        if ((++sp & 255u) == 0u) { if (xb_ld(&bar[XB_TMO])) break; if (sp > XB_SPIN_CAP) { atomicAdd(&bar[XB_TMO], 1u); break; } }
    }
    nloc = mine > 0u ? mine : 1u; nx = cnt > 0u ? cnt : 1u;
}

__device__ __forceinline__ void xcd_barrier(const XcdBarrier& b, int tid) {
    asm volatile("s_waitcnt vmcnt(0)" ::: "memory");
    __syncthreads();
    if (tid == 0) {
        unsigned* bar = b.bar;
        __builtin_amdgcn_s_waitcnt(0);
        unsigned nloc = b.st[0], nx = b.st[1];
        if (nloc == 0u) { xcd_barrier_complete(bar, b.x, nloc, nx); b.st[0] = nloc; b.st[1] = nx; }
        const unsigned old = xb_add(&bar[XB_XSUB(b.x)], 1u);
        const unsigned gen = old / nloc;
        if (old + 1u == (gen + 1u) * nloc) {
            __builtin_amdgcn_fence(__ATOMIC_RELEASE, "agent");
            asm volatile("s_waitcnt vmcnt(0)" ::: "memory");
            const unsigned og = xb_add(&bar[XB_TOP], 1u);
            const unsigned tg = og / nx;
            if (og + 1u == (tg + 1u) * nx) xb_add(&bar[XB_TOPGEN], 1u);
            else XB_SPIN(xb_ld(&bar[XB_TOPGEN]) == tg, bar);
            __builtin_amdgcn_fence(__ATOMIC_ACQUIRE, "agent");
            xb_add(&bar[XB_XGEN(b.x)], 1u);
            asm volatile("s_waitcnt vmcnt(0)" ::: "memory");
        } else {
            XB_SPIN(xb_ld(&bar[XB_XGEN(b.x)]) == gen, bar);
            __builtin_amdgcn_fence(__ATOMIC_ACQUIRE, "agent");
            asm volatile("s_waitcnt vmcnt(0)" ::: "memory");
        }
    }
    __syncthreads();
}

DI f32x16 mfma32(bf16x8 a, bf16x8 b, f32x16 c) { return __builtin_amdgcn_mfma_f32_32x32x16_bf16(a, b, c, 0, 0, 0); }
DI int pi32(int r) { return (r & 19) | ((r & 4) << 1) | ((r & 8) >> 1); }
DI int keyidx(int i, int hi) { return 16 * (i >> 3) + 8 * hi + (i & 7); }
DI bf16x8 pack8(const f32x16& x, int s) { u32x4 p; p.x = pk2(x[8 * s], x[8 * s + 1]); p.y = pk2(x[8 * s + 2], x[8 * s + 3]); p.z = pk2(x[8 * s + 4], x[8 * s + 5]); p.w = pk2(x[8 * s + 6], x[8 * s + 7]); return __builtin_bit_cast(bf16x8, p); }
DI f32x16 splat16(float v) { f32x16 z;
#pragma unroll
    for (int i = 0; i < 16; ++i) z[i] = v; return z; }
DI f32x16 zero16() { float z_ = 0.f; asm volatile("" : "+v"(z_)); return splat16(z_); }
template <int BR>
DI void q_prep(bf16x8 (&qf)[4], const bf16_t* qp  , const float* gq  , int hi, int s, const f32x2* rope1, const f32x2* ropea) {
    { int z_ = 0; asm volatile("" : "+v"(z_)); gq += z_; rope1 += z_; ropea += z_; }
    float v[4][8]; float ss = 0.f;
#pragma unroll
    for (int c = 0; c < 4; ++c) { const u32x4 w = *(const u32x4*)(qp + 16 * c);
        v[c][0] = bflo(w.x); v[c][1] = bfhi(w.x); v[c][2] = bflo(w.y); v[c][3] = bfhi(w.y); v[c][4] = bflo(w.z); v[c][5] = bfhi(w.z); v[c][6] = bflo(w.w); v[c][7] = bfhi(w.w);
#pragma unroll
        for (int j = 0; j < 8; ++j) ss += v[c][j] * v[c][j]; }
    ss += shx(ss, 32);
    const float rstd = 1.f / sqrtf(ss * (1.f / 64.f) + EPS);
#pragma unroll
    for (int c = 0; c < 4; ++c) { const f32x4 g0 = *(const f32x4*)(gq + 16 * c + 8 * hi), g1 = *(const f32x4*)(gq + 16 * c + 8 * hi + 4);
#pragma unroll
        for (int j = 0; j < 4; ++j) { v[c][j] *= rstd * g0[j]; v[c][4 + j] *= rstd * g1[j]; } }
    float o[4][8];
    if (BR == 0) {
#pragma unroll
        for (int c = 0; c < 4; ++c)
#pragma unroll
            for (int j = 0; j < 8; ++j) o[c][j] = v[c][j];
    } else {
#pragma unroll
        for (int pp = 0; pp < 2; ++pp) {
            const int cl = (BR == 2) ? pp : 2 * pp, ch = (BR == 2) ? pp + 2 : 2 * pp + 1;
            const f32x2* tp = (BR == 2) ? rope1 + s * 32 + 16 * pp + 8 * hi : ropea + ((pp == 0) ? (s >> 6) : (s & 63)) * 16 + 8 * hi;
#pragma unroll
            for (int j2 = 0; j2 < 4; ++j2) { const f32x4 t = *(const f32x4*)(tp + 2 * j2);
                o[cl][2 * j2] = v[cl][2 * j2] * t[0] - v[ch][2 * j2] * t[1]; o[ch][2 * j2] = v[ch][2 * j2] * t[0] + v[cl][2 * j2] * t[1];
                o[cl][2 * j2 + 1] = v[cl][2 * j2 + 1] * t[2] - v[ch][2 * j2 + 1] * t[3]; o[ch][2 * j2 + 1] = v[ch][2 * j2 + 1] * t[2] + v[cl][2 * j2 + 1] * t[3]; } }
    }
#pragma unroll
    for (int c = 0; c < 4; ++c) { u32x4 w; w.x = pk2(o[c][0] * QSCALE, o[c][1] * QSCALE); w.y = pk2(o[c][2] * QSCALE, o[c][3] * QSCALE); w.z = pk2(o[c][4] * QSCALE, o[c][5] * QSCALE); w.w = pk2(o[c][6] * QSCALE, o[c][7] * QSCALE);
        qf[c] = __builtin_bit_cast(bf16x8, w); }
}
struct QTab { const float* qkg; const f32x2* rope1; const f32x2* ropea; };
constexpr float SM_THR = 8.f;
DI float max16x2(const f32x16& a, const f32x16& b) {
    float m0 = fmaxf(fmaxf(a[0], a[1]), a[2]), m1 = fmaxf(fmaxf(b[0], b[1]), b[2]);
#pragma unroll
    for (int i = 3; i < 15; i += 2) { m0 = fmaxf(fmaxf(m0, a[i]), a[i + 1]); m1 = fmaxf(fmaxf(m1, b[i]), b[i + 1]); }
    return fmaxf(fmaxf(m0, m1), fmaxf(a[15], b[15]));
}
#define SOFTMAX_BODY(UPD_NEGM) \
    const float mx = max16x2(s0, s1); \
    if (__any(mx > SM_THR)) {                                          \
        float delta = fmaxf(fmaxf(mx, shx(mx, 32)), 0.f); asm volatile("" : "+v"(delta));     \
        const float alpha = __builtin_amdgcn_exp2f(-delta); \
        mref += delta; l *= alpha; UPD_NEGM \
        _Pragma("unroll") for (int i = 0; i < 16; ++i) { o0[i] *= alpha; o1[i] *= alpha; s0[i] -= delta; s1[i] -= delta; } \
    } \
    float sum0 = 0.f, sum1 = 0.f; \
    _Pragma("unroll") for (int i = 0; i < 16; ++i) { s0[i] = __builtin_amdgcn_exp2f(s0[i]); s1[i] = __builtin_amdgcn_exp2f(s1[i]); sum0 += s0[i]; sum1 += s1[i]; } \
    l += sum0 + sum1;
DI void softmax_lazy(f32x16& s0, f32x16& s1, float& mref, float& l, f32x16& o0, f32x16& o1) { SOFTMAX_BODY() }
DI void softmax_lazy(f32x16& s0, f32x16& s1, float& mref, f32x16& negm, float& l, f32x16& o0, f32x16& o1) { SOFTMAX_BODY(negm = splat16(-mref);) }
DI void store_o(bf16_t* op  , const f32x16& o0, const f32x16& o1, float l) {
    const float inv = 1.f / (l + shx(l, 32));
#pragma unroll
    for (int g = 0; g < 4; ++g) { u32x2 a, b;
        a.x = pk2(o0[4 * g] * inv, o0[4 * g + 1] * inv); a.y = pk2(o0[4 * g + 2] * inv, o0[4 * g + 3] * inv);
        b.x = pk2(o1[4 * g] * inv, o1[4 * g + 1] * inv); b.y = pk2(o1[4 * g + 2] * inv, o1[4 * g + 3] * inv);
        *(u32x2*)(op + 8 * g) = a; *(u32x2*)(op + 32 + 8 * g) = b; }
}

constexpr int GQ_KB = 128 * 144, GQ_VB = 64 * 272, GQ_BUF = GQ_KB + GQ_VB;
template <bool FAST>
DI void gqa_unit(LAS unsigned char* lds, const QTab& qt, const bf16_t* Q, const bf16_t* Kb, const bf16_t* Vt, bf16_t* OB, int b, int hq, int qb, int tid) {
    const int wave = tid >> 6, lane = tid & 63, r = lane & 31, hi = lane >> 5, kvh = hq / 3;
    const int qtok = b * SEQ + qb * 256 + wave * 32 + r;
    bf16x8 qf[4];
    q_prep<1>(qf, Q + (size_t)qtok * 1024 + (4 + hq) * 64 + 8 * hi, qt.qkg + 2 * 64, hi, qtok & (SEQ - 1), qt.rope1, qt.ropea);
    const int kr0 = tid >> 3, kc0 = tid & 7, vr0 = tid >> 4, vc0 = tid & 15;
    const bf16_t* kg = Kb + (size_t)(b * SEQ + kr0) * 768 + (4 + kvh) * 64 + kc0 * 8;
    const bf16_t* vg = Vt + ((size_t)(b * 12 + 4 + kvh) * 64 + vr0) * SEQ + vc0 * 8;
    const int ksoff = kr0 * 144 + kc0 * 16, vsoff = GQ_KB + vr0 * 272 + vc0 * 16;
    u32x4 ka = *(const u32x4*)kg, kb2 = *(const u32x4*)(kg + (size_t)64 * 768), va = *(const u32x4*)vg, vb2 = *(const u32x4*)(vg + (size_t)32 * SEQ);
    *(LAS u32x4*)(lds + ksoff) = ka; *(LAS u32x4*)(lds + ksoff + 64 * 144) = kb2; *(LAS u32x4*)(lds + vsoff) = va; *(LAS u32x4*)(lds + vsoff + 32 * 272) = vb2;
    __syncthreads();
    float mref = 0.f, l = 0.f; f32x16 o0 = zero16(), o1 = zero16(), negm = zero16(), lacc = zero16();
    const u32x4 ones_u = {0x3F803F80u, 0x3F803F80u, 0x3F803F80u, 0x3F803F80u}; const bf16x8 ones = __builtin_bit_cast(bf16x8, ones_u);
    const int koff = pi32(r) * 144 + hi * 16, voff = GQ_KB + r * 272 + hi * 16;
#define GQ_LDK(dst, base) do { _Pragma("unroll") for (int c_ = 0; c_ < 4; ++c_) { dst[c_] = *(const LAS bf16x8*)((base) + c_ * 32); dst[4 + c_] = *(const LAS bf16x8*)((base) + 32 * 144 + c_ * 32); } } while (0)
#define GQ_LDV(dst, base) do { _Pragma("unroll") for (int c_ = 0; c_ < 4; ++c_) { dst[c_] = *(const LAS bf16x8*)((base) + c_ * 32); dst[4 + c_] = *(const LAS bf16x8*)((base) + 32 * 272 + c_ * 32); } } while (0)
    for (int it = 0; it < 32; ++it) {
        const int cur = it & 1;
        if (it + 1 < 32) { const bf16_t* kn = kg + (size_t)(it + 1) * 128 * 768; const bf16_t* vn = vg + (it + 1) * 128;
            ka = *(const u32x4*)kn; kb2 = *(const u32x4*)(kn + (size_t)64 * 768); va = *(const u32x4*)vn; vb2 = *(const u32x4*)(vn + (size_t)32 * SEQ); }
        const LAS unsigned char* Bc = lds + cur * GQ_BUF;
        bf16x8 kf[8], vf[8], kf2[8];
        GQ_LDK(kf, Bc + koff);
        __builtin_amdgcn_sched_barrier(0);
        f32x16 s0 = FAST ? splat16(0.f) : negm, s1 = FAST ? splat16(0.f) : negm;
#pragma unroll
        for (int c = 0; c < 4; ++c) { s0 = mfma32(kf[c], qf[c], s0); s1 = mfma32(kf[4 + c], qf[c], s1); }
        GQ_LDV(vf, Bc + voff); if constexpr (FAST) GQ_LDK(kf2, Bc + 64 * 144 + koff);
        __builtin_amdgcn_sched_barrier(0);
        if constexpr (FAST) {
#pragma unroll
            for (int i = 0; i < 16; ++i) { s0[i] = __builtin_amdgcn_exp2f(s0[i]); s1[i] = __builtin_amdgcn_exp2f(s1[i]); } }
        else softmax_lazy(s0, s1, mref, negm, l, o0, o1);
#pragma unroll
        for (int s4 = 0; s4 < 4; ++s4) { const bf16x8 pf = pack8(s4 < 2 ? s0 : s1, s4 & 1); o0 = mfma32(vf[s4], pf, o0); o1 = mfma32(vf[4 + s4], pf, o1); if constexpr (FAST) lacc = mfma32(ones, pf, lacc); }
        if constexpr (!FAST) { __builtin_amdgcn_sched_barrier(0); GQ_LDK(kf2, Bc + 64 * 144 + koff); }
        s0 = FAST ? splat16(0.f) : negm; s1 = FAST ? splat16(0.f) : negm;
#pragma unroll
        for (int c = 0; c < 4; ++c) { s0 = mfma32(kf2[c], qf[c], s0); s1 = mfma32(kf2[4 + c], qf[c], s1); }
        GQ_LDV(vf, Bc + voff + 128);
        __builtin_amdgcn_sched_barrier(0);
        if constexpr (FAST) {
#pragma unroll
            for (int i = 0; i < 16; ++i) { s0[i] = __builtin_amdgcn_exp2f(s0[i]); s1[i] = __builtin_amdgcn_exp2f(s1[i]); } }
        else softmax_lazy(s0, s1, mref, negm, l, o0, o1);
#pragma unroll
        for (int s4 = 0; s4 < 4; ++s4) { const bf16x8 pf = pack8(s4 < 2 ? s0 : s1, s4 & 1); o0 = mfma32(vf[s4], pf, o0); o1 = mfma32(vf[4 + s4], pf, o1); if constexpr (FAST) lacc = mfma32(ones, pf, lacc); }
        if (it + 1 < 32) { LAS unsigned char* Bn = lds + (cur ^ 1) * GQ_BUF;
            *(LAS u32x4*)(Bn + ksoff) = ka; *(LAS u32x4*)(Bn + ksoff + 64 * 144) = kb2; *(LAS u32x4*)(Bn + vsoff) = va; *(LAS u32x4*)(Bn + vsoff + 32 * 272) = vb2; }
        __syncthreads();
    }
#undef GQ_LDK
#undef GQ_LDV
    if constexpr (FAST) store_o(OB + (size_t)qtok * 768 + hq * 64 + 4 * hi, o0, o1, 0.5f * lacc[0]);
    else store_o(OB + (size_t)qtok * 768 + hq * 64 + 4 * hi, o0, o1, l);
}

template <int NT>
DI void gqa3_wave(LAS unsigned char* lds, const QTab& qt, const bf16_t* Q, const bf16_t* Kb, const bf16_t* Vt, bf16_t* OB, int b, int kvh, int qblk, int wave, int lane) {
    const int r = lane & 31, hi = lane >> 5;
    const int tq0 = (NT == 2) ? 2 * wave : 8 + (wave - 4), hl = tq0 >> 2, hq = 3 * kvh + hl;
    int qtok[NT]; bf16x8 qf[NT][4]; f32x16 o0[NT], o1[NT]; float l[NT];
#pragma unroll
    for (int t = 0; t < NT; ++t) { qtok[t] = b * SEQ + qblk * 128 + ((tq0 + t) & 3) * 32 + r;
        q_prep<1>(qf[t], Q + (size_t)qtok[t] * 1024 + (4 + hq) * 64 + 8 * hi, qt.qkg + 2 * 64, hi, qtok[t] & (SEQ - 1), qt.rope1, qt.ropea);
        __builtin_amdgcn_sched_barrier(0); }
#pragma unroll
    for (int t = 0; t < NT; ++t) { o0[t] = zero16(); o1[t] = zero16(); l[t] = 0.f; }
    const int st = (wave & 3) * 64 + lane;
    const bf16_t* kg = Kb + (size_t)(b * SEQ + (st >> 3)) * 768 + (4 + kvh) * 64 + (st & 7) * 8;
    const bf16_t* vg = Vt + ((size_t)(b * 12 + 4 + kvh) * 64 + (st >> 4)) * SEQ + (st & 15) * 8;
    const int ksoff = (st >> 3) * 144 + (st & 7) * 16, vsoff = GQ_KB + (st >> 4) * 272 + (st & 15) * 16;
    u32x4 kq[4], vq[4];
#define G3_GLOAD(T_) do { _Pragma("unroll") for (int i_ = 0; i_ < 4; ++i_) { kq[i_] = *(const u32x4*)(kg + (size_t)((T_) * 128 + 32 * i_) * 768); vq[i_] = *(const u32x4*)(vg + (size_t)16 * i_ * SEQ + (T_) * 128); } } while (0)
#define G3_LSTORE(B_) do { LAS unsigned char* Bn_ = lds + (B_) * GQ_BUF; _Pragma("unroll") for (int i_ = 0; i_ < 4; ++i_) { *(LAS u32x4*)(Bn_ + ksoff + 32 * i_ * 144) = kq[i_]; *(LAS u32x4*)(Bn_ + vsoff + 16 * i_ * 272) = vq[i_]; } } while (0)
    if (NT == 1) { G3_GLOAD(0); G3_LSTORE(0); }
    __syncthreads();
    const int koff = pi32(r) * 144 + hi * 16, voff = GQ_KB + r * 272 + hi * 16;
#pragma unroll 1
    for (int it = 0; it < 32; ++it) {
        const int cur = it & 1;
        if (NT == 1 && it + 1 < 32) G3_GLOAD(it + 1);
        const LAS unsigned char* Bc = lds + cur * GQ_BUF;
#pragma unroll
        for (int hf = 0; hf < 2; ++hf) {
            bf16x8 kf[8], pf[NT][4];
#pragma unroll
            for (int c = 0; c < 4; ++c) { kf[c] = *(const LAS bf16x8*)(Bc + hf * 64 * 144 + koff + c * 32); kf[4 + c] = *(const LAS bf16x8*)(Bc + hf * 64 * 144 + koff + 32 * 144 + c * 32); }
#define G3_QK(t_, s0_, s1_) do { _Pragma("unroll") for (int c = 0; c < 4; ++c) { s0_ = mfma32(kf[c], qf[t_][c], s0_); s1_ = mfma32(kf[4 + c], qf[t_][c], s1_); } } while (0)
#define G3_SM(t_, s0_, s1_) do { float sum0 = 0.f, sum1 = 0.f; \
                _Pragma("unroll") for (int i = 0; i < 16; ++i) { s0_[i] = __builtin_amdgcn_exp2f(s0_[i]); s1_[i] = __builtin_amdgcn_exp2f(s1_[i]); sum0 += s0_[i]; sum1 += s1_[i]; } \
                l[t_] += sum0 + sum1; pf[t_][0] = pack8(s0_, 0); pf[t_][1] = pack8(s0_, 1); pf[t_][2] = pack8(s1_, 0); pf[t_][3] = pack8(s1_, 1); } while (0)
#define G3_LDV() do { _Pragma("unroll") for (int c = 0; c < 4; ++c) { vf[c] = *(const LAS bf16x8*)(Bc + voff + hf * 128 + c * 32); vf[4 + c] = *(const LAS bf16x8*)(Bc + voff + hf * 128 + 32 * 272 + c * 32); } } while (0)
#define G3_PV(t_) do { _Pragma("unroll") for (int s4 = 0; s4 < 4; ++s4) { o0[t_] = mfma32(vf[s4], pf[t_][s4], o0[t_]); o1[t_] = mfma32(vf[4 + s4], pf[t_][s4], o1[t_]); } } while (0)
            bf16x8 vf[8];
            if constexpr (NT == 2) {
                f32x16 sa0 = splat16(0.f), sa1 = splat16(0.f), sb0 = splat16(0.f), sb1 = splat16(0.f);
                bf16x8 vh[4];
#define G3_HSM(t_, s_, j_) do { float sum_ = 0.f; _Pragma("unroll") for (int i = 0; i < 16; ++i) { s_[i] = __builtin_amdgcn_exp2f(s_[i]); sum_ += s_[i]; } \
                l[t_] += sum_; pf[t_][2 * (j_)] = pack8(s_, 0); pf[t_][2 * (j_) + 1] = pack8(s_, 1); } while (0)
#define G3_FENCE() __builtin_amdgcn_sched_barrier(0)
#define G3_PIN(x_) asm volatile("" : "+v"(x_))
                G3_QK(0, sa0, sa1);
                G3_PIN(sa0); G3_PIN(sa1); G3_FENCE();
                G3_HSM(0, sa0, 0); _Pragma("unroll") for (int c = 0; c < 4; ++c) sb0 = mfma32(kf[c], qf[1][c], sb0);
                G3_PIN(sb0); G3_PIN(pf[0][0]); G3_PIN(pf[0][1]); G3_PIN(l[0]); G3_FENCE();
                G3_HSM(0, sa1, 1); _Pragma("unroll") for (int c = 0; c < 4; ++c) sb1 = mfma32(kf[4 + c], qf[1][c], sb1);
                G3_PIN(sb1); G3_PIN(pf[0][2]); G3_PIN(pf[0][3]); G3_PIN(l[0]); G3_FENCE();
                _Pragma("unroll") for (int c = 0; c < 4; ++c) vf[c] = *(const LAS bf16x8*)(Bc + voff + hf * 128 + c * 32);
                G3_HSM(1, sb0, 0); _Pragma("unroll") for (int s4 = 0; s4 < 4; ++s4) o0[0] = mfma32(vf[s4], pf[0][s4], o0[0]);
                G3_PIN(o0[0]); G3_PIN(pf[1][0]); G3_PIN(pf[1][1]); G3_PIN(l[1]); G3_FENCE();
                _Pragma("unroll") for (int c = 0; c < 4; ++c) vh[c] = *(const LAS bf16x8*)(Bc + voff + hf * 128 + 32 * 272 + c * 32);
                G3_HSM(1, sb1, 1); _Pragma("unroll") for (int s4 = 0; s4 < 4; ++s4) o1[0] = mfma32(vh[s4], pf[0][s4], o1[0]);
                G3_PIN(o1[0]); G3_PIN(pf[1][2]); G3_PIN(pf[1][3]); G3_PIN(l[1]); G3_FENCE();
                _Pragma("unroll") for (int s4 = 0; s4 < 4; ++s4) { o0[1] = mfma32(vf[s4], pf[1][s4], o0[1]); o1[1] = mfma32(vh[s4], pf[1][s4], o1[1]); }
                G3_PIN(o0[1]); G3_PIN(o1[1]); G3_FENCE();
#undef G3_PIN
#undef G3_HSM
#undef G3_FENCE
            } else {
                f32x16 sa0 = splat16(0.f), sa1 = splat16(0.f);
                G3_QK(0, sa0, sa1); G3_SM(0, sa0, sa1); G3_LDV(); G3_PV(0);
            }
#undef G3_QK
#undef G3_SM
#undef G3_LDV
#undef G3_PV
        }
        if (NT == 1 && it + 1 < 32) G3_LSTORE(cur ^ 1);
        __syncthreads();
    }
#undef G3_GLOAD
#undef G3_LSTORE
    { const int ln = lane_v(), r2 = ln & 31, hi2 = ln >> 5;
#pragma unroll
      for (int t = 0; t < NT; ++t) store_o(OB + (size_t)(b * SEQ + qblk * 128 + ((tq0 + t) & 3) * 32 + r2) * 768 + hq * 64 + 4 * hi2, o0[t], o1[t], l[t]); }
}

struct WTile { u32x4 k[4], v[4]; };
DI void wt_store(LAS unsigned char* wl, const WTile& T, int lane) {
#pragma unroll
    for (int i = 0; i < 4; ++i) { const int kr = 8 * i + (lane >> 3), vr = 16 * i + (lane >> 2);
        *(LAS u32x4*)(wl + kr * 128 + (((lane & 7) ^ ((kr >> 1) & 7)) << 4)) = T.k[i];
        *(LAS u32x4*)(wl + 4096 + vr * 64 + (((lane & 3) ^ ((vr >> 2) & 3)) << 4)) = T.v[i]; }
}
DI void wt_ldk(bf16x8 (&kf)[4], const LAS unsigned char* wl, int pr, int hi) {
#pragma unroll
    for (int c = 0; c < 4; ++c) kf[c] = *(const LAS bf16x8*)(wl + pr * 128 + (((2 * c + hi) ^ ((pr >> 1) & 7)) << 4));
}
DI void wt_ldv(bf16x8 (&vf)[4], const LAS unsigned char* wl, int r, int hi) {
#pragma unroll
    for (int dt = 0; dt < 2; ++dt)
#pragma unroll
        for (int sk = 0; sk < 2; ++sk) { const int row = 32 * dt + r; vf[2 * dt + sk] = *(const LAS bf16x8*)(wl + 4096 + row * 64 + (((2 * sk + hi) ^ ((row >> 2) & 3)) << 4)); }
}
DI void softmax_lazy1(f32x16& s, float& mref, float& l, f32x16& o0, f32x16& o1) {
    float mx = fmaxf(fmaxf(s[0], s[1]), s[2]);
#pragma unroll
    for (int i = 3; i < 15; i += 2) mx = fmaxf(fmaxf(mx, s[i]), s[i + 1]);
    mx = fmaxf(mx, s[15]);
    if (__any(mx > SM_THR)) {
        float delta = fmaxf(fmaxf(mx, shx(mx, 32)), 0.f); asm volatile("" : "+v"(delta));
        const float alpha = __builtin_amdgcn_exp2f(-delta);
        mref += delta; l *= alpha;
#pragma unroll
        for (int i = 0; i < 16; ++i) { o0[i] *= alpha; o1[i] *= alpha; s[i] -= delta; }
    }
    float sum = 0.f;
#pragma unroll
    for (int i = 0; i < 16; ++i) { s[i] = __builtin_amdgcn_exp2f(s[i]); sum += s[i]; }
    l += sum;
}
DI void pv_step(f32x16& o0, f32x16& o1, const f32x16& p, const bf16x8 (&vf)[4]) {
    const bf16x8 p0 = pack8(p, 0), p1 = pack8(p, 1);
    o0 = mfma32(vf[0], p0, o0); o1 = mfma32(vf[2], p0, o1); o0 = mfma32(vf[1], p1, o0); o1 = mfma32(vf[3], p1, o1);
}

DI void na_unit(LAS unsigned char* wl, const QTab& qt, const LAS float* biasl, const bf16_t* Q, const bf16_t* Kb, const bf16_t* Vt, bf16_t* OA, int b, int rp, int h, int a, int lane) {
    const int r = lane & 31, hi = lane >> 5, pr = pi32(r);
    const int grow = 2 * rp + (r >> 4), qcol = 16 * a + (r & 15), qtok = b * SEQ + grow * 64 + qcol;
    bf16x8 qf[4];
    q_prep<0>(qf, Q + (size_t)qtok * 1024 + h * 64 + 8 * hi, qt.qkg, hi, 0, qt.rope1, qt.ropea);
    const int rs = min(max(grow - 4, 0), 56), cs = min(max(qcol - 8, 0), 48);
    const int krs = min(max(2 * rp - 4, 0), 56), nk = min(max(2 * rp - 3, 0), 56) + 8 - krs, kc0 = min(max(16 * a - 8, 0), 32);
    const bf16_t* kp = Kb + (size_t)(b * SEQ + krs * 64 + kc0 + (lane >> 3)) * 768 + h * 64 + (lane & 7) * 8;
    const bf16_t* vp = Vt + ((size_t)(b * 12 + h) * 64 + (lane >> 2)) * SEQ + krs * 64 + kc0 + (lane & 3) * 8;
    float mref = 0.f, l = 0.f; f32x16 o0 = zero16(), o1 = zero16();
    WTile T;
#pragma unroll
    for (int i = 0; i < 4; ++i) { T.k[i] = *(const u32x4*)(kp + (size_t)8 * i * 768); T.v[i] = *(const u32x4*)(vp + (size_t)16 * i * SEQ); }
    wt_store(wl, T, lane);
#pragma unroll 1
    for (int st = 0; st < nk; ++st) {
        if (st + 1 < nk) { const int n = st + 1;
#pragma unroll
            for (int i = 0; i < 4; ++i) { T.k[i] = *(const u32x4*)(kp + (size_t)(64 * n + 8 * i) * 768); T.v[i] = *(const u32x4*)(vp + (size_t)16 * i * SEQ + 64 * n); } }
        bf16x8 kf[4], vf[4];
        wt_ldk(kf, wl, pr, hi);
        f32x16 sc = splat16(0.f);
#pragma unroll
        for (int c = 0; c < 4; ++c) sc = mfma32(kf[c], qf[c], sc);
        wt_ldv(vf, wl, r, hi);
        const int kr = krs + st; const bool rowok = (kr >= rs) && (kr < rs + 8);
        const LAS float* brow = biasl + (h * 15 + min(max(kr - grow + 7, 0), 14)) * 31 + 15 - qcol;
#pragma unroll
        for (int i = 0; i < 16; ++i) { const int c0 = kc0 + keyidx(i, hi);
            const bool v0 = rowok && (c0 >= cs) && (c0 < cs + 16);
            const float b0 = brow[v0 ? c0 : qcol];
            sc[i] = v0 ? sc[i] + (b0 - mref) : -1e30f; }
        softmax_lazy1(sc, mref, l, o0, o1);
        pv_step(o0, o1, sc, vf);
        if (st + 1 < nk) wt_store(wl, T, lane);
    }
    store_o(OA + (size_t)qtok * 768 + h * 64 + 4 * hi, o0, o1, l);
}

#define DIL_ISSUE(G_, KS_, T_) do { \
    constexpr int sh_ = 2 * (G_), Sd_ = SEQ >> sh_, dd_ = 1 << sh_; const int hk_ = 6 + 2 * (G_) + hs, rd_ = r16 & (dd_ - 1); \
    const bf16_t* kb_ = Kb + (size_t)(b * SEQ + rd_) * 768 + hk_ * 64 + (lane & 7) * 8; \
    const bf16_t* vb_ = Vt + ((size_t)(b * 12 + hk_) * 64 + (lane >> 2)) * SEQ + rd_ * Sd_ + min(max((KS_) + 8 * (lane & 3), 0), Sd_ - 8); \
    _Pragma("unroll") for (int i_ = 0; i_ < 4; ++i_) { const int ik_ = min(max((KS_) + 8 * i_ + (lane >> 3), 0), Sd_ - 1); \
        T_.k[i_] = *(const u32x4*)(kb_ + (size_t)(ik_ << sh_) * 768); T_.v[i_] = *(const u32x4*)(vb_ + (size_t)16 * i_ * SEQ); } } while (0)

template <int G>
DI void dil_group(LAS unsigned char* wl, const QTab& qt, WTile& T, const bf16_t* Q, const bf16_t* Kb, const bf16_t* Vt, int b, int hs, int r16, int ib, int qtok, int lane,
                  float& mref, float& l, f32x16& o0, f32x16& o1) {
    constexpr int sh = 2 * G, Sd = SEQ >> sh, step = 16 >> sh;
    const int r = lane & 31, hi = lane >> 5, pr = pi32(r);
    bf16x8 qf[4];
    q_prep<2>(qf, Q + (size_t)qtok * 1024 + (10 + 2 * G + hs) * 64 + 8 * hi, qt.qkg + 4 * 64, hi, qtok & (SEQ - 1), qt.rope1, qt.ropea);
    const int qd = r16 >> sh, iq = qd + step * (32 * ib + r);
    const int lo = qd + step * 32 * ib - 64, hiend = qd + step * (32 * ib + 31) + 64;
#pragma unroll 1
    for (int ks = (lo >> 5) << 5; ks <= hiend; ks += 32) {
        const bool more = ks + 32 <= hiend;
        if (more) DIL_ISSUE(G, ks + 32, T);
        else if (G < 2) { constexpr int G1 = G < 2 ? G + 1 : 2, sh1 = 2 * G1, step1 = 16 >> sh1; const int lo1 = (r16 >> sh1) + step1 * 32 * ib - 64; DIL_ISSUE(G1, (lo1 >> 5) << 5, T); }
        bf16x8 kf[4], vf[4];
        wt_ldk(kf, wl, pr, hi);
        f32x16 sc = splat16(0.f);
#pragma unroll
        for (int c = 0; c < 4; ++c) sc = mfma32(kf[c], qf[c], sc);
        wt_ldv(vf, wl, r, hi);
#pragma unroll
        for (int i = 0; i < 16; ++i) { const int a0 = ks + keyidx(i, hi);
            const bool v0 = (a0 >= 0) && (a0 < Sd) && (abs(a0 - iq) <= 64);
            sc[i] = v0 ? sc[i] - mref : -1e30f; }
        softmax_lazy1(sc, mref, l, o0, o1);
        pv_step(o0, o1, sc, vf);
        if (more || G < 2) wt_store(wl, T, lane);
    }
}
DI void dil_unit(LAS unsigned char* wl, const QTab& qt, const bf16_t* Q, const bf16_t* Kb, const bf16_t* Vt, bf16_t* OC, int b, int hs, int r16, int ib, int lane) {
    const int r = lane & 31, hi = lane >> 5;
    const int qtok = b * SEQ + r16 + 16 * (32 * ib + r);
    float mref = 0.f, l = 0.f; f32x16 o0 = zero16(), o1 = zero16();
    WTile T;
    { const int lo0 = r16 + 16 * 32 * ib - 64; DIL_ISSUE(0, (lo0 >> 5) << 5, T); wt_store(wl, T, lane); }
    dil_group<0>(wl, qt, T, Q, Kb, Vt, b, hs, r16, ib, qtok, lane, mref, l, o0, o1);
    dil_group<1>(wl, qt, T, Q, Kb, Vt, b, hs, r16, ib, qtok, lane, mref, l, o0, o1);
    dil_group<2>(wl, qt, T, Q, Kb, Vt, b, hs, r16, ib, qtok, lane, mref, l, o0, o1);
    store_o(OC + (size_t)qtok * 768 + hs * 64 + 4 * hi, o0, o1, l);
}

DI void phase_attn(const Ptrs& P, int layer, LAS unsigned char* lds, int tid) {
    const int wave = __builtin_amdgcn_readfirstlane(tid >> 6), lane = tid & 63, c = blockIdx.x;
    const bf16_t* Q = (const bf16_t*)(P.ws + WS_Q); const bf16_t* Kb = (const bf16_t*)(P.ws + WS_K); const bf16_t* Vt = (const bf16_t*)(P.ws + WS_VT);
    bf16_t* OA = (bf16_t*)(P.ws + WS_OALL); bf16_t* OB = OA + 256; bf16_t* OC = OA + 640;
    const QTab qt{P.in[3] + (size_t)layer * 384, (const f32x2*)(P.ws + WS_ROPE1), (const f32x2*)(P.ws + WS_ROPEA)};
    bool gqa_fast;
    { float gq = fabsf(qt.qkg[2 * 64 + lane]), gk = fabsf(qt.qkg[3 * 64 + lane]);
#pragma unroll
      for (int o = 1; o < 64; o <<= 1) { gq = fmaxf(gq, shx(gq, o)); gk = fmaxf(gk, shx(gk, o)); }
      gqa_fast = __builtin_amdgcn_readfirstlane((int)(64.f * QSCALE * gq * gk < 60.f)) != 0; }
    LAS float* biasl = (LAS float*)(lds + LDS_MISC + 1024);
    LAS unsigned char* wl = lds + LDS_SCR + wave * 16384;
    { const float* rpb = P.in[4] + (size_t)layer * 4 * 15 * 31;
      for (int i = tid; i < 4 * 15 * 31; i += NTHR) biasl[i] = rpb[i] * LOG2E; }
    __syncthreads();
#ifndef NO_NA
    int cx = (c & 7) * 32 + (c >> 3); asm volatile("" : "+s"(cx));
    RP(16) for (int u = 0; u < 2; ++u) na_unit(wl, qt, biasl, Q, Kb, Vt, OA, cx >> 5, cx & 31, wave >> 1, 2 * (wave & 1) + u, lane);
#endif
#ifndef NO_DIL
    RP(17) { const int w = cx * 8 + wave; dil_unit(wl, qt, Q, Kb, Vt, OC, w >> 8, (w >> 7) & 1, (w >> 3) & 15, w & 7, lane); }
    __syncthreads();
#endif
#ifndef NO_GQA
    { const int xcd = c & 7, loc = c >> 3;
      if (gqa_fast) { RP(18) for (int i = 0; i < 2; ++i) { const int j = loc + 32 * i, pair = 2 * xcd + (j >> 5), qblk = j & 31;
          if (wave < 4) gqa3_wave<2>(lds + LDS_SCR, qt, Q, Kb, Vt, OB, pair >> 1, pair & 1, qblk, wave, lane_v());
          else gqa3_wave<1>(lds + LDS_SCR, qt, Q, Kb, Vt, OB, pair >> 1, pair & 1, qblk, wave, lane_v()); } }
      else { for (int i = 0; i < 3; ++i) { const int j = loc + 32 * i, pair = 2 * xcd + j / 48, jj = j % 48;
          const int tid2 = (wave << 6) | lane_v();
          gqa_unit<false>(lds + LDS_SCR, qt, Q, Kb, Vt, OB, pair >> 1, (pair & 1) * 3 + jj / 16, jj & 15, tid2); } } }
#endif
}


__global__ void __launch_bounds__(NTHR, 2) mk_fwd(Args a) {
    extern __shared__ __attribute__((aligned(16))) unsigned char lds_raw[];
    LAS unsigned char* lds = (LAS unsigned char*)lds_raw;
    const int tid0 = threadIdx.x;
    const int wid_s = __builtin_amdgcn_readfirstlane(tid0 >> 6);
#define OTID() ({ int l_; asm volatile("v_mbcnt_lo_u32_b32 %0, -1, 0\n\tv_mbcnt_hi_u32_b32 %0, -1, %0" : "=v"(l_)); (wid_s << 6) | l_; })
    for (int i = tid0; i < 256; i += NTHR) ((LAS unsigned*)(lds + LDS_MISC))[i] = 0u;
    __syncthreads();
#define P a
#define ws (a.ws)
    const bool multi = (a.hi - a.lo) > 1;
    XcdBarrier bar; bar.bar = (unsigned*)ws + CW_BAR; bar.x = 0; bar.st = (volatile LAS unsigned*)(lds + LDS_MISC);
    if (multi) bar = xcd_barrier_post((unsigned*)ws + CW_BAR, (volatile LAS unsigned*)(lds + LDS_MISC), tid0);
#define RUN(s) (a.lo <= (s) && (s) < a.hi)

#if TSEL >= 0
    unsigned long long* tsb = (unsigned long long*)(ws + WS_CTL + 262144); int tsi = 0;
#define TSTAMP() do { if (blockIdx.x == 0 && OTID() == 0) tsb[tsi] = __builtin_amdgcn_s_memrealtime(); ++tsi; } while (0)
    TSTAMP();
#else
#define TSTAMP() do { } while (0)
#endif
#define SEAM() do { if (multi) xcd_barrier(bar, OTID()); TSTAMP(); } while (0)
#define H ((bf16_t*)(ws + WS_H))
#define YB ((bf16_t*)(ws + WS_YBUF))
#define ACT ((bf16_t*)(ws + WS_ACT))
#define XS ((bf16_t*)(ws + WS_XS))
#define topi ((int*)(ws + WS_TOPI))
#define topw ((float*)(ws + WS_TOPW))
#define perm ((int*)(ws + WS_PERM))
#define rgate ((float*)(ws + WS_RGATE))
#define cnt ((int*)(ws + WS_CNT))
#define G ((int)gridDim.x)
#define c ((int)blockIdx.x)

    if (PM(0) && RUN(0)) { RP(0) phase_prep(P, lds, OTID()); SEAM(); }

    for (int L = 0; L < DEPTH; ++L) {
        const int base = 1 + 10 * L;
        const bool moe = (L & 1) != 0;
        const float* xcur = (L == 0) ? P.in[0] : (const float*)P.out;
        const float* gains = P.in[1] + (size_t)L * 2 * 1024;
        const bool fuse1 = FUSE_NORM && (L & 1);
        const bool f8in = ((F8_IN >> L) & 1) != 0;
        if (PM(1) && RUN(base + 0) && !fuse1) {
            if (L == 2) { if (f8in) phase_norm<true, false, true>(P.out, P.out, YB, gains, H, nullptr, nullptr, nullptr, nullptr, nullptr, lds, OTID());
                          else phase_norm<true, false, false>(P.out, P.out, YB, gains, H, nullptr, nullptr, nullptr, nullptr, nullptr, lds, OTID()); }
            else { if (f8in) RP(1) phase_norm<false, false, true>(xcur, nullptr, nullptr, gains, H, nullptr, nullptr, nullptr, nullptr, nullptr, lds, OTID());
                   else RP(1) phase_norm<false, false, false>(xcur, nullptr, nullptr, gains, H, nullptr, nullptr, nullptr, nullptr, nullptr, lds, OTID()); }
            SEAM(); }
        if (PM(2) && RUN(base + 1)) {
            pg8::Gemm g{H, (const bf16_t*)(ws + WS_W_IN + (size_t)L * INW * 1024 * 2), f8in ? 512 : 1024, 0x7A7A7A7A}; pg8::StaticOrderR S; S.init(NTOK, INW, G, c); S.ssq = fuse1 ? (const float*)(ws + WS_SSQ) : nullptr; S.tab = (LAS float*)(lds + LDS_MISC + 1024); S.wid = wid_s;
            EpiIn E{(bf16_t*)(ws + WS_Q), (bf16_t*)(ws + WS_K), (bf16_t*)(ws + WS_VRAW), (bf16_t*)(ws + WS_G), fuse1 ? (const LAS float*)(lds + LDS_MISC + 1024) : nullptr};
            if (f8in) RP(2) pg8::gemm_phase<EpiIn, pg8::StaticOrderR, true, true, true>(lds + LDS_SCR, g, S, E, OTID());
            else RP(2) pg8::gemm_phase<EpiIn, pg8::StaticOrderR, true, true, false>(lds + LDS_SCR, g, S, E, OTID());
            SEAM(); }
        if (PM(3) && RUN(base + 2)) { phase_qkvprep(P, L, lds, OTID()); SEAM(); }
        if (PM(4) && RUN(base + 3)) { RP(4) phase_attn(P, L, lds, OTID()); SEAM(); }
        if (PM(5) && RUN(base + 4)) {
            pg8::Gemm g{(const bf16_t*)(ws + WS_OALL), (const bf16_t*)(ws + WS_W_BR) + (size_t)L * 1024 * 768, 768, 0}; pg8::StaticOrder S; S.init(NTOK, 1024, G, c);
            EpiGate E{(const unsigned char*)(ws + WS_G), (bf16_t*)(ws + WS_MERGED)};
            RP(5) pg8::gemm_phase<EpiGate, pg8::StaticOrder, true, true>(lds + LDS_SCR, g, S, E, OTID());
            SEAM(); }
        if (PM(6) && RUN(base + 5)) {
            pg8::Gemm g{(const bf16_t*)(ws + WS_MERGED), (const bf16_t*)(ws + WS_W_OUT) + (size_t)L * 1024 * 1024, 1024, 0}; pg8::StaticOrder S; S.init(NTOK, 1024, G, c);
            const bool fuse2 = FUSE_NORM && !moe;
            EpiResidN E{xcur, P.out, fuse2 ? (unsigned char*)H : nullptr, (float*)(ws + WS_SSQ), (int)((F8_FFN >> (L >> 1)) & 1)};
            pg8::gemm_phase<EpiResidN, pg8::StaticOrder, true, true>(lds + LDS_SCR, g, S, E, OTID());
            SEAM(); }
        if (!moe) {
            const int di = L >> 1; const bool f8d = ((F8_FFN >> di) & 1) != 0;
            if (PM(7) && RUN(base + 6) && !FUSE_NORM) {
                if (f8d) RP(7) phase_norm<false, false, true>(P.out, nullptr, nullptr, gains + 1024, H, nullptr, nullptr, nullptr, nullptr, nullptr, lds, OTID());
                else RP(7) phase_norm<false, false, false>(P.out, nullptr, nullptr, gains + 1024, H, nullptr, nullptr, nullptr, nullptr, nullptr, lds, OTID());
                SEAM(); }
            if (PM(8) && RUN(base + 7)) {
                pg8::StaticOrderR S; S.init(NTOK, 2 * FF, G, c); S.ssq = FUSE_NORM ? (const float*)(ws + WS_SSQ) : nullptr; S.tab = (LAS float*)(lds + LDS_MISC + 1024); S.wid = wid_s;
                if (f8d) { pg8::Gemm g{H, (const bf16_t*)(ws + WS_W_FGU + (size_t)di * 2 * FF * 1024 * 2), 512, 0x7A7A7A7A}; EpiSwiglu<true> E{(unsigned char*)ACT, FF, FUSE_NORM ? (const LAS float*)(lds + LDS_MISC + 1024) : nullptr};
                    RP(8) pg8::gemm_phase<EpiSwiglu<true>, pg8::StaticOrderR, true, true, true>(lds + LDS_SCR, g, S, E, OTID()); }
                else { pg8::Gemm g{H, (const bf16_t*)(ws + WS_W_FGU + (size_t)di * 2 * FF * 1024 * 2), 1024, 0}; EpiSwiglu<false> E{(unsigned char*)ACT, FF, FUSE_NORM ? (const LAS float*)(lds + LDS_MISC + 1024) : nullptr};
                    RP(8) pg8::gemm_phase<EpiSwiglu<false>, pg8::StaticOrderR, true, true, false>(lds + LDS_SCR, g, S, E, OTID()); }
                SEAM(); }
            if (PM(9) && RUN(base + 8)) {
                pg8::StaticOrder S; S.init(NTOK, 1024, G, c); EpiResidN E{P.out, P.out, FUSE_NORM ? (unsigned char*)H : nullptr, (float*)(ws + WS_SSQ), (int)((F8_IN >> (L + 1)) & 1)};
                if (f8d) { pg8::Gemm g{ACT, (const bf16_t*)(ws + WS_W_FDN + (size_t)di * 1024 * FF * 2), FF / 2, 0x79797979};
                    pg8::gemm_phase<EpiResidN, pg8::StaticOrder, true, true, true>(lds + LDS_SCR, g, S, E, OTID()); }
                else { pg8::Gemm g{ACT, (const bf16_t*)(ws + WS_W_FDN + (size_t)di * 1024 * FF * 2), FF, 0};
                    pg8::gemm_phase<EpiResidN, pg8::StaticOrder, true, true, false>(lds + LDS_SCR, g, S, E, OTID()); }
                SEAM(); }
        } else {
            const int li = L >> 1;
            const bool f8 = ((F8_MOE >> li) & 1) != 0;
            if (PM(10) && RUN(base + 6)) {
                if (f8) RP(10) phase_norm<false, true, true>(P.out, nullptr, nullptr, gains + 1024, H, P.in[9] + (size_t)li * 1024 * 8, topi, topw, cnt, perm, lds, OTID());
                else RP(10) phase_norm<false, true, false>(P.out, nullptr, nullptr, gains + 1024, H, P.in[9] + (size_t)li * 1024 * 8, topi, topw, cnt, perm, lds, OTID());
                SEAM(); }
            if (PM(11) && RUN(base + 7)) {
                if (f8) RP(11) phase_scatter<true>(cnt, topi, topw, H, XS, perm, rgate, lds, OTID());
                else RP(11) phase_scatter<false>(cnt, topi, topw, H, XS, perm, rgate, lds, OTID());
                SEAM(); }
            if ((PM(12) || PM(13)) && (RUN(base + 8) || RUN(base + 9))) {
                volatile LAS int* misc = (volatile LAS int*)(lds + LDS_MISC + 64);
                moe_totals(cnt, misc, OTID());
                pg8::GroupedOrder S; S.c8 = c & 7; S.loc = c >> 3; S.per = G >> 3;
                S.tp[0] = 0;
#pragma unroll
                for (int e = 0; e < 8; ++e) S.tp[e + 1] = S.tp[e] + ((__builtin_amdgcn_readfirstlane(misc[e]) + 255) >> 8);
                if (PM(12) && RUN(base + 8)) {
                    S.nN = 2 * ED / 256; S.cb = 7;
                    if (f8) { S.bstride = (long)2 * ED * 1024;
                        pg8::Gemm g{XS, (const bf16_t*)(ws + WS_W_MGU + (size_t)li * 8 * 2 * ED * 1024 * 2), 512, 0x7A7A7A7A};
                        EpiSwiglu<true> E{(unsigned char*)ACT, ED, nullptr};
                        RP(12) pg8::gemm_phase<EpiSwiglu<true>, pg8::GroupedOrder, true, true, true>(lds + LDS_SCR, g, S, E, OTID()); }
                    else { S.bstride = (long)2 * ED * 1024 * 2;
                        pg8::Gemm g{XS, (const bf16_t*)(ws + WS_W_MGU + (size_t)li * 8 * 2 * ED * 1024 * 2), 1024, 0};
                        EpiSwiglu<false> E{(unsigned char*)ACT, ED, nullptr};
                        RP(12) pg8::gemm_phase<EpiSwiglu<false>, pg8::GroupedOrder, true, true, false>(lds + LDS_SCR, g, S, E, OTID()); }
                    SEAM(); }
                if (PM(13) && RUN(base + 9)) {
                    S.nN = 4; S.cb = 4;
                    EpiMoeDown E{perm, rgate, YB};
                    if (f8) { S.bstride = (long)1024 * ED;
                        pg8::Gemm g{ACT, (const bf16_t*)(ws + WS_W_MDN + (size_t)li * 8 * 1024 * ED * 2), ED / 2, 0x79797979};
                        RP(13) pg8::gemm_phase<EpiMoeDown, pg8::GroupedOrder, true, true, true>(lds + LDS_SCR, g, S, E, OTID()); }
                    else { S.bstride = (long)1024 * ED * 2;
                        pg8::Gemm g{ACT, (const bf16_t*)(ws + WS_W_MDN + (size_t)li * 8 * 1024 * ED * 2), ED, 0};
                        RP(13) pg8::gemm_phase<EpiMoeDown, pg8::GroupedOrder, true, true, false>(lds + LDS_SCR, g, S, E, OTID()); }
                    SEAM(); }
            }
        }
    }
    if (PM(14) && RUN(41)) phase_final(P.out, YB, P.out, OTID());
#if TSEL >= 0
    xcd_barrier(bar, OTID()); TSTAMP();
    if (blockIdx.x == 0 && OTID() == 0) { asm volatile("s_waitcnt vmcnt(0)" ::: "memory"); const unsigned long long d = tsb[TSEL + 1] - tsb[TSEL]; P.out[0] += (float)d * (0.01f * 0.25f); }
#endif
#undef RUN
#undef SEAM
#undef P
#undef ws
#undef H
#undef YB
#undef ACT
#undef XS
#undef topi
#undef topw
#undef perm
#undef rgate
#undef cnt
#undef G
#undef c
}

#if MK_DEBUG
DI unsigned hsh(unsigned x) { x ^= x >> 16; x *= 0x7feb352du; x ^= x >> 15; x *= 0x846ca68bu; x ^= x >> 16; return x; }
DI void rep(unsigned* ctl, int slot, float got, float ref, float scale) { float e = fabsf(got - ref) / (fabsf(ref) + scale); if (!(e == e) || e > 1e30f) e = 1e30f; atomicMax(ctl + CW_ERR + slot, __float_as_uint(e)); }
DI float dotbf(const bf16_t* a, const bf16_t* b, int K, int lane) { float s = 0.f; for (int k = lane; k < K; k += 64) s += bf2f(a[k]) * bf2f(b[k]); return wave_sum(s); }
DI float rbf(float x) { return bflo(pk2(x, 0.f) & 0xffffu); }

__global__ void chk_prep(Args a) {
    unsigned* ctl = (unsigned*)a.ws; const unsigned h0 = hsh(blockIdx.x * 64 + threadIdx.x + 1);
    unsigned h = h0;
#define NXT() (h = hsh(h + 0x9e3779b9u))
    { const int L = NXT() % 4, n = NXT() % 5632, k = NXT() % 1024; rep(ctl, 0, bf2f(((const bf16_t*)(a.ws + WS_W_IN))[((size_t)L * 5632 + n) * 1024 + k]), rbf(a.in[2][((size_t)L * 1024 + k) * 5632 + n]), 1e-3f); }
    { const int L = NXT() % 4, n = NXT() % 1024, k = NXT() % 768; rep(ctl, 0, bf2f(((const bf16_t*)(a.ws + WS_W_BR))[((size_t)L * 1024 + n) * 768 + k]), rbf(a.in[5][((size_t)L * 768 + k) * 1024 + n]), 1e-3f); }
    { const int L = NXT() % 4, n = NXT() % 1024, k = NXT() % 1024; rep(ctl, 0, bf2f(((const bf16_t*)(a.ws + WS_W_OUT))[((size_t)L * 1024 + n) * 1024 + k]), rbf(a.in[6][((size_t)L * 1024 + k) * 1024 + n]), 1e-3f); }
    { const int L = NXT() % 2, n = NXT() % 5632, k = NXT() % 1024, pn = n >> 8, j = n & 255, cc = j < 128 ? pn * 128 + j : FF + pn * 128 + j - 128;
      rep(ctl, 0, bf2f(((const bf16_t*)(a.ws + WS_W_FGU))[((size_t)L * 5632 + n) * 1024 + k]), rbf(a.in[7][((size_t)L * 1024 + k) * 5632 + cc]), 1e-3f); }
    { const int L = NXT() % 2, n = NXT() % 1024, k = NXT() % 2816; rep(ctl, 0, bf2f(((const bf16_t*)(a.ws + WS_W_FDN))[((size_t)L * 1024 + n) * 2816 + k]), rbf(a.in[8][((size_t)L * 2816 + k) * 1024 + n]), 1e-3f); }
    { const int L = NXT() % 16, n = NXT() % 7168, k = NXT() % 1024, pn = n >> 8, j = n & 255, cc = j < 128 ? pn * 128 + j : ED + pn * 128 + j - 128;
      rep(ctl, 0, bf2f(((const bf16_t*)(a.ws + WS_W_MGU))[((size_t)L * 7168 + n) * 1024 + k]), rbf(a.in[10][((size_t)L * 1024 + k) * 7168 + cc]), 1e-3f); }
    { const int L = NXT() % 16, n = NXT() % 1024, k = NXT() % 3584; rep(ctl, 0, bf2f(((const bf16_t*)(a.ws + WS_W_MDN))[((size_t)L * 1024 + n) * 3584 + k]), rbf(a.in[11][((size_t)L * 3584 + k) * 1024 + n]), 1e-3f); }
#undef NXT
}
__global__ void chk_norm(Args a, const float* xin, const float* gain, int comb, int slot) {
    unsigned* ctl = (unsigned*)a.ws; const int lane = threadIdx.x; const int row = blockIdx.x == 0 ? 0 : (blockIdx.x == 1 ? NTOK - 1 : hsh(blockIdx.x * 7 + slot) % NTOK);
    const bf16_t* H = (const bf16_t*)(a.ws + WS_H); const bf16_t* yb = (const bf16_t*)(a.ws + WS_YBUF);
    float v[16], ss = 0.f;
    for (int j = 0; j < 16; ++j) { const int cidx = lane + 64 * j; float x = xin[(size_t)row * 1024 + cidx];
        if (comb) { x += bf2f(yb[(size_t)row * 1024 + cidx]) + bf2f(yb[((size_t)NTOK + row) * 1024 + cidx]); rep(ctl, slot, a.out[(size_t)row * 1024 + cidx], x, 1e-2f); }
        v[j] = x; ss += x * x; }
    const float rstd = 1.f / sqrtf(wave_sum(ss) / 1024.f + EPS);
    for (int j = 0; j < 16; ++j) { const int cidx = lane + 64 * j; rep(ctl, slot, bf2f(H[(size_t)row * 1024 + cidx]), v[j] * rstd * gain[cidx], 2e-2f); }
}
__global__ void chk_gemm_in(Args a, int L) {
    unsigned* ctl = (unsigned*)a.ws; const int lane = threadIdx.x; unsigned h = hsh(blockIdx.x + 77 * L + 5);
    const int row = blockIdx.x < 4 ? (blockIdx.x & 1 ? NTOK - 1 : 0) : h % NTOK; h = hsh(h + 1); const int col = blockIdx.x < 2 ? 0 : (blockIdx.x < 4 ? INW - 1 : h % INW);
    const float d = dotbf((const bf16_t*)(a.ws + WS_H) + (size_t)row * 1024, (const bf16_t*)(a.ws + WS_W_IN) + ((size_t)L * INW + col) * 1024, 1024, lane);
    float got;
    if (col < 1024) got = bf2f(((const bf16_t*)(a.ws + WS_Q))[(size_t)row * 1024 + col]);
    else if (col < 1792) got = bf2f(((const bf16_t*)(a.ws + WS_K))[(size_t)row * 768 + col - 1024]);
    else if (col < 2560) got = bf2f(((const bf16_t*)(a.ws + WS_VRAW))[(size_t)row * 768 + col - 1792]);
    else got = ((float)((const unsigned char*)(a.ws + WS_G))[(size_t)row * 3072 + col - 2560] + 0.5f) * (1.f / 256.f);
    const float ref = col < 2560 ? d : 1.f / (1.f + expf(-d));
    if (lane == 0) rep(ctl, 2, got, ref, 5e-2f);
}
__global__ void chk_qk(Args a, int L) {
    unsigned* ctl = (unsigned*)a.ws; const int j = threadIdx.x; unsigned h = hsh(blockIdx.x + 131 * L + 9);
    const int tok = blockIdx.x == 0 ? 0 : (blockIdx.x == 1 ? NTOK - 1 : h % NTOK); h = hsh(h + 1); const int isk = 1; h = hsh(h + 1); const int head = h % 12;
    const int col = (isk ? 1024 : 0) + head * 64 + j;
    const bf16_t* hr = (const bf16_t*)(a.ws + WS_H) + (size_t)tok * 1024; const bf16_t* wr = (const bf16_t*)(a.ws + WS_W_IN) + ((size_t)L * INW + col) * 1024;
    float d = 0.f; for (int k = 0; k < 1024; ++k) d += bf2f(hr[k]) * bf2f(wr[k]);
    d = rbf(d);
    const float rstd = 1.f / sqrtf(wave_sum(d * d) / 64.f + EPS);
    const int br = isk ? (head < 4 ? 0 : (head < 6 ? 1 : 2)) : (head < 4 ? 0 : (head < 10 ? 1 : 2));
    const float y = d * rstd * a.in[3][((size_t)(L * 3 + br) * 2 + isk) * 64 + j];
    const int s = tok & 4095; float o = y;
    if (br == 2) { const int i = j & 31; const float ang = (float)s * powf(10000.f, -(float)(2 * i) / 64.f); const float p = __shfl_xor(y, 32); o = j < 32 ? y * cosf(ang) - p * sinf(ang) : y * cosf(ang) + p * sinf(ang); }
    if (br == 1) { const int i = j & 15; const float pos = (float)((j < 32) ? (s >> 6) : (s & 63)); const float ang = pos * powf(10000.f, -(float)(2 * i) / 32.f); const float p = __shfl_xor(y, 16);
        o = (j & 16) == 0 ? y * cosf(ang) - p * sinf(ang) : y * cosf(ang) + p * sinf(ang); }
    if (!isk) o *= QSCALE;
    const float got = isk ? bf2f(((const bf16_t*)(a.ws + WS_K))[(size_t)tok * 768 + head * 64 + j]) : bf2f(((const bf16_t*)(a.ws + WS_Q))[(size_t)tok * 1024 + head * 64 + j]);
    rep(ctl, 3, got, o, 3e-2f);
}
__global__ void chk_vt(Args a) {
    unsigned* ctl = (unsigned*)a.ws; unsigned h = hsh(blockIdx.x * 64 + threadIdx.x + 3);
    const int b = h % 8; h = hsh(h + 1); const int hv = h % 12; h = hsh(h + 1); const int d = h % 64; h = hsh(h + 1); const int s = h % 4096;
    const int g = hv < 6 ? 0 : (hv - 6) >> 1, dd = 1 << (2 * g), Sd = 4096 / dd, pos = (s % dd) * Sd + s / dd;
    rep(ctl, 4, bf2f(((const bf16_t*)(a.ws + WS_VT))[((size_t)(b * 12 + hv) * 64 + d) * 4096 + pos]), bf2f(((const bf16_t*)(a.ws + WS_VRAW))[(size_t)(b * 4096 + s) * 768 + hv * 64 + d]), 1e-3f);
}
DI float dot64(const bf16_t* x, const bf16_t* y) { float s = 0.f; for (int k = 0; k < 64; ++k) s += bf2f(x[k]) * bf2f(y[k]); return s; }
DI float dot64q(const float* x, const bf16_t* y) { float s = 0.f; for (int k = 0; k < 64; ++k) s += x[k] * bf2f(y[k]); return s; }
DI float chk_qn(const Args& a, int L, int tok, int head, int t) {
    const float d = bf2f(((const bf16_t*)(a.ws + WS_Q))[(size_t)tok * 1024 + head * 64 + t]);
    const float rstd = 1.f / sqrtf(wave_sum(d * d) / 64.f + EPS);
    const int br = head < 4 ? 0 : (head < 10 ? 1 : 2);
    const float y = d * rstd * a.in[3][((size_t)(L * 3 + br) * 2 + 0) * 64 + t];
    const int s = tok & 4095; float o = y;
    if (br == 2) { const int i = t & 31; const float ang = (float)s * powf(10000.f, -(float)(2 * i) / 64.f); const float p = __shfl_xor(y, 32); o = t < 32 ? y * cosf(ang) - p * sinf(ang) : y * cosf(ang) + p * sinf(ang); }
    if (br == 1) { const int i = t & 15; const float pos = (float)((t < 32) ? (s >> 6) : (s & 63)); const float ang = pos * powf(10000.f, -(float)(2 * i) / 32.f); const float p = __shfl_xor(y, 16);
        o = (t & 16) == 0 ? y * cosf(ang) - p * sinf(ang) : y * cosf(ang) + p * sinf(ang); }
    return rbf(o * QSCALE);
}
__global__ void chk_na(Args a, int L) {
    __shared__ float p[128]; __shared__ float qn[64]; unsigned* ctl = (unsigned*)a.ws; const int t = threadIdx.x; unsigned h = hsh(blockIdx.x + 31 * L + 11);
    const int tok = blockIdx.x == 0 ? 0 : (blockIdx.x == 1 ? NTOK - 1 : h % NTOK); h = hsh(h + 1); const int hd = h % 4;
    const int b = tok >> 12, s = tok & 4095, gr = s >> 6, cq = s & 63, rs = min(max(gr - 4, 0), 56), cs = min(max(cq - 8, 0), 48);
    const bf16_t* Kb = (const bf16_t*)(a.ws + WS_K); const bf16_t* V = (const bf16_t*)(a.ws + WS_VRAW);
    qn[t] = chk_qn(a, L, tok, hd, t); __syncthreads();
    float mx = -1e30f;
    for (int q = 0; q < 2; ++q) { const int idx = t + 64 * q, kr = rs + idx / 16, ck = cs + idx % 16, kt = b * 4096 + kr * 64 + ck;
        const float sc = dot64q(qn, Kb + (size_t)kt * 768 + hd * 64) + LOG2E * a.in[4][(((size_t)L * 4 + hd) * 15 + (kr - gr + 7)) * 31 + (ck - cq + 15)];
        p[idx] = sc; mx = fmaxf(mx, sc); }
    for (int o = 1; o < 64; o <<= 1) mx = fmaxf(mx, __shfl_xor(mx, o));
    __syncthreads();
    float sum = 0.f, acc = 0.f;
    for (int idx = 0; idx < 128; ++idx) { const int kr = rs + idx / 16, ck = cs + idx % 16, kt = b * 4096 + kr * 64 + ck; const float e = exp2f(p[idx] - mx); sum += e; acc += e * bf2f(V[(size_t)kt * 768 + hd * 64 + t]); }
    rep(ctl, 5, bf2f(((const bf16_t*)(a.ws + WS_OALL))[(size_t)tok * 768 + hd * 64 + t]), acc / sum, 3e-2f);
}
__global__ void chk_dil(Args a, int L) {
    __shared__ float p[3][192]; __shared__ float qn[3][64]; unsigned* ctl = (unsigned*)a.ws; const int t = threadIdx.x; unsigned h = hsh(blockIdx.x + 37 * L + 13);
    const int tok = blockIdx.x == 0 ? 0 : (blockIdx.x == 1 ? NTOK - 1 : (blockIdx.x == 2 ? 4095 : (blockIdx.x == 3 ? 4096 + 70 : h % NTOK))); h = hsh(h + 1); const int hs = h & 1;
    const int b = tok >> 12, s = tok & 4095;
    const bf16_t* Kb = (const bf16_t*)(a.ws + WS_K); const bf16_t* V = (const bf16_t*)(a.ws + WS_VRAW);
    for (int g = 0; g < 3; ++g) qn[g][t] = chk_qn(a, L, tok, 10 + 2 * g + hs, t);
    __syncthreads();
    float lse[3], og[3];
    for (int g = 0; g < 3; ++g) { const int dd = 1 << (2 * g), hq = 10 + 2 * g + hs, hk = 6 + 2 * g + hs; float mx = -1e30f;
        for (int q = 0; q < 3; ++q) { const int idx = t + 64 * q; if (idx < 129) { const int pos = s + dd * (idx - 64); float sc = -1e30f;
            if (pos >= 0 && pos < 4096) sc = dot64q(qn[g], Kb + (size_t)(b * 4096 + pos) * 768 + hk * 64);
            p[g][idx] = sc; mx = fmaxf(mx, sc); } }
        for (int o = 1; o < 64; o <<= 1) mx = fmaxf(mx, __shfl_xor(mx, o));
        __syncthreads();
        float sum = 0.f, acc = 0.f;
        for (int idx = 0; idx < 129; ++idx) { const int pos = s + dd * (idx - 64); if (pos >= 0 && pos < 4096) { const float e = exp2f(p[g][idx] - mx); sum += e; acc += e * bf2f(V[(size_t)(b * 4096 + pos) * 768 + hk * 64 + t]); } }
        lse[g] = mx + log2f(sum); og[g] = acc / sum; }
    const float M = fmaxf(lse[0], fmaxf(lse[1], lse[2])); const float w0 = exp2f(lse[0] - M), w1 = exp2f(lse[1] - M), w2 = exp2f(lse[2] - M);
    rep(ctl, 6, bf2f(((const bf16_t*)(a.ws + WS_OALL))[(size_t)tok * 768 + 640 + hs * 64 + t]), (w0 * og[0] + w1 * og[1] + w2 * og[2]) / (w0 + w1 + w2), 3e-2f);
}
__global__ void chk_gqa(Args a, int L) {
    __shared__ float p[4096]; __shared__ float qn[64]; unsigned* ctl = (unsigned*)a.ws; const int t = threadIdx.x; unsigned h = hsh(blockIdx.x + 41 * L + 17);
    const int tok = blockIdx.x == 0 ? 0 : (blockIdx.x == 1 ? NTOK - 1 : h % NTOK); h = hsh(h + 1); const int hq = h % 6, kvh = hq / 3, b = tok >> 12;
    const bf16_t* Kb = (const bf16_t*)(a.ws + WS_K); const bf16_t* V = (const bf16_t*)(a.ws + WS_VRAW);
    qn[t] = chk_qn(a, L, tok, 4 + hq, t); __syncthreads();
    float mx = -1e30f;
    for (int k = t; k < 4096; k += 64) { const float sc = dot64q(qn, Kb + (size_t)(b * 4096 + k) * 768 + (4 + kvh) * 64); p[k] = sc; mx = fmaxf(mx, sc); }
    for (int o = 1; o < 64; o <<= 1) mx = fmaxf(mx, __shfl_xor(mx, o));
    __syncthreads();
    float sum = 0.f, acc = 0.f;
    for (int k = 0; k < 4096; ++k) { const float e = exp2f(p[k] - mx); sum += e; acc += e * bf2f(V[(size_t)(b * 4096 + k) * 768 + (4 + kvh) * 64 + t]); }
    rep(ctl, 7, bf2f(((const bf16_t*)(a.ws + WS_OALL))[(size_t)tok * 768 + 256 + hq * 64 + t]), acc / sum, 3e-2f);
}
__global__ void chk_gate(Args a, int L) {
    unsigned* ctl = (unsigned*)a.ws; const int lane = threadIdx.x; unsigned h = hsh(blockIdx.x + 43 * L + 19);
    const int row = blockIdx.x < 2 ? (blockIdx.x ? NTOK - 1 : 0) : h % NTOK; h = hsh(h + 1); const int col = blockIdx.x < 2 ? (blockIdx.x ? 1023 : 0) : h % 1024;
    const bf16_t* orow = (const bf16_t*)(a.ws + WS_OALL) + (size_t)row * 768; const bf16_t* wrow = (const bf16_t*)(a.ws + WS_W_BR) + ((size_t)L * 1024 + col) * 768;
    const float ya = dotbf(orow, wrow, 256, lane), yb = dotbf(orow + 256, wrow + 256, 384, lane), yc = dotbf(orow + 640, wrow + 640, 128, lane);
    const unsigned char* G = (const unsigned char*)(a.ws + WS_G) + (size_t)row * 3072;
    const float ref = (((float)G[col] + 0.5f) * ya + ((float)G[1024 + col] + 0.5f) * yb + ((float)G[2048 + col] + 0.5f) * yc) * (1.f / 256.f);
    if (lane == 0) rep(ctl, 8, bf2f(((const bf16_t*)(a.ws + WS_MERGED))[(size_t)row * 1024 + col]), ref, 5e-2f);
}
__global__ void chk_resid(Args a, const float* xold, const bf16_t* A, const bf16_t* Bt, int K, int slot) {
    unsigned* ctl = (unsigned*)a.ws; const int lane = threadIdx.x; unsigned h = hsh(blockIdx.x + 47 * slot + 23);
    const int row = blockIdx.x < 2 ? (blockIdx.x ? NTOK - 1 : 0) : h % NTOK; h = hsh(h + 1); const int col = blockIdx.x < 2 ? (blockIdx.x ? 1023 : 0) : h % 1024;
    const float d = dotbf(A + (size_t)row * K, Bt + (size_t)col * K, K, lane);
    if (lane == 0) rep(ctl, slot, a.out[(size_t)row * 1024 + col], xold[(size_t)row * 1024 + col] + d, 5e-2f);
}
__global__ void chk_router(Args a, const float* gain, const float* wr) {
    unsigned* ctl = (unsigned*)a.ws; const int lane = threadIdx.x; const int row = blockIdx.x == 0 ? 0 : (blockIdx.x == 1 ? NTOK - 1 : hsh(blockIdx.x + 29) % NTOK);
    float v[16], ss = 0.f;
    for (int j = 0; j < 16; ++j) { v[j] = a.out[(size_t)row * 1024 + lane + 64 * j]; ss += v[j] * v[j]; }
    const float rstd = 1.f / sqrtf(wave_sum(ss) / 1024.f + EPS);
    float lg[8];
    for (int e = 0; e < 8; ++e) { float s = 0.f; for (int j = 0; j < 16; ++j) { const int k = lane + 64 * j; s += v[j] * rstd * gain[k] * wr[k * 8 + e]; } lg[e] = wave_sum(s); }
    int e0 = 0; for (int e = 1; e < 8; ++e) if (lg[e] > lg[e0]) e0 = e;
    int e1 = e0 == 0 ? 1 : 0; for (int e = 0; e < 8; ++e) if (e != e0 && lg[e] > lg[e1]) e1 = e;
    float third = -1e30f; for (int e = 0; e < 8; ++e) if (e != e0 && e != e1) third = fmaxf(third, lg[e]);
    const int* topi = (const int*)(a.ws + WS_TOPI); const float* topw = (const float*)(a.ws + WS_TOPW);
    if (lane == 0) { const bool clear = (lg[e0] - lg[e1] > 1e-3f) && (lg[e1] - third > 1e-3f);
        if (clear) { rep(ctl, 13, (float)topi[row * 2], (float)e0, 1e-3f); rep(ctl, 13, (float)topi[row * 2 + 1], (float)e1, 1e-3f);
            const float t = expf(lg[e1] - lg[e0]); rep(ctl, 13, topw[row * 2], 1.f / (1.f + t), 1e-2f); rep(ctl, 13, topw[row * 2 + 1], t / (1.f + t), 1e-2f); } }
}
__global__ void chk_up(Args a, const bf16_t* A, const bf16_t* Wt, int ffd, int slot) {
    unsigned* ctl = (unsigned*)a.ws; const int lane = threadIdx.x; unsigned h = hsh(blockIdx.x + 53 * slot + 3);
    const int row = blockIdx.x < 2 ? (blockIdx.x ? NTOK - 1 : 0) : h % NTOK; h = hsh(h + 1); const int j = blockIdx.x < 2 ? (blockIdx.x ? ffd - 1 : 0) : h % ffd;
    const int pn = j >> 7, jj = j & 127;
    const float g = dotbf(A + (size_t)row * 1024, Wt + (size_t)(256 * pn + jj) * 1024, 1024, lane), u = dotbf(A + (size_t)row * 1024, Wt + (size_t)(256 * pn + 128 + jj) * 1024, 1024, lane);
    if (lane == 0) rep(ctl, slot, bf2f(((const bf16_t*)(a.ws + WS_ACT))[(size_t)row * ffd + j]), g / (1.f + expf(-g)) * u, 3e-2f);
}
__global__ void chk_scatter(Args a) {
    unsigned* ctl = (unsigned*)a.ws; const int lane = threadIdx.x; const int* cnt = (const int*)(a.ws + WS_CNT); const int* perm = (const int*)(a.ws + WS_PERM);
    const int* topi = (const int*)(a.ws + WS_TOPI); const float* topw = (const float*)(a.ws + WS_TOPW); const float* rg = (const float*)(a.ws + WS_RGATE);
    int tot[8], base[9]; base[0] = 0;
    for (int e = 0; e < 8; ++e) { int s = 0; for (int w = lane; w < 256; w += 64) s += cnt[w * 8 + e]; for (int o = 1; o < 64; o <<= 1) s += __shfl_xor(s, o); tot[e] = s; base[e + 1] = base[e] + ((s + 255) >> 8 << 8); }
    if (blockIdx.x == 0) { int sum = 0; for (int e = 0; e < 8; ++e) sum += tot[e]; if (lane == 0) rep(ctl, 14, (float)sum, 65536.f, 1e-3f);
        unsigned long long cs = 0; int nv = 0; for (int i = lane; i < MROWS; i += 64) { const int p = perm[i]; if (p >= 0) { cs += (unsigned long long)p; ++nv; } }
        for (int o = 1; o < 64; o <<= 1) { cs += __shfl_xor(cs, o); nv += __shfl_xor(nv, o); }
        if (lane == 0) { rep(ctl, 14, (float)nv, 65536.f, 1e-3f); rep(ctl, 14, (float)(cs == 65536ull * 65535ull / 2ull), 1.f, 1e-3f); } }
    const int pos = hsh(blockIdx.x + 5) % MROWS; const int p = perm[pos];
    int e = 0; for (int k = 1; k < 8; ++k) e += pos >= base[k];
    const bool inr = pos < base[e] + tot[e];
    if (lane == 0) rep(ctl, 14, (float)(p >= 0), (float)inr, 1e-3f);
    if (p >= 0 && inr) { const int tok = p >> 1, slot = p & 1;
        if (lane == 0) { rep(ctl, 14, (float)topi[tok * 2 + slot], (float)e, 1e-3f); rep(ctl, 14, rg[pos], topw[tok * 2 + slot], 1e-3f); }
        for (int j = 0; j < 16; ++j) rep(ctl, 14, bf2f(((const bf16_t*)(a.ws + WS_XS))[(size_t)pos * 1024 + lane + 64 * j]), bf2f(((const bf16_t*)(a.ws + WS_H))[(size_t)tok * 1024 + lane + 64 * j]), 1e-3f); }
}
__global__ void chk_moe(Args a, int li, int down) {
    unsigned* ctl = (unsigned*)a.ws; const int lane = threadIdx.x; const int* perm = (const int*)(a.ws + WS_PERM); const int* topi = (const int*)(a.ws + WS_TOPI); const float* rg = (const float*)(a.ws + WS_RGATE);
    unsigned h = hsh(blockIdx.x + 59 * down + 7); int pos = h % MROWS; while (perm[pos] < 0) pos = (pos + 1) % MROWS;
    const int p = perm[pos], tok = p >> 1, slot = p & 1, e = topi[tok * 2 + slot]; h = hsh(h + 1);
    if (!down) { const int j = h % ED, pn = j >> 7, jj = j & 127; const bf16_t* Wt = (const bf16_t*)(a.ws + WS_W_MGU) + (size_t)(li * 8 + e) * 2 * ED * 1024; const bf16_t* A = (const bf16_t*)(a.ws + WS_XS) + (size_t)pos * 1024;
        const float g = dotbf(A, Wt + (size_t)(256 * pn + jj) * 1024, 1024, lane), u = dotbf(A, Wt + (size_t)(256 * pn + 128 + jj) * 1024, 1024, lane);
        if (lane == 0) rep(ctl, 15, bf2f(((const bf16_t*)(a.ws + WS_ACT))[(size_t)pos * ED + j]), g / (1.f + expf(-g)) * u, 3e-2f); }
    else { const int col = h % 1024; const float d = dotbf((const bf16_t*)(a.ws + WS_ACT) + (size_t)pos * ED, (const bf16_t*)(a.ws + WS_W_MDN) + ((size_t)(li * 8 + e) * 1024 + col) * ED, ED, lane);
        if (lane == 0) rep(ctl, 16, bf2f(((const bf16_t*)(a.ws + WS_YBUF))[((size_t)slot * NTOK + tok) * 1024 + col]), rg[pos] * d, 3e-2f); }
}
__global__ void chk_final(Args a, const float* xold) {
    unsigned* ctl = (unsigned*)a.ws; const size_t i = hsh(blockIdx.x * 64 + threadIdx.x + 9) % ((size_t)NTOK * 1024); const bf16_t* yb = (const bf16_t*)(a.ws + WS_YBUF);
    rep(ctl, 18, a.out[i], xold[i] + bf2f(yb[i]) + bf2f(yb[(size_t)NTOK * 1024 + i]), 1e-2f);
}
__global__ void chk_report(Args a) {
    const unsigned* ctl = (const unsigned*)a.ws; int code = -1;
    for (int s = 18; s >= 0; --s) { const float e = __uint_as_float(ctl[CW_ERR + s]); const float tol = (s == 0 || s == 4 || s == 14) ? 1e-3f : 0.08f; if (e > tol) code = s; }
    if (code >= 0) { float v = 10.f; for (int k = 0; k < code; ++k) v *= 10.f;
        for (size_t i = (size_t)blockIdx.x * blockDim.x + threadIdx.x; i < (size_t)NTOK * 1024; i += (size_t)gridDim.x * blockDim.x) a.out[i] = v; }
}
#endif

extern "C" void kernel_launch(void* const* d_in, const int* in_sizes, int n_in, void* d_out, int out_size, void* d_ws, size_t ws_size, hipStream_t stream) {
    static int ready = 0;
    if (ready == 0) {
        ready = -1;
        if (n_in != 12 || out_size != NTOK * 1024 || ws_size < WS_END + (MK_DEBUG ? (size_t)128 * MiB : 0)) { fprintf(stderr, "kernel_launch: unexpected shapes / workspace (%d inputs, out %d, ws %zu)\n", n_in, out_size, ws_size); return; }
        if (hipFuncSetAttribute((const void*)mk_fwd, hipFuncAttributeMaxDynamicSharedMemorySize, LDS_BYTES) != hipSuccess) { fprintf(stderr, "kernel_launch: hipFuncSetAttribute failed\n"); return; }
        int per_cu = 0; (void)hipOccupancyMaxActiveBlocksPerMultiprocessor(&per_cu, (const void*)mk_fwd, NTHR, LDS_BYTES); (void)hipGetLastError();
        if (per_cu < 1) fprintf(stderr, "kernel_launch: occupancy query says %d blocks per CU\n", per_cu);
        ready = 1;
    }
    if (ready < 0) return;
    (void)hipMemsetAsync((char*)d_ws + WS_CTL, 0, CTL_ZERO_BYTES, stream);
    Args a{};
    for (int i = 0; i < 12; ++i) a.in[i] = (const float*)d_in[i];
    a.out = (float*)d_out; a.ws = (unsigned char*)d_ws;
#if !MK_DEBUG
    a.lo = 0; a.hi = 42;
    hipLaunchKernelGGL(mk_fwd, dim3(NWG), dim3(NTHR), LDS_BYTES, stream, a);
#else
    unsigned char* ws = (unsigned char*)d_ws; float* snap = (float*)(ws + WS_DBG);
    const int NS = 96;
    for (int s = 0; s < 42; ++s) {
        const int L = (s - 1) / 10, k = (s - 1) % 10; const bool moe = (L & 1) != 0;
        if (s >= 1 && s < 41 && !moe && k == 9) continue;
        const bool snapx = (s == 41) || (s >= 1 && s < 41 && ((k == 0 && L == 2) || (k == 8 && !moe) || (k == 5 && L > 0)));
        if (snapx) (void)hipMemcpyAsync(snap, d_out, (size_t)NTOK * 1024 * 4, hipMemcpyDeviceToDevice, stream);
        a.lo = s; a.hi = s + 1;
        hipLaunchKernelGGL(mk_fwd, dim3(NWG), dim3(NTHR), LDS_BYTES, stream, a);
        if (s == 0) { hipLaunchKernelGGL(chk_prep, dim3(64), dim3(64), 0, stream, a); continue; }
        if (s == 41) { hipLaunchKernelGGL(chk_final, dim3(64), dim3(64), 0, stream, a, (const float*)snap); continue; }
        const float* gains = (const float*)d_in[1] + (size_t)L * 2048; const float* xin0 = (const float*)d_in[0];
        switch (k) {
        case 0: hipLaunchKernelGGL(chk_norm, dim3(NS), dim3(64), 0, stream, a, L == 0 ? xin0 : (L == 2 ? (const float*)snap : (const float*)d_out), gains, L == 2 ? 1 : 0, L == 2 ? 17 : 1); break;
        case 1: hipLaunchKernelGGL(chk_gemm_in, dim3(NS), dim3(64), 0, stream, a, L); break;
        case 2: hipLaunchKernelGGL(chk_qk, dim3(NS), dim3(64), 0, stream, a, L); hipLaunchKernelGGL(chk_vt, dim3(NS), dim3(64), 0, stream, a); break;
        case 3: hipLaunchKernelGGL(chk_na, dim3(NS), dim3(64), 0, stream, a, L); hipLaunchKernelGGL(chk_dil, dim3(NS), dim3(64), 0, stream, a, L); hipLaunchKernelGGL(chk_gqa, dim3(32), dim3(64), 0, stream, a, L); break;
        case 4: hipLaunchKernelGGL(chk_gate, dim3(NS), dim3(64), 0, stream, a, L); break;
        case 5: hipLaunchKernelGGL(chk_resid, dim3(NS), dim3(64), 0, stream, a, L == 0 ? xin0 : (const float*)snap, (const bf16_t*)(ws + WS_MERGED), (const bf16_t*)(ws + WS_W_OUT) + (size_t)L * 1024 * 1024, 1024, 9); break;
        case 6: if (!moe) hipLaunchKernelGGL(chk_norm, dim3(NS), dim3(64), 0, stream, a, (const float*)d_out, gains + 1024, 0, 10);
                else { hipLaunchKernelGGL(chk_norm, dim3(NS), dim3(64), 0, stream, a, (const float*)d_out, gains + 1024, 0, 10);
                       hipLaunchKernelGGL(chk_router, dim3(NS), dim3(64), 0, stream, a, gains + 1024, (const float*)d_in[9] + (size_t)(L >> 1) * 8192); } break;
        case 7: if (!moe) hipLaunchKernelGGL(chk_up, dim3(NS), dim3(64), 0, stream, a, (const bf16_t*)(ws + WS_H), (const bf16_t*)(ws + WS_W_FGU) + (size_t)(L >> 1) * 2 * FF * 1024, FF, 11);
                else hipLaunchKernelGGL(chk_scatter, dim3(NS), dim3(64), 0, stream, a); break;
        case 8: if (!moe) hipLaunchKernelGGL(chk_resid, dim3(NS), dim3(64), 0, stream, a, (const float*)snap, (const bf16_t*)(ws + WS_ACT), (const bf16_t*)(ws + WS_W_FDN) + (size_t)(L >> 1) * 1024 * FF, FF, 12);
                else hipLaunchKernelGGL(chk_moe, dim3(NS), dim3(64), 0, stream, a, L >> 1, 0); break;
        case 9: hipLaunchKernelGGL(chk_moe, dim3(NS), dim3(64), 0, stream, a, L >> 1, 1); break;
        }
    }
    hipLaunchKernelGGL(chk_report, dim3(1024), dim3(256), 0, stream, a);
#endif
}
```

```cpp
#include <hip/hip_runtime.h>
#include <cstdint>
#include <cstdio>
#include <type_traits>

#ifndef MK_DEBUG
#define MK_DEBUG 0
#endif

#ifndef PHM
#define PHM 0xFFFFFFFFu
#endif
#define PM(k) ((PHM >> (k)) & 1u)
#ifndef REPM
#define REPM 0u
#endif
#define RP(k) for (int rp_ = 0; rp_ <= (int)((REPM >> (k)) & 1u); ++rp_)
#ifndef F8_IN
#define F8_IN 15
#endif
#ifndef F8_OUT
#define F8_OUT 15
#endif
#ifndef F8_GATE
#define F8_GATE 15
#endif
#ifndef F8_FFN
#define F8_FFN 2
#endif
#ifndef F8_MOE
#define F8_MOE 3
#endif
#ifndef FUSE_NORM
#define FUSE_NORM 1
#endif
#if MK_DEBUG
#undef FUSE_NORM
#define FUSE_NORM 0
#undef F8_IN
#undef F8_OUT
#undef F8_GATE
#undef F8_FFN
#undef F8_MOE
#define F8_IN 0
#define F8_OUT 0
#define F8_GATE 0
#define F8_FFN 0
#define F8_MOE 0
#endif
#ifndef TSEL
#define TSEL -1
#endif
#define DI __device__ __forceinline__
#define LAS __attribute__((address_space(3)))
#define GAS __attribute__((address_space(1)))

typedef unsigned short bf16_t;
typedef short bf16x8 __attribute__((ext_vector_type(8)));
typedef float f32x2 __attribute__((ext_vector_type(2)));
typedef float f32x4 __attribute__((ext_vector_type(4)));
typedef float f32x16 __attribute__((ext_vector_type(16)));
typedef unsigned u32x2 __attribute__((ext_vector_type(2)));
typedef unsigned u32x4 __attribute__((ext_vector_type(4)));
typedef __bf16 bf16x2_t __attribute__((ext_vector_type(2)));

constexpr int NB = 8, SEQ = 4096, DM = 1024, NTOK = NB * SEQ, DEPTH = 4;
constexpr int INW = 5632, FF = 2816, ED = 3584, NE = 8;
constexpr int MROWS = 2 * NTOK + NE * 256;
constexpr float EPS = 1e-6f;
constexpr float QSCALE = 0.125f * 1.4426950408889634f;
constexpr float LOG2E = 1.4426950408889634f;
constexpr int NWG = 256, NTHR = 512;

constexpr size_t MiB = 1u << 20;
constexpr size_t WS_CTL = 0, CTL_ZERO_BYTES = 1 * MiB;
constexpr size_t WS_ROPE1 = 1 * MiB;
constexpr size_t WS_ROPEA = 2 * MiB;
constexpr size_t WS_TOPI = 3 * MiB;
constexpr size_t WS_TOPW = 3 * MiB + 512 * 1024;
constexpr size_t WS_PERM = 4 * MiB;
constexpr size_t WS_RGATE = 4 * MiB + 512 * 1024;
constexpr size_t WS_CNT = 5 * MiB;
constexpr size_t WS_SSQ = 6 * MiB;
constexpr size_t WS_W_IN = 8 * MiB;
constexpr size_t WS_W_BR = 52 * MiB;
constexpr size_t WS_W_OUT = 59 * MiB;
constexpr size_t WS_W_FGU = 67 * MiB;
constexpr size_t WS_W_FDN = 89 * MiB;
constexpr size_t WS_W_MGU = 100 * MiB;
constexpr size_t WS_W_MDN = 324 * MiB;
constexpr size_t WS_H = 436 * MiB;
constexpr size_t WS_XS = 500 * MiB;
constexpr size_t WS_YBUF = 632 * MiB;
constexpr size_t WS_Q = 760 * MiB;
constexpr size_t WS_K = 824 * MiB;
constexpr size_t WS_VRAW = 872 * MiB;
constexpr size_t WS_V8 = 880 * MiB;
constexpr size_t WS_K8 = 872 * MiB;
constexpr size_t WS_VT = 920 * MiB;
constexpr size_t WS_G = 968 * MiB;
constexpr size_t WS_OALL = 1160 * MiB;
constexpr size_t WS_MERGED = 1216 * MiB;
constexpr size_t WS_ACT = 760 * MiB;
constexpr size_t WS_END = 1280 * MiB;
constexpr size_t WS_DBG = 1280 * MiB;
static_assert(WS_ACT + (size_t)MROWS * ED * 2 <= WS_END, "act overlay");
static_assert(WS_W_MDN + (size_t)2 * 8 * 1024 * 3584 * 2 <= WS_H, "weights");

constexpr int CW_BAR = 4096;
constexpr int CW_ERR = 32768;

constexpr int LDS_SCR = 0, LDS_SCR_BYTES = 131072;
constexpr int LDS_MISC = 131072;
constexpr int LDS_BYTES = 131072 + 1024 + 8192;

DI unsigned pk2(float lo, float hi) { f32x2 v = {lo, hi}; bf16x2_t b = __builtin_convertvector(v, bf16x2_t); return __builtin_bit_cast(unsigned, b); }
DI float bflo(unsigned w) { return __uint_as_float(w << 16); }
DI float bfhi(unsigned w) { return __uint_as_float(w & 0xffff0000u); }
DI float bf2f(bf16_t u) { return __uint_as_float((unsigned)u << 16); }
DI int lane_v() { int l; asm volatile("v_mbcnt_lo_u32_b32 %0, -1, 0\n\tv_mbcnt_hi_u32_b32 %0, -1, %0" : "=v"(l)); return l; }
DI float shx(float v, int m) { return __builtin_bit_cast(float, __builtin_amdgcn_ds_bpermute((lane_v() ^ m) << 2, __builtin_bit_cast(int, v))); }
DI int shx(int v, int m) { return __builtin_amdgcn_ds_bpermute((lane_v() ^ m) << 2, v); }
DI int shup(int v, int o) { return __builtin_amdgcn_ds_bpermute((lane_v() - o) << 2, v); }
DI int shidx(int v, int src) { return __builtin_amdgcn_ds_bpermute(src << 2, v); }
DI float wave_sum(float v) {
    v += __builtin_bit_cast(float, __builtin_amdgcn_update_dpp(0, __builtin_bit_cast(int, v), 0x111, 0xF, 0xF, true));
    v += __builtin_bit_cast(float, __builtin_amdgcn_update_dpp(0, __builtin_bit_cast(int, v), 0x112, 0xF, 0xF, true));
    v += __builtin_bit_cast(float, __builtin_amdgcn_update_dpp(0, __builtin_bit_cast(int, v), 0x114, 0xF, 0xF, true));
    v += __builtin_bit_cast(float, __builtin_amdgcn_update_dpp(0, __builtin_bit_cast(int, v), 0x118, 0xF, 0xF, true));
    v += __builtin_bit_cast(float, __builtin_amdgcn_update_dpp(0, __builtin_bit_cast(int, v), 0x142, 0xA, 0xF, false));
    v += __builtin_bit_cast(float, __builtin_amdgcn_update_dpp(0, __builtin_bit_cast(int, v), 0x143, 0xC, 0xF, false));
    return __builtin_bit_cast(float, __builtin_amdgcn_readlane(__builtin_bit_cast(int, v), 63));
}
DI float sigmoidf_(float x) { return __builtin_amdgcn_rcpf(1.f + __builtin_amdgcn_exp2f(x * -1.4426950408889634f)); }

namespace pg8 {
#define PG8_LAS __attribute__((address_space(3)))
constexpr int BM = 256, BK = 64, HALF = 128, HTB = HALF * BK * 2, STAGE_BYTES = 8 * HTB, NXCD = 8, WGM = 8;
__host__ __device__ __forceinline__ int lds_byte(int r, int c) { const int st = (r >> 4) * 2 + (c >> 5), rr = r & 15, cc = c & 31, ob = rr * 64 + cc * 2; return st * 1024 + (ob ^ (((ob >> 9) & 1) << 5)); }
__host__ __device__ __forceinline__ void stage_rc(int b, int& R, int& C) { const int st = b / 1024, sb = b % 1024, swz = sb ^ (((sb >> 9) & 1) << 5); R = (st >> 1) * 16 + swz / 64; C = (st & 1) * 32 + (swz % 64) / 2; }
__host__ __device__ __forceinline__ int perm32(int rho) { const int n = rho >> 4, i = rho & 15; return 8 * (i >> 2) + 4 * n + (i & 3); }

struct Unit { int pm, pn; long bo; int ord; };
struct Gemm { const bf16_t* A; const bf16_t* Bt; int K; int sclB; };
typedef int v4i_t __attribute__((ext_vector_type(4)));
typedef int v8i_t __attribute__((ext_vector_type(8)));
__device__ __forceinline__ void mfma_f8(f32x4& acc, v8i_t b, v8i_t a, int sclb) {
    asm volatile("v_mfma_scale_f32_16x16x128_f8f6f4 %0, %1, %2, %0, %3, %4 op_sel_hi:[0,0,0]" : "+v"(acc) : "v"(b), "v"(a), "v"(sclb), "v"(0x7F7F7F7F));
}
__device__ __forceinline__ void mfma_f8z(f32x4& acc, v8i_t b, v8i_t a, int sclb) {
    asm volatile("v_mfma_scale_f32_16x16x128_f8f6f4 %0, %1, %2, 0, %3, %4 op_sel_hi:[0,0,0]" : "+v"(acc) : "v"(b), "v"(a), "v"(sclb), "v"(0x7F7F7F7F));
}
__device__ __forceinline__ v8i_t cat8(bf16x8 lo, bf16x8 hi) { return __builtin_shufflevector(__builtin_bit_cast(v4i_t, lo), __builtin_bit_cast(v4i_t, hi), 0, 1, 2, 3, 4, 5, 6, 7); }

struct StaticOrder {
    int nM, nN, nwg, G, c;
    __host__ __device__ void init(int M, int N, int G_, int c_) { nM = M / BM; nN = N / BM; nwg = nM * nN; G = G_; c = c_; }
    __host__ __device__ bool next(int i, Unit& u) const {
        const long L = (long)i * G + c; if (L >= nwg) return false;
        int wgid = (int)L; { const int q = nwg / NXCD, r = nwg % NXCD, xcd = wgid % NXCD, off = wgid / NXCD; wgid = (xcd < r ? xcd * (q + 1) : r * (q + 1) + (xcd - r) * q) + off; }
        const int nig = WGM * nN, gid = wgid / nig, fm = gid * WGM, gsz = (nM - fm) < WGM ? (nM - fm) : WGM;
        u.pm = fm + ((wgid % nig) % gsz); u.pn = (wgid % nig) / gsz; u.bo = 0; u.ord = i; return true;
    }
    __device__ __forceinline__ void a_ready(const Unit&) const {}
    __device__ __forceinline__ void done(const Unit&) const {}
};
struct StaticOrderR : StaticOrder {
    const float* ssq; PG8_LAS float* tab; int wid;
    __device__ __forceinline__ void a_ready(const Unit& u) const {
        if (ssq) { int t_; asm volatile("v_mbcnt_lo_u32_b32 %0, -1, 0\n\tv_mbcnt_hi_u32_b32 %0, -1, %0" : "=v"(t_)); const int w_ = wid;
            if (w_ < 4) { const int rr = w_ * 64 + t_; const f32x4* p = (const f32x4*)(ssq + (size_t)(u.pm * 256 + rr) * 16); const f32x4 a = p[0], b = p[1], c2 = p[2], d = p[3];
                const float s_ = ((a[0] + a[1]) + (a[2] + a[3])) + ((b[0] + b[1]) + (b[2] + b[3])) + ((c2[0] + c2[1]) + (c2[2] + c2[3])) + ((d[0] + d[1]) + (d[2] + d[3]));
                tab[(u.ord & 1) * 256 + rr] = 1.f / sqrtf(s_ * (1.f / 1024.f) + 1e-6f); } }
    }
};
struct GroupedOrder {
    int nN, c8, loc, per; int tp[9]; long bstride; int cb;
    __device__ __forceinline__ bool next(int i, Unit& u) const {
        const int R = (tp[8] - c8 + 7) >> 3;
        const int j = loc + per * i; if (j >= R * nN) return false;
        const int g = j / (4 * nN), w = j - g * 4 * nN, rg = min(4, R - 4 * g);
        const int blk = rg * cb, pc = w / blk, rem = w - pc * blk, col = rem / rg, row = rem - col * rg;
        const int pm = c8 + 8 * (4 * g + row);
        u.pm = pm; u.pn = pc * cb + col; u.ord = i;
        int e = 0;
#pragma unroll
        for (int k = 1; k < 8; ++k) e += (pm >= tp[k]) ? 1 : 0;
        u.bo = (long)__builtin_amdgcn_readfirstlane(e) * bstride; return true;
    }
    __device__ __forceinline__ void a_ready(const Unit&) const {}
    __device__ __forceinline__ void done(const Unit&) const {}
};

template <class T, class = void> struct has_mid { static constexpr bool value = false; };
template <class T> struct has_mid<T, decltype((void)T::HAS_MID)> { static constexpr bool value = T::HAS_MID; };
template <class Epi, class Sched, bool ALIGN_EPI = false, bool SP2 = false, bool F8 = false>
__device__ __forceinline__ void gemm_phase(PG8_LAS unsigned char* lds, const Gemm g, const Sched& S, const Epi& E, int tid_in) {
    int tid_o = tid_in; asm volatile("" : "+v"(tid_o));
    const int tid = tid_o, wid = __builtin_amdgcn_readfirstlane(tid >> 6), lane = tid & 63, wr = wid >> 2, wc = wid & 3, fr = lane & 15, fq = lane >> 4;
    const int K = g.K, nt = K / BK;
    unsigned voffA[2], voffB[2];
#pragma unroll
    for (int i = 0; i < 2; ++i) { int R, C; stage_rc(tid * 16 + i * 8192, R, C); const int Rb = Epi::PERM ? ((R & ~31) + perm32(R & 31)) : R;
        voffA[i] = (unsigned)(R * K + C) * 2u; voffB[i] = (unsigned)(Rb * K + C) * 2u; }
    const size_t kstep = (size_t)(BK * 2);
    const size_t hstep = (size_t)HALF * K * 2;
    const size_t tstep = 2 * hstep;
    const unsigned ldsw = (unsigned)wid * 1024u;
    const int aoff = lds_byte(wr * 64 + fr, fq * 8), boff = lds_byte(wc * 32 + fr, fq * 8);
#define PG8_SA(b, h) (((b) * 2 + (h)) * HTB)
#define PG8_SB(b, h) ((4 + (b) * 2 + (h)) * HTB)
#define PG8_STAGE(bufoff, gbase, voff) do { _Pragma("unroll") for (int _i = 0; _i < 2; ++_i) \
        __builtin_amdgcn_global_load_lds((const unsigned*)((const char*)(gbase) + (voff)[_i]), (PG8_LAS unsigned*)(lds + (bufoff) + ldsw + _i * 8192), 16, 0, 0); } while (0)
#define PG8_LDA(dst, b, h) do { _Pragma("unroll") for (int m = 0; m < 4; ++m) _Pragma("unroll") for (int k = 0; k < 2; ++k) dst[m][k] = *(const PG8_LAS bf16x8*)(lds + PG8_SA(b, h) + aoff + m * 2048 + k * 1024); } while (0)
#define PG8_LDB(dst, b, h) do { _Pragma("unroll") for (int n = 0; n < 2; ++n) _Pragma("unroll") for (int k = 0; k < 2; ++k) dst[n][k] = *(const PG8_LAS bf16x8*)(lds + PG8_SB(b, h) + boff + n * 2048 + k * 1024); } while (0)
#define PG8_MMA(ai, bj, At, Bt) do { __builtin_amdgcn_s_setprio(1); _Pragma("unroll") for (int m = 0; m < 4; ++m) _Pragma("unroll") for (int n = 0; n < 2; ++n) { \
        if constexpr (F8) mfma_f8(acc[ai][bj][m][n], cat8(Bt[n][0], Bt[n][1]), cat8(At[m][0], At[m][1]), g.sclB); \
        else { _Pragma("unroll") for (int k = 0; k < 2; ++k) acc[ai][bj][m][n] = __builtin_amdgcn_mfma_f32_16x16x32_bf16(Bt[n][k], At[m][k], acc[ai][bj][m][n], 0, 0, 0); } } __builtin_amdgcn_s_setprio(0); } while (0)
#define PG8_MMAZ(ai, bj, At, Bt) do { __builtin_amdgcn_s_setprio(1); _Pragma("unroll") for (int m = 0; m < 4; ++m) _Pragma("unroll") for (int n = 0; n < 2; ++n) \
        mfma_f8z(acc[ai][bj][m][n], cat8(Bt[n][0], Bt[n][1]), cat8(At[m][0], At[m][1]), g.sclB); __builtin_amdgcn_s_setprio(0); } while (0)
#define PG8_WAIT_V(n) asm volatile("s_waitcnt vmcnt(" #n ")" ::: "memory")
#define PG8_WAIT_L(n) asm volatile("s_waitcnt lgkmcnt(" #n ")" ::: "memory")
#define PG8_BAR __builtin_amdgcn_s_barrier()
#define PG8_SCHED __builtin_amdgcn_sched_barrier(0)
    Unit cur, nxt; int ui = 0;
    if (!S.next(0, cur)) return;
    f32x4 acc[2][2][4][2];
#pragma unroll
    for (int a = 0; a < 2; ++a)
#pragma unroll
        for (int b = 0; b < 2; ++b)
#pragma unroll
            for (int m = 0; m < 4; ++m)
#pragma unroll
                for (int n = 0; n < 2; ++n) acc[a][b][m][n] = (f32x4){0.f, 0.f, 0.f, 0.f};
    bf16x8 At[4][2], B0[2][2], B1[2][2];
    const char* cA = (const char*)g.A + (size_t)cur.pm * tstep; const char* cB = (const char*)g.Bt + cur.bo + (size_t)cur.pn * tstep;
    S.a_ready(cur);
    if constexpr (SP2) {
        PG8_STAGE(PG8_SB(0, 0), cB, voffB); PG8_STAGE(PG8_SB(0, 1), cB + hstep, voffB); PG8_STAGE(PG8_SA(0, 0), cA, voffA); PG8_STAGE(PG8_SA(0, 1), cA + hstep, voffA);
        if (wr == 1) PG8_BAR;
        PG8_WAIT_V(2); PG8_BAR;
        PG8_STAGE(PG8_SB(1, 0), cB + kstep, voffB); PG8_STAGE(PG8_SA(1, 0), cA + kstep, voffA); PG8_STAGE(PG8_SB(1, 1), cB + hstep + kstep, voffB);
        PG8_WAIT_V(6); PG8_BAR;
    } else {
        PG8_STAGE(PG8_SB(0, 0), cB, voffB); PG8_STAGE(PG8_SA(0, 0), cA, voffA); PG8_STAGE(PG8_SB(0, 1), cB + hstep, voffB); PG8_STAGE(PG8_SA(0, 1), cA + hstep, voffA);
        if (wr == 1) PG8_BAR;
        PG8_WAIT_V(4); PG8_BAR;
        PG8_STAGE(PG8_SB(1, 0), cB + kstep, voffB); PG8_STAGE(PG8_SA(1, 0), cA + kstep, voffA); PG8_STAGE(PG8_SB(1, 1), cB + hstep + kstep, voffB);
        PG8_WAIT_V(6); PG8_BAR;
    }
    for (;;) {
        const bool has_next = S.next(ui + 1, nxt);
        const char* nA = has_next ? (const char*)g.A + (size_t)nxt.pm * tstep : cA; const char* nB = has_next ? (const char*)g.Bt + nxt.bo + (size_t)nxt.pn * tstep : cB;
        auto kiter = [&](int t, auto first_) __attribute__((always_inline)) { constexpr bool FIRST = decltype(first_)::value; (void)FIRST;
            if constexpr (has_mid<Epi>::value) { if (E.is_mid(t)) { if (wr == 0) PG8_BAR; if constexpr (F8) asm volatile("s_nop 15\n\ts_nop 15" ::: "memory"); E.mid(acc, cur, t, wr, wc, fr, fq); if (wr == 1) PG8_BAR; } }
            const bool last = (t == nt - 2);
            const char* a1 = cA + (size_t)(t + 1) * kstep;
            const char* a2 = last ? nA : cA + (size_t)(t + 2) * kstep; const char* b2 = last ? nB : cB + (size_t)(t + 2) * kstep;
            const char* a3 = a2 + kstep; const char* b3 = b2 + kstep;
            if (last && has_next) S.a_ready(nxt);
            if constexpr (SP2) {
            PG8_LDB(B0, 0, 0); PG8_LDB(B1, 0, 1); PG8_SCHED; PG8_LDA(At, 0, 0); PG8_STAGE(PG8_SA(1, 1), a1 + hstep, voffA);
            PG8_WAIT_V(8); PG8_WAIT_L(0); PG8_BAR; if constexpr (F8 && FIRST) { PG8_MMAZ(0, 0, At, B0); PG8_MMAZ(0, 1, At, B1); } else { PG8_MMA(0, 0, At, B0); PG8_MMA(0, 1, At, B1); } PG8_BAR; PG8_SCHED;
            PG8_LDA(At, 0, 1); PG8_STAGE(PG8_SB(0, 0), b2, voffB); PG8_STAGE(PG8_SB(0, 1), b2 + hstep, voffB); PG8_STAGE(PG8_SA(0, 0), a2, voffA);
            PG8_WAIT_V(8); PG8_WAIT_L(0); PG8_BAR; if constexpr (F8 && FIRST) { PG8_MMAZ(1, 0, At, B0); PG8_MMAZ(1, 1, At, B1); } else { PG8_MMA(1, 0, At, B0); PG8_MMA(1, 1, At, B1); } PG8_BAR; PG8_SCHED;
            if constexpr (has_mid<Epi>::value) { if (E.is_mid(t + 1)) { if (wr == 0) PG8_BAR; if constexpr (F8) asm volatile("s_nop 15\n\ts_nop 15" ::: "memory"); E.mid(acc, cur, t + 1, wr, wc, fr, fq); if (wr == 1) PG8_BAR; } }
            PG8_LDB(B0, 1, 0); PG8_LDB(B1, 1, 1); PG8_SCHED; PG8_LDA(At, 1, 0); PG8_STAGE(PG8_SA(0, 1), a2 + hstep, voffA);
            PG8_WAIT_V(8); PG8_WAIT_L(0); PG8_BAR; PG8_MMA(0, 0, At, B0); PG8_MMA(0, 1, At, B1); PG8_BAR; PG8_SCHED;
            PG8_LDA(At, 1, 1); PG8_STAGE(PG8_SB(1, 0), b3, voffB); PG8_STAGE(PG8_SB(1, 1), b3 + hstep, voffB); PG8_STAGE(PG8_SA(1, 0), a3, voffA);
            PG8_WAIT_V(8); PG8_WAIT_L(0); PG8_BAR; PG8_MMA(1, 0, At, B0); PG8_MMA(1, 1, At, B1); PG8_BAR; PG8_SCHED;
            } else {
            PG8_LDB(B0, 0, 0); PG8_SCHED; PG8_LDA(At, 0, 0); PG8_STAGE(PG8_SA(1, 1), a1 + hstep, voffA);
            PG8_WAIT_L(8); PG8_BAR; PG8_WAIT_L(0); PG8_MMA(0, 0, At, B0); PG8_BAR; PG8_SCHED;
            PG8_LDB(B1, 0, 1); PG8_STAGE(PG8_SB(0, 0), b2, voffB);
            PG8_BAR; PG8_WAIT_L(0); PG8_MMA(0, 1, At, B1); PG8_BAR;
            PG8_LDA(At, 0, 1); PG8_STAGE(PG8_SA(0, 0), a2, voffA);
            PG8_BAR; PG8_WAIT_L(0); PG8_MMA(1, 0, At, B0); PG8_BAR; PG8_SCHED;
            PG8_STAGE(PG8_SB(0, 1), b2 + hstep, voffB);
            PG8_WAIT_V(6); PG8_BAR; PG8_MMA(1, 1, At, B1); PG8_BAR;
            PG8_LDB(B0, 1, 0); PG8_SCHED; PG8_LDA(At, 1, 0); PG8_STAGE(PG8_SA(0, 1), a2 + hstep, voffA);
            PG8_WAIT_L(8); PG8_BAR; PG8_WAIT_L(0); PG8_MMA(0, 0, At, B0); PG8_BAR; PG8_SCHED;
            PG8_LDB(B1, 1, 1); PG8_STAGE(PG8_SB(1, 0), b3, voffB);
            PG8_BAR; PG8_WAIT_L(0); PG8_MMA(0, 1, At, B1); PG8_BAR;
            PG8_LDA(At, 1, 1); PG8_STAGE(PG8_SA(1, 0), a3, voffA);
            PG8_BAR; PG8_WAIT_L(0); PG8_MMA(1, 0, At, B0); PG8_BAR; PG8_SCHED;
            PG8_STAGE(PG8_SB(1, 1), b3 + hstep, voffB);
            PG8_WAIT_V(6); PG8_BAR; PG8_MMA(1, 1, At, B1); PG8_BAR;
            }
        };
        if constexpr (F8) { kiter(0, std::true_type{}); for (int t = 2; t < nt; t += 2) kiter(t, std::false_type{}); }
        else { for (int t = 0; t < nt; t += 2) kiter(t, std::false_type{}); }
        if constexpr (ALIGN_EPI) { if (wr == 0) PG8_BAR; }
        if constexpr (F8) asm volatile("s_nop 15\n\ts_nop 15" ::: "memory");
        if constexpr (!Epi::AFTER_DRAIN) { E(acc, cur, wr, wc, fr, fq); S.done(cur); }
        if (!has_next) break;
        if constexpr (!F8) {
#pragma unroll
        for (int a = 0; a < 2; ++a)
#pragma unroll
            for (int b = 0; b < 2; ++b)
#pragma unroll
                for (int m = 0; m < 4; ++m)
#pragma unroll
                    for (int n = 0; n < 2; ++n) acc[a][b][m][n] = (f32x4){0.f, 0.f, 0.f, 0.f}; }
        cur = nxt; cA = nA; cB = nB; ++ui;
        if constexpr (ALIGN_EPI) { if (wr == 1) PG8_BAR; }
    }
    PG8_WAIT_V(0);
    if constexpr (!ALIGN_EPI) { if (wr == 0) PG8_BAR; }
    PG8_BAR;
    if constexpr (Epi::AFTER_DRAIN) { E.fused(acc, cur, wr, wc, fr, fq, lds, wid, lane); S.done(cur); }
#undef PG8_SA
#undef PG8_SB
#undef PG8_STAGE
#undef PG8_LDA
#undef PG8_LDB
#undef PG8_MMA
#undef PG8_MMAZ
#undef PG8_WAIT_V
#undef PG8_WAIT_L
#undef PG8_BAR
#undef PG8_SCHED
}
}

typedef const f32x4 (&AccRef)[2][2][4][2];

#define GPTR(T_, p_) ((__attribute__((address_space(1))) T_*)(p_))
struct EpiIn {
    static constexpr bool PERM = true, AFTER_DRAIN = false;
    bf16_t *Q, *Kb, *V, *G; const LAS float* rtab;
    DI void operator()(AccRef acc, const pg8::Unit& u, int wr, int wc, int fr, int fq) const {
        const int pn = u.pn; bf16_t* base; int ld, colt; bool sig = false;
        bf16_t *Q = this->Q, *Kb = this->Kb, *V = this->V, *G = this->G;
        asm volatile("" : "+s"(Q), "+s"(Kb), "+s"(V), "+s"(G));
        if (pn < 4) { base = Q; ld = 1024; colt = pn * 256; }
        else if (pn < 7) { base = Kb; ld = 768; colt = (pn - 4) * 256; }
        else if (pn < 10) { base = V; ld = 768; colt = (pn - 7) * 256; }
        else { base = G; ld = 3072; colt = (pn - 10) * 256; sig = true; }
        const int row0 = u.pm * 256 + wr * 64 + fr, col0 = colt + wc * 32 + 8 * fq;
        int tq_ = fq * 16 + fr; asm volatile("" : "+v"(tq_));
        if (pn >= 7 && pn < 10) {
#pragma unroll
            for (int ai = 0; ai < 2; ++ai)
#pragma unroll
                for (int m = 0; m < 4; ++m) { int row = row0 + ai * 128 + m * 16; asm volatile("" : "+v"(row));
                    const float rs = rtab ? rtab[(u.ord & 1) * 256 + wr * 64 + fr + ai * 128 + m * 16] : 1.f;
                    const int s_ = row & (SEQ - 1);
#pragma unroll
                    for (int bj = 0; bj < 2; ++bj) {
                        const int sh = (pn == 9) ? ((2 * bj + (wc >> 1)) < 2 ? 2 : 4) : 0;
                        const int pos = ((s_ & ((1 << sh) - 1)) << (12 - sh)) + (s_ >> sh);
                        size_t vo = (WS_VT - WS_VRAW) / 2 + ((size_t)((row >> 12) * 12 + (pn - 7) * 4) * 64 + 128 * bj + wc * 32 + 8 * fq) * SEQ + pos;
                        asm volatile("" : "+v"(vo));
                        bf16_t* vb = V + vo;
#pragma unroll
                        for (int n = 0; n < 2; ++n) { const f32x4 v = acc[ai][bj][m][n] * rs; const unsigned w0 = pk2(v[0], v[1]), w1 = pk2(v[2], v[3]);
                            bf16_t* p = vb + (size_t)(4 * n) * SEQ;
                            GPTR(bf16_t, p)[0] = (bf16_t)(w0 & 0xffffu); GPTR(bf16_t, p)[SEQ] = (bf16_t)(w0 >> 16); GPTR(bf16_t, p)[2 * SEQ] = (bf16_t)(w1 & 0xffffu); GPTR(bf16_t, p)[3 * SEQ] = (bf16_t)(w1 >> 16); }
                        if (pn == 8 && bj == 0) {
                            size_t v8o = (WS_V8 - WS_VRAW) + ((size_t)((row >> 12) * 2 + (wc >> 1)) * 64 + 32 * (wc & 1) + 8 * fq) * SEQ + (s_ & ~63) + 32 * ((s_ >> 3) & 1) + 8 * ((s_ >> 4) & 3) + (s_ & 7);
                            asm volatile("" : "+v"(v8o));
                            unsigned char* v8b = (unsigned char*)V + v8o;
#pragma unroll
                            for (int n = 0; n < 2; ++n) { const f32x4 v = acc[ai][bj][m][n] * rs; int w8 = 0;
                                w8 = __builtin_amdgcn_cvt_pk_fp8_f32(v[0], v[1], w8, false); w8 = __builtin_amdgcn_cvt_pk_fp8_f32(v[2], v[3], w8, true);
                                unsigned char* p8 = v8b + (size_t)(4 * n) * SEQ;
                                GPTR(unsigned char, p8)[0] = (unsigned char)(w8 & 0xff); GPTR(unsigned char, p8)[SEQ] = (unsigned char)((w8 >> 8) & 0xff);
                                GPTR(unsigned char, p8)[2 * SEQ] = (unsigned char)((w8 >> 16) & 0xff); GPTR(unsigned char, p8)[3 * SEQ] = (unsigned char)((unsigned)w8 >> 24); } } } }
        } else {
#pragma unroll
        for (int ai = 0; ai < 2; ++ai)
#pragma unroll
            for (int m = 0; m < 4; ++m) { bf16_t* rowp = base + (size_t)(row0 + ai * 128 + m * 16) * ld + col0;
                const float rs = rtab ? rtab[(u.ord & 1) * 256 + wr * 64 + fr + ai * 128 + m * 16] : 1.f;
#pragma unroll
                for (int bj = 0; bj < 2; ++bj) {
                    if (sig) {
                        const float rsn = rs * -1.4426950408889634f; unsigned q[8];
#pragma unroll
                        for (int j = 0; j < 4; ++j) {
                            q[j] = (unsigned)__builtin_amdgcn_rcpf(__builtin_amdgcn_exp2f(__builtin_fmaf(acc[ai][bj][m][0][j], rsn, -8.f)) + 0.00390720367431640625f);
                            q[4 + j] = (unsigned)__builtin_amdgcn_rcpf(__builtin_amdgcn_exp2f(__builtin_fmaf(acc[ai][bj][m][1][j], rsn, -8.f)) + 0.00390720367431640625f); }
                        u32x2 w; w.x = q[0] | (q[1] << 8) | (q[2] << 16) | (q[3] << 24); w.y = q[4] | (q[5] << 8) | (q[6] << 16) | (q[7] << 24);
                        *GPTR(u32x2, (unsigned char*)G + ((size_t)(u.pm * 3 + ((pn - 10) >> 2)) * 4 + ((pn - 10) & 3)) * 65536 + (size_t)((((ai * 4 + m) * 512) + (wr * 4 + wc) * 64 + tq_) * 16 + bj * 8)) = w; }
                    else { const f32x4 v0 = acc[ai][bj][m][0] * rs, v1 = acc[ai][bj][m][1] * rs;
                        u32x4 w; w.x = pk2(v0[0], v0[1]); w.y = pk2(v0[2], v0[3]); w.z = pk2(v1[0], v1[1]); w.w = pk2(v1[2], v1[3]);
                        *GPTR(u32x4, rowp + bj * 128) = w; } } }
        }
    }
};

struct EpiGate {
    static constexpr bool PERM = true, AFTER_DRAIN = false, HAS_MID = true;
    const unsigned char* G; bf16_t* Mg; int f8, m0, m1;
    DI bool is_mid(int t) const { return t == m0 || t == m1; }
    static DI float gq(unsigned w, int k) { return (float)((w >> (8 * k)) & 0xffu) + 0.5f; }
    DI void mid(f32x4 (&acc)[2][2][4][2], const pg8::Unit& u, int t, int wr, int wc, int fr, int fq) const {
        int fr_o = fr, fq_o = fq; asm volatile("" : "+v"(fr_o), "+v"(fq_o));
        const int br = (t == m0) ? 0 : 1;
        const unsigned char* gl_ = G + ((size_t)(u.pm * 3 + br) * 4 + u.pn) * 65536 + (size_t)(((wr * 4 + wc) * 64 + fq_o * 16 + fr_o) * 16);
#pragma unroll
        for (int ai = 0; ai < 2; ++ai) {
            __builtin_amdgcn_sched_barrier(0);
            u32x4 gn4[4], gd4[4];
#pragma unroll
            for (int k4 = 0; k4 < 4; ++k4) { gn4[k4] = *(const u32x4*)(gl_ + (ai * 4 + k4) * 8192); gd4[k4] = *(const u32x4*)(gl_ + 4 * 65536 + (ai * 4 + k4) * 8192); }
#pragma unroll
            for (int m = 0; m < 4; ++m) {
#pragma unroll
                for (int bj = 0; bj < 2; ++bj) { const int e_ = m * 2 + bj; u32x2 gn, gd;
                    gn.x = (e_ & 1) ? gn4[e_ >> 1].z : gn4[e_ >> 1].x; gn.y = (e_ & 1) ? gn4[e_ >> 1].w : gn4[e_ >> 1].y;
                    gd.x = (e_ & 1) ? gd4[e_ >> 1].z : gd4[e_ >> 1].x; gd.y = (e_ & 1) ? gd4[e_ >> 1].w : gd4[e_ >> 1].y;
                    f32x4 r0, r1;
#pragma unroll
                    for (int k = 0; k < 4; ++k) { r0[k] = gq(gn.x, k) * __builtin_amdgcn_rcpf(gq(gd.x, k)); r1[k] = gq(gn.y, k) * __builtin_amdgcn_rcpf(gq(gd.y, k)); }
                    acc[ai][bj][m][0] = acc[ai][bj][m][0] * r0; acc[ai][bj][m][1] = acc[ai][bj][m][1] * r1; } } }
        __builtin_amdgcn_sched_barrier(0);
    }
    DI void operator()(AccRef acc, const pg8::Unit& u, int wr, int wc, int fr_, int fq_) const {
        int fr = fr_, fq = fq_; asm volatile("" : "+v"(fr), "+v"(fq));
        const int row0 = u.pm * 256 + wr * 64 + fr, col0 = u.pn * 256 + wc * 32 + 8 * fq;
        const unsigned char* gl_ = G + ((size_t)(u.pm * 3 + 2) * 4 + u.pn) * 65536 + (size_t)(((wr * 4 + wc) * 64 + fq * 16 + fr) * 16);
#pragma unroll
        for (int ai = 0; ai < 2; ++ai)
#pragma unroll
            for (int m = 0; m < 4; ++m) { const size_t row = (size_t)(row0 + ai * 128 + m * 16);
#pragma unroll
                for (int bj = 0; bj < 2; ++bj) { const int col = col0 + bj * 128;
                    const u32x2 g = *(const u32x2*)(gl_ + (ai * 4 + m) * 8192 + bj * 8);
                    const f32x4 v0 = acc[ai][bj][m][0] * (1.f / 256.f), v1 = acc[ai][bj][m][1] * (1.f / 256.f);
                    const float e0 = gq(g.x, 0) * v0[0], e1 = gq(g.x, 1) * v0[1], e2 = gq(g.x, 2) * v0[2], e3 = gq(g.x, 3) * v0[3];
                    const float e4 = gq(g.y, 0) * v1[0], e5 = gq(g.y, 1) * v1[1], e6 = gq(g.y, 2) * v1[2], e7 = gq(g.y, 3) * v1[3];
                    if (f8) { int w0 = 0, w1 = 0; w0 = __builtin_amdgcn_cvt_pk_fp8_f32(e0, e1, w0, false); w0 = __builtin_amdgcn_cvt_pk_fp8_f32(e2, e3, w0, true);
                        w1 = __builtin_amdgcn_cvt_pk_fp8_f32(e4, e5, w1, false); w1 = __builtin_amdgcn_cvt_pk_fp8_f32(e6, e7, w1, true);
                        u32x2 w; w.x = (unsigned)w0; w.y = (unsigned)w1; *(u32x2*)((unsigned char*)Mg + row * 1024 + col) = w; }
                    else { u32x4 w; w.x = pk2(e0, e1); w.y = pk2(e2, e3); w.z = pk2(e4, e5); w.w = pk2(e6, e7);
                        *(u32x4*)(Mg + row * 1024 + col) = w; } } }
    }
};

struct EpiResidN {
    static constexpr bool PERM = true, AFTER_DRAIN = false;
    const float* xin; float* xout; unsigned char* xb; float* ssq; int f8;
    DI void operator()(AccRef acc, const pg8::Unit& u, int wr, int wc, int fr, int fq) const {
        const int row0 = u.pm * 256 + wr * 64 + fr, col0 = u.pn * 256 + wc * 32 + 8 * fq;
#pragma unroll
        for (int ai = 0; ai < 2; ++ai)
#pragma unroll
            for (int m = 0; m < 4; ++m) { const int row = row0 + ai * 128 + m * 16; const size_t ro = (size_t)row * 1024; float ss = 0.f;
#pragma unroll
                for (int bj = 0; bj < 2; ++bj) { const size_t o = ro + col0 + bj * 128;
                    const f32x4 x0 = *(const f32x4*)(xin + o) + acc[ai][bj][m][0], x1 = *(const f32x4*)(xin + o + 4) + acc[ai][bj][m][1];
                    *(f32x4*)(xout + o) = x0; *(f32x4*)(xout + o + 4) = x1;
                    if (xb) { ss += ((x0[0] * x0[0] + x0[1] * x0[1]) + (x0[2] * x0[2] + x0[3] * x0[3])) + ((x1[0] * x1[0] + x1[1] * x1[1]) + (x1[2] * x1[2] + x1[3] * x1[3]));
                        if (f8) { int w0 = 0, w1 = 0; w0 = __builtin_amdgcn_cvt_pk_fp8_f32(x0[0], x0[1], w0, false); w0 = __builtin_amdgcn_cvt_pk_fp8_f32(x0[2], x0[3], w0, true);
                            w1 = __builtin_amdgcn_cvt_pk_fp8_f32(x1[0], x1[1], w1, false); w1 = __builtin_amdgcn_cvt_pk_fp8_f32(x1[2], x1[3], w1, true);
                            u32x2 w; w.x = (unsigned)w0; w.y = (unsigned)w1; *(u32x2*)(xb + o) = w; }
                        else { u32x4 w; w.x = pk2(x0[0], x0[1]); w.y = pk2(x0[2], x0[3]); w.z = pk2(x1[0], x1[1]); w.w = pk2(x1[2], x1[3]); *(u32x4*)(xb + 2 * o) = w; } } }
                if (xb) { ss += shx(ss, 16); ss += shx(ss, 32);
                    if (fq == 0) ssq[(size_t)row * 16 + 4 * u.pn + wc] = ss; } }
    }
};

struct EpiResid {
    static constexpr bool PERM = false, AFTER_DRAIN = false;
    const float* xin; float* xout;
    DI void operator()(AccRef acc, const pg8::Unit& u, int wr, int wc, int fr, int fq) const {
        const int row0 = u.pm * 256 + wr * 64 + fr, col0 = u.pn * 256 + wc * 32 + 4 * fq;
#pragma unroll
        for (int ai = 0; ai < 2; ++ai)
#pragma unroll
            for (int m = 0; m < 4; ++m) { const size_t ro = (size_t)(row0 + ai * 128 + m * 16) * 1024;
#pragma unroll
                for (int bj = 0; bj < 2; ++bj)
#pragma unroll
                    for (int n = 0; n < 2; ++n) { const size_t o = ro + col0 + bj * 128 + n * 16;
                        const f32x4 xv = *(const f32x4*)(xin + o); *(f32x4*)(xout + o) = xv + acc[ai][bj][m][n]; } }
    }
};

template <bool F8O>
struct EpiSwiglu {
    static constexpr bool PERM = true, AFTER_DRAIN = false;
    unsigned char* act; int ld; const LAS float* rtab;
    DI void operator()(AccRef acc, const pg8::Unit& u, int wr, int wc, int fr, int fq) const {
        const int row0 = u.pm * 256 + wr * 64 + fr, col0 = u.pn * 128 + wc * 32 + 8 * fq;
#pragma unroll
        for (int ai = 0; ai < 2; ++ai)
#pragma unroll
            for (int m = 0; m < 4; ++m) { const size_t eo = (size_t)(row0 + ai * 128 + m * 16) * ld + col0;
                const float rs = rtab ? rtab[(u.ord & 1) * 256 + wr * 64 + fr + ai * 128 + m * 16] : 1.f;
                const float rsn = rs * -1.4426950408889634f, irs2 = rtab ? __builtin_amdgcn_rcpf(rs * rs) : 1.f;
                float o[8];
#pragma unroll
                for (int n = 0; n < 2; ++n)
#pragma unroll
                    for (int j = 0; j < 4; ++j) { const float ga = acc[ai][0][m][n][j], ua = acc[ai][1][m][n][j];
                        const float e = __builtin_amdgcn_exp2f(ga * rsn); o[4 * n + j] = (ga * ua) * __builtin_amdgcn_rcpf(__builtin_fmaf(e, irs2, irs2)); }
                if constexpr (F8O) { int w0 = 0, w1 = 0;
                    w0 = __builtin_amdgcn_cvt_pk_fp8_f32(o[0], o[1], w0, false); w0 = __builtin_amdgcn_cvt_pk_fp8_f32(o[2], o[3], w0, true);
                    w1 = __builtin_amdgcn_cvt_pk_fp8_f32(o[4], o[5], w1, false); w1 = __builtin_amdgcn_cvt_pk_fp8_f32(o[6], o[7], w1, true);
                    u32x2 w; w.x = (unsigned)w0; w.y = (unsigned)w1; *(u32x2*)(act + eo) = w; }
                else { u32x4 w; w.x = pk2(o[0], o[1]); w.y = pk2(o[2], o[3]); w.z = pk2(o[4], o[5]); w.w = pk2(o[6], o[7]); *(u32x4*)(act + 2 * eo) = w; } }
    }
};

struct EpiMoeDown {
    static constexpr bool PERM = true, AFTER_DRAIN = false;
    const int* perm; const float* rgate; bf16_t* ybuf;
    DI void operator()(AccRef acc, const pg8::Unit& u, int wr, int wc, int fr_, int fq) const {
        int fr = fr_; asm volatile("" : "+v"(fr));
        const int row0 = u.pm * 256 + wr * 64 + fr, col0 = u.pn * 256 + wc * 32 + 8 * fq;
#pragma unroll
        for (int ai = 0; ai < 2; ++ai)
#pragma unroll
            for (int m = 0; m < 4; ++m) { const int row = row0 + ai * 128 + m * 16; const int p = perm[row];
                if (p >= 0) { const float gt = rgate[row]; bf16_t* dst = ybuf + ((size_t)(p & 1) * NTOK + (size_t)(p >> 1)) * 1024 + col0;
#pragma unroll
                    for (int bj = 0; bj < 2; ++bj) { const f32x4 v0 = acc[ai][bj][m][0] * gt, v1 = acc[ai][bj][m][1] * gt;
                        u32x4 w; w.x = pk2(v0[0], v0[1]); w.y = pk2(v0[2], v0[3]); w.z = pk2(v1[0], v1[1]); w.w = pk2(v1[2], v1[3]);
                        *(u32x4*)(dst + bj * 128) = w; } } }
    }
};

#define LDS_WAIT() asm volatile("s_waitcnt lgkmcnt(0)" ::: "memory")

DI void prep_tile(const float* src, int src_ld, bool zero, unsigned char* dst, int dst_ld, float f8mul, const float* kg  , LAS bf16_t* t, int lane) {
#pragma unroll
    for (int i = 0; i < 16; ++i) { const int k = i * 4 + (lane >> 4), c = (lane & 15) * 4;
        f32x4 v = {0.f, 0.f, 0.f, 0.f}; if (!zero) v = *(const f32x4*)(src + (size_t)k * src_ld + c);
        if (kg) v = v * kg[k];
        u32x2 w; w.x = pk2(v[0], v[1]); w.y = pk2(v[2], v[3]); *(LAS u32x2*)(t + k * 68 + c) = w; }
    LDS_WAIT();
#pragma unroll
    for (int kc = 0; kc < 8; ++kc) { unsigned e[8];
#pragma unroll
        for (int j = 0; j < 8; ++j) e[j] = t[(8 * kc + j) * 68 + lane];
        if (f8mul != 0.f) { int w0 = 0, w1 = 0;
            w0 = __builtin_amdgcn_cvt_pk_fp8_f32(bflo(e[0]) * f8mul, bflo(e[1]) * f8mul, w0, false); w0 = __builtin_amdgcn_cvt_pk_fp8_f32(bflo(e[2]) * f8mul, bflo(e[3]) * f8mul, w0, true);
            w1 = __builtin_amdgcn_cvt_pk_fp8_f32(bflo(e[4]) * f8mul, bflo(e[5]) * f8mul, w1, false); w1 = __builtin_amdgcn_cvt_pk_fp8_f32(bflo(e[6]) * f8mul, bflo(e[7]) * f8mul, w1, true);
            u32x2 w; w.x = (unsigned)w0; w.y = (unsigned)w1; *(u32x2*)(dst + (size_t)lane * dst_ld + 8 * kc) = w; }
        else { u32x4 w; w.x = e[0] | (e[1] << 16); w.y = e[2] | (e[3] << 16); w.z = e[4] | (e[5] << 16); w.w = e[6] | (e[7] << 16);
            *(u32x4*)(dst + ((size_t)lane * dst_ld + 8 * kc) * 2) = w; } }
    LDS_WAIT();
}

struct Args { const float* in[12]; float* out; unsigned char* ws; int lo, hi; };
typedef Args Ptrs;

DI void prep_wg_tile(const float* src0, const float* src1, int src_ld, unsigned char* dst, int dst_ld, float f8mul, const float* kg, LAS bf16_t* t, int tid) {
    { const int c = (tid & 127) * 4, kk = tid >> 7;
      const float* sp; int dn;
      if (src1) { const int run = c >> 8, cc = c & 255; sp = (run ? src1 : src0) + cc; dn = ((cc >> 7) << 8) + (run << 7) + (cc & 127); } else { sp = src0 + c; dn = c; }
#pragma unroll
      for (int p = 0; p < 16; ++p) { const int k = 4 * p + kk; f32x4 v = *(const f32x4*)(sp + (size_t)k * src_ld);
          if (kg) v = v * kg[k];
          u32x2 w; w.x = pk2(v[0], v[1]); w.y = pk2(v[2], v[3]); *(LAS u32x2*)(t + k * 520 + (dn ^ (((k >> 3) & 7) << 3))) = w; } }
    __syncthreads();
    { const int kc = tid & 7;
#pragma unroll
      for (int i = 0; i < 8; ++i) { const int n = 64 * i + (tid >> 3); unsigned e[8];
#pragma unroll
          for (int j = 0; j < 8; ++j) e[j] = t[(8 * kc + j) * 520 + (n ^ (kc << 3))];
          if (f8mul != 0.f) { int w0 = 0, w1 = 0;
              w0 = __builtin_amdgcn_cvt_pk_fp8_f32(bflo(e[0]) * f8mul, bflo(e[1]) * f8mul, w0, false); w0 = __builtin_amdgcn_cvt_pk_fp8_f32(bflo(e[2]) * f8mul, bflo(e[3]) * f8mul, w0, true);
              w1 = __builtin_amdgcn_cvt_pk_fp8_f32(bflo(e[4]) * f8mul, bflo(e[5]) * f8mul, w1, false); w1 = __builtin_amdgcn_cvt_pk_fp8_f32(bflo(e[6]) * f8mul, bflo(e[7]) * f8mul, w1, true);
              u32x2 w; w.x = (unsigned)w0; w.y = (unsigned)w1; *(u32x2*)(dst + (size_t)n * dst_ld + 8 * kc) = w; }
          else { u32x4 w; w.x = e[0] | (e[1] << 16); w.y = e[2] | (e[3] << 16); w.z = e[4] | (e[5] << 16); w.w = e[6] | (e[7] << 16);
              *(u32x4*)(dst + ((size_t)n * dst_ld + 8 * kc) * 2) = w; } } }
    __syncthreads();
}

struct PrepDesc { const float* src0; const float* src1; const float* kg; unsigned char* dst; int src_ld, dst_ld; float f8mul; };
constexpr int T0 = 4 * 176, T3 = T0 + 4 * 24, T4 = T3 + 4 * 32, T5 = T4 + 2 * 176, T6 = T5 + 2 * 88, T7 = T6 + 16 * 224, T8 = T7 + 16 * 112;
DI PrepDesc prep_decode(const Ptrs& P, int it) {
    const float* src; const float* src1 = nullptr; int src_ld; size_t wsb; size_t eo; int dst_ld; float f8mul = 0.f; const float* kg = nullptr;
        int r = it;
        if (r < T0) { const int L = r / 176, q = r % 176, kt = q / 11, nt = q % 11;
            src = P.in[2] + (size_t)L * 1024 * 5632 + (size_t)kt * 64 * 5632 + nt * 512; src_ld = 5632;
            wsb = WS_W_IN + (size_t)L * 5632 * 1024 * 2; eo = (size_t)(nt * 512) * 1024 + kt * 64; dst_ld = 1024; f8mul = ((F8_IN >> L) & 1) ? 32.f : 0.f;
            if (FUSE_NORM && (L & 1)) kg = P.in[1] + (size_t)L * 2048 + kt * 64; }
        else if (r < T3) { r -= T0; const int L = r / 24, q = r % 24, kt = q / 2, nt = q % 2;
            src = P.in[5] + (size_t)L * 768 * 1024 + (size_t)(kt * 64) * 1024 + nt * 512; src_ld = 1024;
            wsb = WS_W_BR + (size_t)L * 1024 * 768 * 2; eo = (size_t)(nt * 512) * 768 + kt * 64; dst_ld = 768; f8mul = ((F8_GATE >> L) & 1) ? 32.f : 0.f; }
        else if (r < T4) { r -= T3; const int L = r / 32, q = r % 32, kt = q / 2, nt = q % 2;
            src = P.in[6] + (size_t)L * 1024 * 1024 + (size_t)(kt * 64) * 1024 + nt * 512; src_ld = 1024;
            wsb = WS_W_OUT + (size_t)L * 1024 * 1024 * 2; eo = (size_t)(nt * 512) * 1024 + kt * 64; dst_ld = 1024; f8mul = ((F8_OUT >> L) & 1) ? 32.f : 0.f; }
        else if (r < T5) { r -= T4; const int L = r / 176, q = r % 176, kt = q / 11, nt = q % 11;
            src = P.in[7] + (size_t)L * 1024 * 5632 + (size_t)(kt * 64) * 5632 + nt * 256; src1 = src + FF; src_ld = 5632;
            wsb = WS_W_FGU + (size_t)L * 5632 * 1024 * 2; eo = (size_t)(nt * 512) * 1024 + kt * 64; dst_ld = 1024; f8mul = ((F8_FFN >> L) & 1) ? 32.f : 0.f;
            if (FUSE_NORM) kg = P.in[1] + (size_t)(2 * L) * 2048 + 1024 + kt * 64; }
        else if (r < T6) { r -= T5; const int L = r / 88, q = r % 88, kt = q / 2, nt = q % 2;
            src = P.in[8] + (size_t)L * 2816 * 1024 + (size_t)(kt * 64) * 1024 + nt * 512; src_ld = 1024;
            wsb = WS_W_FDN + (size_t)L * 1024 * 2816 * 2; eo = (size_t)(nt * 512) * 2816 + kt * 64; dst_ld = 2816; f8mul = ((F8_FFN >> L) & 1) ? 64.f : 0.f; }
        else if (r < T7) { r -= T6; const int L = r / 224, q = r % 224, kt = q / 14, nt = q % 14;
            src = P.in[10] + (size_t)L * 1024 * 7168 + (size_t)(kt * 64) * 7168 + nt * 256; src1 = src + ED; src_ld = 7168;
            wsb = WS_W_MGU + (size_t)(L >> 3) * 8 * 7168 * 1024 * 2; eo = ((size_t)(L & 7) * 7168 + nt * 512) * 1024 + kt * 64; dst_ld = 1024; f8mul = ((F8_MOE >> (L >> 3)) & 1) ? 32.f : 0.f; }
        else { r -= T7; const int L = r / 112, q = r % 112, kt = q / 2, nt = q % 2;
            src = P.in[11] + (size_t)L * 3584 * 1024 + (size_t)(kt * 64) * 1024 + nt * 512; src_ld = 1024;
            wsb = WS_W_MDN + (size_t)(L >> 3) * 8 * 1024 * 3584 * 2; eo = ((size_t)(L & 7) * 1024 + nt * 512) * 3584 + kt * 64; dst_ld = 3584; f8mul = ((F8_MOE >> (L >> 3)) & 1) ? 64.f : 0.f; }
    PrepDesc d; d.src0 = src; d.src1 = src1; d.kg = kg; d.dst = P.ws + wsb + eo * (f8mul != 0.f ? 1 : 2); d.src_ld = src_ld; d.dst_ld = dst_ld; d.f8mul = f8mul; return d;
}
DI void prep_load(const PrepDesc& d, f32x4 (&v)[16], int tid) {
    const int c = (tid & 127) * 4, kk = tid >> 7; const float* sp;
    if (d.src1) { const int run = c >> 8, cc = c & 255; sp = (run ? d.src1 : d.src0) + cc; } else sp = d.src0 + c;
#pragma unroll
    for (int p = 0; p < 16; ++p) v[p] = *(const f32x4*)(sp + (size_t)(4 * p + kk) * d.src_ld);
}
DI void prep_to_lds(const PrepDesc& d, const f32x4 (&v)[16], LAS bf16_t* t, int tid) {
    const int c = (tid & 127) * 4, kk = tid >> 7; int dn;
    if (d.src1) { const int run = c >> 8, cc = c & 255; dn = ((cc >> 7) << 8) + (run << 7) + (cc & 127); } else dn = c;
#pragma unroll
    for (int p = 0; p < 16; ++p) { const int k = 4 * p + kk; f32x4 x = v[p];
        if (d.kg) x = x * d.kg[k];
        u32x2 w; w.x = pk2(x[0], x[1]); w.y = pk2(x[2], x[3]); *(LAS u32x2*)(t + k * 520 + (dn ^ (((k >> 3) & 7) << 3))) = w; }
}
DI void prep_out(const PrepDesc& d, const LAS bf16_t* t, int tid) {
    const int kc = tid & 7; const float f8mul = d.f8mul; unsigned char* dst = d.dst; const int dst_ld = d.dst_ld;
#pragma unroll
    for (int i = 0; i < 8; ++i) { const int n = 64 * i + (tid >> 3); unsigned e[8];
#pragma unroll
        for (int j = 0; j < 8; ++j) e[j] = t[(8 * kc + j) * 520 + (n ^ (kc << 3))];
        if (f8mul != 0.f) { int w0 = 0, w1 = 0;
            w0 = __builtin_amdgcn_cvt_pk_fp8_f32(bflo(e[0]) * f8mul, bflo(e[1]) * f8mul, w0, false); w0 = __builtin_amdgcn_cvt_pk_fp8_f32(bflo(e[2]) * f8mul, bflo(e[3]) * f8mul, w0, true);
            w1 = __builtin_amdgcn_cvt_pk_fp8_f32(bflo(e[4]) * f8mul, bflo(e[5]) * f8mul, w1, false); w1 = __builtin_amdgcn_cvt_pk_fp8_f32(bflo(e[6]) * f8mul, bflo(e[7]) * f8mul, w1, true);
            u32x2 w; w.x = (unsigned)w0; w.y = (unsigned)w1; *(u32x2*)(dst + (size_t)n * dst_ld + 8 * kc) = w; }
        else { u32x4 w; w.x = e[0] | (e[1] << 16); w.y = e[2] | (e[3] << 16); w.z = e[4] | (e[5] << 16); w.w = e[6] | (e[7] << 16);
            *(u32x4*)(dst + ((size_t)n * dst_ld + 8 * kc) * 2) = w; } }
}

DI void phase_prep(const Ptrs& P, LAS unsigned char* lds, int tid) {
    LAS bf16_t* t = (LAS bf16_t*)(lds + LDS_SCR);
    { f32x4 v[16]; int it = blockIdx.x; PrepDesc d = prep_decode(P, it < T8 ? it : 0);
      if (it < T8) prep_load(d, v, tid);
      for (; it < T8; it += gridDim.x) {
          prep_to_lds(d, v, t, tid);
          __syncthreads();
          const PrepDesc dcur = d; const int nx = it + (int)gridDim.x;
          if (nx < T8) { d = prep_decode(P, nx); prep_load(d, v, tid); }
          prep_out(dcur, t, tid);
          __syncthreads(); } }
    const int gid = blockIdx.x * NTHR + tid;
    if (gid < 4096 * 32) { const int pos = gid >> 5, i = gid & 31; const float inv = powf(10000.f, -(float)(2 * i) / 64.f); float s, c; sincosf((float)pos * inv, &s, &c);
        ((f32x2*)(P.ws + WS_ROPE1))[gid] = (f32x2){c, s}; }
    if (gid < 64 * 16) { const int pos = gid >> 4, i = gid & 15; const float inv = powf(10000.f, -(float)(2 * i) / 32.f); float s, c; sincosf((float)pos * inv, &s, &c);
        ((f32x2*)(P.ws + WS_ROPEA))[gid] = (f32x2){c, s}; }
}

template <bool COMBINE, bool ROUTER, bool HF8>
DI void phase_norm(const float* xin, float* xout, const bf16_t* ybuf, const float* gain, bf16_t* H, const float* wrt, int* topi, float* topw, int* cnt, int* perm,
                   LAS unsigned char* lds, int tid) {
    const int wave = tid >> 6, lane = tid & 63, w = blockIdx.x;
    LAS int* cntl = (LAS int*)(lds + LDS_SCR + 32768);
    float wr[8][16];
    if (ROUTER) {
#pragma unroll
        for (int q = 0; q < 4; ++q)
#pragma unroll
            for (int c4 = 0; c4 < 4; ++c4) { const f32x4* p = (const f32x4*)(wrt + (size_t)(256 * q + 4 * lane + c4) * 8); const f32x4 a = p[0], b = p[1];
                wr[0][4 * q + c4] = a[0]; wr[1][4 * q + c4] = a[1]; wr[2][4 * q + c4] = a[2]; wr[3][4 * q + c4] = a[3];
                wr[4][4 * q + c4] = b[0]; wr[5][4 * q + c4] = b[1]; wr[6][4 * q + c4] = b[2]; wr[7][4 * q + c4] = b[3]; }
        if (tid < 8) cntl[tid] = 0;
        for (int i = tid; i < MROWS / NWG; i += NTHR) perm[w * (MROWS / NWG) + i] = -1;
        __syncthreads();
    }
    f32x4 g[4];
#pragma unroll
    for (int q = 0; q < 4; ++q) g[q] = *(const f32x4*)(gain + 256 * q + 4 * lane);
    f32x4 nv[4]; u32x2 na[4], nb[4];
#define PN_LOAD(row_) do { const size_t ro_ = (size_t)(row_) * 1024; _Pragma("unroll") for (int q = 0; q < 4; ++q) { nv[q] = *(const f32x4*)(xin + ro_ + 256 * q + 4 * lane); \
        if (COMBINE) { na[q] = *(const u32x2*)(ybuf + ro_ + 256 * q + 4 * lane); nb[q] = *(const u32x2*)(ybuf + (size_t)NTOK * 1024 + ro_ + 256 * q + 4 * lane); } } } while (0)
    PN_LOAD(w * 128 + wave * 16);
    for (int j = 0; j < 16; ++j) {
        const int row = w * 128 + wave * 16 + j; const size_t ro = (size_t)row * 1024;
        f32x4 v[4]; u32x2 ya[4], yb[4]; float ss = 0.f;
#pragma unroll
        for (int q = 0; q < 4; ++q) { v[q] = nv[q]; if (COMBINE) { ya[q] = na[q]; yb[q] = nb[q]; } }
        if (j + 1 < 16) PN_LOAD(row + 1);
#pragma unroll
        for (int q = 0; q < 4; ++q) {
            if (COMBINE) { const u32x2 a = ya[q], b = yb[q];
                v[q][0] += bflo(a.x) + bflo(b.x); v[q][1] += bfhi(a.x) + bfhi(b.x); v[q][2] += bflo(a.y) + bflo(b.y); v[q][3] += bfhi(a.y) + bfhi(b.y);
                *(f32x4*)(xout + ro + 256 * q + 4 * lane) = v[q]; }
            ss += (v[q][0] * v[q][0] + v[q][1] * v[q][1]) + (v[q][2] * v[q][2] + v[q][3] * v[q][3]); }
        const float rstd = 1.f / sqrtf(wave_sum(ss) * (1.f / 1024.f) + EPS);
#pragma unroll
        for (int q = 0; q < 4; ++q) { v[q] = v[q] * rstd * g[q];
            if constexpr (HF8) { int w = 0; w = __builtin_amdgcn_cvt_pk_fp8_f32(v[q][0], v[q][1], w, false); w = __builtin_amdgcn_cvt_pk_fp8_f32(v[q][2], v[q][3], w, true);
                *(int*)((unsigned char*)H + ro + 256 * q + 4 * lane) = w; }
            else { u32x2 o; o.x = pk2(v[q][0], v[q][1]); o.y = pk2(v[q][2], v[q][3]); *(u32x2*)(H + ro + 256 * q + 4 * lane) = o; } }
        if (ROUTER) {
            float lg[8];
#pragma unroll
            for (int e = 0; e < 8; ++e) { float a = 0.f;
#pragma unroll
                for (int q = 0; q < 4; ++q) a += (v[q][0] * wr[e][4 * q] + v[q][1] * wr[e][4 * q + 1]) + (v[q][2] * wr[e][4 * q + 2] + v[q][3] * wr[e][4 * q + 3]);
                lg[e] = wave_sum(a); }
            float v0 = -3.0e38f; int e0 = 0;
#pragma unroll
            for (int e = 0; e < 8; ++e) if (lg[e] > v0) { v0 = lg[e]; e0 = e; }
            float v1 = -3.0e38f; int e1 = 0;
#pragma unroll
            for (int e = 0; e < 8; ++e) if (e != e0 && lg[e] > v1) { v1 = lg[e]; e1 = e; }
            if (lane == 0) { const float t = __expf(v1 - v0), w0 = 1.f / (1.f + t);
                topi[row * 2] = e0; topi[row * 2 + 1] = e1; topw[row * 2] = w0; topw[row * 2 + 1] = t * w0;
                atomicAdd((int*)(cntl + e0), 1); atomicAdd((int*)(cntl + e1), 1); }
        }
    }
#undef PN_LOAD
    if (ROUTER) { __syncthreads(); if (tid < 8) cnt[w * 8 + tid] = cntl[tid]; }
}

DI void moe_totals(const int* cnt, volatile LAS int* misc, int tid) {
    const int e = tid >> 6, lane = tid & 63, w = blockIdx.x;
    int c[4]; int s4 = 0;
#pragma unroll
    for (int i = 0; i < 4; ++i) { c[i] = cnt[(4 * lane + i) * 8 + e]; s4 += c[i]; }
    int x = s4;
#pragma unroll
    for (int o = 1; o < 64; o <<= 1) { const int y = shup(x, o); if (lane >= o) x += y; }
    const int total = shidx(x, 63);
    int p = x - s4;
#pragma unroll
    for (int i = 0; i < 3; ++i) if (i < (w & 3)) p += c[i];
    p = shidx(p, w >> 2);
    if (lane == 0) { misc[e] = total; misc[8 + e] = p; }
    __syncthreads();
}

template <bool F8>
DI void phase_scatter(const int* cnt, const int* topi, const float* topw, const bf16_t* H, bf16_t* XS, int* perm, float* rgate, LAS unsigned char* lds, int tid) {
    const int wave = tid >> 6, lane = tid & 63, w = blockIdx.x;
    volatile LAS int* misc = (volatile LAS int*)(lds + LDS_MISC + 64);
    LAS int* posl = (LAS int*)(lds + LDS_SCR);
    moe_totals(cnt, misc, tid);
    { const int e = wave; int base = 0;
        for (int k = 0; k < e; ++k) base += ((misc[k] + 255) >> 8) << 8;
        int running = base + misc[8 + e];
        for (int pss = 0; pss < 2; ++pss) { const int j = 64 * pss + lane, tok = w * 128 + j;
            const int a0 = topi[tok * 2], a1 = topi[tok * 2 + 1]; const bool f0 = a0 == e, f1 = a1 == e, has = f0 || f1;
            const unsigned long long mask = __ballot(has); const int rank = __popcll(mask & ((1ull << lane) - 1ull));
            if (has) { const int pos = running + rank, slot = f1 ? 1 : 0; perm[pos] = tok * 2 + slot; rgate[pos] = topw[tok * 2 + slot]; posl[j * 2 + slot] = pos; }
            running += __popcll(mask); }
    }
    __syncthreads();
    for (int i0 = 0; i0 < 32; i0 += 8) {
        if constexpr (F8) { u32x4 t[8]; int ps[8];
#pragma unroll
            for (int k = 0; k < 8; ++k) { const int pr = wave * 32 + i0 + k, tok = w * 128 + (pr >> 1); ps[k] = posl[pr];
                t[k] = *((const u32x4*)((const unsigned char*)H + (size_t)tok * 1024) + lane); }
#pragma unroll
            for (int k = 0; k < 8; ++k) *((u32x4*)((unsigned char*)XS + (size_t)ps[k] * 1024) + lane) = t[k]; }
        else { u32x4 ta[8], tb[8]; int ps[8];
#pragma unroll
            for (int k = 0; k < 8; ++k) { const int pr = wave * 32 + i0 + k, tok = w * 128 + (pr >> 1); ps[k] = posl[pr];
                const u32x4* s = (const u32x4*)(H + (size_t)tok * 1024) + lane; ta[k] = s[0]; tb[k] = s[64]; }
#pragma unroll
            for (int k = 0; k < 8; ++k) { u32x4* d = (u32x4*)(XS + (size_t)ps[k] * 1024) + lane; d[0] = ta[k]; d[64] = tb[k]; } } }
}

DI void phase_final(const float* x, const bf16_t* ybuf, float* out, int tid) {
    const size_t n4 = (size_t)NTOK * 1024 / 4;
    for (size_t i = (size_t)blockIdx.x * NTHR + tid; i < n4; i += (size_t)gridDim.x * NTHR) {
        f32x4 v = ((const f32x4*)x)[i]; const u32x2 a = ((const u32x2*)ybuf)[i], b = ((const u32x2*)(ybuf + (size_t)NTOK * 1024))[i];
        v[0] += bflo(a.x) + bflo(b.x); v[1] += bfhi(a.x) + bfhi(b.x); v[2] += bflo(a.y) + bflo(b.y); v[3] += bfhi(a.y) + bfhi(b.y);
        ((f32x4*)out)[i] = v; }
}

struct QKRaw { u32x2 w[4]; };
DI void qk_load(QKRaw& R, const bf16_t* rowp, int lane, bool active) {
    const bf16_t* hp = rowp + (active ? (lane >> 2) * 64 + 4 * (lane & 3) : 0);
#pragma unroll
    for (int m = 0; m < 4; ++m) R.w[m] = *(const u32x2*)(hp + 16 * m);
}
DI void qk_finish(const QKRaw& R, bf16_t* rowp, int nh0, int nh1, const LAS float* gl  , int which, float scale, const LAS f32x2* r1l  , const LAS f32x2* ral  ,
                  int sl  , int s, int lane, bool active, unsigned char* k8row = nullptr  ) {
    const int head = lane >> 2, q = lane & 3;
    const int br = head < nh0 ? 0 : (head < nh0 + nh1 ? 1 : 2);
    float v[4][4], ss = 0.f;
#pragma unroll
    for (int m = 0; m < 4; ++m) { const u32x2 w = R.w[m]; v[m][0] = bflo(w.x); v[m][1] = bfhi(w.x); v[m][2] = bflo(w.y); v[m][3] = bfhi(w.y);
        ss += (v[m][0] * v[m][0] + v[m][1] * v[m][1]) + (v[m][2] * v[m][2] + v[m][3] * v[m][3]); }
    ss += shx(ss, 1); ss += shx(ss, 2);
    const float rstd = 1.f / sqrtf(ss * (1.f / 64.f) + EPS);
    const LAS float* gp = gl + (br * 2 + which) * 64 + 4 * q;
    float o[4][4];
    f32x4 cs[4][2];
#pragma unroll
    for (int m = 0; m < 4; ++m) { const f32x4 g4 = *(const LAS f32x4*)(gp + 16 * m);
#pragma unroll
        for (int j = 0; j < 4; ++j) v[m][j] = v[m][j] * rstd * g4[j];
        const LAS f32x2* tp = (br == 2) ? r1l + sl * 32 + (m & 1) * 16 + 4 * q : ral + ((m < 2) ? (s >> 6) : (s & 63)) * 16 + 4 * q;
        cs[m][0] = *(const LAS f32x4*)tp; cs[m][1] = *(const LAS f32x4*)(tp + 2); }
#pragma unroll
    for (int m = 0; m < 4; ++m) { const bool first = (br == 2) ? (m < 2) : ((m & 1) == 0);
#pragma unroll
        for (int j = 0; j < 4; ++j) { const float pv = (br == 2) ? v[m ^ 2][j] : v[m ^ 1][j]; const float c = cs[m][j >> 1][2 * (j & 1)], sn = cs[m][j >> 1][2 * (j & 1) + 1];
            const float rot = first ? v[m][j] * c - pv * sn : v[m][j] * c + pv * sn;
            o[m][j] = ((br == 0) ? v[m][j] : rot) * scale; } }
    if (active) { bf16_t* hp = rowp + head * 64 + 4 * q;
#pragma unroll
        for (int m = 0; m < 4; ++m) { u32x2 w; w.x = pk2(o[m][0], o[m][1]); w.y = pk2(o[m][2], o[m][3]); *(u32x2*)(hp + 16 * m) = w; } }
    if (k8row && (head == 4 || head == 5)) { unsigned char* kp = k8row + (head - 4) * 64 + (q >> 1) * 32 + 4 * (q & 1);
#pragma unroll
        for (int m = 0; m < 4; ++m) { int w = 0; w = __builtin_amdgcn_cvt_pk_fp8_f32(o[m][0], o[m][1], w, false); w = __builtin_amdgcn_cvt_pk_fp8_f32(o[m][2], o[m][3], w, true);
            *(int*)(kp + 8 * m) = w; } }
}

DI void qk_rows_wave(const Ptrs& P, const LAS float* gl, const LAS f32x2* r1l, const LAS f32x2* ral, int wave, int lane) {
    bf16_t* Kb = (bf16_t*)(P.ws + WS_K);
    unsigned char* K8 = P.ws + WS_K8;
    const int t0 = blockIdx.x * 128 + wave * 16;
    const bool act = lane < 48;
    QKRaw a0, a1, a2, a3, b0, b1, b2, b3;
    qk_load(a0, Kb + (size_t)t0 * 768, lane, act); qk_load(a1, Kb + (size_t)(t0 + 1) * 768, lane, act); qk_load(a2, Kb + (size_t)(t0 + 2) * 768, lane, act); qk_load(a3, Kb + (size_t)(t0 + 3) * 768, lane, act);
#pragma unroll 1
    for (int j = 0; j < 16; j += 4) { const int tok = t0 + j, tn = (j + 4 < 16) ? tok + 4 : tok, s = tok & (SEQ - 1), sl = wave * 16 + j;
        qk_load(b0, Kb + (size_t)tn * 768, lane, act); qk_load(b1, Kb + (size_t)(tn + 1) * 768, lane, act); qk_load(b2, Kb + (size_t)(tn + 2) * 768, lane, act); qk_load(b3, Kb + (size_t)(tn + 3) * 768, lane, act);
        qk_finish(a0, Kb + (size_t)tok * 768, 4, 2, gl, 1, 1.0f, r1l, ral, sl, s, lane, act, K8 + (size_t)tok * 128);
        qk_finish(a1, Kb + (size_t)(tok + 1) * 768, 4, 2, gl, 1, 1.0f, r1l, ral, sl + 1, s + 1, lane, act, K8 + (size_t)(tok + 1) * 128);
        qk_finish(a2, Kb + (size_t)(tok + 2) * 768, 4, 2, gl, 1, 1.0f, r1l, ral, sl + 2, s + 2, lane, act, K8 + (size_t)(tok + 2) * 128);
        qk_finish(a3, Kb + (size_t)(tok + 3) * 768, 4, 2, gl, 1, 1.0f, r1l, ral, sl + 3, s + 3, lane, act, K8 + (size_t)(tok + 3) * 128);
        a0 = b0; a1 = b1; a2 = b2; a3 = b3; }
}
DI void v_units_wave(const Ptrs& P, LAS unsigned* L, int gw, int NGW, int lane) {
    const bf16_t* V = (const bf16_t*)(P.ws + WS_VRAW); bf16_t* Vt = (bf16_t*)(P.ws + WS_VT);
    u32x4 rw[8];
    { const int tt = gw >> 2, hv = 8 + (gw & 3); const bf16_t* src = V + (size_t)(tt * 64 + lane) * 768 + hv * 64;
#pragma unroll
      for (int c = 0; c < 8; ++c) rw[c] = *(const u32x4*)(src + c * 8); }
#pragma unroll 1
    for (int un = gw; un < 512 * 4; un += NGW) { const int tt = un >> 2, hv = 8 + (un & 3), tok0 = tt * 64, b = tok0 >> 12, s0 = tok0 & (SEQ - 1);
        const int g = hv < 6 ? 0 : ((hv - 6) >> 1), sh = 2 * g, dd = 1 << sh, Sd = SEQ >> sh, run = 64 >> sh;
        const int pos = (lane & (dd - 1)) * run + (lane >> sh);
#pragma unroll
        for (int c = 0; c < 8; ++c) { L[(4 * c + 0) * 68 + pos] = rw[c].x; L[(4 * c + 1) * 68 + pos] = rw[c].y; L[(4 * c + 2) * 68 + pos] = rw[c].z; L[(4 * c + 3) * 68 + pos] = rw[c].w; }
        { const int un2 = (un + NGW < 512 * 4) ? un + NGW : un; const int tt2 = un2 >> 2, hv2 = 8 + (un2 & 3); const bf16_t* src = V + (size_t)(tt2 * 64 + lane) * 768 + hv2 * 64;
#pragma unroll
          for (int c = 0; c < 8; ++c) rw[c] = *(const u32x4*)(src + c * 8); }
        LDS_WAIT();
        const int ch = lane & 7, p = 8 * ch;
        const size_t g1 = (size_t)(p >> (6 - sh)) * Sd + (s0 >> sh) + (p & (run - 1)), g2 = (size_t)((p + 4) >> (6 - sh)) * Sd + (s0 >> sh) + ((p + 4) & (run - 1));
#pragma unroll
        for (int i = 0; i < 8; ++i) { const int d = 8 * i + (lane >> 3), k = d >> 1;
            const u32x4 wa = *(const LAS u32x4*)(L + k * 68 + p), wb = *(const LAS u32x4*)(L + k * 68 + p + 4);
            const unsigned sel = (d & 1) ? 0x07060302u : 0x05040100u;
            u32x4 o; o.x = __builtin_amdgcn_perm(wa.y, wa.x, sel); o.y = __builtin_amdgcn_perm(wa.w, wa.z, sel); o.z = __builtin_amdgcn_perm(wb.y, wb.x, sel); o.w = __builtin_amdgcn_perm(wb.w, wb.z, sel);
            bf16_t* drow = Vt + ((size_t)(b * 12 + hv) * 64 + d) * SEQ;
            if (run >= 8) *(u32x4*)(drow + g1) = o;
            else { u32x2 t; t.x = o.x; t.y = o.y; *(u32x2*)(drow + g1) = t; t.x = o.z; t.y = o.w; *(u32x2*)(drow + g2) = t; } }
        LDS_WAIT();
    }
}
DI void phase_qkvprep(const Ptrs& P, int layer, LAS unsigned char* lds, int tid) {
    const int wave = tid >> 6, lane = tid & 63, gw = blockIdx.x * 8 + wave, NGW = gridDim.x * 8;
    LAS f32x4* r1l4 = (LAS f32x4*)(lds + LDS_SCR); LAS f32x4* ral4 = (LAS f32x4*)(lds + LDS_SCR + 32768); LAS float* gl = (LAS float*)(lds + LDS_SCR + 40960);
    const int s0 = (blockIdx.x * 128) & (SEQ - 1);
    const f32x4* r1g = (const f32x4*)(P.ws + WS_ROPE1) + (size_t)s0 * 16; const f32x4* rag = (const f32x4*)(P.ws + WS_ROPEA);
    for (int i = tid; i < 128 * 16; i += NTHR) r1l4[i] = r1g[i];
    for (int i = tid; i < 64 * 8; i += NTHR) ral4[i] = rag[i];
    if (tid < 384) gl[tid] = (P.in[3] + (size_t)layer * 384)[tid];
    __syncthreads();
    const LAS f32x2* r1l = (const LAS f32x2*)(lds + LDS_SCR); const LAS f32x2* ral = (const LAS f32x2*)(lds + LDS_SCR + 32768);
    LAS unsigned* L = (LAS unsigned*)(lds + LDS_SCR + 49152 + wave * 8704);
    (void)L; (void)gw; (void)NGW;
    qk_rows_wave(P, gl, r1l, ral, wave, lane);
}

#define XB_TMO      128
#define XB_XCNT(j)  (256  + 64 * (j))
#define XB_XSUB(j)  (1280 + 64 * (j))
#define XB_XGEN(j)  (2304 + 64 * (j))
#define XB_TOP      3328
#define XB_TOPGEN   3392
#define XCD_BAR_WORDS 3456
#define XB_SPIN_CAP (1u << 18)

__device__ __forceinline__ unsigned xb_ld(unsigned* p)              { return __hip_atomic_load(p, __ATOMIC_RELAXED, __HIP_MEMORY_SCOPE_AGENT); }
__device__ __forceinline__ unsigned xb_add(unsigned* p, unsigned v) { return __hip_atomic_fetch_add(p, v, __ATOMIC_RELAXED, __HIP_MEMORY_SCOPE_AGENT); }
__device__ __forceinline__ unsigned xb_xcc_id() { return (unsigned)__builtin_amdgcn_s_getreg((3 << 11) | 20) & 0xFu; }
#define XB_SPIN(cond, bar) do { unsigned _sp = 0; while (cond) { __builtin_amdgcn_s_sleep(1); \
    if ((++_sp & 255u) == 0u) { if (xb_ld(&(bar)[XB_TMO])) break; if (_sp > XB_SPIN_CAP) { atomicAdd(&(bar)[XB_TMO], 1u); break; } } } } while (0)

struct XcdBarrier {
    unsigned* bar; unsigned x;
    volatile LAS unsigned* st;
};

__device__ __forceinline__ XcdBarrier xcd_barrier_post(unsigned* bar, volatile LAS unsigned* st, int tid) {
    XcdBarrier b; b.bar = bar; b.x = xb_xcc_id(); b.st = st;
    if (tid == 0) (void)xb_add(&bar[XB_XCNT(b.x)], 1u);
    return b;
}
__device__ __forceinline__ void xcd_barrier_complete(unsigned* bar, unsigned x, unsigned& nloc, unsigned& nx) {
    const unsigned G = gridDim.x * gridDim.y * gridDim.z;
    unsigned sum, cnt, mine, sp = 0u;
    for (;;) {
        sum = 0u; cnt = 0u; mine = 0u;
#pragma unroll
        for (unsigned j = 0; j < 16; ++j) { const unsigned c = xb_ld(&bar[XB_XCNT(j)]); sum += c; cnt += (c > 0u) ? 1u : 0u; mine = (j == x) ? c : mine; }
        if (sum == G) break;
        __builtin_amdgcn_s_sleep(1);
        if ((++sp & 255u) == 0u) { if (xb_ld(&bar[XB_TMO])) break; if (sp > XB_SPIN_CAP) { atomicAdd(&bar[XB_TMO], 1u); break; } }
    }
    nloc = mine > 0u ? mine : 1u; nx = cnt > 0u ? cnt : 1u;
}

__device__ __forceinline__ void xcd_barrier(const XcdBarrier& b, int tid) {
    asm volatile("s_waitcnt vmcnt(0)" ::: "memory");
    __syncthreads();
    if (tid == 0) {
        unsigned* bar = b.bar;
        __builtin_amdgcn_s_waitcnt(0);
        unsigned nloc = b.st[0], nx = b.st[1];
        if (nloc == 0u) { xcd_barrier_complete(bar, b.x, nloc, nx); b.st[0] = nloc; b.st[1] = nx; }
        const unsigned old = xb_add(&bar[XB_XSUB(b.x)], 1u);
        const unsigned gen = old / nloc;
        if (old + 1u == (gen + 1u) * nloc) {
            __builtin_amdgcn_fence(__ATOMIC_RELEASE, "agent");
            asm volatile("s_waitcnt vmcnt(0)" ::: "memory");
            const unsigned og = xb_add(&bar[XB_TOP], 1u);
            const unsigned tg = og / nx;
            if (og + 1u == (tg + 1u) * nx) xb_add(&bar[XB_TOPGEN], 1u);
            else XB_SPIN(xb_ld(&bar[XB_TOPGEN]) == tg, bar);
            __builtin_amdgcn_fence(__ATOMIC_ACQUIRE, "agent");
            xb_add(&bar[XB_XGEN(b.x)], 1u);
            asm volatile("s_waitcnt vmcnt(0)" ::: "memory");
        } else {
            XB_SPIN(xb_ld(&bar[XB_XGEN(b.x)]) == gen, bar);
            __builtin_amdgcn_fence(__ATOMIC_ACQUIRE, "agent");
            asm volatile("s_waitcnt vmcnt(0)" ::: "memory");
        }
    }
    __syncthreads();
}

DI f32x16 mfma32(bf16x8 a, bf16x8 b, f32x16 c) { return __builtin_amdgcn_mfma_f32_32x32x16_bf16(a, b, c, 0, 0, 0); }
DI int pi32(int r) { return (r & 19) | ((r & 4) << 1) | ((r & 8) >> 1); }
DI int keyidx(int i, int hi) { return 16 * (i >> 3) + 8 * hi + (i & 7); }
DI bf16x8 pack8(const f32x16& x, int s) { u32x4 p; p.x = pk2(x[8 * s], x[8 * s + 1]); p.y = pk2(x[8 * s + 2], x[8 * s + 3]); p.z = pk2(x[8 * s + 4], x[8 * s + 5]); p.w = pk2(x[8 * s + 6], x[8 * s + 7]); return __builtin_bit_cast(bf16x8, p); }
DI f32x16 splat16(float v) { f32x16 z;
#pragma unroll
    for (int i = 0; i < 16; ++i) z[i] = v; return z; }
DI f32x16 zero16() { float z_ = 0.f; asm volatile("" : "+v"(z_)); return splat16(z_); }
template <int BR>
DI void q_prep(bf16x8 (&qf)[4], const bf16_t* qp  , const float* gq  , int hi, int s, const f32x2* rope1, const f32x2* ropea) {
    { int z_ = 0; asm volatile("" : "+v"(z_)); gq += z_; rope1 += z_; ropea += z_; }
    float v[4][8]; float ss = 0.f;
#pragma unroll
    for (int c = 0; c < 4; ++c) { const u32x4 w = *(const u32x4*)(qp + 16 * c);
        v[c][0] = bflo(w.x); v[c][1] = bfhi(w.x); v[c][2] = bflo(w.y); v[c][3] = bfhi(w.y); v[c][4] = bflo(w.z); v[c][5] = bfhi(w.z); v[c][6] = bflo(w.w); v[c][7] = bfhi(w.w);
#pragma unroll
        for (int j = 0; j < 8; ++j) ss += v[c][j] * v[c][j]; }
    ss += shx(ss, 32);
    const float rstd = 1.f / sqrtf(ss * (1.f / 64.f) + EPS);
#pragma unroll
    for (int c = 0; c < 4; ++c) { const f32x4 g0 = *(const f32x4*)(gq + 16 * c + 8 * hi), g1 = *(const f32x4*)(gq + 16 * c + 8 * hi + 4);
#pragma unroll
        for (int j = 0; j < 4; ++j) { v[c][j] *= rstd * g0[j]; v[c][4 + j] *= rstd * g1[j]; } }
    float o[4][8];
    if (BR == 0) {
#pragma unroll
        for (int c = 0; c < 4; ++c)
#pragma unroll
            for (int j = 0; j < 8; ++j) o[c][j] = v[c][j];
    } else {
#pragma unroll
        for (int pp = 0; pp < 2; ++pp) {
            const int cl = (BR == 2) ? pp : 2 * pp, ch = (BR == 2) ? pp + 2 : 2 * pp + 1;
            const f32x2* tp = (BR == 2) ? rope1 + s * 32 + 16 * pp + 8 * hi : ropea + ((pp == 0) ? (s >> 6) : (s & 63)) * 16 + 8 * hi;
#pragma unroll
            for (int j2 = 0; j2 < 4; ++j2) { const f32x4 t = *(const f32x4*)(tp + 2 * j2);
                o[cl][2 * j2] = v[cl][2 * j2] * t[0] - v[ch][2 * j2] * t[1]; o[ch][2 * j2] = v[ch][2 * j2] * t[0] + v[cl][2 * j2] * t[1];
                o[cl][2 * j2 + 1] = v[cl][2 * j2 + 1] * t[2] - v[ch][2 * j2 + 1] * t[3]; o[ch][2 * j2 + 1] = v[ch][2 * j2 + 1] * t[2] + v[cl][2 * j2 + 1] * t[3]; } }
    }
#pragma unroll
    for (int c = 0; c < 4; ++c) { u32x4 w; w.x = pk2(o[c][0] * QSCALE, o[c][1] * QSCALE); w.y = pk2(o[c][2] * QSCALE, o[c][3] * QSCALE); w.z = pk2(o[c][4] * QSCALE, o[c][5] * QSCALE); w.w = pk2(o[c][6] * QSCALE, o[c][7] * QSCALE);
        qf[c] = __builtin_bit_cast(bf16x8, w); }
}
using pg8::v8i_t;
struct QTab { const float* qkg; const f32x2* rope1; const f32x2* ropea; bf16_t* obase; int of8; };
constexpr float SM_THR = 8.f;
DI float max16x2(const f32x16& a, const f32x16& b) {
    float m0 = fmaxf(fmaxf(a[0], a[1]), a[2]), m1 = fmaxf(fmaxf(b[0], b[1]), b[2]);
#pragma unroll
    for (int i = 3; i < 15; i += 2) { m0 = fmaxf(fmaxf(m0, a[i]), a[i + 1]); m1 = fmaxf(fmaxf(m1, b[i]), b[i + 1]); }
    return fmaxf(fmaxf(m0, m1), fmaxf(a[15], b[15]));
}
#define SOFTMAX_BODY(UPD_NEGM) \
    const float mx = max16x2(s0, s1); \
    if (__any(mx > SM_THR)) {                                          \
        float delta = fmaxf(fmaxf(mx, shx(mx, 32)), 0.f); asm volatile("" : "+v"(delta));     \
        const float alpha = __builtin_amdgcn_exp2f(-delta); \
        mref += delta; l *= alpha; UPD_NEGM \
        _Pragma("unroll") for (int i = 0; i < 16; ++i) { o0[i] *= alpha; o1[i] *= alpha; s0[i] -= delta; s1[i] -= delta; } \
    } \
    float sum0 = 0.f, sum1 = 0.f; \
    _Pragma("unroll") for (int i = 0; i < 16; ++i) { s0[i] = __builtin_amdgcn_exp2f(s0[i]); s1[i] = __builtin_amdgcn_exp2f(s1[i]); sum0 += s0[i]; sum1 += s1[i]; } \
    l += sum0 + sum1;
DI void softmax_lazy(f32x16& s0, f32x16& s1, float& mref, float& l, f32x16& o0, f32x16& o1) { SOFTMAX_BODY() }
DI void softmax_lazy(f32x16& s0, f32x16& s1, float& mref, f32x16& negm, float& l, f32x16& o0, f32x16& o1) { SOFTMAX_BODY(negm = splat16(-mref);) }
DI void store_o(const QTab& qt, bf16_t* op  , const f32x16& o0, const f32x16& o1, float l) {
    const float inv = 1.f / (l + shx(l, 32));
    if (qt.of8) { unsigned char* bp = (unsigned char*)qt.obase + (op - qt.obase);
#pragma unroll
        for (int g = 0; g < 4; ++g) { int a = 0, b = 0;
            a = __builtin_amdgcn_cvt_pk_fp8_f32(o0[4 * g] * inv, o0[4 * g + 1] * inv, a, false); a = __builtin_amdgcn_cvt_pk_fp8_f32(o0[4 * g + 2] * inv, o0[4 * g + 3] * inv, a, true);
            b = __builtin_amdgcn_cvt_pk_fp8_f32(o1[4 * g] * inv, o1[4 * g + 1] * inv, b, false); b = __builtin_amdgcn_cvt_pk_fp8_f32(o1[4 * g + 2] * inv, o1[4 * g + 3] * inv, b, true);
            *(unsigned*)(bp + 8 * g) = (unsigned)a; *(unsigned*)(bp + 32 + 8 * g) = (unsigned)b; }
        return; }
#pragma unroll
    for (int g = 0; g < 4; ++g) { u32x2 a, b;
        a.x = pk2(o0[4 * g] * inv, o0[4 * g + 1] * inv); a.y = pk2(o0[4 * g + 2] * inv, o0[4 * g + 3] * inv);
        b.x = pk2(o1[4 * g] * inv, o1[4 * g + 1] * inv); b.y = pk2(o1[4 * g + 2] * inv, o1[4 * g + 3] * inv);
        *(u32x2*)(op + 8 * g) = a; *(u32x2*)(op + 32 + 8 * g) = b; }
}

constexpr int GQ_KB = 128 * 144, GQ_VB = 64 * 272, GQ_BUF = GQ_KB + GQ_VB;
template <bool FAST>
DI void gqa_unit(LAS unsigned char* lds, const QTab& qt, const bf16_t* Q, const bf16_t* Kb, const bf16_t* Vt, bf16_t* OB, int b, int hq, int qb, int tid) {
    const int wave = tid >> 6, lane = tid & 63, r = lane & 31, hi = lane >> 5, kvh = hq / 3;
    const int qtok = b * SEQ + qb * 256 + wave * 32 + r;
    bf16x8 qf[4];
    q_prep<1>(qf, Q + (size_t)qtok * 1024 + (4 + hq) * 64 + 8 * hi, qt.qkg + 2 * 64, hi, qtok & (SEQ - 1), qt.rope1, qt.ropea);
    const int kr0 = tid >> 3, kc0 = tid & 7, vr0 = tid >> 4, vc0 = tid & 15;
    const bf16_t* kg = Kb + (size_t)(b * SEQ + kr0) * 768 + (4 + kvh) * 64 + kc0 * 8;
    const bf16_t* vg = Vt + ((size_t)(b * 12 + 4 + kvh) * 64 + vr0) * SEQ + vc0 * 8;
    const int ksoff = kr0 * 144 + kc0 * 16, vsoff = GQ_KB + vr0 * 272 + vc0 * 16;
    u32x4 ka = *(const u32x4*)kg, kb2 = *(const u32x4*)(kg + (size_t)64 * 768), va = *(const u32x4*)vg, vb2 = *(const u32x4*)(vg + (size_t)32 * SEQ);
    *(LAS u32x4*)(lds + ksoff) = ka; *(LAS u32x4*)(lds + ksoff + 64 * 144) = kb2; *(LAS u32x4*)(lds + vsoff) = va; *(LAS u32x4*)(lds + vsoff + 32 * 272) = vb2;
    __syncthreads();
    float mref = 0.f, l = 0.f; f32x16 o0 = zero16(), o1 = zero16(), negm = zero16(), lacc = zero16();
    const u32x4 ones_u = {0x3F803F80u, 0x3F803F80u, 0x3F803F80u, 0x3F803F80u}; const bf16x8 ones = __builtin_bit_cast(bf16x8, ones_u);
    const int koff = pi32(r) * 144 + hi * 16, voff = GQ_KB + r * 272 + hi * 16;
#define GQ_LDK(dst, base) do { _Pragma("unroll") for (int c_ = 0; c_ < 4; ++c_) { dst[c_] = *(const LAS bf16x8*)((base) + c_ * 32); dst[4 + c_] = *(const LAS bf16x8*)((base) + 32 * 144 + c_ * 32); } } while (0)
#define GQ_LDV(dst, base) do { _Pragma("unroll") for (int c_ = 0; c_ < 4; ++c_) { dst[c_] = *(const LAS bf16x8*)((base) + c_ * 32); dst[4 + c_] = *(const LAS bf16x8*)((base) + 32 * 272 + c_ * 32); } } while (0)
    for (int it = 0; it < 32; ++it) {
        const int cur = it & 1;
        if (it + 1 < 32) { const bf16_t* kn = kg + (size_t)(it + 1) * 128 * 768; const bf16_t* vn = vg + (it + 1) * 128;
            ka = *(const u32x4*)kn; kb2 = *(const u32x4*)(kn + (size_t)64 * 768); va = *(const u32x4*)vn; vb2 = *(const u32x4*)(vn + (size_t)32 * SEQ); }
        const LAS unsigned char* Bc = lds + cur * GQ_BUF;
        bf16x8 kf[8], vf[8], kf2[8];
        GQ_LDK(kf, Bc + koff);
        __builtin_amdgcn_sched_barrier(0);
        f32x16 s0 = FAST ? splat16(0.f) : negm, s1 = FAST ? splat16(0.f) : negm;
#pragma unroll
        for (int c = 0; c < 4; ++c) { s0 = mfma32(kf[c], qf[c], s0); s1 = mfma32(kf[4 + c], qf[c], s1); }
        GQ_LDV(vf, Bc + voff); if constexpr (FAST) GQ_LDK(kf2, Bc + 64 * 144 + koff);
        __builtin_amdgcn_sched_barrier(0);
        if constexpr (FAST) {
#pragma unroll
            for (int i = 0; i < 16; ++i) { s0[i] = __builtin_amdgcn_exp2f(s0[i]); s1[i] = __builtin_amdgcn_exp2f(s1[i]); } }
        else softmax_lazy(s0, s1, mref, negm, l, o0, o1);
#pragma unroll
        for (int s4 = 0; s4 < 4; ++s4) { const bf16x8 pf = pack8(s4 < 2 ? s0 : s1, s4 & 1); o0 = mfma32(vf[s4], pf, o0); o1 = mfma32(vf[4 + s4], pf, o1); if constexpr (FAST) lacc = mfma32(ones, pf, lacc); }
        if constexpr (!FAST) { __builtin_amdgcn_sched_barrier(0); GQ_LDK(kf2, Bc + 64 * 144 + koff); }
        s0 = FAST ? splat16(0.f) : negm; s1 = FAST ? splat16(0.f) : negm;
#pragma unroll
        for (int c = 0; c < 4; ++c) { s0 = mfma32(kf2[c], qf[c], s0); s1 = mfma32(kf2[4 + c], qf[c], s1); }
        GQ_LDV(vf, Bc + voff + 128);
        __builtin_amdgcn_sched_barrier(0);
        if constexpr (FAST) {
#pragma unroll
            for (int i = 0; i < 16; ++i) { s0[i] = __builtin_amdgcn_exp2f(s0[i]); s1[i] = __builtin_amdgcn_exp2f(s1[i]); } }
        else softmax_lazy(s0, s1, mref, negm, l, o0, o1);
#pragma unroll
        for (int s4 = 0; s4 < 4; ++s4) { const bf16x8 pf = pack8(s4 < 2 ? s0 : s1, s4 & 1); o0 = mfma32(vf[s4], pf, o0); o1 = mfma32(vf[4 + s4], pf, o1); if constexpr (FAST) lacc = mfma32(ones, pf, lacc); }
        if (it + 1 < 32) { LAS unsigned char* Bn = lds + (cur ^ 1) * GQ_BUF;
            *(LAS u32x4*)(Bn + ksoff) = ka; *(LAS u32x4*)(Bn + ksoff + 64 * 144) = kb2; *(LAS u32x4*)(Bn + vsoff) = va; *(LAS u32x4*)(Bn + vsoff + 32 * 272) = vb2; }
        __syncthreads();
    }
#undef GQ_LDK
#undef GQ_LDV
    if constexpr (FAST) store_o(qt, OB + (size_t)qtok * 768 + hq * 64 + 4 * hi, o0, o1, 0.5f * lacc[0]);
    else store_o(qt, OB + (size_t)qtok * 768 + hq * 64 + 4 * hi, o0, o1, l);
}

template <int NT>
DI void gqa3_wave(LAS unsigned char* lds, const QTab& qt, const bf16_t* Q, const bf16_t* Kb, const bf16_t* Vt  , bf16_t* OB, int b, int kvh, int qblk, int wave, int lane, float negC) {
    const int r = lane & 31, hi = lane >> 5;
    const int tq0 = (NT == 2) ? 2 * wave : 8 + (wave - 4), hl = tq0 >> 2, hq = 3 * kvh + hl;
    int qtok[NT]; v8i_t q8[NT]; f32x16 o0[NT], o1[NT]; float l[NT];
#pragma unroll
    for (int t = 0; t < NT; ++t) { qtok[t] = b * SEQ + qblk * 128 + ((tq0 + t) & 3) * 32 + r; bf16x8 qf[4];
        q_prep<1>(qf, Q + (size_t)qtok[t] * 1024 + (4 + hq) * 64 + 8 * hi, qt.qkg + 2 * 64, hi, qtok[t] & (SEQ - 1), qt.rope1, qt.ropea);
#pragma unroll
        for (int c = 0; c < 4; ++c) { const u32x4 w = __builtin_bit_cast(u32x4, qf[c]); int lo = 0, hi8 = 0;
            lo = __builtin_amdgcn_cvt_pk_fp8_f32(bflo(w.x) * 16.f, bfhi(w.x) * 16.f, lo, false); lo = __builtin_amdgcn_cvt_pk_fp8_f32(bflo(w.y) * 16.f, bfhi(w.y) * 16.f, lo, true);
            hi8 = __builtin_amdgcn_cvt_pk_fp8_f32(bflo(w.z) * 16.f, bfhi(w.z) * 16.f, hi8, false); hi8 = __builtin_amdgcn_cvt_pk_fp8_f32(bflo(w.w) * 16.f, bfhi(w.w) * 16.f, hi8, true);
            q8[t][2 * c] = lo; q8[t][2 * c + 1] = hi8; }
        __builtin_amdgcn_sched_barrier(0); }
#pragma unroll
    for (int t = 0; t < NT; ++t) { o0[t] = zero16(); o1[t] = zero16(); l[t] = 0.f; }
    const int st = (wave & 3) * 64 + lane;
    const unsigned char* kg = (const unsigned char*)Kb + (size_t)(b * SEQ + (st >> 2)) * 128 + kvh * 64 + (st & 3) * 16;
    const unsigned char* vg = (const unsigned char*)Vt + ((size_t)(b * 2 + kvh) * 64 + (st >> 3)) * SEQ + (st & 7) * 16;
    const int ksoff = (st >> 2) * 80 + (st & 3) * 16, vsoff = GQ_KB + (st >> 3) * 144 + (st & 7) * 16;
    u32x4 kq[2], vq[2];
#define G3_GLOAD(T_) do { _Pragma("unroll") for (int i_ = 0; i_ < 2; ++i_) { kq[i_] = *(const u32x4*)(kg + (size_t)((T_) * 128 + 64 * i_) * 128); vq[i_] = *(const u32x4*)(vg + (size_t)32 * i_ * SEQ + (T_) * 128); } } while (0)
#define G3_LSTORE(B_) do { LAS unsigned char* Bn_ = lds + (B_) * GQ_BUF; _Pragma("unroll") for (int i_ = 0; i_ < 2; ++i_) { *(LAS u32x4*)(Bn_ + ksoff + 64 * i_ * 80) = kq[i_]; *(LAS u32x4*)(Bn_ + vsoff + 32 * i_ * 144) = vq[i_]; } } while (0)
    if (NT == 1) { G3_GLOAD(0); G3_LSTORE(0); }
    __syncthreads();
    const int koff = pi32(r) * 80 + hi * 32, voff = GQ_KB + r * 144 + hi * 32;
    f32x16 lacc[NT]; v8i_t ones8;
#pragma unroll
    for (int t = 0; t < NT; ++t) lacc[t] = zero16();
    { int o_ = 0x38383838; asm volatile("" : "+v"(o_)); ones8 = (v8i_t){o_, o_, o_, o_, o_, o_, o_, o_}; }
    f32x16 negc16 = splat16(negC); asm volatile("" : "+v"(negc16));
#pragma unroll 2
    for (int it = 0; it < 32; ++it) {
        const int cur = it & 1;
        if (NT == 1 && it + 1 < 32) G3_GLOAD(it + 1);
        const LAS unsigned char* Bc = lds + cur * GQ_BUF;
#pragma unroll
        for (int hf = 0; hf < 2; ++hf) {
            v8i_t kf[2], vf8[2], p8[NT];
#pragma unroll
            for (int h2 = 0; h2 < 2; ++h2) { const u32x4 a_ = *(const LAS u32x4*)(Bc + (hf * 64 + h2 * 32) * 80 + koff), b_ = *(const LAS u32x4*)(Bc + (hf * 64 + h2 * 32) * 80 + koff + 16);
                kf[h2] = (v8i_t){(int)a_.x, (int)a_.y, (int)a_.z, (int)a_.w, (int)b_.x, (int)b_.y, (int)b_.z, (int)b_.w}; }
#define G3_MF8(k_, t_) __builtin_amdgcn_mfma_scale_f32_32x32x64_f8f6f4(kf[k_], q8[t_], negc16, 0, 0, 0, 0x7F7F7F7F, 0, 0x7B7B7B7B)
#define G3_PV8(acc_, vk_, t_) acc_ = __builtin_amdgcn_mfma_scale_f32_32x32x64_f8f6f4(vf8[vk_], p8[t_], acc_, 0, 1, 0, 0x7F7F7F7F, 0, 0x7F7F7F7F)
#define G3_LS8(t_) lacc[t_] = __builtin_amdgcn_mfma_scale_f32_32x32x64_f8f6f4(ones8, p8[t_], lacc[t_], 0, 1, 0, 0x7F7F7F7F, 0, 0x7F7F7F7F)
#define G3_LDV8(vk_) do { const u32x4 a_ = *(const LAS u32x4*)(Bc + voff + (vk_) * 32 * 144 + hf * 64), b_ = *(const LAS u32x4*)(Bc + voff + (vk_) * 32 * 144 + hf * 64 + 16); \
                vf8[vk_] = (v8i_t){(int)a_.x, (int)a_.y, (int)a_.z, (int)a_.w, (int)b_.x, (int)b_.y, (int)b_.z, (int)b_.w}; } while (0)
#define G3_HSM(t_, s_, j_) do { _Pragma("unroll") for (int i = 0; i < 16; ++i) s_[i] = __builtin_amdgcn_exp2f(s_[i]); \
                _Pragma("unroll") for (int g = 0; g < 4; ++g) { int w_ = 0; w_ = __builtin_amdgcn_cvt_pk_bf8_f32(s_[4 * g], s_[4 * g + 1], w_, false); w_ = __builtin_amdgcn_cvt_pk_bf8_f32(s_[4 * g + 2], s_[4 * g + 3], w_, true); \
                    asm volatile("" : "+v"(w_)); p8[t_][4 * (j_) + g] = w_; } } while (0)
#define G3_FENCE() __builtin_amdgcn_sched_barrier(0)
#define G3_PIN(x_) asm volatile("" : "+v"(x_))
            if constexpr (NT == 2) {
                f32x16 sa0, sa1, sb0, sb1;
                sa0 = G3_MF8(0, 0); sa1 = G3_MF8(1, 0);
                G3_PIN(sa0); G3_PIN(sa1); G3_FENCE();
                G3_HSM(0, sa0, 0); sb0 = G3_MF8(0, 1);
                G3_PIN(sb0); G3_FENCE();
                G3_HSM(0, sa1, 1); sb1 = G3_MF8(1, 1);
                G3_PIN(sb1); G3_FENCE();
                G3_LDV8(0);
                G3_HSM(1, sb0, 0); G3_PV8(o0[0], 0, 0); G3_LS8(0);
                G3_PIN(o0[0]); G3_PIN(lacc[0]); G3_FENCE();
                G3_LDV8(1);
                G3_HSM(1, sb1, 1); G3_PV8(o1[0], 1, 0);
                G3_PIN(o1[0]); G3_FENCE();
                G3_PV8(o0[1], 0, 1); G3_PV8(o1[1], 1, 1); G3_LS8(1);
                G3_PIN(o0[1]); G3_PIN(o1[1]); G3_PIN(lacc[1]); G3_FENCE();
            } else {
                f32x16 sa0, sa1;
                sa0 = G3_MF8(0, 0); sa1 = G3_MF8(1, 0);
                G3_PIN(sa0); G3_PIN(sa1); G3_FENCE();
                G3_LDV8(0); G3_LDV8(1);
                G3_HSM(0, sa0, 0); G3_HSM(0, sa1, 1);
                G3_PV8(o0[0], 0, 0); G3_PV8(o1[0], 1, 0); G3_LS8(0);
                G3_PIN(o0[0]); G3_PIN(o1[0]); G3_PIN(lacc[0]); G3_FENCE();
            }
#undef G3_PIN
#undef G3_FENCE
#undef G3_HSM
#undef G3_LDV8
#undef G3_LS8
#undef G3_PV8
#undef G3_MF8
        }
        if (NT == 1 && it + 1 < 32) G3_LSTORE(cur ^ 1);
        __syncthreads();
    }
#undef G3_GLOAD
#undef G3_LSTORE
    { const int ln = lane_v(), r2 = ln & 31, hi2 = ln >> 5;
#pragma unroll
      for (int t = 0; t < NT; ++t) store_o(qt, OB + (size_t)(b * SEQ + qblk * 128 + ((tq0 + t) & 3) * 32 + r2) * 768 + hq * 64 + 4 * hi2, o0[t], o1[t], 0.5f * lacc[t][0]); }
}

struct WTile { u32x4 k[4], v[4]; };
DI void wt_store(LAS unsigned char* wl, const WTile& T, int lane) {
#pragma unroll
    for (int i = 0; i < 4; ++i) { const int kr = 8 * i + (lane >> 3), vr = 16 * i + (lane >> 2);
        *(LAS u32x4*)(wl + kr * 128 + (((lane & 7) ^ ((kr >> 1) & 7)) << 4)) = T.k[i];
        *(LAS u32x4*)(wl + 4096 + vr * 64 + (((lane & 3) ^ ((vr >> 2) & 3)) << 4)) = T.v[i]; }
}
DI void wt_ldk(bf16x8 (&kf)[4], const LAS unsigned char* wl, int pr, int hi) {
#pragma unroll
    for (int c = 0; c < 4; ++c) kf[c] = *(const LAS bf16x8*)(wl + pr * 128 + (((2 * c + hi) ^ ((pr >> 1) & 7)) << 4));
}
DI void wt_ldv(bf16x8 (&vf)[4], const LAS unsigned char* wl, int r, int hi) {
#pragma unroll
    for (int dt = 0; dt < 2; ++dt)
#pragma unroll
        for (int sk = 0; sk < 2; ++sk) { const int row = 32 * dt + r; vf[2 * dt + sk] = *(const LAS bf16x8*)(wl + 4096 + row * 64 + (((2 * sk + hi) ^ ((row >> 2) & 3)) << 4)); }
}
DI void softmax_lazy1(f32x16& s, float& mref, float& l, f32x16& o0, f32x16& o1) {
    float mx = fmaxf(fmaxf(s[0], s[1]), s[2]);
#pragma unroll
    for (int i = 3; i < 15; i += 2) mx = fmaxf(fmaxf(mx, s[i]), s[i + 1]);
    mx = fmaxf(mx, s[15]);
    if (__any(mx > SM_THR)) {
        float delta = fmaxf(fmaxf(mx, shx(mx, 32)), 0.f); asm volatile("" : "+v"(delta));
        const float alpha = __builtin_amdgcn_exp2f(-delta);
        mref += delta; l *= alpha;
#pragma unroll
        for (int i = 0; i < 16; ++i) { o0[i] *= alpha; o1[i] *= alpha; s[i] -= delta; }
    }
    float sum = 0.f;
#pragma unroll
    for (int i = 0; i < 16; ++i) { s[i] = __builtin_amdgcn_exp2f(s[i]); sum += s[i]; }
    l += sum;
}
DI void pv_step(f32x16& o0, f32x16& o1, const f32x16& p, const bf16x8 (&vf)[4]) {
    const bf16x8 p0 = pack8(p, 0), p1 = pack8(p, 1);
    o0 = mfma32(vf[0], p0, o0); o1 = mfma32(vf[2], p0, o1); o0 = mfma32(vf[1], p1, o0); o1 = mfma32(vf[3], p1, o1);
}

DI void na_unit(LAS unsigned char* wl, const QTab& qt, const LAS float* biasl, const bf16_t* Q, const bf16_t* Kb, const bf16_t* Vt, bf16_t* OA, int b, int rp, int h, int a, int lane) {
    const int r = lane & 31, hi = lane >> 5, pr = pi32(r);
    const int grow = 2 * rp + (r >> 4), qcol = 16 * a + (r & 15), qtok = b * SEQ + grow * 64 + qcol;
    bf16x8 qf[4];
    q_prep<0>(qf, Q + (size_t)qtok * 1024 + h * 64 + 8 * hi, qt.qkg, hi, 0, qt.rope1, qt.ropea);
    const int rs = min(max(grow - 4, 0), 56), cs = min(max(qcol - 8, 0), 48);
    const int krs = min(max(2 * rp - 4, 0), 56), nk = min(max(2 * rp - 3, 0), 56) + 8 - krs, kc0 = min(max(16 * a - 8, 0), 32);
    const bf16_t* kp = Kb + (size_t)(b * SEQ + krs * 64 + kc0 + (lane >> 3)) * 768 + h * 64 + (lane & 7) * 8;
    const bf16_t* vp = Vt + ((size_t)(b * 12 + h) * 64 + (lane >> 2)) * SEQ + krs * 64 + kc0 + (lane & 3) * 8;
    float mref = 0.f, l = 0.f; f32x16 o0 = zero16(), o1 = zero16();
    WTile T;
#pragma unroll
    for (int i = 0; i < 4; ++i) { T.k[i] = *(const u32x4*)(kp + (size_t)8 * i * 768); T.v[i] = *(const u32x4*)(vp + (size_t)16 * i * SEQ); }
    wt_store(wl, T, lane);
#pragma unroll 1
    for (int st = 0; st < nk; ++st) {
        if (st + 1 < nk) { const int n = st + 1;
#pragma unroll
            for (int i = 0; i < 4; ++i) { T.k[i] = *(const u32x4*)(kp + (size_t)(64 * n + 8 * i) * 768); T.v[i] = *(const u32x4*)(vp + (size_t)16 * i * SEQ + 64 * n); } }
        bf16x8 kf[4], vf[4];
        wt_ldk(kf, wl, pr, hi);
        f32x16 sc = splat16(0.f);
#pragma unroll
        for (int c = 0; c < 4; ++c) sc = mfma32(kf[c], qf[c], sc);
        wt_ldv(vf, wl, r, hi);
        const int kr = krs + st; const bool rowok = (kr >= rs) && (kr < rs + 8);
        const LAS float* brow = biasl + (h * 15 + min(max(kr - grow + 7, 0), 14)) * 31 + 15 - qcol;
#pragma unroll
        for (int i = 0; i < 16; ++i) { const int c0 = kc0 + keyidx(i, hi);
            const bool v0 = rowok && (c0 >= cs) && (c0 < cs + 16);
            const float b0 = brow[v0 ? c0 : qcol];
            sc[i] = v0 ? sc[i] + (b0 - mref) : -1e30f; }
        softmax_lazy1(sc, mref, l, o0, o1);
        pv_step(o0, o1, sc, vf);
        if (st + 1 < nk) wt_store(wl, T, lane);
    }
    store_o(qt, OA + (size_t)qtok * 768 + h * 64 + 4 * hi, o0, o1, l);
}

#define DIL_ISSUE(G_, KS_, T_) do { \
    constexpr int sh_ = 2 * (G_), Sd_ = SEQ >> sh_, dd_ = 1 << sh_; const int hk_ = 6 + 2 * (G_) + hs, rd_ = r16 & (dd_ - 1); \
    const bf16_t* kb_ = Kb + (size_t)(b * SEQ + rd_) * 768 + hk_ * 64 + (lane & 7) * 8; \
    const bf16_t* vb_ = Vt + ((size_t)(b * 12 + hk_) * 64 + (lane >> 2)) * SEQ + rd_ * Sd_ + min(max((KS_) + 8 * (lane & 3), 0), Sd_ - 8); \
    _Pragma("unroll") for (int i_ = 0; i_ < 4; ++i_) { const int ik_ = min(max((KS_) + 8 * i_ + (lane >> 3), 0), Sd_ - 1); \
        T_.k[i_] = *(const u32x4*)(kb_ + (size_t)(ik_ << sh_) * 768); T_.v[i_] = *(const u32x4*)(vb_ + (size_t)16 * i_ * SEQ); } } while (0)

template <int G>
DI void dil_group(LAS unsigned char* wl, const QTab& qt, WTile& T, const bf16_t* Q, const bf16_t* Kb, const bf16_t* Vt, int b, int hs, int r16, int ib, int qtok, int lane,
                  float& mref, float& l, f32x16& o0, f32x16& o1) {
    constexpr int sh = 2 * G, Sd = SEQ >> sh, step = 16 >> sh;
    const int r = lane & 31, hi = lane >> 5, pr = pi32(r);
    bf16x8 qf[4];
    q_prep<2>(qf, Q + (size_t)qtok * 1024 + (10 + 2 * G + hs) * 64 + 8 * hi, qt.qkg + 4 * 64, hi, qtok & (SEQ - 1), qt.rope1, qt.ropea);
    const int qd = r16 >> sh, iq = qd + step * (32 * ib + r);
    const int lo = qd + step * 32 * ib - 64, hiend = qd + step * (32 * ib + 31) + 64;
#pragma unroll 1
    for (int ks = (lo >> 5) << 5; ks <= hiend; ks += 32) {
        const bool more = ks + 32 <= hiend;
        if (more) DIL_ISSUE(G, ks + 32, T);
        else if (G < 2) { constexpr int G1 = G < 2 ? G + 1 : 2, sh1 = 2 * G1, step1 = 16 >> sh1; const int lo1 = (r16 >> sh1) + step1 * 32 * ib - 64; DIL_ISSUE(G1, (lo1 >> 5) << 5, T); }
        bf16x8 kf[4], vf[4];
        wt_ldk(kf, wl, pr, hi);
        f32x16 sc = splat16(0.f);
#pragma unroll
        for (int c = 0; c < 4; ++c) sc = mfma32(kf[c], qf[c], sc);
        wt_ldv(vf, wl, r, hi);
#pragma unroll
        for (int i = 0; i < 16; ++i) { const int a0 = ks + keyidx(i, hi);
            const bool v0 = (a0 >= 0) && (a0 < Sd) && (abs(a0 - iq) <= 64);
            sc[i] = v0 ? sc[i] - mref : -1e30f; }
        softmax_lazy1(sc, mref, l, o0, o1);
        pv_step(o0, o1, sc, vf);
        if (more || G < 2) wt_store(wl, T, lane);
    }
}
DI void dil_unit(LAS unsigned char* wl, const QTab& qt, const bf16_t* Q, const bf16_t* Kb, const bf16_t* Vt, bf16_t* OC, int b, int hs, int r16, int ib, int lane) {
    const int r = lane & 31, hi = lane >> 5;
    const int qtok = b * SEQ + r16 + 16 * (32 * ib + r);
    float mref = 0.f, l = 0.f; f32x16 o0 = zero16(), o1 = zero16();
    WTile T;
    { const int lo0 = r16 + 16 * 32 * ib - 64; DIL_ISSUE(0, (lo0 >> 5) << 5, T); wt_store(wl, T, lane); }
    dil_group<0>(wl, qt, T, Q, Kb, Vt, b, hs, r16, ib, qtok, lane, mref, l, o0, o1);
    dil_group<1>(wl, qt, T, Q, Kb, Vt, b, hs, r16, ib, qtok, lane, mref, l, o0, o1);
    dil_group<2>(wl, qt, T, Q, Kb, Vt, b, hs, r16, ib, qtok, lane, mref, l, o0, o1);
    store_o(qt, OC + (size_t)qtok * 768 + hs * 64 + 4 * hi, o0, o1, l);
}

DI void phase_attn(const Ptrs& P, int layer, LAS unsigned char* lds, int tid) {
    const int wave = __builtin_amdgcn_readfirstlane(tid >> 6), lane = tid & 63, c = blockIdx.x;
    const bf16_t* Q = (const bf16_t*)(P.ws + WS_Q); const bf16_t* Kb = (const bf16_t*)(P.ws + WS_K); const bf16_t* Vt = (const bf16_t*)(P.ws + WS_VT);
    bf16_t* OA = (bf16_t*)(P.ws + WS_OALL); bf16_t* OB = OA + 256; bf16_t* OC = OA + 640;
    const QTab qt{P.in[3] + (size_t)layer * 384, (const f32x2*)(P.ws + WS_ROPE1), (const f32x2*)(P.ws + WS_ROPEA), OA, (int)((F8_GATE >> layer) & 1)};
    bool gqa_fast; float gqa_negc;
    { float gq = fabsf(qt.qkg[2 * 64 + lane]), gk = fabsf(qt.qkg[3 * 64 + lane]);
#pragma unroll
      for (int o = 1; o < 64; o <<= 1) { gq = fmaxf(gq, shx(gq, o)); gk = fmaxf(gk, shx(gk, o)); }
      gqa_fast = __builtin_amdgcn_readfirstlane((int)(64.f * QSCALE * gq * gk < 26.f && gq < 16.f && gk < 48.f)) != 0;
      gqa_negc = -fmaxf(64.f * QSCALE * gq * gk - 15.f, 0.f); }
    LAS float* biasl = (LAS float*)(lds + LDS_MISC + 1024);
    LAS unsigned char* wl = lds + LDS_SCR + wave * 16384;
    { const float* rpb = P.in[4] + (size_t)layer * 4 * 15 * 31;
      for (int i = tid; i < 4 * 15 * 31; i += NTHR) biasl[i] = rpb[i] * LOG2E; }
    __syncthreads();
#ifndef NO_NA
    int cx = (c & 7) * 32 + (c >> 3); asm volatile("" : "+s"(cx));
    RP(16) for (int u = 0; u < 2; ++u) na_unit(wl, qt, biasl, Q, Kb, Vt, OA, cx >> 5, cx & 31, wave >> 1, 2 * (wave & 1) + u, lane);
#endif
#ifndef NO_DIL
    RP(17) { const int w = cx * 8 + wave; dil_unit(wl, qt, Q, Kb, Vt, OC, w >> 8, (w >> 7) & 1, (w >> 3) & 15, w & 7, lane); }
    __syncthreads();
#endif
#ifndef NO_GQA
    { const int xcd = c & 7, loc = c >> 3;
      if (gqa_fast) { RP(18) for (int i = 0; i < 2; ++i) { const int j = loc + 32 * i, pair = 2 * xcd + (j >> 5), qblk = j & 31;
          const bf16_t* K8 = (const bf16_t*)(P.ws + WS_K8); const bf16_t* V8 = (const bf16_t*)(P.ws + WS_V8);
          if (wave < 4) gqa3_wave<2>(lds + LDS_SCR, qt, Q, K8, V8, OB, pair >> 1, pair & 1, qblk, wave, lane_v(), gqa_negc);
          else gqa3_wave<1>(lds + LDS_SCR, qt, Q, K8, V8, OB, pair >> 1, pair & 1, qblk, wave, lane_v(), gqa_negc); } }
      else { for (int i = 0; i < 3; ++i) { const int j = loc + 32 * i, pair = 2 * xcd + j / 48, jj = j % 48;
          const int tid2 = (wave << 6) | lane_v();
          gqa_unit<false>(lds + LDS_SCR, qt, Q, Kb, Vt, OB, pair >> 1, (pair & 1) * 3 + jj / 16, jj & 15, tid2); } } }
#endif
}


__global__ void __launch_bounds__(NTHR, 2) mk_fwd(Args a) {
    extern __shared__ __attribute__((aligned(16))) unsigned char lds_raw[];
    LAS unsigned char* lds = (LAS unsigned char*)lds_raw;
    const int tid0 = threadIdx.x;
    const int wid_s = __builtin_amdgcn_readfirstlane(tid0 >> 6);
#define OTID() ({ int l_; asm volatile("v_mbcnt_lo_u32_b32 %0, -1, 0\n\tv_mbcnt_hi_u32_b32 %0, -1, %0" : "=v"(l_)); (wid_s << 6) | l_; })
    for (int i = tid0; i < 256; i += NTHR) ((LAS unsigned*)(lds + LDS_MISC))[i] = 0u;
    __syncthreads();
#define P a
#define ws (a.ws)
    const bool multi = (a.hi - a.lo) > 1;
    XcdBarrier bar; bar.bar = (unsigned*)ws + CW_BAR; bar.x = 0; bar.st = (volatile LAS unsigned*)(lds + LDS_MISC);
    if (multi) bar = xcd_barrier_post((unsigned*)ws + CW_BAR, (volatile LAS unsigned*)(lds + LDS_MISC), tid0);
#define RUN(s) (a.lo <= (s) && (s) < a.hi)

#if TSEL >= 0
    unsigned long long* tsb = (unsigned long long*)(ws + WS_CTL + 262144); int tsi = 0;
#define TSTAMP() do { if (blockIdx.x == 0 && OTID() == 0) tsb[tsi] = __builtin_amdgcn_s_memrealtime(); ++tsi; } while (0)
    TSTAMP();
#else
#define TSTAMP() do { } while (0)
#endif
#define SEAM() do { if (multi) xcd_barrier(bar, OTID()); TSTAMP(); } while (0)
#define H ((bf16_t*)(ws + WS_H))
#define YB ((bf16_t*)(ws + WS_YBUF))
#define ACT ((bf16_t*)(ws + WS_ACT))
#define XS ((bf16_t*)(ws + WS_XS))
#define topi ((int*)(ws + WS_TOPI))
#define topw ((float*)(ws + WS_TOPW))
#define perm ((int*)(ws + WS_PERM))
#define rgate ((float*)(ws + WS_RGATE))
#define cnt ((int*)(ws + WS_CNT))
#define G ((int)gridDim.x)
#define c ((int)blockIdx.x)

    if (PM(0) && RUN(0)) { RP(0) phase_prep(P, lds, OTID()); SEAM(); }

    for (int L = 0; L < DEPTH; ++L) {
        const int base = 1 + 10 * L;
        const bool moe = (L & 1) != 0;
        const float* xcur = (L == 0) ? P.in[0] : (const float*)P.out;
        const float* gains = P.in[1] + (size_t)L * 2 * 1024;
        const bool fuse1 = FUSE_NORM && (L & 1);
        const bool f8in = ((F8_IN >> L) & 1) != 0;
        if (PM(1) && RUN(base + 0) && !fuse1) {
            if (L == 2) { if (f8in) phase_norm<true, false, true>(P.out, P.out, YB, gains, H, nullptr, nullptr, nullptr, nullptr, nullptr, lds, OTID());
                          else phase_norm<true, false, false>(P.out, P.out, YB, gains, H, nullptr, nullptr, nullptr, nullptr, nullptr, lds, OTID()); }
            else { if (f8in) RP(1) phase_norm<false, false, true>(xcur, nullptr, nullptr, gains, H, nullptr, nullptr, nullptr, nullptr, nullptr, lds, OTID());
                   else RP(1) phase_norm<false, false, false>(xcur, nullptr, nullptr, gains, H, nullptr, nullptr, nullptr, nullptr, nullptr, lds, OTID()); }
            SEAM(); }
        if (PM(2) && RUN(base + 1)) {
            pg8::Gemm g{H, (const bf16_t*)(ws + WS_W_IN + (size_t)L * INW * 1024 * 2), f8in ? 512 : 1024, 0x7A7A7A7A}; pg8::StaticOrderR S; S.init(NTOK, INW, G, c); S.ssq = fuse1 ? (const float*)(ws + WS_SSQ) : nullptr; S.tab = (LAS float*)(lds + LDS_MISC + 1024); S.wid = wid_s;
            EpiIn E{(bf16_t*)(ws + WS_Q), (bf16_t*)(ws + WS_K), (bf16_t*)(ws + WS_VRAW), (bf16_t*)(ws + WS_G), fuse1 ? (const LAS float*)(lds + LDS_MISC + 1024) : nullptr};
            if (f8in) RP(2) pg8::gemm_phase<EpiIn, pg8::StaticOrderR, true, true, true>(lds + LDS_SCR, g, S, E, OTID());
            else RP(2) pg8::gemm_phase<EpiIn, pg8::StaticOrderR, true, true, false>(lds + LDS_SCR, g, S, E, OTID());
            SEAM(); }
        if (PM(3) && RUN(base + 2)) { phase_qkvprep(P, L, lds, OTID()); SEAM(); }
        if (PM(4) && RUN(base + 3)) { RP(4) phase_attn(P, L, lds, OTID()); SEAM(); }
        if (PM(5) && RUN(base + 4)) {
            const bool f8g = ((F8_GATE >> L) & 1) != 0;
            pg8::Gemm g{(const bf16_t*)(ws + WS_OALL), (const bf16_t*)(ws + WS_W_BR) + (size_t)L * 1024 * 768, f8g ? 384 : 768, 0x7A7A7A7A}; pg8::StaticOrder S; S.init(NTOK, 1024, G, c);
            EpiGate E{(const unsigned char*)(ws + WS_G), (bf16_t*)(ws + WS_MERGED), (int)((F8_OUT >> L) & 1), f8g ? 2 : 4, f8g ? 5 : 10};
            if (f8g) RP(5) pg8::gemm_phase<EpiGate, pg8::StaticOrder, true, true, true>(lds + LDS_SCR, g, S, E, OTID());
            else RP(5) pg8::gemm_phase<EpiGate, pg8::StaticOrder, true, true, false>(lds + LDS_SCR, g, S, E, OTID());
            SEAM(); }
        if (PM(6) && RUN(base + 5)) {
            const bool f8o = ((F8_OUT >> L) & 1) != 0;
            pg8::Gemm g{(const bf16_t*)(ws + WS_MERGED), (const bf16_t*)(ws + WS_W_OUT) + (size_t)L * 1024 * 1024, f8o ? 512 : 1024, 0x7A7A7A7A}; pg8::StaticOrder S; S.init(NTOK, 1024, G, c);
            const bool fuse2 = FUSE_NORM && !moe;
            EpiResidN E{xcur, P.out, fuse2 ? (unsigned char*)H : nullptr, (float*)(ws + WS_SSQ), (int)((F8_FFN >> (L >> 1)) & 1)};
            if (f8o) pg8::gemm_phase<EpiResidN, pg8::StaticOrder, true, true, true>(lds + LDS_SCR, g, S, E, OTID());
            else pg8::gemm_phase<EpiResidN, pg8::StaticOrder, true, true, false>(lds + LDS_SCR, g, S, E, OTID());
            SEAM(); }
        if (!moe) {
            const int di = L >> 1; const bool f8d = ((F8_FFN >> di) & 1) != 0;
            if (PM(7) && RUN(base + 6) && !FUSE_NORM) {
                if (f8d) RP(7) phase_norm<false, false, true>(P.out, nullptr, nullptr, gains + 1024, H, nullptr, nullptr, nullptr, nullptr, nullptr, lds, OTID());
                else RP(7) phase_norm<false, false, false>(P.out, nullptr, nullptr, gains + 1024, H, nullptr, nullptr, nullptr, nullptr, nullptr, lds, OTID());
                SEAM(); }
            if (PM(8) && RUN(base + 7)) {
                pg8::StaticOrderR S; S.init(NTOK, 2 * FF, G, c); S.ssq = FUSE_NORM ? (const float*)(ws + WS_SSQ) : nullptr; S.tab = (LAS float*)(lds + LDS_MISC + 1024); S.wid = wid_s;
                if (f8d) { pg8::Gemm g{H, (const bf16_t*)(ws + WS_W_FGU + (size_t)di * 2 * FF * 1024 * 2), 512, 0x7A7A7A7A}; EpiSwiglu<true> E{(unsigned char*)ACT, FF, FUSE_NORM ? (const LAS float*)(lds + LDS_MISC + 1024) : nullptr};
                    RP(8) pg8::gemm_phase<EpiSwiglu<true>, pg8::StaticOrderR, true, true, true>(lds + LDS_SCR, g, S, E, OTID()); }
                else { pg8::Gemm g{H, (const bf16_t*)(ws + WS_W_FGU + (size_t)di * 2 * FF * 1024 * 2), 1024, 0}; EpiSwiglu<false> E{(unsigned char*)ACT, FF, FUSE_NORM ? (const LAS float*)(lds + LDS_MISC + 1024) : nullptr};
                    RP(8) pg8::gemm_phase<EpiSwiglu<false>, pg8::StaticOrderR, true, true, false>(lds + LDS_SCR, g, S, E, OTID()); }
                SEAM(); }
            if (PM(9) && RUN(base + 8)) {
                pg8::StaticOrder S; S.init(NTOK, 1024, G, c); EpiResidN E{P.out, P.out, FUSE_NORM ? (unsigned char*)H : nullptr, (float*)(ws + WS_SSQ), (int)((F8_IN >> (L + 1)) & 1)};
                if (f8d) { pg8::Gemm g{ACT, (const bf16_t*)(ws + WS_W_FDN + (size_t)di * 1024 * FF * 2), FF / 2, 0x79797979};
                    pg8::gemm_phase<EpiResidN, pg8::StaticOrder, true, true, true>(lds + LDS_SCR, g, S, E, OTID()); }
                else { pg8::Gemm g{ACT, (const bf16_t*)(ws + WS_W_FDN + (size_t)di * 1024 * FF * 2), FF, 0};
                    pg8::gemm_phase<EpiResidN, pg8::StaticOrder, true, true, false>(lds + LDS_SCR, g, S, E, OTID()); }
                SEAM(); }
        } else {
            const int li = L >> 1;
            const bool f8 = ((F8_MOE >> li) & 1) != 0;
            if (PM(10) && RUN(base + 6)) {
                if (f8) RP(10) phase_norm<false, true, true>(P.out, nullptr, nullptr, gains + 1024, H, P.in[9] + (size_t)li * 1024 * 8, topi, topw, cnt, perm, lds, OTID());
                else RP(10) phase_norm<false, true, false>(P.out, nullptr, nullptr, gains + 1024, H, P.in[9] + (size_t)li * 1024 * 8, topi, topw, cnt, perm, lds, OTID());
                SEAM(); }
            if (PM(11) && RUN(base + 7)) {
                if (f8) RP(11) phase_scatter<true>(cnt, topi, topw, H, XS, perm, rgate, lds, OTID());
                else RP(11) phase_scatter<false>(cnt, topi, topw, H, XS, perm, rgate, lds, OTID());
                SEAM(); }
            if ((PM(12) || PM(13)) && (RUN(base + 8) || RUN(base + 9))) {
                volatile LAS int* misc = (volatile LAS int*)(lds + LDS_MISC + 64);
                moe_totals(cnt, misc, OTID());
                pg8::GroupedOrder S; S.c8 = c & 7; S.loc = c >> 3; S.per = G >> 3;
                S.tp[0] = 0;
#pragma unroll
                for (int e = 0; e < 8; ++e) S.tp[e + 1] = S.tp[e] + ((__builtin_amdgcn_readfirstlane(misc[e]) + 255) >> 8);
                if (PM(12) && RUN(base + 8)) {
                    S.nN = 2 * ED / 256; S.cb = 7;
                    if (f8) { S.bstride = (long)2 * ED * 1024;
                        pg8::Gemm g{XS, (const bf16_t*)(ws + WS_W_MGU + (size_t)li * 8 * 2 * ED * 1024 * 2), 512, 0x7A7A7A7A};
                        EpiSwiglu<true> E{(unsigned char*)ACT, ED, nullptr};
                        RP(12) pg8::gemm_phase<EpiSwiglu<true>, pg8::GroupedOrder, true, true, true>(lds + LDS_SCR, g, S, E, OTID()); }
                    else { S.bstride = (long)2 * ED * 1024 * 2;
                        pg8::Gemm g{XS, (const bf16_t*)(ws + WS_W_MGU + (size_t)li * 8 * 2 * ED * 1024 * 2), 1024, 0};
                        EpiSwiglu<false> E{(unsigned char*)ACT, ED, nullptr};
                        RP(12) pg8::gemm_phase<EpiSwiglu<false>, pg8::GroupedOrder, true, true, false>(lds + LDS_SCR, g, S, E, OTID()); }
                    SEAM(); }
                if (PM(13) && RUN(base + 9)) {
                    S.nN = 4; S.cb = 4;
                    EpiMoeDown E{perm, rgate, YB};
                    if (f8) { S.bstride = (long)1024 * ED;
                        pg8::Gemm g{ACT, (const bf16_t*)(ws + WS_W_MDN + (size_t)li * 8 * 1024 * ED * 2), ED / 2, 0x79797979};
                        RP(13) pg8::gemm_phase<EpiMoeDown, pg8::GroupedOrder, true, true, true>(lds + LDS_SCR, g, S, E, OTID()); }
                    else { S.bstride = (long)1024 * ED * 2;
                        pg8::Gemm g{ACT, (const bf16_t*)(ws + WS_W_MDN + (size_t)li * 8 * 1024 * ED * 2), ED, 0};
                        RP(13) pg8::gemm_phase<EpiMoeDown, pg8::GroupedOrder, true, true, false>(lds + LDS_SCR, g, S, E, OTID()); }
                    SEAM(); }
            }
        }
    }
    if (PM(14) && RUN(41)) phase_final(P.out, YB, P.out, OTID());
#if TSEL >= 0
    xcd_barrier(bar, OTID()); TSTAMP();
    if (blockIdx.x == 0 && OTID() == 0) { asm volatile("s_waitcnt vmcnt(0)" ::: "memory"); const unsigned long long d = tsb[TSEL + 1] - tsb[TSEL]; P.out[0] += (float)d * (0.01f * 0.25f); }
#endif
#undef RUN
#undef SEAM
#undef P
#undef ws
#undef H
#undef YB
#undef ACT
#undef XS
#undef topi
#undef topw
#undef perm
#undef rgate
#undef cnt
#undef G
#undef c
}

#if MK_DEBUG
DI unsigned hsh(unsigned x) { x ^= x >> 16; x *= 0x7feb352du; x ^= x >> 15; x *= 0x846ca68bu; x ^= x >> 16; return x; }
DI void rep(unsigned* ctl, int slot, float got, float ref, float scale) { float e = fabsf(got - ref) / (fabsf(ref) + scale); if (!(e == e) || e > 1e30f) e = 1e30f; atomicMax(ctl + CW_ERR + slot, __float_as_uint(e)); }
DI float dotbf(const bf16_t* a, const bf16_t* b, int K, int lane) { float s = 0.f; for (int k = lane; k < K; k += 64) s += bf2f(a[k]) * bf2f(b[k]); return wave_sum(s); }
DI float rbf(float x) { return bflo(pk2(x, 0.f) & 0xffffu); }

__global__ void chk_prep(Args a) {
    unsigned* ctl = (unsigned*)a.ws; const unsigned h0 = hsh(blockIdx.x * 64 + threadIdx.x + 1);
    unsigned h = h0;
#define NXT() (h = hsh(h + 0x9e3779b9u))
    { const int L = NXT() % 4, n = NXT() % 5632, k = NXT() % 1024; rep(ctl, 0, bf2f(((const bf16_t*)(a.ws + WS_W_IN))[((size_t)L * 5632 + n) * 1024 + k]), rbf(a.in[2][((size_t)L * 1024 + k) * 5632 + n]), 1e-3f); }
    { const int L = NXT() % 4, n = NXT() % 1024, k = NXT() % 768; rep(ctl, 0, bf2f(((const bf16_t*)(a.ws + WS_W_BR))[((size_t)L * 1024 + n) * 768 + k]), rbf(a.in[5][((size_t)L * 768 + k) * 1024 + n]), 1e-3f); }
    { const int L = NXT() % 4, n = NXT() % 1024, k = NXT() % 1024; rep(ctl, 0, bf2f(((const bf16_t*)(a.ws + WS_W_OUT))[((size_t)L * 1024 + n) * 1024 + k]), rbf(a.in[6][((size_t)L * 1024 + k) * 1024 + n]), 1e-3f); }
    { const int L = NXT() % 2, n = NXT() % 5632, k = NXT() % 1024, pn = n >> 8, j = n & 255, cc = j < 128 ? pn * 128 + j : FF + pn * 128 + j - 128;
      rep(ctl, 0, bf2f(((const bf16_t*)(a.ws + WS_W_FGU))[((size_t)L * 5632 + n) * 1024 + k]), rbf(a.in[7][((size_t)L * 1024 + k) * 5632 + cc]), 1e-3f); }
    { const int L = NXT() % 2, n = NXT() % 1024, k = NXT() % 2816; rep(ctl, 0, bf2f(((const bf16_t*)(a.ws + WS_W_FDN))[((size_t)L * 1024 + n) * 2816 + k]), rbf(a.in[8][((size_t)L * 2816 + k) * 1024 + n]), 1e-3f); }
    { const int L = NXT() % 16, n = NXT() % 7168, k = NXT() % 1024, pn = n >> 8, j = n & 255, cc = j < 128 ? pn * 128 + j : ED + pn * 128 + j - 128;
      rep(ctl, 0, bf2f(((const bf16_t*)(a.ws + WS_W_MGU))[((size_t)L * 7168 + n) * 1024 + k]), rbf(a.in[10][((size_t)L * 1024 + k) * 7168 + cc]), 1e-3f); }
    { const int L = NXT() % 16, n = NXT() % 1024, k = NXT() % 3584; rep(ctl, 0, bf2f(((const bf16_t*)(a.ws + WS_W_MDN))[((size_t)L * 1024 + n) * 3584 + k]), rbf(a.in[11][((size_t)L * 3584 + k) * 1024 + n]), 1e-3f); }
#undef NXT
}
__global__ void chk_norm(Args a, const float* xin, const float* gain, int comb, int slot) {
    unsigned* ctl = (unsigned*)a.ws; const int lane = threadIdx.x; const int row = blockIdx.x == 0 ? 0 : (blockIdx.x == 1 ? NTOK - 1 : hsh(blockIdx.x * 7 + slot) % NTOK);
    const bf16_t* H = (const bf16_t*)(a.ws + WS_H); const bf16_t* yb = (const bf16_t*)(a.ws + WS_YBUF);
    float v[16], ss = 0.f;
    for (int j = 0; j < 16; ++j) { const int cidx = lane + 64 * j; float x = xin[(size_t)row * 1024 + cidx];
        if (comb) { x += bf2f(yb[(size_t)row * 1024 + cidx]) + bf2f(yb[((size_t)NTOK + row) * 1024 + cidx]); rep(ctl, slot, a.out[(size_t)row * 1024 + cidx], x, 1e-2f); }
        v[j] = x; ss += x * x; }
    const float rstd = 1.f / sqrtf(wave_sum(ss) / 1024.f + EPS);
    for (int j = 0; j < 16; ++j) { const int cidx = lane + 64 * j; rep(ctl, slot, bf2f(H[(size_t)row * 1024 + cidx]), v[j] * rstd * gain[cidx], 2e-2f); }
}
__global__ void chk_gemm_in(Args a, int L) {
    unsigned* ctl = (unsigned*)a.ws; const int lane = threadIdx.x; unsigned h = hsh(blockIdx.x + 77 * L + 5);
    const int row = blockIdx.x < 4 ? (blockIdx.x & 1 ? NTOK - 1 : 0) : h % NTOK; h = hsh(h + 1); const int col = blockIdx.x < 2 ? 0 : (blockIdx.x < 4 ? INW - 1 : h % INW);
    const float d = dotbf((const bf16_t*)(a.ws + WS_H) + (size_t)row * 1024, (const bf16_t*)(a.ws + WS_W_IN) + ((size_t)L * INW + col) * 1024, 1024, lane);
    float got;
    if (col < 1024) got = bf2f(((const bf16_t*)(a.ws + WS_Q))[(size_t)row * 1024 + col]);
    else if (col < 1792) got = bf2f(((const bf16_t*)(a.ws + WS_K))[(size_t)row * 768 + col - 1024]);
    else if (col < 2560) got = bf2f(((const bf16_t*)(a.ws + WS_VRAW))[(size_t)row * 768 + col - 1792]);
    else got = ((float)((const unsigned char*)(a.ws + WS_G))[(size_t)row * 3072 + col - 2560] + 0.5f) * (1.f / 256.f);
    const float ref = col < 2560 ? d : 1.f / (1.f + expf(-d));
    if (lane == 0) rep(ctl, 2, got, ref, 5e-2f);
}
__global__ void chk_qk(Args a, int L) {
    unsigned* ctl = (unsigned*)a.ws; const int j = threadIdx.x; unsigned h = hsh(blockIdx.x + 131 * L + 9);
    const int tok = blockIdx.x == 0 ? 0 : (blockIdx.x == 1 ? NTOK - 1 : h % NTOK); h = hsh(h + 1); const int isk = 1; h = hsh(h + 1); const int head = h % 12;
    const int col = (isk ? 1024 : 0) + head * 64 + j;
    const bf16_t* hr = (const bf16_t*)(a.ws + WS_H) + (size_t)tok * 1024; const bf16_t* wr = (const bf16_t*)(a.ws + WS_W_IN) + ((size_t)L * INW + col) * 1024;
    float d = 0.f; for (int k = 0; k < 1024; ++k) d += bf2f(hr[k]) * bf2f(wr[k]);
    d = rbf(d);
    const float rstd = 1.f / sqrtf(wave_sum(d * d) / 64.f + EPS);
    const int br = isk ? (head < 4 ? 0 : (head < 6 ? 1 : 2)) : (head < 4 ? 0 : (head < 10 ? 1 : 2));
    const float y = d * rstd * a.in[3][((size_t)(L * 3 + br) * 2 + isk) * 64 + j];
    const int s = tok & 4095; float o = y;
    if (br == 2) { const int i = j & 31; const float ang = (float)s * powf(10000.f, -(float)(2 * i) / 64.f); const float p = __shfl_xor(y, 32); o = j < 32 ? y * cosf(ang) - p * sinf(ang) : y * cosf(ang) + p * sinf(ang); }
    if (br == 1) { const int i = j & 15; const float pos = (float)((j < 32) ? (s >> 6) : (s & 63)); const float ang = pos * powf(10000.f, -(float)(2 * i) / 32.f); const float p = __shfl_xor(y, 16);
        o = (j & 16) == 0 ? y * cosf(ang) - p * sinf(ang) : y * cosf(ang) + p * sinf(ang); }
    if (!isk) o *= QSCALE;
    const float got = isk ? bf2f(((const bf16_t*)(a.ws + WS_K))[(size_t)tok * 768 + head * 64 + j]) : bf2f(((const bf16_t*)(a.ws + WS_Q))[(size_t)tok * 1024 + head * 64 + j]);
    rep(ctl, 3, got, o, 3e-2f);
}
__global__ void chk_vt(Args a) {
    unsigned* ctl = (unsigned*)a.ws; unsigned h = hsh(blockIdx.x * 64 + threadIdx.x + 3);
    const int b = h % 8; h = hsh(h + 1); const int hv = h % 12; h = hsh(h + 1); const int d = h % 64; h = hsh(h + 1); const int s = h % 4096;
    const int g = hv < 6 ? 0 : (hv - 6) >> 1, dd = 1 << (2 * g), Sd = 4096 / dd, pos = (s % dd) * Sd + s / dd;
    rep(ctl, 4, bf2f(((const bf16_t*)(a.ws + WS_VT))[((size_t)(b * 12 + hv) * 64 + d) * 4096 + pos]), bf2f(((const bf16_t*)(a.ws + WS_VRAW))[(size_t)(b * 4096 + s) * 768 + hv * 64 + d]), 1e-3f);
}
DI float dot64(const bf16_t* x, const bf16_t* y) { float s = 0.f; for (int k = 0; k < 64; ++k) s += bf2f(x[k]) * bf2f(y[k]); return s; }
DI float dot64q(const float* x, const bf16_t* y) { float s = 0.f; for (int k = 0; k < 64; ++k) s += x[k] * bf2f(y[k]); return s; }
DI float chk_qn(const Args& a, int L, int tok, int head, int t) {
    const float d = bf2f(((const bf16_t*)(a.ws + WS_Q))[(size_t)tok * 1024 + head * 64 + t]);
    const float rstd = 1.f / sqrtf(wave_sum(d * d) / 64.f + EPS);
    const int br = head < 4 ? 0 : (head < 10 ? 1 : 2);
    const float y = d * rstd * a.in[3][((size_t)(L * 3 + br) * 2 + 0) * 64 + t];
    const int s = tok & 4095; float o = y;
    if (br == 2) { const int i = t & 31; const float ang = (float)s * powf(10000.f, -(float)(2 * i) / 64.f); const float p = __shfl_xor(y, 32); o = t < 32 ? y * cosf(ang) - p * sinf(ang) : y * cosf(ang) + p * sinf(ang); }
    if (br == 1) { const int i = t & 15; const float pos = (float)((t < 32) ? (s >> 6) : (s & 63)); const float ang = pos * powf(10000.f, -(float)(2 * i) / 32.f); const float p = __shfl_xor(y, 16);
        o = (t & 16) == 0 ? y * cosf(ang) - p * sinf(ang) : y * cosf(ang) + p * sinf(ang); }
    return rbf(o * QSCALE);
}
__global__ void chk_na(Args a, int L) {
    __shared__ float p[128]; __shared__ float qn[64]; unsigned* ctl = (unsigned*)a.ws; const int t = threadIdx.x; unsigned h = hsh(blockIdx.x + 31 * L + 11);
    const int tok = blockIdx.x == 0 ? 0 : (blockIdx.x == 1 ? NTOK - 1 : h % NTOK); h = hsh(h + 1); const int hd = h % 4;
    const int b = tok >> 12, s = tok & 4095, gr = s >> 6, cq = s & 63, rs = min(max(gr - 4, 0), 56), cs = min(max(cq - 8, 0), 48);
    const bf16_t* Kb = (const bf16_t*)(a.ws + WS_K); const bf16_t* V = (const bf16_t*)(a.ws + WS_VRAW);
    qn[t] = chk_qn(a, L, tok, hd, t); __syncthreads();
    float mx = -1e30f;
    for (int q = 0; q < 2; ++q) { const int idx = t + 64 * q, kr = rs + idx / 16, ck = cs + idx % 16, kt = b * 4096 + kr * 64 + ck;
        const float sc = dot64q(qn, Kb + (size_t)kt * 768 + hd * 64) + LOG2E * a.in[4][(((size_t)L * 4 + hd) * 15 + (kr - gr + 7)) * 31 + (ck - cq + 15)];
        p[idx] = sc; mx = fmaxf(mx, sc); }
    for (int o = 1; o < 64; o <<= 1) mx = fmaxf(mx, __shfl_xor(mx, o));
    __syncthreads();
    float sum = 0.f, acc = 0.f;
    for (int idx = 0; idx < 128; ++idx) { const int kr = rs + idx / 16, ck = cs + idx % 16, kt = b * 4096 + kr * 64 + ck; const float e = exp2f(p[idx] - mx); sum += e; acc += e * bf2f(V[(size_t)kt * 768 + hd * 64 + t]); }
    rep(ctl, 5, bf2f(((const bf16_t*)(a.ws + WS_OALL))[(size_t)tok * 768 + hd * 64 + t]), acc / sum, 3e-2f);
}
__global__ void chk_dil(Args a, int L) {
    __shared__ float p[3][192]; __shared__ float qn[3][64]; unsigned* ctl = (unsigned*)a.ws; const int t = threadIdx.x; unsigned h = hsh(blockIdx.x + 37 * L + 13);
    const int tok = blockIdx.x == 0 ? 0 : (blockIdx.x == 1 ? NTOK - 1 : (blockIdx.x == 2 ? 4095 : (blockIdx.x == 3 ? 4096 + 70 : h % NTOK))); h = hsh(h + 1); const int hs = h & 1;
    const int b = tok >> 12, s = tok & 4095;
    const bf16_t* Kb = (const bf16_t*)(a.ws + WS_K); const bf16_t* V = (const bf16_t*)(a.ws + WS_VRAW);
    for (int g = 0; g < 3; ++g) qn[g][t] = chk_qn(a, L, tok, 10 + 2 * g + hs, t);
    __syncthreads();
    float lse[3], og[3];
    for (int g = 0; g < 3; ++g) { const int dd = 1 << (2 * g), hq = 10 + 2 * g + hs, hk = 6 + 2 * g + hs; float mx = -1e30f;
        for (int q = 0; q < 3; ++q) { const int idx = t + 64 * q; if (idx < 129) { const int pos = s + dd * (idx - 64); float sc = -1e30f;
            if (pos >= 0 && pos < 4096) sc = dot64q(qn[g], Kb + (size_t)(b * 4096 + pos) * 768 + hk * 64);
            p[g][idx] = sc; mx = fmaxf(mx, sc); } }
        for (int o = 1; o < 64; o <<= 1) mx = fmaxf(mx, __shfl_xor(mx, o));
        __syncthreads();
        float sum = 0.f, acc = 0.f;
        for (int idx = 0; idx < 129; ++idx) { const int pos = s + dd * (idx - 64); if (pos >= 0 && pos < 4096) { const float e = exp2f(p[g][idx] - mx); sum += e; acc += e * bf2f(V[(size_t)(b * 4096 + pos) * 768 + hk * 64 + t]); } }
        lse[g] = mx + log2f(sum); og[g] = acc / sum; }
    const float M = fmaxf(lse[0], fmaxf(lse[1], lse[2])); const float w0 = exp2f(lse[0] - M), w1 = exp2f(lse[1] - M), w2 = exp2f(lse[2] - M);
    rep(ctl, 6, bf2f(((const bf16_t*)(a.ws + WS_OALL))[(size_t)tok * 768 + 640 + hs * 64 + t]), (w0 * og[0] + w1 * og[1] + w2 * og[2]) / (w0 + w1 + w2), 3e-2f);
}
__global__ void chk_gqa(Args a, int L) {
    __shared__ float p[4096]; __shared__ float qn[64]; unsigned* ctl = (unsigned*)a.ws; const int t = threadIdx.x; unsigned h = hsh(blockIdx.x + 41 * L + 17);
    const int tok = blockIdx.x == 0 ? 0 : (blockIdx.x == 1 ? NTOK - 1 : h % NTOK); h = hsh(h + 1); const int hq = h % 6, kvh = hq / 3, b = tok >> 12;
    const bf16_t* Kb = (const bf16_t*)(a.ws + WS_K); const bf16_t* V = (const bf16_t*)(a.ws + WS_VRAW);
    qn[t] = chk_qn(a, L, tok, 4 + hq, t); __syncthreads();
    float mx = -1e30f;
    for (int k = t; k < 4096; k += 64) { const float sc = dot64q(qn, Kb + (size_t)(b * 4096 + k) * 768 + (4 + kvh) * 64); p[k] = sc; mx = fmaxf(mx, sc); }
    for (int o = 1; o < 64; o <<= 1) mx = fmaxf(mx, __shfl_xor(mx, o));
    __syncthreads();
    float sum = 0.f, acc = 0.f;
    for (int k = 0; k < 4096; ++k) { const float e = exp2f(p[k] - mx); sum += e; acc += e * bf2f(V[(size_t)(b * 4096 + k) * 768 + (4 + kvh) * 64 + t]); }
    rep(ctl, 7, bf2f(((const bf16_t*)(a.ws + WS_OALL))[(size_t)tok * 768 + 256 + hq * 64 + t]), acc / sum, 3e-2f);
}
__global__ void chk_gate(Args a, int L) {
    unsigned* ctl = (unsigned*)a.ws; const int lane = threadIdx.x; unsigned h = hsh(blockIdx.x + 43 * L + 19);
    const int row = blockIdx.x < 2 ? (blockIdx.x ? NTOK - 1 : 0) : h % NTOK; h = hsh(h + 1); const int col = blockIdx.x < 2 ? (blockIdx.x ? 1023 : 0) : h % 1024;
    const bf16_t* orow = (const bf16_t*)(a.ws + WS_OALL) + (size_t)row * 768; const bf16_t* wrow = (const bf16_t*)(a.ws + WS_W_BR) + ((size_t)L * 1024 + col) * 768;
    const float ya = dotbf(orow, wrow, 256, lane), yb = dotbf(orow + 256, wrow + 256, 384, lane), yc = dotbf(orow + 640, wrow + 640, 128, lane);
    const unsigned char* G = (const unsigned char*)(a.ws + WS_G) + (size_t)row * 3072;
    const float ref = (((float)G[col] + 0.5f) * ya + ((float)G[1024 + col] + 0.5f) * yb + ((float)G[2048 + col] + 0.5f) * yc) * (1.f / 256.f);
    if (lane == 0) rep(ctl, 8, bf2f(((const bf16_t*)(a.ws + WS_MERGED))[(size_t)row * 1024 + col]), ref, 5e-2f);
}
__global__ void chk_resid(Args a, const float* xold, const bf16_t* A, const bf16_t* Bt, int K, int slot) {
    unsigned* ctl = (unsigned*)a.ws; const int lane = threadIdx.x; unsigned h = hsh(blockIdx.x + 47 * slot + 23);
    const int row = blockIdx.x < 2 ? (blockIdx.x ? NTOK - 1 : 0) : h % NTOK; h = hsh(h + 1); const int col = blockIdx.x < 2 ? (blockIdx.x ? 1023 : 0) : h % 1024;
    const float d = dotbf(A + (size_t)row * K, Bt + (size_t)col * K, K, lane);
    if (lane == 0) rep(ctl, slot, a.out[(size_t)row * 1024 + col], xold[(size_t)row * 1024 + col] + d, 5e-2f);
}
__global__ void chk_router(Args a, const float* gain, const float* wr) {
    unsigned* ctl = (unsigned*)a.ws; const int lane = threadIdx.x; const int row = blockIdx.x == 0 ? 0 : (blockIdx.x == 1 ? NTOK - 1 : hsh(blockIdx.x + 29) % NTOK);
    float v[16], ss = 0.f;
    for (int j = 0; j < 16; ++j) { v[j] = a.out[(size_t)row * 1024 + lane + 64 * j]; ss += v[j] * v[j]; }
    const float rstd = 1.f / sqrtf(wave_sum(ss) / 1024.f + EPS);
    float lg[8];
    for (int e = 0; e < 8; ++e) { float s = 0.f; for (int j = 0; j < 16; ++j) { const int k = lane + 64 * j; s += v[j] * rstd * gain[k] * wr[k * 8 + e]; } lg[e] = wave_sum(s); }
    int e0 = 0; for (int e = 1; e < 8; ++e) if (lg[e] > lg[e0]) e0 = e;
    int e1 = e0 == 0 ? 1 : 0; for (int e = 0; e < 8; ++e) if (e != e0 && lg[e] > lg[e1]) e1 = e;
    float third = -1e30f; for (int e = 0; e < 8; ++e) if (e != e0 && e != e1) third = fmaxf(third, lg[e]);
    const int* topi = (const int*)(a.ws + WS_TOPI); const float* topw = (const float*)(a.ws + WS_TOPW);
    if (lane == 0) { const bool clear = (lg[e0] - lg[e1] > 1e-3f) && (lg[e1] - third > 1e-3f);
        if (clear) { rep(ctl, 13, (float)topi[row * 2], (float)e0, 1e-3f); rep(ctl, 13, (float)topi[row * 2 + 1], (float)e1, 1e-3f);
            const float t = expf(lg[e1] - lg[e0]); rep(ctl, 13, topw[row * 2], 1.f / (1.f + t), 1e-2f); rep(ctl, 13, topw[row * 2 + 1], t / (1.f + t), 1e-2f); } }
}
__global__ void chk_up(Args a, const bf16_t* A, const bf16_t* Wt, int ffd, int slot) {
    unsigned* ctl = (unsigned*)a.ws; const int lane = threadIdx.x; unsigned h = hsh(blockIdx.x + 53 * slot + 3);
    const int row = blockIdx.x < 2 ? (blockIdx.x ? NTOK - 1 : 0) : h % NTOK; h = hsh(h + 1); const int j = blockIdx.x < 2 ? (blockIdx.x ? ffd - 1 : 0) : h % ffd;
    const int pn = j >> 7, jj = j & 127;
    const float g = dotbf(A + (size_t)row * 1024, Wt + (size_t)(256 * pn + jj) * 1024, 1024, lane), u = dotbf(A + (size_t)row * 1024, Wt + (size_t)(256 * pn + 128 + jj) * 1024, 1024, lane);
    if (lane == 0) rep(ctl, slot, bf2f(((const bf16_t*)(a.ws + WS_ACT))[(size_t)row * ffd + j]), g / (1.f + expf(-g)) * u, 3e-2f);
}
__global__ void chk_scatter(Args a) {
    unsigned* ctl = (unsigned*)a.ws; const int lane = threadIdx.x; const int* cnt = (const int*)(a.ws + WS_CNT); const int* perm = (const int*)(a.ws + WS_PERM);
    const int* topi = (const int*)(a.ws + WS_TOPI); const float* topw = (const float*)(a.ws + WS_TOPW); const float* rg = (const float*)(a.ws + WS_RGATE);
    int tot[8], base[9]; base[0] = 0;
    for (int e = 0; e < 8; ++e) { int s = 0; for (int w = lane; w < 256; w += 64) s += cnt[w * 8 + e]; for (int o = 1; o < 64; o <<= 1) s += __shfl_xor(s, o); tot[e] = s; base[e + 1] = base[e] + ((s + 255) >> 8 << 8); }
    if (blockIdx.x == 0) { int sum = 0; for (int e = 0; e < 8; ++e) sum += tot[e]; if (lane == 0) rep(ctl, 14, (float)sum, 65536.f, 1e-3f);
        unsigned long long cs = 0; int nv = 0; for (int i = lane; i < MROWS; i += 64) { const int p = perm[i]; if (p >= 0) { cs += (unsigned long long)p; ++nv; } }
        for (int o = 1; o < 64; o <<= 1) { cs += __shfl_xor(cs, o); nv += __shfl_xor(nv, o); }
        if (lane == 0) { rep(ctl, 14, (float)nv, 65536.f, 1e-3f); rep(ctl, 14, (float)(cs == 65536ull * 65535ull / 2ull), 1.f, 1e-3f); } }
    const int pos = hsh(blockIdx.x + 5) % MROWS; const int p = perm[pos];
    int e = 0; for (int k = 1; k < 8; ++k) e += pos >= base[k];
    const bool inr = pos < base[e] + tot[e];
    if (lane == 0) rep(ctl, 14, (float)(p >= 0), (float)inr, 1e-3f);
    if (p >= 0 && inr) { const int tok = p >> 1, slot = p & 1;
        if (lane == 0) { rep(ctl, 14, (float)topi[tok * 2 + slot], (float)e, 1e-3f); rep(ctl, 14, rg[pos], topw[tok * 2 + slot], 1e-3f); }
        for (int j = 0; j < 16; ++j) rep(ctl, 14, bf2f(((const bf16_t*)(a.ws + WS_XS))[(size_t)pos * 1024 + lane + 64 * j]), bf2f(((const bf16_t*)(a.ws + WS_H))[(size_t)tok * 1024 + lane + 64 * j]), 1e-3f); }
}
__global__ void chk_moe(Args a, int li, int down) {
    unsigned* ctl = (unsigned*)a.ws; const int lane = threadIdx.x; const int* perm = (const int*)(a.ws + WS_PERM); const int* topi = (const int*)(a.ws + WS_TOPI); const float* rg = (const float*)(a.ws + WS_RGATE);
    unsigned h = hsh(blockIdx.x + 59 * down + 7); int pos = h % MROWS; while (perm[pos] < 0) pos = (pos + 1) % MROWS;
    const int p = perm[pos], tok = p >> 1, slot = p & 1, e = topi[tok * 2 + slot]; h = hsh(h + 1);
    if (!down) { const int j = h % ED, pn = j >> 7, jj = j & 127; const bf16_t* Wt = (const bf16_t*)(a.ws + WS_W_MGU) + (size_t)(li * 8 + e) * 2 * ED * 1024; const bf16_t* A = (const bf16_t*)(a.ws + WS_XS) + (size_t)pos * 1024;
        const float g = dotbf(A, Wt + (size_t)(256 * pn + jj) * 1024, 1024, lane), u = dotbf(A, Wt + (size_t)(256 * pn + 128 + jj) * 1024, 1024, lane);
        if (lane == 0) rep(ctl, 15, bf2f(((const bf16_t*)(a.ws + WS_ACT))[(size_t)pos * ED + j]), g / (1.f + expf(-g)) * u, 3e-2f); }
    else { const int col = h % 1024; const float d = dotbf((const bf16_t*)(a.ws + WS_ACT) + (size_t)pos * ED, (const bf16_t*)(a.ws + WS_W_MDN) + ((size_t)(li * 8 + e) * 1024 + col) * ED, ED, lane);
        if (lane == 0) rep(ctl, 16, bf2f(((const bf16_t*)(a.ws + WS_YBUF))[((size_t)slot * NTOK + tok) * 1024 + col]), rg[pos] * d, 3e-2f); }
}
__global__ void chk_final(Args a, const float* xold) {
    unsigned* ctl = (unsigned*)a.ws; const size_t i = hsh(blockIdx.x * 64 + threadIdx.x + 9) % ((size_t)NTOK * 1024); const bf16_t* yb = (const bf16_t*)(a.ws + WS_YBUF);
    rep(ctl, 18, a.out[i], xold[i] + bf2f(yb[i]) + bf2f(yb[(size_t)NTOK * 1024 + i]), 1e-2f);
}
__global__ void chk_report(Args a) {
    const unsigned* ctl = (const unsigned*)a.ws; int code = -1;
    for (int s = 18; s >= 0; --s) { const float e = __uint_as_float(ctl[CW_ERR + s]); const float tol = (s == 0 || s == 4 || s == 14) ? 1e-3f : 0.08f; if (e > tol) code = s; }
    if (code >= 0) { float v = 10.f; for (int k = 0; k < code; ++k) v *= 10.f;
        for (size_t i = (size_t)blockIdx.x * blockDim.x + threadIdx.x; i < (size_t)NTOK * 1024; i += (size_t)gridDim.x * blockDim.x) a.out[i] = v; }
}
#endif

extern "C" void kernel_launch(void* const* d_in, const int* in_sizes, int n_in, void* d_out, int out_size, void* d_ws, size_t ws_size, hipStream_t stream) {
    static int ready = 0;
    if (ready == 0) {
        ready = -1;
        if (n_in != 12 || out_size != NTOK * 1024 || ws_size < WS_END + (MK_DEBUG ? (size_t)128 * MiB : 0)) { fprintf(stderr, "kernel_launch: unexpected shapes / workspace (%d inputs, out %d, ws %zu)\n", n_in, out_size, ws_size); return; }
        if (hipFuncSetAttribute((const void*)mk_fwd, hipFuncAttributeMaxDynamicSharedMemorySize, LDS_BYTES) != hipSuccess) { fprintf(stderr, "kernel_launch: hipFuncSetAttribute failed\n"); return; }
        int per_cu = 0; (void)hipOccupancyMaxActiveBlocksPerMultiprocessor(&per_cu, (const void*)mk_fwd, NTHR, LDS_BYTES); (void)hipGetLastError();
        if (per_cu < 1) fprintf(stderr, "kernel_launch: occupancy query says %d blocks per CU\n", per_cu);
        ready = 1;
    }
    if (ready < 0) return;
    (void)hipMemsetAsync((char*)d_ws + WS_CTL, 0, CTL_ZERO_BYTES, stream);
    Args a{};
    for (int i = 0; i < 12; ++i) a.in[i] = (const float*)d_in[i];
    a.out = (float*)d_out; a.ws = (unsigned char*)d_ws;
#if !MK_DEBUG
    a.lo = 0; a.hi = 42;
    hipLaunchKernelGGL(mk_fwd, dim3(NWG), dim3(NTHR), LDS_BYTES, stream, a);
#else
    unsigned char* ws = (unsigned char*)d_ws; float* snap = (float*)(ws + WS_DBG);
    const int NS = 96;
    for (int s = 0; s < 42; ++s) {
        const int L = (s - 1) / 10, k = (s - 1) % 10; const bool moe = (L & 1) != 0;
        if (s >= 1 && s < 41 && !moe && k == 9) continue;
        const bool snapx = (s == 41) || (s >= 1 && s < 41 && ((k == 0 && L == 2) || (k == 8 && !moe) || (k == 5 && L > 0)));
        if (snapx) (void)hipMemcpyAsync(snap, d_out, (size_t)NTOK * 1024 * 4, hipMemcpyDeviceToDevice, stream);
        a.lo = s; a.hi = s + 1;
        hipLaunchKernelGGL(mk_fwd, dim3(NWG), dim3(NTHR), LDS_BYTES, stream, a);
        if (s == 0) { hipLaunchKernelGGL(chk_prep, dim3(64), dim3(64), 0, stream, a); continue; }
        if (s == 41) { hipLaunchKernelGGL(chk_final, dim3(64), dim3(64), 0, stream, a, (const float*)snap); continue; }
        const float* gains = (const float*)d_in[1] + (size_t)L * 2048; const float* xin0 = (const float*)d_in[0];
        switch (k) {
        case 0: hipLaunchKernelGGL(chk_norm, dim3(NS), dim3(64), 0, stream, a, L == 0 ? xin0 : (L == 2 ? (const float*)snap : (const float*)d_out), gains, L == 2 ? 1 : 0, L == 2 ? 17 : 1); break;
        case 1: hipLaunchKernelGGL(chk_gemm_in, dim3(NS), dim3(64), 0, stream, a, L); break;
        case 2: hipLaunchKernelGGL(chk_qk, dim3(NS), dim3(64), 0, stream, a, L); hipLaunchKernelGGL(chk_vt, dim3(NS), dim3(64), 0, stream, a); break;
        case 3: hipLaunchKernelGGL(chk_na, dim3(NS), dim3(64), 0, stream, a, L); hipLaunchKernelGGL(chk_dil, dim3(NS), dim3(64), 0, stream, a, L); hipLaunchKernelGGL(chk_gqa, dim3(32), dim3(64), 0, stream, a, L); break;
        case 4: hipLaunchKernelGGL(chk_gate, dim3(NS), dim3(64), 0, stream, a, L); break;
        case 5: hipLaunchKernelGGL(chk_resid, dim3(NS), dim3(64), 0, stream, a, L == 0 ? xin0 : (const float*)snap, (const bf16_t*)(ws + WS_MERGED), (const bf16_t*)(ws + WS_W_OUT) + (size_t)L * 1024 * 1024, 1024, 9); break;
        case 6: if (!moe) hipLaunchKernelGGL(chk_norm, dim3(NS), dim3(64), 0, stream, a, (const float*)d_out, gains + 1024, 0, 10);
                else { hipLaunchKernelGGL(chk_norm, dim3(NS), dim3(64), 0, stream, a, (const float*)d_out, gains + 1024, 0, 10);
                       hipLaunchKernelGGL(chk_router, dim3(NS), dim3(64), 0, stream, a, gains + 1024, (const float*)d_in[9] + (size_t)(L >> 1) * 8192); } break;
        case 7: if (!moe) hipLaunchKernelGGL(chk_up, dim3(NS), dim3(64), 0, stream, a, (const bf16_t*)(ws + WS_H), (const bf16_t*)(ws + WS_W_FGU) + (size_t)(L >> 1) * 2 * FF * 1024, FF, 11);
                else hipLaunchKernelGGL(chk_scatter, dim3(NS), dim3(64), 0, stream, a); break;
        case 8: if (!moe) hipLaunchKernelGGL(chk_resid, dim3(NS), dim3(64), 0, stream, a, (const float*)snap, (const bf16_t*)(ws + WS_ACT), (const bf16_t*)(ws + WS_W_FDN) + (size_t)(L >> 1) * 1024 * FF, FF, 12);
                else hipLaunchKernelGGL(chk_moe, dim3(NS), dim3(64), 0, stream, a, L >> 1, 0); break;
        case 9: hipLaunchKernelGGL(chk_moe, dim3(NS), dim3(64), 0, stream, a, L >> 1, 1); break;
        }
    }
    hipLaunchKernelGGL(chk_report, dim3(1024), dim3(256), 0, stream, a);
#endif
}
```
